# Optimizing an MI355X kernel written in HIP

```python
import jax
import jax.numpy as jnp
from jax import lax
import numpy as np

D_MODEL = 2048
BATCH = 8
SEQ = 2048
DEPTH = 1

HEAD_DIM = 128
MOBA_HEADS = 8
MOBA_WIDTH = MOBA_HEADS * HEAD_DIM
MOBA_BLOCK = 256
MOBA_TOPK = 3
MOBA_QROWS = 128
ROPE_THETA = 500000.0
ROPE_DIM = HEAD_DIM // 4

DN_HEADS = 8
DN_KEY_DIM = 128
DN_VAL_DIM = 128
DN_QK_WIDTH = DN_HEADS * DN_KEY_DIM
DN_V_WIDTH = DN_HEADS * DN_VAL_DIM
DN_CONV_WIDTH = 4
DN_CHUNK = 64

MOE_GROUPS = 4
MOE_EXPERTS_PER_GROUP = 8
MOE_EXPERTS = MOE_GROUPS * MOE_EXPERTS_PER_GROUP
MOE_TOPK = 2
MOE_FF = 512
MOE_ROWS = 128

NORM_EPS = 1e-6
N_MOD = 6

IN_SPLITS = (MOBA_WIDTH, MOBA_WIDTH, MOBA_WIDTH, 2 * DN_QK_WIDTH + DN_V_WIDTH, DN_V_WIDTH,
             DN_HEADS, DN_HEADS, D_MODEL, D_MODEL)
IN_WIDTH = 3 * MOBA_WIDTH + 2 * DN_QK_WIDTH + 2 * DN_V_WIDTH + 2 * DN_HEADS + 2 * D_MODEL

kernel_name = "hybrid_moba_gdn_hmoe_block"


def _rms_norm(x, gain):
    x32 = x.astype(jnp.float32)
    y = x32 * lax.rsqrt(jnp.mean(x32 * x32, axis=-1, keepdims=True) + NORM_EPS)
    return y.astype(x.dtype) * gain


def _l2_normalize(x):
    return x * lax.rsqrt(jnp.sum(x * x, axis=-1, keepdims=True) + NORM_EPS)


def _partial_rotary(x, positions):
    half = ROPE_DIM // 2
    inv_freq = jnp.power(ROPE_THETA, -jnp.arange(half, dtype=jnp.float32) * (2.0 / ROPE_DIM))
    ang = positions.astype(jnp.float32)[..., None] * inv_freq
    cos = jnp.cos(ang)[:, :, None, :]
    sin = jnp.sin(ang)[:, :, None, :]
    x1 = x[..., :half]
    x2 = x[..., half:ROPE_DIM]
    rot = jnp.concatenate([x1 * cos - x2 * sin, x2 * cos + x1 * sin], axis=-1).astype(x.dtype)
    return jnp.concatenate([rot, x[..., ROPE_DIM:]], axis=-1)


def _padded_rows(n_valid, n_groups, rows):
    total = n_valid + n_groups * (rows - 1)
    return -(-total // rows) * rows


def _group_rows(group_id, valid, n_groups, n_rows, rows):
    key = jnp.where(valid, group_id, n_groups)
    order = jnp.argsort(key).astype(jnp.int32)
    skey = key[order]
    counts = jnp.bincount(key, length=n_groups + 1)[:n_groups]
    padded = (counts + rows - 1) // rows * rows
    start = jnp.cumsum(counts) - counts
    pad_end = jnp.cumsum(padded)
    pad_start = pad_end - padded
    gc = jnp.minimum(skey, n_groups - 1)
    rank = jnp.arange(key.shape[0], dtype=jnp.int32) - start[gc]
    dest = jnp.where(skey < n_groups, pad_start[gc] + rank, n_rows)
    row_src = jnp.zeros((n_rows,), jnp.int32).at[dest].set(order, mode="drop")
    row_valid = jnp.zeros((n_rows,), bool).at[dest].set(True, mode="drop")
    block_start = jnp.arange(n_rows // rows, dtype=pad_end.dtype) * rows
    block_group = jnp.minimum(jnp.searchsorted(pad_end, block_start, side="right"), n_groups - 1)
    return row_src, row_valid, block_group


def _moba_single(q, k, v):
    s_pad, dh = q.shape
    nblk = s_pad // MOBA_BLOCK
    scale = dh ** -0.5
    qb = q.reshape(nblk, MOBA_BLOCK, dh)
    kb = k.reshape(nblk, MOBA_BLOCK, dh)
    vb = v.reshape(nblk, MOBA_BLOCK, dh)
    causal = jnp.tril(jnp.ones((MOBA_BLOCK, MOBA_BLOCK), dtype=bool))
    s_own = jnp.where(causal, jnp.einsum("nqd,nkd->nqk", qb, kb) * scale, -jnp.inf)
    lse_own = jax.nn.logsumexp(s_own, axis=-1)
    o_own = jnp.einsum("nqk,nkd->nqd", jnp.exp(s_own - lse_own[..., None]), vb).reshape(s_pad, dh)
    lse_own = lse_own.reshape(s_pad)
    k_sel = min(MOBA_TOPK, nblk - 1)
    if k_sel == 0:
        return o_own
    q_blk = jnp.arange(s_pad) // MOBA_BLOCK
    k_mean = kb.mean(axis=1)
    gate = jnp.where(jnp.arange(nblk)[None, :] < q_blk[:, None], q @ k_mean.T, -jnp.inf)
    _, sel_blk = lax.top_k(gate, k_sel)
    sel_valid = jnp.arange(k_sel)[None, :] < q_blk[:, None]
    n_valid = sum(MOBA_BLOCK * min(k_sel, j) for j in range(nblk))
    n_rows = _padded_rows(n_valid, nblk, MOBA_QROWS)
    row_src, row_valid, block_of = _group_rows(sel_blk.reshape(-1), sel_valid.reshape(-1),
                                               nblk, n_rows, MOBA_QROWS)
    row_q = row_src // k_sel

    def attend_block(args):
        rq, blk = args
        s = (q[rq] @ kb[blk].T) * scale
        lse = jax.nn.logsumexp(s, axis=-1)
        return jnp.exp(s - lse[:, None]) @ vb[blk], lse

    o_sel, lse_sel = lax.map(attend_block, (row_q.reshape(-1, MOBA_QROWS), block_of))
    o_sel = o_sel.reshape(n_rows, dh)
    lse_sel = jnp.where(row_valid, lse_sel.reshape(n_rows), -jnp.inf)
    m = jnp.maximum(lse_own, jax.ops.segment_max(lse_sel, row_q, num_segments=s_pad))
    w_sel = jnp.where(row_valid, jnp.exp(lse_sel - m[row_q]), 0.0)
    w_own = jnp.exp(lse_own - m)
    num = w_own[:, None] * o_own + jax.ops.segment_sum(w_sel[:, None] * o_sel, row_q, num_segments=s_pad)
    den = w_own + jax.ops.segment_sum(w_sel, row_q, num_segments=s_pad)
    return num / den[:, None]


def _moba_branch(q, k, v, positions):
    b, s, _ = q.shape
    q = _partial_rotary(q.reshape(b, s, MOBA_HEADS, HEAD_DIM), positions)
    k = _partial_rotary(k.reshape(b, s, MOBA_HEADS, HEAD_DIM), positions)
    v = v.reshape(b, s, MOBA_HEADS, HEAD_DIM)
    pad = (-s) % MOBA_BLOCK

    def prep(t):
        t = t.astype(jnp.float32).transpose(0, 2, 1, 3)
        return jnp.pad(t, ((0, 0), (0, 0), (0, pad), (0, 0)))

    o = jax.vmap(jax.vmap(_moba_single))(prep(q), prep(k), prep(v))
    return o[:, :, :s].transpose(0, 2, 1, 3).reshape(b, s, MOBA_WIDTH)


def _causal_short_conv(x, w):
    return lax.conv_general_dilated(
        x, w[:, None, :].astype(x.dtype), window_strides=(1,),
        padding=[(DN_CONV_WIDTH - 1, 0)], dimension_numbers=("NWC", "WIO", "NWC"),
        feature_group_count=x.shape[-1])


def _chunk_gated_delta(q, k, v, g, beta):
    b, h, s, dk = q.shape
    dv = v.shape[-1]
    c = DN_CHUNK
    n = s // c
    q = (q * dk ** -0.5).reshape(b, h, n, c, dk)
    k = k.reshape(b, h, n, c, dk)
    v = v.reshape(b, h, n, c, dv)
    beta = beta.reshape(b, h, n, c)
    big_g = jnp.cumsum(g.reshape(b, h, n, c), axis=-1)
    lower = jnp.tril(jnp.ones((c, c), dtype=bool))
    strict = jnp.tril(jnp.ones((c, c), dtype=bool), -1)
    diff = big_g[..., :, None] - big_g[..., None, :]
    decay = jnp.where(lower, jnp.exp(jnp.where(lower, diff, 0.0)), 0.0)
    k_beta = k * beta[..., None]
    v_beta = v * beta[..., None]
    kk = jnp.where(strict, jnp.einsum("bhnid,bhnjd->bhnij", k_beta, k) * decay, 0.0)
    a_mat = kk + jnp.eye(c, dtype=kk.dtype)
    u = lax.linalg.triangular_solve(a_mat, v_beta, left_side=True, lower=True, unit_diagonal=True)
    w = lax.linalg.triangular_solve(a_mat, k_beta * jnp.exp(big_g)[..., None],
                                    left_side=True, lower=True, unit_diagonal=True)
    qk = jnp.einsum("bhnid,bhnjd->bhnij", q, k) * decay
    q_dec = q * jnp.exp(big_g)[..., None]
    g_last = big_g[..., -1]
    k_tail = k * jnp.exp(g_last[..., None] - big_g)[..., None]
    xs = tuple(jnp.moveaxis(t, 2, 0) for t in (q_dec, qk, u, w, k_tail, g_last))

    def step(state, chunk):
        q_c, qk_c, u_c, w_c, kt_c, gl_c = chunk
        v_new = u_c - jnp.einsum("bhcd,bhdv->bhcv", w_c, state)
        o_c = jnp.einsum("bhcd,bhdv->bhcv", q_c, state) + jnp.einsum("bhij,bhjv->bhiv", qk_c, v_new)
        state = state * jnp.exp(gl_c)[..., None, None] + jnp.einsum("bhcd,bhcv->bhdv", kt_c, v_new)
        return state, o_c

    state0 = jnp.zeros((b, h, dk, dv), jnp.float32)
    _, o = lax.scan(step, state0, xs)
    return jnp.moveaxis(o, 0, 2).reshape(b, h, s, dv)


def _deltanet_branch(qkv, z, beta_raw, a_raw, conv_w, a_log, dt_bias, out_gain):
    b, s, _ = qkv.shape
    qkv = jax.nn.silu(_causal_short_conv(qkv, conv_w)).astype(jnp.float32)
    q, k, v = jnp.split(qkv, [DN_QK_WIDTH, 2 * DN_QK_WIDTH], axis=-1)
    q = _l2_normalize(q.reshape(b, s, DN_HEADS, DN_KEY_DIM))
    k = _l2_normalize(k.reshape(b, s, DN_HEADS, DN_KEY_DIM))
    v = v.reshape(b, s, DN_HEADS, DN_VAL_DIM)
    beta = jax.nn.sigmoid(beta_raw.astype(jnp.float32))
    g = -jnp.exp(a_log.astype(jnp.float32)) * jax.nn.softplus(
        a_raw.astype(jnp.float32) + dt_bias.astype(jnp.float32))
    o = _chunk_gated_delta(q.transpose(0, 2, 1, 3), k.transpose(0, 2, 1, 3), v.transpose(0, 2, 1, 3),
                           g.transpose(0, 2, 1), beta.transpose(0, 2, 1))
    o = o.transpose(0, 2, 1, 3)
    o = _rms_norm(o, out_gain.astype(jnp.float32)) * jax.nn.silu(
        z.reshape(b, s, DN_HEADS, DN_VAL_DIM).astype(jnp.float32))
    return o.reshape(b, s, DN_V_WIDTH)


def _mixer(u, positions, w_in, conv_w, a_log, dt_bias, dn_out_norm, w_branch_moba, w_branch_delta, w_out):
    proj = u @ w_in
    split_at = np.cumsum(IN_SPLITS)[:-1].tolist()
    qa, ka, va, qkv_d, z_d, beta_raw, a_raw, gate_a, gate_b = jnp.split(proj, split_at, axis=-1)
    y_a = _moba_branch(qa, ka, va, positions).astype(u.dtype)
    y_b = _deltanet_branch(qkv_d, z_d, beta_raw, a_raw, conv_w, a_log, dt_bias, dn_out_norm).astype(u.dtype)
    merged = jax.nn.sigmoid(gate_a) * (y_a @ w_branch_moba) + jax.nn.sigmoid(gate_b) * (y_b @ w_branch_delta)
    return merged @ w_out


def _hier_moe(h, w_rg, b_rg, w_re, b_re, w_gate, w_up, w_down):
    b, s, d = h.shape
    t = b * s
    tok = h.reshape(t, d)
    g_logits = (tok @ w_rg + b_rg).astype(jnp.float32)
    p_group = jax.nn.softmax(g_logits, axis=-1)
    g_sel = jnp.argmax(g_logits, axis=-1)
    e_logits = (tok @ w_re + b_re).astype(jnp.float32).reshape(t, MOE_GROUPS, MOE_EXPERTS_PER_GROUP)
    e_logits = jnp.take_along_axis(e_logits, g_sel[:, None, None], axis=1)[:, 0]
    top_p, top_e = lax.top_k(jax.nn.softmax(e_logits, axis=-1), MOE_TOPK)
    weights = jnp.take_along_axis(p_group, g_sel[:, None], axis=1) * top_p / jnp.sum(top_p, axis=-1, keepdims=True)
    expert_id = g_sel[:, None] * MOE_EXPERTS_PER_GROUP + top_e
    n_rows = _padded_rows(t * MOE_TOPK, MOE_EXPERTS, MOE_ROWS)
    row_src, row_valid, block_expert = _group_rows(
        expert_id.reshape(-1), jnp.ones((t * MOE_TOPK,), bool), MOE_EXPERTS, n_rows, MOE_ROWS)
    row_tok = row_src // MOE_TOPK
    row_w = jnp.where(row_valid, weights.reshape(-1)[row_src], 0.0)

    def expert_block(args):
        rt, e = args
        xb = tok[rt]
        return (jax.nn.silu(xb @ w_gate[e]) * (xb @ w_up[e])) @ w_down[e]

    yb = lax.map(expert_block, (row_tok.reshape(-1, MOE_ROWS), block_expert)).reshape(n_rows, d)
    y = jax.ops.segment_sum(yb * row_w[:, None].astype(yb.dtype), row_tok, num_segments=t)
    return y.reshape(b, s, d)


def setup_inputs(seed: int = 0) -> dict:
    key = jax.random.key(seed)
    ks = jax.random.split(key, 24)
    nrm = jax.random.normal
    f32 = jnp.float32
    x = nrm(ks[0], (BATCH, SEQ, D_MODEL), f32)
    c = nrm(ks[1], (BATCH, D_MODEL), f32)
    offset = jax.random.randint(ks[2], (BATCH, 1), 0, 4096, dtype=jnp.int32)
    positions = (offset + jnp.arange(SEQ, dtype=jnp.int32)[None, :]).astype(jnp.int32)

    def gain(k):
        return 1.0 + 0.05 * nrm(k, (DEPTH, D_MODEL), f32)

    gk = jax.random.split(ks[3], 5)
    dt = jnp.exp(jax.random.uniform(ks[4], (DEPTH, DN_HEADS), f32, np.log(1e-3), np.log(1e-1)))
    return {
        "x": x,
        "c": c,
        "positions": positions,
        "w_ada": nrm(ks[5], (DEPTH, D_MODEL, N_MOD * D_MODEL), f32) * (0.5 * D_MODEL ** -0.5),
        "b_ada": 0.02 * nrm(ks[6], (DEPTH, N_MOD * D_MODEL), f32),
        "norm_mix_pre": gain(gk[0]),
        "norm_mix_post": gain(gk[1]),
        "norm_ffn_pre": gain(gk[2]),
        "norm_ffn_post": gain(gk[3]),
        "w_in": nrm(ks[7], (DEPTH, D_MODEL, IN_WIDTH), f32) * D_MODEL ** -0.5,
        "conv_w": nrm(ks[8], (DEPTH, DN_CONV_WIDTH, 2 * DN_QK_WIDTH + DN_V_WIDTH), f32) * DN_CONV_WIDTH ** -0.5,
        "dn_a_log": jnp.log(jax.random.uniform(ks[9], (DEPTH, DN_HEADS), f32, 1.0, 16.0)),
        "dn_dt_bias": dt + jnp.log(-jnp.expm1(-dt)),
        "dn_out_norm": 1.0 + 0.05 * nrm(gk[4], (DEPTH, DN_VAL_DIM), f32),
        "w_branch_moba": nrm(ks[10], (DEPTH, MOBA_WIDTH, D_MODEL), f32) * MOBA_WIDTH ** -0.5,
        "w_branch_delta": nrm(ks[11], (DEPTH, DN_V_WIDTH, D_MODEL), f32) * DN_V_WIDTH ** -0.5,
        "w_out": nrm(ks[12], (DEPTH, D_MODEL, D_MODEL), f32) * D_MODEL ** -0.5,
        "router_group_w": nrm(ks[13], (DEPTH, D_MODEL, MOE_GROUPS), f32) * D_MODEL ** -0.5,
        "router_group_b": 0.01 * nrm(ks[14], (DEPTH, MOE_GROUPS), f32),
        "router_expert_w": nrm(ks[15], (DEPTH, D_MODEL, MOE_EXPERTS), f32) * D_MODEL ** -0.5,
        "router_expert_b": 0.01 * nrm(ks[16], (DEPTH, MOE_EXPERTS), f32),
        "expert_w_gate": nrm(ks[17], (DEPTH, MOE_EXPERTS, D_MODEL, MOE_FF), f32) * D_MODEL ** -0.5,
        "expert_w_up": nrm(ks[18], (DEPTH, MOE_EXPERTS, D_MODEL, MOE_FF), f32) * D_MODEL ** -0.5,
        "expert_w_down": nrm(ks[19], (DEPTH, MOE_EXPERTS, MOE_FF, D_MODEL), f32) * MOE_FF ** -0.5,
    }


def reference(x, c, positions, w_ada, b_ada, norm_mix_pre, norm_mix_post, norm_ffn_pre, norm_ffn_post,
              w_in, conv_w, dn_a_log, dn_dt_bias, dn_out_norm, w_branch_moba, w_branch_delta, w_out,
              router_group_w, router_group_b, router_expert_w, router_expert_b,
              expert_w_gate, expert_w_up, expert_w_down):
    cond = jax.nn.silu(c)
    for layer in range(DEPTH):
        mod = cond @ w_ada[layer] + b_ada[layer]
        sh1, sc1, gt1, sh2, sc2, gt2 = [m[:, None, :] for m in jnp.split(mod, N_MOD, axis=-1)]
        u = _rms_norm(x, norm_mix_pre[layer]) * (1.0 + sc1) + sh1
        y = _mixer(u, positions, w_in[layer], conv_w[layer], dn_a_log[layer], dn_dt_bias[layer],
                   dn_out_norm[layer], w_branch_moba[layer], w_branch_delta[layer], w_out[layer])
        x = x + gt1 * _rms_norm(y, norm_mix_post[layer])
        u = _rms_norm(x, norm_ffn_pre[layer]) * (1.0 + sc2) + sh2
        y = _hier_moe(u, router_group_w[layer], router_group_b[layer], router_expert_w[layer],
                      router_expert_b[layer], expert_w_gate[layer], expert_w_up[layer], expert_w_down[layer])
        x = x + gt2 * _rms_norm(y, norm_ffn_post[layer])
    return x
```

```cpp
#include <hip/hip_runtime.h>
#include <hip/hip_cooperative_groups.h>
#include <cstdio>
#include <cstdint>
namespace cg = cooperative_groups;

#define LAS __attribute__((address_space(3)))
#define DI __device__ __forceinline__
typedef unsigned short bf16_t;
typedef short bf16x8 __attribute__((ext_vector_type(8)));
typedef short s16x4 __attribute__((ext_vector_type(4)));
typedef float f32x2 __attribute__((ext_vector_type(2)));
typedef float f32x4 __attribute__((ext_vector_type(4)));
typedef float f32x16 __attribute__((ext_vector_type(16)));
typedef unsigned u32x2 __attribute__((ext_vector_type(2)));
typedef unsigned u32x4 __attribute__((ext_vector_type(4)));
typedef __bf16 bf16x2_t __attribute__((ext_vector_type(2)));

constexpr int NB = 8, SEQ = 2048, T = NB * SEQ, DM = 2048;
constexpr int NHEAD = 8, HD = 128;
constexpr int PP = 11264;
constexpr int NPROJ = 11520;
constexpr int C_Q = 0, C_K = 1024, C_V = 2048, C_DN = 3072, C_Z = 6144, C_GA = 7168, C_GB = 9216;
constexpr int NEXP = 32, FF = 512, ECAP = 16384;
constexpr float EPS = 1e-6f;

constexpr size_t MiB = 1u << 20;
constexpr size_t WS_CTL = 0, CTL_ZERO_BYTES = 1 * MiB;
constexpr size_t WS_MOD = 1 * MiB;
constexpr size_t WS_CS = 2 * MiB;
constexpr size_t WS_KMEAN = 4 * MiB;
constexpr size_t WS_WR = 4 * MiB + 512 * 1024;
constexpr size_t WS_BA = 5 * MiB;
constexpr size_t WS_REC = 6 * MiB;
constexpr size_t WS_RTOK = 7 * MiB;
constexpr size_t WS_WMD = 10 * MiB;
constexpr size_t WS_WOUT = 18 * MiB;
constexpr size_t WS_A = 26 * MiB;
constexpr size_t WS_B = 90 * MiB;
constexpr size_t WS_C = 442 * MiB;
constexpr size_t WS_D = 588 * MiB;
constexpr size_t WS_END = 652 * MiB;
constexpr size_t WS_OUTMIX = WS_B, WS_WGU = WS_B + 128 * MiB, WS_WDN = WS_B + 256 * MiB, WS_YBUF = WS_B;
constexpr size_t WS_WIN = WS_C, WS_DNP = WS_C, WS_MERGED = WS_C, WS_H = WS_C + 64 * MiB;
constexpr int CW_CNT = 64;
constexpr int CW_BAR = 4096;
constexpr int DN_U = 0, DN_W = 16384, DN_QD = 32768, DN_KT = 49152, DN_QK = 65536, DN_SC = 73728, DN_STRIDE = 73984;

struct Params {
    const float* x; const float* c; const int* pos; const float* w_ada; const float* b_ada;
    const float* g_mix_pre; const float* g_mix_post; const float* g_ffn_pre; const float* g_ffn_post;
    const float* w_in; const float* conv_w; const float* a_log; const float* dt_bias; const float* dn_gain;
    const float* w_bm; const float* w_bd; const float* w_out;
    const float* w_rg; const float* b_rg; const float* w_re; const float* b_re;
    const float* w_gate; const float* w_up; const float* w_down;
    float* out; unsigned char* ws;
    int ph_lo, ph_hi;
};

DI unsigned cvtpk(float lo, float hi) { f32x2 v = {lo, hi}; bf16x2_t b = __builtin_convertvector(v, bf16x2_t); return __builtin_bit_cast(unsigned, b); }
DI float bflo(unsigned w) { return __uint_as_float(w << 16); }
DI float bfhi(unsigned w) { return __uint_as_float(w & 0xffff0000u); }
DI float bf2f(bf16_t b) { return __uint_as_float((unsigned)b << 16); }
DI bf16_t f2bf(float f) { return (bf16_t)(cvtpk(f, 0.f) & 0xffffu); }
DI float wave_sum(float v) {
#pragma unroll
    for (int o = 1; o < 64; o <<= 1) v += __shfl_xor(v, o);
    return v;
}
DI float sigmoidf_(float x) { return 1.f / (1.f + __expf(-x)); }
DI float siluf_(float x) { return x / (1.f + __expf(-x)); }
DI float siluf_acc(float x) { return x / (1.f + expf(-x)); }
constexpr float SCALE_Q = 0.08838834764831845f;
DI int perm16(int p) { return (p & 3) | ((p & 4) << 1) | ((p & 8) >> 1); }
DI int crow(int r, int hi) { return (r & 3) + 8 * (r >> 2) + 4 * hi; }
#define MFMA32(a, b, c) __builtin_amdgcn_mfma_f32_32x32x16_bf16((a), (b), (c), 0, 0, 0)
#define MFMA16(a, b, c) __builtin_amdgcn_mfma_f32_16x16x32_bf16((a), (b), (c), 0, 0, 0)

namespace pg8 {
constexpr int BM = 256, BK = 64, HALF = 128, HTB = HALF * BK * 2, STAGE_BYTES = 8 * HTB, NXCD = 8, WGM = 8;
DI int lds_byte(int r, int c) { const int st = (r >> 4) * 2 + (c >> 5), rr = r & 15, cc = c & 31, ob = rr * 64 + cc * 2; return st * 1024 + (ob ^ (((ob >> 9) & 1) << 5)); }
DI void stage_rc(int b, int& R, int& C) { const int st = b / 1024, sb = b % 1024, swz = sb ^ (((sb >> 9) & 1) << 5); R = (st >> 1) * 16 + swz / 64; C = (st & 1) * 32 + (swz % 64) / 2; }
DI int perm32(int rho) { const int n = rho >> 4, i = rho & 15; return 8 * (i >> 2) + 4 * n + (i & 3); }

struct Unit { int pm, pn, ga, gn; };
struct Gemm { const bf16_t* A; const bf16_t* Bt; int K; const int* gidx; };

struct StaticOrder {
    int nM, nN, nwg, G, c;
    DI void init(int M, int N, int G_, int c_) { nM = M / BM; nN = N / BM; nwg = nM * nN; G = G_; c = c_; }
    DI bool next(int i, Unit& u) const {
        const long L = (long)i * G + c; if (L >= nwg) return false;
        int wgid = (int)L; { const int q = nwg / NXCD, r = nwg % NXCD, xcd = wgid % NXCD, off = wgid / NXCD; wgid = (xcd < r ? xcd * (q + 1) : r * (q + 1) + (xcd - r) * q) + off; }
        const int nig = WGM * nN, gid = wgid / nig, fm = gid * WGM, gsz = (nM - fm) < WGM ? (nM - fm) : WGM;
        u.pm = fm + ((wgid % nig) % gsz); u.pn = (wgid % nig) / gsz; u.ga = 0; u.gn = 0; return true;
    }
};

typedef f32x4 Acc[2][2][4][2];

template <class Epi, class Sched, bool ALIGN_EPI, bool GATHER>
DI void gemm_phase(LAS unsigned char* lds, const Gemm g, const Sched& S, const Epi& E) {
    const int tid = threadIdx.x, wid = __builtin_amdgcn_readfirstlane(tid >> 6), lane = tid & 63, wr = wid >> 2, wc = wid & 3, fr = lane & 15, fq = lane >> 4;
    const int K = g.K, nt = K / BK;
    unsigned voffA[2], voffB[2]; int gR[2], gC[2];
#pragma unroll
    for (int i = 0; i < 2; ++i) { int R, C; stage_rc(tid * 16 + i * 8192, R, C); const int Rb = (R & ~31) + perm32(R & 31);
        voffA[i] = (unsigned)(R * K + C) * 2u; voffB[i] = (unsigned)(Rb * K + C) * 2u; gR[i] = R; gC[i] = C; }
    const size_t kstep = (size_t)(BK * 2);
    const size_t hstep = (size_t)HALF * K * 2;
    const size_t tstep = 2 * hstep;
    const unsigned ldsw = (unsigned)wid * 1024u;
    const int aoff = lds_byte(wr * 64 + fr, fq * 8), boff = lds_byte(wc * 32 + fr, fq * 8);
#define PG8_SA(b, h) (((b) * 2 + (h)) * HTB)
#define PG8_SB(b, h) ((4 + (b) * 2 + (h)) * HTB)
#define PG8_STAGE(bufoff, gbase, voff) do { _Pragma("unroll") for (int _i = 0; _i < 2; ++_i) \
        __builtin_amdgcn_global_load_lds((const unsigned*)((const char*)(gbase) + (voff)[_i]), (LAS unsigned*)(lds + (bufoff) + ldsw + _i * 8192), 16, 0, 0); } while (0)
#define PG8_LDA(dst, b, h) do { _Pragma("unroll") for (int m = 0; m < 4; ++m) _Pragma("unroll") for (int k = 0; k < 2; ++k) dst[m][k] = *(const LAS bf16x8*)(lds + PG8_SA(b, h) + aoff + m * 2048 + k * 1024); } while (0)
#define PG8_LDB(dst, b, h) do { _Pragma("unroll") for (int n = 0; n < 2; ++n) _Pragma("unroll") for (int k = 0; k < 2; ++k) dst[n][k] = *(const LAS bf16x8*)(lds + PG8_SB(b, h) + boff + n * 2048 + k * 1024); } while (0)
#define PG8_MMA(ai, bj, At, Bt) do { __builtin_amdgcn_s_setprio(1); _Pragma("unroll") for (int m = 0; m < 4; ++m) _Pragma("unroll") for (int n = 0; n < 2; ++n) _Pragma("unroll") for (int k = 0; k < 2; ++k) \
        acc[ai][bj][m][n] = __builtin_amdgcn_mfma_f32_16x16x32_bf16(Bt[n][k], At[m][k], acc[ai][bj][m][n], 0, 0, 0); __builtin_amdgcn_s_setprio(0); } while (0)
#define PG8_WAIT_V(n) asm volatile("s_waitcnt vmcnt(" #n ")" ::: "memory")
#define PG8_WAIT_L(n) asm volatile("s_waitcnt lgkmcnt(" #n ")" ::: "memory")
#define PG8_BAR __builtin_amdgcn_s_barrier()
#define PG8_SCHED __builtin_amdgcn_sched_barrier(0)
    Unit cur, nxt; int ui = 0;
    if (!S.next(0, cur)) return;
    Acc acc;
#pragma unroll
    for (int a = 0; a < 2; ++a)
#pragma unroll
        for (int b = 0; b < 2; ++b)
#pragma unroll
            for (int m = 0; m < 4; ++m)
#pragma unroll
                for (int n = 0; n < 2; ++n) acc[a][b][m][n] = (f32x4){0.f, 0.f, 0.f, 0.f};
    bf16x8 At[4][2], B0[2][2], B1[2][2];
    unsigned vA0[2], vA1[2];
#define PG8_SET_VOFF(u) do { if constexpr (GATHER) { _Pragma("unroll") for (int _i = 0; _i < 2; ++_i) { \
                const int _r0 = gR[_i], _r1 = HALF + gR[_i]; \
                const int _t0 = _r0 < (u).gn ? g.gidx[(u).ga + _r0] : 0, _t1 = _r1 < (u).gn ? g.gidx[(u).ga + _r1] : 0; \
                vA0[_i] = (unsigned)(_t0 * K + gC[_i]) * 2u; vA1[_i] = (unsigned)(_t1 * K + gC[_i]) * 2u; } \
        } else { vA0[0] = voffA[0]; vA0[1] = voffA[1]; vA1[0] = voffA[0] + (unsigned)hstep; vA1[1] = voffA[1] + (unsigned)hstep; } } while (0)
    PG8_SET_VOFF(cur);
    const char* cA = GATHER ? (const char*)g.A : (const char*)g.A + (size_t)cur.pm * tstep; const char* cB = (const char*)g.Bt + (size_t)cur.pn * tstep;
    PG8_STAGE(PG8_SB(0, 0), cB, voffB); PG8_STAGE(PG8_SB(0, 1), cB + hstep, voffB); PG8_STAGE(PG8_SA(0, 0), cA, vA0); PG8_STAGE(PG8_SA(0, 1), cA, vA1);
    if (wr == 1) PG8_BAR;
    PG8_WAIT_V(2); PG8_BAR;
    PG8_STAGE(PG8_SB(1, 0), cB + kstep, voffB); PG8_STAGE(PG8_SA(1, 0), cA + kstep, vA0); PG8_STAGE(PG8_SB(1, 1), cB + hstep + kstep, voffB);
    PG8_WAIT_V(6); PG8_BAR;
    for (;;) {
        const bool has_next = S.next(ui + 1, nxt);
        const char* nA = GATHER ? (const char*)g.A : (has_next ? (const char*)g.A + (size_t)nxt.pm * tstep : cA);
        const char* nB = has_next ? (const char*)g.Bt + (size_t)nxt.pn * tstep : cB;
#define PG8_KTRIP(t) do { \
            const bool last = (t == nt - 2); \
            const char* a1 = cA + (size_t)(t + 1) * kstep; \
            const char* a2 = last ? nA : cA + (size_t)(t + 2) * kstep; const char* b2 = last ? nB : cB + (size_t)(t + 2) * kstep; \
            const char* a3 = a2 + kstep; const char* b3 = b2 + kstep; \
            PG8_LDB(B0, 0, 0); PG8_LDB(B1, 0, 1); PG8_SCHED; PG8_LDA(At, 0, 0); PG8_STAGE(PG8_SA(1, 1), a1, vA1); \
            PG8_WAIT_V(8); PG8_WAIT_L(0); PG8_BAR; PG8_MMA(0, 0, At, B0); PG8_MMA(0, 1, At, B1); PG8_BAR; PG8_SCHED; \
            if constexpr (GATHER) { if (last && has_next) PG8_SET_VOFF(nxt); } \
            PG8_LDA(At, 0, 1); PG8_STAGE(PG8_SB(0, 0), b2, voffB); PG8_STAGE(PG8_SB(0, 1), b2 + hstep, voffB); PG8_STAGE(PG8_SA(0, 0), a2, vA0); \
            PG8_WAIT_V(8); PG8_WAIT_L(0); PG8_BAR; PG8_MMA(1, 0, At, B0); PG8_MMA(1, 1, At, B1); PG8_BAR; PG8_SCHED; \
            PG8_LDB(B0, 1, 0); PG8_LDB(B1, 1, 1); PG8_SCHED; PG8_LDA(At, 1, 0); PG8_STAGE(PG8_SA(0, 1), a2, vA1); \
            PG8_WAIT_V(8); PG8_WAIT_L(0); PG8_BAR; PG8_MMA(0, 0, At, B0); PG8_MMA(0, 1, At, B1); PG8_BAR; PG8_SCHED; \
            PG8_LDA(At, 1, 1); PG8_STAGE(PG8_SB(1, 0), b3, voffB); PG8_STAGE(PG8_SB(1, 1), b3 + hstep, voffB); PG8_STAGE(PG8_SA(1, 0), a3, vA0); \
            PG8_WAIT_V(8); PG8_WAIT_L(0); PG8_BAR; PG8_MMA(1, 0, At, B0); PG8_MMA(1, 1, At, B1); PG8_BAR; PG8_SCHED; \
        } while (0)
        if constexpr (Epi::HAS_MID) {
            for (int t = 0; t < (nt >> 1); t += 2) PG8_KTRIP(t);
            E.mid(acc, cur, wr, wc, fr, fq);
            for (int t = (nt >> 1); t < nt; t += 2) PG8_KTRIP(t);
        } else {
            for (int t = 0; t < nt; t += 2) PG8_KTRIP(t);
        }
#undef PG8_KTRIP
        if constexpr (ALIGN_EPI) { if (wr == 0) PG8_BAR; }
        E(acc, cur, wr, wc, fr, fq);
        if (!has_next) break;
#pragma unroll
        for (int a = 0; a < 2; ++a)
#pragma unroll
            for (int b = 0; b < 2; ++b)
#pragma unroll
                for (int m = 0; m < 4; ++m)
#pragma unroll
                    for (int n = 0; n < 2; ++n) acc[a][b][m][n] = (f32x4){0.f, 0.f, 0.f, 0.f};
        cur = nxt; cA = nA; cB = nB; ++ui;
        if constexpr (ALIGN_EPI) { if (wr == 1) PG8_BAR; }
    }
    PG8_WAIT_V(0);
    if constexpr (!ALIGN_EPI) { if (wr == 0) PG8_BAR; }
    PG8_BAR;
#undef PG8_SET_VOFF
#undef PG8_SA
#undef PG8_SB
#undef PG8_STAGE
#undef PG8_LDA
#undef PG8_LDB
#undef PG8_MMA
#undef PG8_WAIT_V
#undef PG8_WAIT_L
#undef PG8_BAR
#undef PG8_SCHED
}

struct EpiStore {
    static constexpr bool HAS_MID = false;
    bf16_t* O; int ldc; int ntn;
    DI void operator()(const Acc& acc, const Unit& u, int wr, int wc, int fr, int fq) const {
        const int row0 = u.pm * BM + wr * 64 + fr, col0 = (u.pn % ntn) * BM + wc * 32 + 8 * fq;
#pragma unroll
        for (int ai = 0; ai < 2; ++ai)
#pragma unroll
            for (int m = 0; m < 4; ++m) { bf16_t* rowp = O + (size_t)(row0 + ai * HALF + m * 16) * ldc + col0;
#pragma unroll
                for (int bj = 0; bj < 2; ++bj) { const f32x4 v0 = acc[ai][bj][m][0], v1 = acc[ai][bj][m][1];
                    u32x4 w; w.x = cvtpk(v0[0], v0[1]); w.y = cvtpk(v0[2], v0[3]); w.z = cvtpk(v1[0], v1[1]); w.w = cvtpk(v1[2], v1[3]);
                    *(u32x4*)(rowp + bj * HALF) = w; } }
    }
};
struct EpiProj {
    static constexpr bool HAS_MID = false;
    bf16_t* O; float* BA;
    DI void operator()(const Acc& acc, const Unit& u, int wr, int wc, int fr, int fq) const {
        const int row0 = u.pm * BM + wr * 64 + fr;
        if (u.pn < 44) {
            const int col0 = u.pn * BM + wc * 32 + 8 * fq;
#pragma unroll
            for (int ai = 0; ai < 2; ++ai)
#pragma unroll
                for (int m = 0; m < 4; ++m) { bf16_t* rowp = O + (size_t)(row0 + ai * HALF + m * 16) * PP + col0;
#pragma unroll
                    for (int bj = 0; bj < 2; ++bj) { const f32x4 v0 = acc[ai][bj][m][0], v1 = acc[ai][bj][m][1];
                        u32x4 w; w.x = cvtpk(v0[0], v0[1]); w.y = cvtpk(v0[2], v0[3]); w.z = cvtpk(v1[0], v1[1]); w.w = cvtpk(v1[2], v1[3]);
                        *(u32x4*)(rowp + bj * HALF) = w; } }
        } else if (wc == 0 && fq < 2) {
#pragma unroll
            for (int ai = 0; ai < 2; ++ai)
#pragma unroll
                for (int m = 0; m < 4; ++m) { float* rowp = BA + (size_t)(row0 + ai * HALF + m * 16) * 16 + 8 * fq;
                    *(f32x4*)rowp = acc[ai][0][m][0]; *(f32x4*)(rowp + 4) = acc[ai][0][m][1]; }
        }
    }
};
struct EpiMerged {
    static constexpr bool HAS_MID = true;
    const bf16_t* P; bf16_t* O;
    DI void mid(Acc& acc, const Unit& u, int wr, int wc, int fr, int fq) const {
        const unsigned ro = (unsigned)((u.pm * BM + wr * 64 + fr) * PP + u.pn * BM + wc * 32 + 8 * fq);
#pragma unroll
        for (int ai = 0; ai < 2; ++ai)
#pragma unroll
            for (int m = 0; m < 4; ++m) {
#pragma unroll
                for (int bj = 0; bj < 2; ++bj) { const unsigned off = ro + (unsigned)((ai * HALF + m * 16) * PP + bj * HALF);
                    const u32x4 a = *(const u32x4*)(P + off + C_GA), b = *(const u32x4*)(P + off + C_GB);
                    float ga[8] = {bflo(a.x), bfhi(a.x), bflo(a.y), bfhi(a.y), bflo(a.z), bfhi(a.z), bflo(a.w), bfhi(a.w)};
                    float gb[8] = {bflo(b.x), bfhi(b.x), bflo(b.y), bfhi(b.y), bflo(b.z), bfhi(b.z), bflo(b.w), bfhi(b.w)};
#pragma unroll
                    for (int n = 0; n < 2; ++n)
#pragma unroll
                        for (int j = 0; j < 4; ++j) { const float r = (1.f + __expf(-gb[4 * n + j])) * __builtin_amdgcn_rcpf(1.f + __expf(-ga[4 * n + j])); acc[ai][bj][m][n][j] *= r; } }
                asm volatile("" ::: "memory"); __builtin_amdgcn_sched_barrier(0); }
    }
    DI void operator()(const Acc& acc, const Unit& u, int wr, int wc, int fr, int fq) const {
        const unsigned ro = (unsigned)((u.pm * BM + wr * 64 + fr) * PP + u.pn * BM + wc * 32 + 8 * fq);
        const unsigned oo = (unsigned)((u.pm * BM + wr * 64 + fr) * DM + u.pn * BM + wc * 32 + 8 * fq);
#pragma unroll
        for (int ai = 0; ai < 2; ++ai)
#pragma unroll
            for (int m = 0; m < 4; ++m) {
#pragma unroll
                for (int bj = 0; bj < 2; ++bj) { const u32x4 b = *(const u32x4*)(P + ro + (unsigned)((ai * HALF + m * 16) * PP + bj * HALF) + C_GB);
                    float gb[8] = {bflo(b.x), bfhi(b.x), bflo(b.y), bfhi(b.y), bflo(b.z), bfhi(b.z), bflo(b.w), bfhi(b.w)};
                    float v[8];
#pragma unroll
                    for (int n = 0; n < 2; ++n)
#pragma unroll
                        for (int j = 0; j < 4; ++j) v[4 * n + j] = acc[ai][bj][m][n][j] * __builtin_amdgcn_rcpf(1.f + __expf(-gb[4 * n + j]));
                    u32x4 w; w.x = cvtpk(v[0], v[1]); w.y = cvtpk(v[2], v[3]); w.z = cvtpk(v[4], v[5]); w.w = cvtpk(v[6], v[7]);
                    *(u32x4*)(O + oo + (unsigned)((ai * HALF + m * 16) * DM + bj * HALF)) = w; }
                asm volatile("" ::: "memory"); __builtin_amdgcn_sched_barrier(0); }
    }
};
struct EpiGU {
    static constexpr bool HAS_MID = false;
    bf16_t* H;
    DI void operator()(const Acc& acc, const Unit& u, int wr, int wc, int fr, int fq) const {
        const int row0 = u.pm * BM + wr * 64 + fr, col0 = (u.pn & 3) * HALF + wc * 32 + 8 * fq;
#pragma unroll
        for (int ai = 0; ai < 2; ++ai)
#pragma unroll
            for (int m = 0; m < 4; ++m) { float v[8];
#pragma unroll
                for (int n = 0; n < 2; ++n)
#pragma unroll
                    for (int j = 0; j < 4; ++j) v[4 * n + j] = siluf_(acc[ai][0][m][n][j]) * acc[ai][1][m][n][j];
                u32x4 w; w.x = cvtpk(v[0], v[1]); w.y = cvtpk(v[2], v[3]); w.z = cvtpk(v[4], v[5]); w.w = cvtpk(v[6], v[7]);
                *(u32x4*)(H + (size_t)(row0 + ai * HALF + m * 16) * FF + col0) = w; }
    }
};
}

namespace moba {
constexpr int NW = 8, QBLK = 32, KVBLK = 64, QB = NW * QBLK, D = 128;
constexpr int RS = PP;
constexpr int RSO = DM;
constexpr float SCALE = 0.08838834764831845f;
constexpr float THR = 8.f;
constexpr int SHM_V = KVBLK * D * 2, SHM_K = KVBLK * D * 2;
constexpr int LDS_BYTES = 2 * SHM_V + 2 * SHM_K + NW * 64 * 4;
typedef bf16_t bf16;
#define KSWZ(row, colB) ((row) * 256 + ((colB) ^ (((row) & 7) << 4)))
#define SBAR() __builtin_amdgcn_sched_barrier(0)
DI int v_st(int k, int c) { const int kk = (k & ~0xC) | ((k & 4) << 1) | ((k & 8) >> 1); return ((kk >> 3) * 4 + (c >> 5)) * 512 + ((kk & 7) * 32 + (c & 31)) * 2; }
DI int v_rd_base(int lane) { return ((lane & 3) << 3) | (((lane >> 2) & 3) << 6) | (((lane >> 4) & 1) << 5) | (((lane >> 5) & 1) << 8); }
constexpr int v_rd_off(int d0, int ks, int half) { return d0 * 512 + ks * 4096 + half * 2048; }
DI bf16x8 load8(const bf16* p) { return *reinterpret_cast<const bf16x8*>(p); }
DI void mask_tile(f32x16& p0, f32x16& p1, int dq) {
    const float NEG = -__builtin_inff();
#pragma unroll
    for (int r = 0; r < 16; ++r) {
        const int c = (r & 3) + 8 * (r >> 2);
        if (dq - c < 0) p0[r] = NEG;
        if (dq - c - 32 < 0) p1[r] = NEG;
    }
}
DI void mask_all(f32x16& p0, f32x16& p1, bool kill) {
    const float NEG = -__builtin_inff();
#pragma unroll
    for (int r = 0; r < 16; ++r) { if (kill) p0[r] = NEG; if (kill) p1[r] = NEG; }
}
DI void partialSM(f32x16& p0, f32x16& p1, float& m_reg, float& mn, float& alpha) {
    float pmax = p0[0];
#pragma unroll
    for (int r = 1; r < 16; ++r) pmax = fmaxf(pmax, p0[r]);
#pragma unroll
    for (int r = 0; r < 16; ++r) pmax = fmaxf(pmax, p1[r]);
    { auto rr = __builtin_amdgcn_permlane32_swap(__float_as_uint(pmax), __float_as_uint(pmax), false, false);
      pmax = fmaxf(__uint_as_float(rr[0]), __uint_as_float(rr[1])); }
    constexpr float C2 = 1.4426950408889634f * SCALE;
    if (__builtin_expect(__all((pmax - m_reg) * SCALE <= THR), 1)) { mn = m_reg; alpha = 1.f; }
    else { mn = fmaxf(m_reg, pmax); alpha = __builtin_amdgcn_exp2f((m_reg - mn) * C2); m_reg = mn; }
    const float mnL = -mn * C2;
#pragma unroll
    for (int r = 0; r < 16; ++r) p0[r] = fmaf(p0[r], C2, mnL);
#pragma unroll
    for (int r = 0; r < 16; ++r) p1[r] = fmaf(p1[r], C2, mnL);
#pragma unroll
    for (int r = 0; r < 16; ++r) p0[r] = __builtin_amdgcn_exp2f(p0[r]);
}
DI void finishSM(f32x16& p0, f32x16& p1, float alpha, float& l_reg, bf16x8& pa0, bf16x8& pa1, bf16x8& pa2, bf16x8& pa3) {
#pragma unroll
    for (int r = 0; r < 16; ++r) p1[r] = __builtin_amdgcn_exp2f(p1[r]);
    float ps = 0;
#pragma unroll
    for (int r = 0; r < 16; ++r) ps += p0[r];
#pragma unroll
    for (int r = 0; r < 16; ++r) ps += p1[r];
    { auto rr = __builtin_amdgcn_permlane32_swap(__float_as_uint(ps), __float_as_uint(ps), false, false);
      ps = __uint_as_float(rr[0]) + __uint_as_float(rr[1]); }
    l_reg = l_reg * alpha + ps;
#define PK4(P, B_, OUT) do { unsigned a0 = cvtpk(P[B_+0], P[B_+1]), a1 = cvtpk(P[B_+2], P[B_+3]);                          \
        unsigned b0 = cvtpk(P[B_+4], P[B_+5]), b1 = cvtpk(P[B_+6], P[B_+7]);                                             \
        auto r0 = __builtin_amdgcn_permlane32_swap(a0, b0, false, false); auto r1 = __builtin_amdgcn_permlane32_swap(a1, b1, false, false); \
        u32x4 w = {r0[0], r1[0], r0[1], r1[1]}; OUT = __builtin_bit_cast(bf16x8, w); } while (0)
    PK4(p0, 0, pa0); PK4(p0, 8, pa1); PK4(p1, 0, pa2); PK4(p1, 8, pa3);
#undef PK4
}
template <int KB>
DI void qkt(f32x16& p0, f32x16& p1, const char* K_lds, int r32, int hi, const bf16x8* qr) {
    p0 = f32x16{}; p1 = f32x16{};
    const char* kb[4];
#pragma unroll
    for (int dd = 0; dd < 4; ++dd) kb[dd] = K_lds + KB * SHM_K + KSWZ(r32, (dd * 16 + hi * 8) * 2);
#pragma unroll
    for (int d0 = 0; d0 < 8; ++d0) { const char* a = kb[d0 & 3] + (d0 >> 2) * 128;
        bf16x8 b0 = *reinterpret_cast<const bf16x8*>(a);
        bf16x8 b1 = *reinterpret_cast<const bf16x8*>(a + 32 * 256);
        p0 = MFMA32(b0, qr[d0], p0);
        p1 = MFMA32(b1, qr[d0], p1); }
}
template <int VB>
DI void pv_tile(f32x16* o, int vb0, bf16x8 pa0, bf16x8 pa1, bf16x8 pa2, bf16x8 pa3) {
#define TRRD(dst, off) asm volatile("ds_read_b64_tr_b16 %0, %1 offset:%2" : "=&v"(dst) : "v"(vb0), "i"(off) : "memory")
#define PV_D0(d0) do { s16x4 l0, l1, l2, l3, h0, h1, h2, h3; constexpr int b_ = VB * SHM_V + v_rd_off(d0, 0, 0); \
        TRRD(l0, b_); TRRD(h0, b_ + 2048); TRRD(l1, b_ + 4096); TRRD(h1, b_ + 6144); TRRD(l2, b_ + 8192); TRRD(h2, b_ + 10240); TRRD(l3, b_ + 12288); TRRD(h3, b_ + 14336); \
        asm volatile("s_waitcnt lgkmcnt(0)" ::: "memory"); SBAR();   \
        o[d0] = MFMA32(pa0, ((bf16x8){l0[0], l0[1], l0[2], l0[3], h0[0], h0[1], h0[2], h0[3]}), o[d0]);   \
        o[d0] = MFMA32(pa1, ((bf16x8){l1[0], l1[1], l1[2], l1[3], h1[0], h1[1], h1[2], h1[3]}), o[d0]);   \
        o[d0] = MFMA32(pa2, ((bf16x8){l2[0], l2[1], l2[2], l2[3], h2[0], h2[1], h2[2], h2[3]}), o[d0]);   \
        o[d0] = MFMA32(pa3, ((bf16x8){l3[0], l3[1], l3[2], l3[3], h3[0], h3[1], h3[2], h3[3]}), o[d0]); } while (0)
    PV_D0(0); PV_D0(1); PV_D0(2); PV_D0(3);
#undef PV_D0
#undef TRRD
}

struct BlockRef { const bf16* Q; const bf16* K; const bf16* V; bf16* O; const bf16* KM; int P0; };
struct Seam { bf16x8 qr[8]; bf16x8 st_v0, st_v1, st_k0, st_k1; };
#define VMW() asm volatile("s_waitcnt vmcnt(0)" ::: "memory")
#define VMWN(n) asm volatile("s_waitcnt vmcnt(%0)" :: "i"(n) : "memory")
#define SLOAD_H(Kp, Vp, k0) do { const bf16* kb__ = (Kp) + (size_t)(k0) * RS; const bf16* vb__ = (Vp) + (size_t)(k0) * RS;              \
                         S.st_v0 = load8(vb__ + goff); S.st_v1 = load8(vb__ + 32 * RS + goff);              \
                         S.st_k0 = load8(kb__ + goff); S.st_k1 = load8(kb__ + 32 * RS + goff); } while (0)
#define SWRITE_HK(bf) do { *(bf16x8*)(K_lds + (bf) * SHM_K + kws) = S.st_k0; *(bf16x8*)(K_lds + (bf) * SHM_K + kws + 32 * 256) = S.st_k1; } while (0)
#define SWRITE_HV(bf) do { *(bf16x8*)(V_lds + (bf) * SHM_V + vst0) = S.st_v0; *(bf16x8*)(V_lds + (bf) * SHM_V + vst1) = S.st_v1; } while (0)
#define SWRITE_H(bf) do { SWRITE_HV(bf); SWRITE_HK(bf); } while (0)
DI void prime(const BlockRef& cur, char* lds, Seam& S) {
    const int tid = threadIdx.x, wid = __builtin_amdgcn_readfirstlane(tid >> 6), lane = tid & 63, r32 = lane & 31, hi = lane >> 5;
    const int sr = tid >> 4, sc = (tid & 15) * 8, kws = KSWZ(sr, sc * 2); char* K_lds = lds + 2 * SHM_V;
    const unsigned goff = (unsigned)(sr * RS + sc), qoff = (unsigned)(r32 * RS + hi * 8);
    { const bf16* qb__ = cur.Q + (size_t)(wid * QBLK) * RS;
#pragma unroll
    for (int d0 = 0; d0 < 8; ++d0) S.qr[d0] = load8(qb__ + qoff + d0 * 16); }
    SLOAD_H(cur.K, cur.V, 0); VMW(); SWRITE_HK(0);
    __syncthreads();
}
DI void block(const BlockRef& cur, const BlockRef& nxt, char* lds, Seam& S) {
    int tid_ = threadIdx.x; asm volatile("" : "+v"(tid_));
    const int tid = tid_, wid = __builtin_amdgcn_readfirstlane(tid >> 6), lane = tid & 63, r32 = lane & 31, hi = lane >> 5;
    const int NT = (cur.P0 + QB) / KVBLK;
    const int qb = cur.P0 / QB;
    const int qlo = cur.P0 + wid * QBLK, qm = qlo + r32 - 4 * hi;
    char* V_lds = lds; char* K_lds = lds + 2 * SHM_V;
    float* ws = (float*)(lds + 2 * SHM_V + 2 * SHM_K) + wid * 64; float* li_l = ws, * al_l = ws + 32;
    unsigned selmask = (1u << qb) - 1u;
    if (qb > 3) {
        f32x16 g0 = f32x16{};
#pragma unroll
        for (int d0 = 0; d0 < 8; ++d0) {
            bf16x8 a = (bf16x8){0, 0, 0, 0, 0, 0, 0, 0};
            if (r32 < 8) a = load8(cur.KM + r32 * D + d0 * 16 + hi * 8);
            g0 = MFMA32(a, S.qr[d0], g0);
        }
        float gt[8];
#pragma unroll
        for (int j = 0; j < 4; ++j) { const float mine = g0[j], oth = __shfl_xor(mine, 32); gt[j] = hi ? oth : mine; gt[4 + j] = hi ? mine : oth; }
        selmask = 0u;
#pragma unroll
        for (int i = 0; i < 8; ++i) { int rank = 0;
#pragma unroll
            for (int j = 0; j < 8; ++j) { if (j != i) { const bool beats = (gt[j] > gt[i]) || (gt[j] == gt[i] && j < i); rank += (j < qb && beats) ? 1 : 0; } }
            if (i < qb && rank < 3) selmask |= (1u << i); }
    }
    float m_reg = -1e30f, l_reg = 0; f32x16 o[4] = {};
    const int sr = tid >> 4, sc = (tid & 15) * 8, vst0 = v_st(sr, sc), vst1 = v_st(32 + sr, sc), kws = KSWZ(sr, sc * 2);
    const unsigned goff = (unsigned)(sr * RS + sc), qoff = (unsigned)(r32 * RS + hi * 8);
    const int vb0 = (int)(uintptr_t)V_lds + v_rd_base(lane);
    const bf16* Kh = cur.K; const bf16* Vh = cur.V;
#define RESC(a) do { if (__any((a) < 1.f)) { if (hi == 0) al_l[r32] = (a); asm volatile("s_waitcnt lgkmcnt(0)" ::: "memory");              \
                     _Pragma("unroll") for (int d_ = 0; d_ < 4; ++d_) _Pragma("unroll") for (int r = 0; r < 16; ++r) o[d_][r] *= al_l[crow(r, hi)]; } } while (0)
#define KBASE(t) ((t) * KVBLK)
#define MASKT(P0_, P1_, t) do { const int kb_ = KBASE(t); const int kblk_ = (t) >> 2; \
        if (kblk_ < qb) { if (qb > 3) mask_all(P0_, P1_, ((selmask >> kblk_) & 1u) == 0u); } \
        else if (kb_ + KVBLK - 1 > qlo) mask_tile(P0_, P1_, qm - kb_); } while (0)
    constexpr int NQL = 8;
#define SEAM_K0() do { VMWN(NQL); SWRITE_HK(0); SBAR(); } while (0)
    f32x16 pA0, pA1, pB0, pB1; float mnA, mnB, alA, alB; bf16x8 pa0, pa1, pa2, pa3;
    SWRITE_HV(0); SBAR();
    if (NT > 1) { SLOAD_H(Kh, Vh, KBASE(1)); }
    SBAR(); qkt<0>(pA0, pA1, K_lds, r32, hi, S.qr);
    MASKT(pA0, pA1, 0); partialSM(pA0, pA1, m_reg, mnA, alA);
    if (NT > 1) { VMW(); SWRITE_H(1); }
    __syncthreads();
#define HALF_STEP(PX0, PX1, mnX, alX, PY0, PY1, alY, t, KB, VB, SB) do {                                                      \
        SBAR(); qkt<KB>(PX0, PX1, K_lds, r32, hi, S.qr);                                             \
        finishSM(PY0, PY1, alY, l_reg, pa0, pa1, pa2, pa3); SBAR();                                                           \
        if ((t) + 1 < NT) { SLOAD_H(Kh, Vh, KBASE((t) + 1)); SBAR(); }                                               \
        pv_tile<VB>(o, vb0, pa0, pa1, pa2, pa3); MASKT(PX0, PX1, (t)); partialSM(PX0, PX1, m_reg, mnX, alX);                                        \
        __syncthreads();                                                                                                      \
        if ((t) + 1 < NT) { VMW(); SWRITE_H(SB); }                                                                          \
        RESC(alX); __syncthreads(); } while (0)
    for (int t = 1; t + 1 < NT; t += 2) {
        HALF_STEP(pB0, pB1, mnB, alB, pA0, pA1, alA, t, 1, 0, 0);
        HALF_STEP(pA0, pA1, mnA, alA, pB0, pB1, alB, t + 1, 0, 1, 1);
    }
    const bool even = (NT & 1) == 0;
    if (even) { SBAR(); qkt<1>(pB0, pB1, K_lds, r32, hi, S.qr); SBAR(); }
    { SLOAD_H(nxt.K, nxt.V, 0); SBAR();
      const bf16* qb__ = nxt.Q + (size_t)(wid * QBLK) * RS;
#pragma unroll
      for (int d0 = 0; d0 < 8; ++d0) S.qr[d0] = load8(qb__ + qoff + d0 * 16); }
    SBAR();
    finishSM(pA0, pA1, alA, l_reg, pa0, pa1, pa2, pa3); SBAR();
    pv_tile<0>(o, vb0, pa0, pa1, pa2, pa3);
    if (even) { MASKT(pB0, pB1, NT - 1); partialSM(pB0, pB1, m_reg, mnB, alB); __syncthreads(); RESC(alB);
        finishSM(pB0, pB1, alB, l_reg, pa0, pa1, pa2, pa3); SBAR(); pv_tile<1>(o, vb0, pa0, pa1, pa2, pa3); }
    SBAR(); SEAM_K0();
    if (hi == 0) li_l[r32] = l_reg; asm volatile("s_waitcnt lgkmcnt(0)" ::: "memory");
    float rli[16];
#pragma unroll
    for (int r = 0; r < 16; ++r) rli[r] = __builtin_amdgcn_rcpf(li_l[crow(r, hi)]);
    bf16* Ow = cur.O + (size_t)(wid * QBLK) * RSO;
    const unsigned ooff = (unsigned)(4 * hi * RSO + r32);
#pragma unroll
    for (int r = 0; r < 16; ++r) { const int orow0 = (r & 3) + 8 * (r >> 2);
#pragma unroll
        for (int d0 = 0; d0 < 4; ++d0) { const float v = o[d0][r] * rli[r];
            const float vn = __shfl_xor(v, 1);
            if ((r32 & 1) == 0) *(unsigned*)(Ow + ooff + (unsigned)(orow0 * RSO + d0 * 32)) = cvtpk(v, vn); } }
    __syncthreads();
#undef RESC
#undef KBASE
#undef MASKT
#undef SEAM_K0
#undef HALF_STEP
}
#undef VMW
#undef VMWN
#undef SLOAD_H
#undef SWRITE_HK
#undef SWRITE_HV
#undef SWRITE_H
#undef KSWZ
#undef SBAR
}

namespace dn {
constexpr int L_QB = 0, L_KB = 17408, L_KF = 34816, L_VF = 67584, L_LM = 100352, L_GV = 117760;
constexpr int RQ = 272, LMS = 68;

DI void prep_chunk(const Params& p, LAS unsigned char* lds, int item, int tid, int lane, int wave) {
    asm volatile("" : "+v"(tid), "+v"(lane));
    const int bh = item >> 5, n = item & 31, b = bh >> 3, h = bh & 7;
    const int tok0 = b * SEQ + n * 64;
    const bf16_t* PROJ = (const bf16_t*)(p.ws + WS_B);
    const float* BA = (const float*)(p.ws + WS_BA);
    unsigned char* rec = p.ws + WS_DNP + (size_t)item * DN_STRIDE;
    LAS float* KF = (LAS float*)(lds + L_KF); LAS float* VF = (LAS float*)(lds + L_VF); LAS float* LM = (LAS float*)(lds + L_LM);
    LAS float* GV = (LAS float*)(lds + L_GV);
    {
        const int i0 = wave * 8, c0 = 2 * lane;
#pragma unroll
        for (int seg = 0; seg < 3; ++seg) {
            const int chan = seg * 1024 + h * HD + c0;
            float w0[4], w1[4];
#pragma unroll
            for (int j = 0; j < 4; ++j) { const f32x2 wv = *(const f32x2*)(p.conv_w + j * 3072 + chan); w0[j] = wv.x; w1[j] = wv.y; }
            float r0[11], r1[11];
#pragma unroll
            for (int jj = 0; jj < 11; ++jj) {
                const int sp = n * 64 + i0 - 3 + jj;
                unsigned v = 0u;
                if (sp >= 0) v = *(const unsigned*)(PROJ + (size_t)(b * SEQ + sp) * PP + C_DN + chan);
                r0[jj] = bflo(v); r1[jj] = bfhi(v);
            }
#pragma unroll
            for (int i = 0; i < 8; ++i) {
                float y0 = 0.f, y1 = 0.f;
#pragma unroll
                for (int j = 0; j < 4; ++j) { y0 += w0[j] * r0[i + j]; y1 += w1[j] * r1[i + j]; }
                y0 = siluf_(y0); y1 = siluf_(y1);
                const int row = i0 + i;
                if (seg < 2) {
                    const float ss = wave_sum(y0 * y0 + y1 * y1);
                    const float rn = 1.0f / sqrtf(ss + EPS);
                    y0 *= rn; y1 *= rn;
                    if (seg == 0) { *(LAS unsigned*)(lds + L_QB + row * RQ + c0 * 2) = cvtpk(y0 * SCALE_Q, y1 * SCALE_Q); }
                    else { *(LAS unsigned*)(lds + L_KB + row * RQ + c0 * 2) = cvtpk(y0, y1); *(LAS f32x2*)(KF + row * 128 + c0) = (f32x2){y0, y1}; }
                } else { *(LAS f32x2*)(VF + row * 128 + c0) = (f32x2){y0, y1}; }
            }
        }
        if (wave == 0) {
            const int t = tok0 + lane;
            const float br = BA[(size_t)t * 16 + h], ar = BA[(size_t)t * 16 + 8 + h];
            const float beta = sigmoidf_(br);
            const float xs = ar + p.dt_bias[h];
            const float sp = xs > 20.f ? xs : log1pf(expf(xs));
            float g = -expf(p.a_log[h]) * sp;
#pragma unroll
            for (int o = 1; o < 64; o <<= 1) { const float u = __shfl_up(g, o); if (lane >= o) g += u; }
            const float g63 = __shfl(g, 63);
            GV[lane] = g; GV[64 + lane] = beta; GV[128 + lane] = expf(g); GV[192 + lane] = expf(g63 - g);
        }
    }
    __syncthreads();
    {
        const int mt = wave >> 1, nt = wave & 1, r = lane & 31, hi = lane >> 5;
        const LAS unsigned char* Ab = lds + (mt < 2 ? L_QB + (32 * mt + r) * RQ : L_KB + (32 * (mt - 2) + r) * RQ);
        const LAS unsigned char* Bb = lds + L_KB + (32 * nt + r) * RQ;
        f32x16 acc = f32x16{};
#pragma unroll
        for (int ks = 0; ks < 8; ++ks) {
            const bf16x8 a = *(const LAS bf16x8*)(Ab + (16 * ks + 8 * hi) * 2), bb = *(const LAS bf16x8*)(Bb + (16 * ks + 8 * hi) * 2);
            acc = MFMA32(a, bb, acc);
        }
        const int j = 32 * nt + r; const float Gj = GV[j];
        if (mt < 2) {
            bf16_t* QK = (bf16_t*)(rec + DN_QK);
            const int pj = (j & ~15) | perm16(j & 15);
#pragma unroll
            for (int i = 0; i < 16; ++i) { const int row = 32 * mt + crow(i, hi);
                const float e = row >= j ? __expf(GV[row] - Gj) : 0.f;
                QK[row * 64 + pj] = f2bf(acc[i] * e); }
        } else {
#pragma unroll
            for (int i = 0; i < 16; ++i) { const int row = 32 * (mt - 2) + crow(i, hi);
                const float e = row > j ? GV[64 + row] * __expf(GV[row] - Gj) : 0.f;
                LM[row * LMS + j] = acc[i] * e; }
        }
    }
    __syncthreads();
    if (wave < 4) {
        const bool isU = wave < 2; const int d = (wave & 1) * 64 + lane;
        float Lr[64];
#pragma unroll
        for (int jq = 0; jq < 16; ++jq) { const f32x4 l = *(const LAS f32x4*)(LM + lane * LMS + 4 * jq); Lr[4 * jq] = l.x; Lr[4 * jq + 1] = l.y; Lr[4 * jq + 2] = l.z; Lr[4 * jq + 3] = l.w; }
        float x[64];
        {   const LAS float* src = isU ? VF : KF; const LAS float* sc2 = isU ? (GV + 64) : (GV + 128);
#pragma unroll
            for (int i = 0; i < 64; ++i) { const float bsc = isU ? GV[64 + i] : GV[64 + i] * sc2[i]; x[i] = bsc * src[i * 128 + d]; }
        }
        __builtin_amdgcn_sched_barrier(0);
#pragma unroll
        for (int i = 1; i < 64; ++i) {
            float s = x[i];
#pragma unroll
            for (int j = 0; j < i; ++j) s -= __int_as_float(__builtin_amdgcn_readlane(__float_as_int(Lr[j]), i)) * x[j];
            x[i] = s;
            __builtin_amdgcn_sched_barrier(0);
        }
        if (isU) { bf16_t* U = (bf16_t*)(rec + DN_U);
#pragma unroll
            for (int i = 0; i < 64; ++i) U[i * 128 + d] = f2bf(x[i]);
        } else { bf16_t* W = (bf16_t*)(rec + DN_W); const int pd = (d & ~15) | perm16(d & 15);
#pragma unroll
            for (int i = 0; i < 64; ++i) W[i * 128 + pd] = f2bf(-x[i]);
        }
    } else {
        const int t2 = tid - 256;
        bf16_t* QD = (bf16_t*)(rec + DN_QD);
#pragma unroll
        for (int rep = 0; rep < 2; ++rep) {
            const int gi = t2 + rep * 256, i = gi >> 3, dg = gi & 7;
            const u32x4 a = *(const LAS u32x4*)(lds + L_QB + i * RQ + dg * 32), c = *(const LAS u32x4*)(lds + L_QB + i * RQ + dg * 32 + 16);
            const float e = GV[128 + i];
            u32x4 o0, o1;
            o0.x = cvtpk(bflo(a.x) * e, bfhi(a.x) * e); o0.y = cvtpk(bflo(a.y) * e, bfhi(a.y) * e);
            o0.z = cvtpk(bflo(c.x) * e, bfhi(c.x) * e); o0.w = cvtpk(bflo(c.y) * e, bfhi(c.y) * e);
            o1.x = cvtpk(bflo(a.z) * e, bfhi(a.z) * e); o1.y = cvtpk(bflo(a.w) * e, bfhi(a.w) * e);
            o1.z = cvtpk(bflo(c.z) * e, bfhi(c.z) * e); o1.w = cvtpk(bflo(c.w) * e, bfhi(c.w) * e);
            *(u32x4*)(QD + i * 128 + dg * 16) = o0; *(u32x4*)(QD + i * 128 + dg * 16 + 8) = o1;
        }
        bf16_t* KT = (bf16_t*)(rec + DN_KT);
#pragma unroll
        for (int rep = 0; rep < 2; ++rep) {
            const int gi = t2 + rep * 256, d = gi & 127, jg = gi >> 7;
            float v[16];
#pragma unroll
            for (int jj = 0; jj < 16; ++jj) { const int j = 16 * jg + jj; v[jj] = KF[j * 128 + d] * GV[192 + j]; }
            u32x4 o0, o1;
            o0.x = cvtpk(v[0], v[1]); o0.y = cvtpk(v[2], v[3]); o0.z = cvtpk(v[8], v[9]); o0.w = cvtpk(v[10], v[11]);
            o1.x = cvtpk(v[4], v[5]); o1.y = cvtpk(v[6], v[7]); o1.z = cvtpk(v[12], v[13]); o1.w = cvtpk(v[14], v[15]);
            *(u32x4*)(KT + d * 64 + jg * 16) = o0; *(u32x4*)(KT + d * 64 + jg * 16 + 8) = o1;
        }
        if (t2 == 0) *(float*)(rec + DN_SC) = GV[128 + 63];
    }
    __syncthreads();
}

DI bf16x8 pack_step(const f32x16& x, int s) {
    u32x4 w;
    if (s == 0) { w.x = cvtpk(x[0], x[1]); w.y = cvtpk(x[2], x[3]); w.z = cvtpk(x[4], x[5]); w.w = cvtpk(x[6], x[7]); }
    else { w.x = cvtpk(x[8], x[9]); w.y = cvtpk(x[10], x[11]); w.z = cvtpk(x[12], x[13]); w.w = cvtpk(x[14], x[15]); }
    return __builtin_bit_cast(bf16x8, w);
}

DI void recur(const Params& p, int bh, int slice, int lane) {
    const int r = lane & 31, hi = lane >> 5, b = bh >> 3, h = bh & 7, dv0 = slice * 32;
    float* ODN = (float*)(p.ws + WS_D);
    f32x16 St[4];
#pragma unroll
    for (int a = 0; a < 4; ++a) St[a] = f32x16{};
    for (int n = 0; n < 32; ++n) {
        const unsigned char* rec = p.ws + WS_DNP + (size_t)(bh * 32 + n) * DN_STRIDE;
        const bf16_t* U = (const bf16_t*)(rec + DN_U); const bf16_t* W = (const bf16_t*)(rec + DN_W); const bf16_t* QD = (const bf16_t*)(rec + DN_QD);
        const bf16_t* KT = (const bf16_t*)(rec + DN_KT); const bf16_t* QK = (const bf16_t*)(rec + DN_QK);
        const float eg = *(const float*)(rec + DN_SC);
        f32x16 Vn[2], O[2];
#pragma unroll
        for (int mt = 0; mt < 2; ++mt)
#pragma unroll
            for (int i = 0; i < 16; ++i) Vn[mt][i] = bf2f(U[(32 * mt + crow(i, hi)) * 128 + dv0 + r]);
        bf16x8 Sf[8];
#pragma unroll
        for (int a = 0; a < 4; ++a) { Sf[2 * a] = pack_step(St[a], 0); Sf[2 * a + 1] = pack_step(St[a], 1); }
#pragma unroll
        for (int mt = 0; mt < 2; ++mt)
#pragma unroll
            for (int ks = 0; ks < 8; ++ks) { const bf16x8 a = *(const bf16x8*)(W + (32 * mt + r) * 128 + 16 * ks + 8 * hi); Vn[mt] = MFMA32(a, Sf[ks], Vn[mt]); }
#pragma unroll
        for (int mt = 0; mt < 2; ++mt) { O[mt] = f32x16{};
#pragma unroll
            for (int ks = 0; ks < 8; ++ks) { const bf16x8 a = *(const bf16x8*)(QD + (32 * mt + r) * 128 + 16 * ks + 8 * hi); O[mt] = MFMA32(a, Sf[ks], O[mt]); } }
        bf16x8 Vf[4];
#pragma unroll
        for (int mt = 0; mt < 2; ++mt) { Vf[2 * mt] = pack_step(Vn[mt], 0); Vf[2 * mt + 1] = pack_step(Vn[mt], 1); }
#pragma unroll
        for (int mt = 0; mt < 2; ++mt)
#pragma unroll
            for (int ks = 0; ks < 4; ++ks) { const bf16x8 a = *(const bf16x8*)(QK + (32 * mt + r) * 64 + 16 * ks + 8 * hi); O[mt] = MFMA32(a, Vf[ks], O[mt]); }
        float* orow = ODN + (size_t)(b * SEQ + n * 64) * 1024 + h * HD + dv0 + r;
#pragma unroll
        for (int mt = 0; mt < 2; ++mt)
#pragma unroll
            for (int i = 0; i < 16; ++i) orow[(size_t)(32 * mt + crow(i, hi)) * 1024] = O[mt][i];
#pragma unroll
        for (int a = 0; a < 4; ++a) {
            St[a] = St[a] * eg;
#pragma unroll
            for (int ks = 0; ks < 4; ++ks) { const bf16x8 kt = *(const bf16x8*)(KT + (32 * a + r) * 64 + 16 * ks + 8 * hi); St[a] = MFMA32(kt, Vf[ks], St[a]); }
        }
    }
}
}

DI void transpose_tile(const float* W, int N, int k0, int sn0, bf16_t* WT, int dpitch, int drow0, int dk0, int nvalid, LAS float* scr, int lane) {
#pragma unroll 8
    for (int i = 0; i < 32; ++i) { const int kk = 2 * i + (lane >> 5); scr[kk * 33 + (lane & 31)] = W[(size_t)(k0 + kk) * N + sn0 + (lane & 31)]; }
    asm volatile("s_waitcnt lgkmcnt(0)" ::: "memory");
    const int c = lane & 7;
#pragma unroll
    for (int j = 0; j < 4; ++j) { const int n = (lane >> 3) + 8 * j; const LAS float* s = scr + (8 * c) * 33 + n;
        u32x4 o; o.x = cvtpk(s[0 * 33], s[1 * 33]); o.y = cvtpk(s[2 * 33], s[3 * 33]); o.z = cvtpk(s[4 * 33], s[5 * 33]); o.w = cvtpk(s[6 * 33], s[7 * 33]);
        if (n < nvalid) *(u32x4*)(WT + (size_t)(drow0 + n) * dpitch + dk0 + k0 + 8 * c) = o; }
    asm volatile("s_waitcnt lgkmcnt(0)" ::: "memory");
}

DI void phase0(const Params& p, LAS unsigned char* lds, int tid, int lane, int wave, int bid, int G) {
    float* MOD = (float*)(p.ws + WS_MOD);
    if (bid < 192) {
        LAS float* sc = (LAS float*)lds;
        LAS float* red = (LAS float*)(lds + 65536);
        for (int i = tid; i < 8 * 2048; i += 512) { const int bb = i >> 11, k = i & 2047; sc[k * 8 + bb] = siluf_acc(p.c[i]); }
        __syncthreads();
        const int n0 = bid * 64;
        float acc[8];
#pragma unroll
        for (int bb = 0; bb < 8; ++bb) acc[bb] = 0.f;
        const float* wp = p.w_ada + (size_t)(wave * 256) * 12288 + n0 + lane;
#pragma unroll 8
        for (int k = 0; k < 256; ++k) {
            const float wv = wp[(size_t)k * 12288];
            const f32x4 s0 = *(const LAS f32x4*)(sc + (wave * 256 + k) * 8), s1 = *(const LAS f32x4*)(sc + (wave * 256 + k) * 8 + 4);
            acc[0] += s0.x * wv; acc[1] += s0.y * wv; acc[2] += s0.z * wv; acc[3] += s0.w * wv;
            acc[4] += s1.x * wv; acc[5] += s1.y * wv; acc[6] += s1.z * wv; acc[7] += s1.w * wv;
        }
#pragma unroll
        for (int bb = 0; bb < 8; ++bb) red[(wave * 8 + bb) * 64 + lane] = acc[bb];
        __syncthreads();
        { const int bb = tid >> 6, col = tid & 63; float s = 0.f;
#pragma unroll
          for (int w = 0; w < 8; ++w) s += red[(w * 8 + bb) * 64 + col];
          MOD[bb * 12288 + n0 + col] = s + p.b_ada[n0 + col]; }
        __syncthreads();
    } else {
        f32x2* CS = (f32x2*)(p.ws + WS_CS);
        for (int i = (bid - 192) * 512 + tid; i < T * 16; i += (G - 192) * 512) {
            const int t = i >> 4, f = i & 15;
            const float inv = powf(500000.0f, -(float)f * (2.0f / 32.0f));
            const float ang = (float)p.pos[t] * inv;
            float sn, cs; sincosf(ang, &sn, &cs);
            CS[i] = (f32x2){cs, sn};
        }
    }
    LAS float* scr = (LAS float*)(lds + wave * 8448);
    const int gw = bid * 8 + wave, NGW = G * 8;
    bf16_t* WIN = (bf16_t*)(p.ws + WS_WIN); bf16_t* WMD = (bf16_t*)(p.ws + WS_WMD); bf16_t* WOUT = (bf16_t*)(p.ws + WS_WOUT); bf16_t* WR = (bf16_t*)(p.ws + WS_WR);
    constexpr int I_A = 32 * 224, I_B = 32 * 128, I_C = 32, I_M = 16 * 64, I_O = 32 * 64, I_RG = 32, I_RE = 32;
    constexpr int NITEMS = I_A + I_B + I_C + 2 * I_M + I_O + I_RG + I_RE;
    for (int it = gw; it < NITEMS; it += NGW) {
        int r = it;
        if (r < I_A) { const int kb = r / 224, nb = r % 224; transpose_tile(p.w_in, 11280, 64 * kb, 32 * nb, WIN, DM, 32 * nb, 0, 32, scr, lane); continue; } r -= I_A;
        if (r < I_B) { const int kb = r / 128, nb = r % 128; transpose_tile(p.w_in, 11280, 64 * kb, 7184 + 32 * nb, WIN, DM, 7168 + 32 * nb, 0, 32, scr, lane); continue; } r -= I_B;
        if (r < I_C) { transpose_tile(p.w_in, 11280, 64 * r, 7168, WIN, DM, 11264, 0, 16, scr, lane); continue; } r -= I_C;
        if (r < I_M) { const int kb = r / 64, nb = r % 64; transpose_tile(p.w_bm, DM, 64 * kb, 32 * nb, WMD, DM, 32 * nb, 0, 32, scr, lane); continue; } r -= I_M;
        if (r < I_M) { const int kb = r / 64, nb = r % 64; transpose_tile(p.w_bd, DM, 64 * kb, 32 * nb, WMD, DM, 32 * nb, 1024, 32, scr, lane); continue; } r -= I_M;
        if (r < I_O) { const int kb = r / 64, nb = r % 64; transpose_tile(p.w_out, DM, 64 * kb, 32 * nb, WOUT, DM, 32 * nb, 0, 32, scr, lane); continue; } r -= I_O;
        if (r < I_RG) {
            const int k = r * 64 + lane;
#pragma unroll
            for (int e = 0; e < 4; ++e) WR[e * DM + k] = f2bf(p.w_rg[k * 4 + e]);
#pragma unroll
            for (int e = 36; e < 48; ++e) WR[e * DM + k] = 0;
            continue; } r -= I_RG;
        { transpose_tile(p.w_re, 32, 64 * r, 0, WR, DM, 4, 0, 32, scr, lane); }
    }
    { u32x4* z = (u32x4*)(WIN + (size_t)11280 * DM); const int nz = 240 * DM * 2 / 16;
      for (int i = bid * 512 + tid; i < nz; i += G * 512) z[i] = (u32x4){0u, 0u, 0u, 0u}; }
}

DI void phase_u1(const Params& p, int lane, int gw, int NGW) {
    const float* MOD = (const float*)(p.ws + WS_MOD); bf16_t* U1 = (bf16_t*)(p.ws + WS_A);
    for (int m = gw; m < T; m += NGW) {
        const int b = m >> 11;
        const f32x4* xr = (const f32x4*)(p.x + (size_t)m * DM) + lane;
        f32x4 v[8]; float s = 0.f;
#pragma unroll
        for (int j = 0; j < 8; ++j) { v[j] = xr[64 * j]; s += (v[j].x * v[j].x + v[j].y * v[j].y) + (v[j].z * v[j].z + v[j].w * v[j].w); }
        const float rstd = 1.0f / sqrtf(wave_sum(s) * (1.0f / DM) + EPS);
        const float* sh = MOD + b * 12288; const float* scl = sh + 2048;
        u32x2* o8 = (u32x2*)(U1 + (size_t)m * DM) + lane;
#pragma unroll
        for (int j = 0; j < 8; ++j) { const int col = 4 * (lane + 64 * j);
            const f32x4 g = *(const f32x4*)(p.g_mix_pre + col), a = *(const f32x4*)(scl + col), c = *(const f32x4*)(sh + col);
            const f32x4 u = (v[j] * rstd * g) * (a + 1.0f) + c;
            o8[64 * j] = (u32x2){cvtpk(u.x, u.y), cvtpk(u.z, u.w)}; }
    }
}

DI void rotary_item(const Params& p, int item, int lane) {
    const int which = item & 1, h = (item >> 1) & 7, blk = (item >> 4) & 7, b = item >> 7;
    bf16_t* PROJ = (bf16_t*)(p.ws + WS_B);
    const f32x2* CS = (const f32x2*)(p.ws + WS_CS);
    const int tok0 = b * SEQ + blk * 256; const int colb = (which ? C_K : C_Q) + h * HD;
    float s0 = 0.f, s1 = 0.f;
    if (which) {
#pragma unroll 8
        for (int rr = 0; rr < 256; ++rr) { const unsigned v = *(const unsigned*)(PROJ + (size_t)(tok0 + rr) * PP + colb + 2 * lane); s0 += bflo(v); s1 += bfhi(v); }
    }
    const int rsub = lane >> 4, i = lane & 15;
    float a0 = 0.f, a1 = 0.f;
#pragma unroll 4
    for (int it = 0; it < 64; ++it) {
        const int t = tok0 + it * 4 + rsub;
        bf16_t* ptr = PROJ + (size_t)t * PP + colb + i;
        const float x1 = bf2f(ptr[0]), x2 = bf2f(ptr[16]);
        const f32x2 cs = CS[t * 16 + i];
        const unsigned w = cvtpk(x1 * cs.x - x2 * cs.y, x2 * cs.x + x1 * cs.y);
        ptr[0] = (bf16_t)(w & 0xffffu); ptr[16] = (bf16_t)(w >> 16);
        a0 += bflo(w); a1 += bfhi(w);
    }
    if (which) {
        a0 += __shfl_xor(a0, 16); a0 += __shfl_xor(a0, 32); a1 += __shfl_xor(a1, 16); a1 += __shfl_xor(a1, 32);
        bf16_t* KM = (bf16_t*)(p.ws + WS_KMEAN) + ((size_t)(b * 8 + h) * 8 + blk) * HD;
        if (lane >= 16) { *(unsigned*)(KM + 2 * lane) = cvtpk(s0 * (1.0f / 256.0f), s1 * (1.0f / 256.0f)); }
        else { KM[lane] = f2bf(a0 * (1.0f / 256.0f)); KM[16 + lane] = f2bf(a1 * (1.0f / 256.0f)); }
    }
}

DI void phase_dn_final(const Params& p, int lane, int gw, int NGW) {
    const float* ODN = (const float*)(p.ws + WS_D); const bf16_t* PROJ = (const bf16_t*)(p.ws + WS_B); bf16_t* YAB = (bf16_t*)(p.ws + WS_A);
    const int d0 = (lane & 7) * 16;
    for (int m = gw; m < T; m += NGW) {
        const float* op = ODN + (size_t)m * 1024 + lane * 16;
        f32x4 v[4]; float s = 0.f;
#pragma unroll
        for (int j = 0; j < 4; ++j) { v[j] = *(const f32x4*)(op + 4 * j); s += (v[j].x * v[j].x + v[j].y * v[j].y) + (v[j].z * v[j].z + v[j].w * v[j].w); }
        s += __shfl_xor(s, 1); s += __shfl_xor(s, 2); s += __shfl_xor(s, 4);
        const float rstd = 1.0f / sqrtf(s * (1.0f / HD) + EPS);
        const u32x4 z0 = *(const u32x4*)(PROJ + (size_t)m * PP + C_Z + lane * 16), z1 = *(const u32x4*)(PROJ + (size_t)m * PP + C_Z + lane * 16 + 8);
        const float zz[16] = {bflo(z0.x), bfhi(z0.x), bflo(z0.y), bfhi(z0.y), bflo(z0.z), bfhi(z0.z), bflo(z0.w), bfhi(z0.w),
                              bflo(z1.x), bfhi(z1.x), bflo(z1.y), bfhi(z1.y), bflo(z1.z), bfhi(z1.z), bflo(z1.w), bfhi(z1.w)};
        float y[16];
#pragma unroll
        for (int j = 0; j < 4; ++j) { const f32x4 g = *(const f32x4*)(p.dn_gain + d0 + 4 * j);
            y[4 * j + 0] = v[j].x * rstd * g.x * siluf_(zz[4 * j + 0]); y[4 * j + 1] = v[j].y * rstd * g.y * siluf_(zz[4 * j + 1]);
            y[4 * j + 2] = v[j].z * rstd * g.z * siluf_(zz[4 * j + 2]); y[4 * j + 3] = v[j].w * rstd * g.w * siluf_(zz[4 * j + 3]); }
        u32x4 o0, o1;
        o0.x = cvtpk(y[0], y[1]); o0.y = cvtpk(y[2], y[3]); o0.z = cvtpk(y[4], y[5]); o0.w = cvtpk(y[6], y[7]);
        o1.x = cvtpk(y[8], y[9]); o1.y = cvtpk(y[10], y[11]); o1.z = cvtpk(y[12], y[13]); o1.w = cvtpk(y[14], y[15]);
        bf16_t* yp = YAB + (size_t)m * DM + 1024 + lane * 16;
        *(u32x4*)yp = o0; *(u32x4*)(yp + 8) = o1;
    }
}

constexpr int L5_LG = 0;
constexpr int L5_HIST = 12288;
constexpr int L5_TOK = 12288 + 256;
DI void phase5_item(const Params& p, LAS unsigned char* lds, int item, int tid, int lane, int wave) {
    const float* MOD = (const float*)(p.ws + WS_MOD); const bf16_t* OM = (const bf16_t*)(p.ws + WS_OUTMIX); bf16_t* U2 = (bf16_t*)(p.ws + WS_A);
    const bf16_t* WR = (const bf16_t*)(p.ws + WS_WR);
    LAS unsigned* hist = (LAS unsigned*)(lds + L5_HIST); LAS unsigned* tokw = (LAS unsigned*)(lds + L5_TOK);
    if (tid < 64) hist[tid] = 0u;
    const int tokb = item * 64;
    for (int rr = 0; rr < 8; ++rr) {
        const int m = tokb + wave * 8 + rr, b = m >> 11;
        const float* mod = MOD + b * 12288;
        float om[32], xv[32];
        float s = 0.f;
#pragma unroll
        for (int j = 0; j < 4; ++j) { const int col = 8 * (lane + 64 * j);
            const u32x4 w = *(const u32x4*)(OM + (size_t)m * DM + col);
            om[8 * j + 0] = bflo(w.x); om[8 * j + 1] = bfhi(w.x); om[8 * j + 2] = bflo(w.y); om[8 * j + 3] = bfhi(w.y);
            om[8 * j + 4] = bflo(w.z); om[8 * j + 5] = bfhi(w.z); om[8 * j + 6] = bflo(w.w); om[8 * j + 7] = bfhi(w.w);
            const f32x4 x0 = *(const f32x4*)(p.x + (size_t)m * DM + col), x1 = *(const f32x4*)(p.x + (size_t)m * DM + col + 4);
            xv[8 * j + 0] = x0.x; xv[8 * j + 1] = x0.y; xv[8 * j + 2] = x0.z; xv[8 * j + 3] = x0.w; xv[8 * j + 4] = x1.x; xv[8 * j + 5] = x1.y; xv[8 * j + 6] = x1.z; xv[8 * j + 7] = x1.w;
#pragma unroll
            for (int e = 0; e < 8; ++e) s += om[8 * j + e] * om[8 * j + e]; }
        const float r1 = 1.0f / sqrtf(wave_sum(s) * (1.0f / DM) + EPS);
        float s2 = 0.f;
#pragma unroll
        for (int j = 0; j < 4; ++j) { const int col = 8 * (lane + 64 * j);
#pragma unroll
            for (int q = 0; q < 2; ++q) { const f32x4 g = *(const f32x4*)(p.g_mix_post + col + 4 * q), gt = *(const f32x4*)(mod + 4096 + col + 4 * q);
                f32x4 o;
                o.x = xv[8 * j + 4 * q + 0] + gt.x * (om[8 * j + 4 * q + 0] * r1 * g.x); o.y = xv[8 * j + 4 * q + 1] + gt.y * (om[8 * j + 4 * q + 1] * r1 * g.y);
                o.z = xv[8 * j + 4 * q + 2] + gt.z * (om[8 * j + 4 * q + 2] * r1 * g.z); o.w = xv[8 * j + 4 * q + 3] + gt.w * (om[8 * j + 4 * q + 3] * r1 * g.w);
                *(f32x4*)(p.out + (size_t)m * DM + col + 4 * q) = o;
                xv[8 * j + 4 * q + 0] = o.x; xv[8 * j + 4 * q + 1] = o.y; xv[8 * j + 4 * q + 2] = o.z; xv[8 * j + 4 * q + 3] = o.w;
                s2 += (o.x * o.x + o.y * o.y) + (o.z * o.z + o.w * o.w); } }
        const float r2 = 1.0f / sqrtf(wave_sum(s2) * (1.0f / DM) + EPS);
#pragma unroll
        for (int j = 0; j < 4; ++j) { const int col = 8 * (lane + 64 * j); float u[8];
#pragma unroll
            for (int q = 0; q < 2; ++q) { const f32x4 g = *(const f32x4*)(p.g_ffn_pre + col + 4 * q), sc = *(const f32x4*)(mod + 5 * 2048 - 2048 + col + 4 * q), sh = *(const f32x4*)(mod + 3 * 2048 + col + 4 * q);
                u[4 * q + 0] = (xv[8 * j + 4 * q + 0] * r2 * g.x) * (1.0f + sc.x) + sh.x; u[4 * q + 1] = (xv[8 * j + 4 * q + 1] * r2 * g.y) * (1.0f + sc.y) + sh.y;
                u[4 * q + 2] = (xv[8 * j + 4 * q + 2] * r2 * g.z) * (1.0f + sc.z) + sh.z; u[4 * q + 3] = (xv[8 * j + 4 * q + 3] * r2 * g.w) * (1.0f + sc.w) + sh.w; }
            u32x4 w; w.x = cvtpk(u[0], u[1]); w.y = cvtpk(u[2], u[3]); w.z = cvtpk(u[4], u[5]); w.w = cvtpk(u[6], u[7]);
            *(u32x4*)(U2 + (size_t)m * DM + col) = w; }
    }
    __syncthreads();
    if (wave < 4) {
        const int tl = lane & 15, kg = lane >> 4;
        const bf16_t* up = U2 + (size_t)(tokb + wave * 16 + tl) * DM + 8 * kg;
        const bf16_t* wp = WR + (size_t)tl * DM + 8 * kg;
        f32x4 a0 = {0.f, 0.f, 0.f, 0.f}, a1 = a0, a2 = a0;
#pragma unroll 4
        for (int s = 0; s < 64; ++s) {
            const bf16x8 bu = *(const bf16x8*)(up + 32 * s);
            const bf16x8 w0 = *(const bf16x8*)(wp + 32 * s), w1 = *(const bf16x8*)(wp + 16 * DM + 32 * s), w2 = *(const bf16x8*)(wp + 32 * DM + 32 * s);
            a0 = MFMA16(w0, bu, a0); a1 = MFMA16(w1, bu, a1); a2 = MFMA16(w2, bu, a2);
        }
        LAS float* lg = (LAS float*)(lds + L5_LG) + wave * 768 + tl * 48 + 4 * kg;
#pragma unroll
        for (int r = 0; r < 4; ++r) { lg[r] = a0[r]; lg[16 + r] = a1[r]; lg[32 + r] = a2[r]; }
        asm volatile("s_waitcnt lgkmcnt(0)" ::: "memory");
        if (lane < 16) {
            const LAS float* l = (const LAS float*)(lds + L5_LG) + wave * 768 + lane * 48;
            float gl[4]; int gs = 0; float gm;
#pragma unroll
            for (int i = 0; i < 4; ++i) gl[i] = l[i] + p.b_rg[i];
            gm = gl[0];
#pragma unroll
            for (int i = 1; i < 4; ++i) if (gl[i] > gm) { gm = gl[i]; gs = i; }
            float gsum = 0.f;
#pragma unroll
            for (int i = 0; i < 4; ++i) gsum += expf(gl[i] - gm);
            const float pg = 1.0f / gsum;
            float el[8]; float em = -3.0e38f;
#pragma unroll
            for (int i = 0; i < 8; ++i) { const float v = l[4 + 8 * gs + i] + p.b_re[8 * gs + i]; el[i] = v; em = fmaxf(em, v); }
            float pe[8]; float esum = 0.f;
#pragma unroll
            for (int i = 0; i < 8; ++i) { pe[i] = expf(el[i] - em); esum += pe[i]; }
            int i0 = 0; float p0 = pe[0];
#pragma unroll
            for (int i = 1; i < 8; ++i) if (pe[i] > p0) { p0 = pe[i]; i0 = i; }
            int i1 = -1; float p1 = -1.f;
#pragma unroll
            for (int i = 0; i < 8; ++i) if (i != i0 && pe[i] > p1) { p1 = pe[i]; i1 = i; }
            const float w0 = pg * p0 / (p0 + p1), w1 = pg * p1 / (p0 + p1);
            const int e0 = 8 * gs + i0, e1 = 8 * gs + i1;
            const unsigned lr0 = __hip_atomic_fetch_add(hist + e0, 1u, __ATOMIC_RELAXED, __HIP_MEMORY_SCOPE_WORKGROUP), lr1 = __hip_atomic_fetch_add(hist + e1, 1u, __ATOMIC_RELAXED, __HIP_MEMORY_SCOPE_WORKGROUP);
            LAS unsigned* tw = tokw + (wave * 16 + lane) * 6;
            tw[0] = (unsigned)e0; tw[1] = (unsigned)e1; tw[2] = lr0; tw[3] = lr1; tw[4] = __float_as_uint(w0); tw[5] = __float_as_uint(w1);
        }
    }
    __syncthreads();
    if (tid < 32) { unsigned* cnt = (unsigned*)(p.ws + WS_CTL) + CW_CNT; const unsigned hcount = hist[tid];
        hist[32 + tid] = hcount ? __hip_atomic_fetch_add(cnt + tid, hcount, __ATOMIC_RELAXED, __HIP_MEMORY_SCOPE_AGENT) : 0u; }
    __syncthreads();
    if (tid < 64) {
        const LAS unsigned* tw = tokw + tid * 6; const int tok = tokb + tid;
        const unsigned e0 = tw[0], e1 = tw[1], q0 = hist[32 + e0] + tw[2], q1 = hist[32 + e1] + tw[3];
        int* RT = (int*)(p.ws + WS_RTOK); RT[e0 * ECAP + q0] = tok; RT[e1 * ECAP + q1] = tok;
        u32x4* rec = (u32x4*)(p.ws + WS_REC) + (size_t)tok * 2;
        rec[0] = (u32x4){e0, e1, q0, q1}; rec[1] = (u32x4){tw[4], tw[5], 0u, 0u};
    }
    __syncthreads();
}
DI void expert_copy_item(const Params& p, int it, LAS float* scr, int lane) {
    const int e = it / 1536, r = it % 1536;
    bf16_t* WGU = (bf16_t*)(p.ws + WS_WGU); bf16_t* WDN = (bf16_t*)(p.ws + WS_WDN);
    if (r < 1024) { const int up = r >> 9, q = r & 511, kb = q >> 4, nb = q & 15, n0 = 32 * nb;
        const float* W = (up ? p.w_up : p.w_gate) + (size_t)e * DM * FF;
        transpose_tile(W, FF, 64 * kb, n0, WGU, DM, e * 1024 + (n0 >> 7) * 256 + (n0 & 127) + up * 128, 0, 32, scr, lane);
    } else { const int q = r - 1024, kb = q >> 6, nb = q & 63;
        transpose_tile(p.w_down + (size_t)e * FF * DM, DM, 64 * kb, 32 * nb, WDN, FF, e * DM + 32 * nb, 0, 32, scr, lane); }
}

struct MoeOrder {
    const LAS int* pref; const LAS int* cnt; int ntn, G, c;
    DI bool next(int i, pg8::Unit& u) const {
        const int L = i * G + c; const int total = pref[32] * ntn; if (L >= total) return false;
        const int tile = L / ntn, pnl = L - tile * ntn;
        int e = 0;
        for (int q = 1; q < 32; ++q) if (tile >= pref[q]) e = q;
        const int m = tile - pref[e];
        u.pm = tile; u.pn = e * ntn + pnl; u.ga = e * ECAP + m * 256; u.gn = cnt[e] - m * 256; return true;
    }
};
DI void moe_tables(const Params& p, LAS int* pref, LAS int* cntl, int tid) {
    if (tid == 0) { const unsigned* cnt = (const unsigned*)(p.ws + WS_CTL) + CW_CNT; int acc = 0;
        for (int e = 0; e < 32; ++e) { const int c = (int)__hip_atomic_load(cnt + e, __ATOMIC_RELAXED, __HIP_MEMORY_SCOPE_AGENT); pref[e] = acc; cntl[e] = c; acc += (c + 255) >> 8; }
        pref[32] = acc; }
    __syncthreads();
}

DI void phase8(const Params& p, const LAS int* pref, int lane, int gw, int NGW) {
    const float* MOD = (const float*)(p.ws + WS_MOD); const bf16_t* YB = (const bf16_t*)(p.ws + WS_YBUF);
    for (int m = gw; m < T; m += NGW) {
        const int b = m >> 11; const float* gt2 = MOD + b * 12288 + 5 * 2048;
        const u32x4* rec = (const u32x4*)(p.ws + WS_REC) + (size_t)m * 2;
        const u32x4 r0 = rec[0], r1 = rec[1];
        const size_t row0 = (size_t)(pref[r0.x] * 256 + (int)r0.z), row1 = (size_t)(pref[r0.y] * 256 + (int)r0.w);
        const float w0 = __uint_as_float(r1.x), w1 = __uint_as_float(r1.y);
        float y[32]; float s = 0.f;
#pragma unroll
        for (int j = 0; j < 4; ++j) { const int col = 8 * (lane + 64 * j);
            const u32x4 a = *(const u32x4*)(YB + row0 * DM + col), c = *(const u32x4*)(YB + row1 * DM + col);
            y[8 * j + 0] = w0 * bflo(a.x) + w1 * bflo(c.x); y[8 * j + 1] = w0 * bfhi(a.x) + w1 * bfhi(c.x);
            y[8 * j + 2] = w0 * bflo(a.y) + w1 * bflo(c.y); y[8 * j + 3] = w0 * bfhi(a.y) + w1 * bfhi(c.y);
            y[8 * j + 4] = w0 * bflo(a.z) + w1 * bflo(c.z); y[8 * j + 5] = w0 * bfhi(a.z) + w1 * bfhi(c.z);
            y[8 * j + 6] = w0 * bflo(a.w) + w1 * bflo(c.w); y[8 * j + 7] = w0 * bfhi(a.w) + w1 * bfhi(c.w);
#pragma unroll
            for (int e = 0; e < 8; ++e) s += y[8 * j + e] * y[8 * j + e]; }
        const float rs = 1.0f / sqrtf(wave_sum(s) * (1.0f / DM) + EPS);
#pragma unroll
        for (int j = 0; j < 4; ++j) { const int col = 8 * (lane + 64 * j);
#pragma unroll
            for (int q = 0; q < 2; ++q) { float* op = p.out + (size_t)m * DM + col + 4 * q;
                const f32x4 x1 = *(const f32x4*)op, g = *(const f32x4*)(p.g_ffn_post + col + 4 * q), gt = *(const f32x4*)(gt2 + col + 4 * q);
                f32x4 o;
                o.x = x1.x + gt.x * (y[8 * j + 4 * q + 0] * rs * g.x); o.y = x1.y + gt.y * (y[8 * j + 4 * q + 1] * rs * g.y);
                o.z = x1.z + gt.z * (y[8 * j + 4 * q + 2] * rs * g.z); o.w = x1.w + gt.w * (y[8 * j + 4 * q + 3] * rs * g.w);
                *(f32x4*)op = o; } }
    }
}

constexpr int NWAVES = 8, NTHREADS = 512;
constexpr int LDS_GEMM = 131072, LDS_TAB = LDS_GEMM, LDS_BYTES = LDS_GEMM + 1024;
constexpr int N_PHASES = 12;
#ifndef MK_N_LAUNCHES
#define MK_N_LAUNCHES 1
#endif

DI moba::BlockRef attn_ref(const Params& p, int bh, int qb) {
    const int b = bh >> 3, h = bh & 7;
    const bf16_t* PROJ = (const bf16_t*)(p.ws + WS_B);
    moba::BlockRef r;
    r.Q = PROJ + (size_t)(b * SEQ + qb * 256) * PP + C_Q + h * HD;
    r.K = PROJ + (size_t)(b * SEQ) * PP + C_K + h * HD;
    r.V = PROJ + (size_t)(b * SEQ) * PP + C_V + h * HD;
    r.O = (bf16_t*)(p.ws + WS_A) + (size_t)(b * SEQ + qb * 256) * DM + h * HD;
    r.KM = (const bf16_t*)(p.ws + WS_KMEAN) + (size_t)bh * 8 * HD;
    r.P0 = qb * 256;
    return r;
}

typedef const __attribute__((address_space(4))) Params* KParams;
#if defined(__HIP_DEVICE_COMPILE__)
#define LOADP() KParams kq_ = kp_; asm volatile("" : "+s"(kq_)); const Params p = *kq_
#else
#define LOADP() const Params p = p_unused
#endif
__global__ void __launch_bounds__(NTHREADS, 2) fwd_kernel(Params p_unused) {
#if defined(__HIP_DEVICE_COMPILE__)
    const KParams kp_ = (KParams)__builtin_amdgcn_kernarg_segment_ptr();
#else
    const Params* kp_ = &p_unused;
#endif
    extern __shared__ __attribute__((aligned(16))) unsigned char lds_raw[];
    LAS unsigned char* lds = (LAS unsigned char*)lds_raw;
    const int bid = blockIdx.x, G = gridDim.x, NGW = G * NWAVES;
#define IDS() int tid_ = threadIdx.x; asm volatile("" : "+v"(tid_)); const int tid = tid_, lane = tid & 63, wave = __builtin_amdgcn_readfirstlane(tid >> 6), gw = bid * NWAVES + wave; (void)lane; (void)gw; (void)wave
    const int vcu = (G % 8 == 0) ? (bid % 8) * (G / 8) + bid / 8 : bid;
    const int lo = kp_->ph_lo, hi = kp_->ph_hi;
#ifdef ONLY
#define IN(k) ((k) == ONLY && lo <= (k) && (k) < hi)
#else
#define IN(k) (lo <= (k) && (k) < hi)
#endif
#define SEAM(k) do { if (IN(k) && IN((k) + 1)) { cg::this_grid().sync(); } } while (0)

    if (IN(0)) { LOADP(); IDS(); phase0(p, lds, tid, lane, wave, bid, G); }
    SEAM(0);
    if (IN(1)) { LOADP(); IDS(); phase_u1(p, lane, gw, NGW); }
    SEAM(1);
    if (IN(2)) { LOADP(); IDS();
        pg8::Gemm g{(const bf16_t*)(p.ws + WS_A), (const bf16_t*)(p.ws + WS_WIN), DM, nullptr};
        pg8::StaticOrder S; S.init(T, NPROJ, G, bid);
        pg8::EpiProj E{(bf16_t*)(p.ws + WS_B), (float*)(p.ws + WS_BA)};
        pg8::gemm_phase<pg8::EpiProj, pg8::StaticOrder, true, false>(lds, g, S, E);
    }
    SEAM(2);
    if (IN(3)) { LOADP(); IDS();
        for (int it = gw; it < 1024; it += NGW) rotary_item(p, it, lane);
        for (int it = bid; it < 64 * 32; it += G) dn::prep_chunk(p, lds, it, tid, lane, wave);
    }
    SEAM(3);
    if (IN(4)) { LOADP(); IDS();
#ifndef NO_ATTN
        for (int L = vcu; L < 256; L += G) {
            const int bh = L >> 2, x = L & 3;
            moba::Seam S;
            const moba::BlockRef r0 = attn_ref(p, bh, x), r1 = attn_ref(p, bh, 7 - x);
            moba::prime(r0, (char*)lds_raw, S);
            moba::block(r0, r1, (char*)lds_raw, S);
            moba::block(r1, r1, (char*)lds_raw, S);
        }
#endif
#ifndef NO_RECUR
        if (wave == 0) { for (int it = bid; it < 256; it += G) dn::recur(p, (it & 7) + 8 * (it >> 5), (it >> 3) & 3, lane); }
#endif
    }
    SEAM(4);
    if (IN(5)) { LOADP(); IDS(); phase_dn_final(p, lane, gw, NGW); }
    SEAM(5);
    if (IN(6)) { LOADP(); IDS();
        pg8::Gemm g{(const bf16_t*)(p.ws + WS_A), (const bf16_t*)(p.ws + WS_WMD), DM, nullptr};
        pg8::StaticOrder S; S.init(T, DM, G, bid);
        pg8::EpiMerged E{(const bf16_t*)(p.ws + WS_B), (bf16_t*)(p.ws + WS_MERGED)};
        pg8::gemm_phase<pg8::EpiMerged, pg8::StaticOrder, true, false>(lds, g, S, E);
    }
    SEAM(6);
    if (IN(7)) { LOADP(); IDS();
        pg8::Gemm g{(const bf16_t*)(p.ws + WS_MERGED), (const bf16_t*)(p.ws + WS_WOUT), DM, nullptr};
        pg8::StaticOrder S; S.init(T, DM, G, bid);
        pg8::EpiStore E{(bf16_t*)(p.ws + WS_OUTMIX), DM, 8};
        pg8::gemm_phase<pg8::EpiStore, pg8::StaticOrder, true, false>(lds, g, S, E);
    }
    SEAM(7);
    if (IN(8)) { LOADP(); IDS();
        for (int it = bid; it < T / 64; it += G) phase5_item(p, lds, it, tid, lane, wave);
        LAS float* scr = (LAS float*)(lds + 16384 + wave * 8448);
        for (int it = gw; it < 32 * 1536; it += NGW) expert_copy_item(p, it, scr, lane);
    }
    SEAM(8);
    LAS int* pref = (LAS int*)(lds + LDS_TAB); LAS int* cntl = pref + 64;
    if (IN(9)) { LOADP(); IDS();
        moe_tables(p, pref, cntl, tid);
        pg8::Gemm g{(const bf16_t*)(p.ws + WS_A), (const bf16_t*)(p.ws + WS_WGU), DM, (const int*)(p.ws + WS_RTOK)};
        MoeOrder S{pref, cntl, 4, G, bid};
        pg8::EpiGU E{(bf16_t*)(p.ws + WS_H)};
        pg8::gemm_phase<pg8::EpiGU, MoeOrder, true, true>(lds, g, S, E);
    }
    SEAM(9);
    if (IN(10)) { LOADP(); IDS();
        if (!IN(9)) moe_tables(p, pref, cntl, tid);
        pg8::Gemm g{(const bf16_t*)(p.ws + WS_H), (const bf16_t*)(p.ws + WS_WDN), FF, nullptr};
        MoeOrder S{pref, cntl, 8, G, bid};
        pg8::EpiStore E{(bf16_t*)(p.ws + WS_YBUF), DM, 8};
        pg8::gemm_phase<pg8::EpiStore, MoeOrder, true, false>(lds, g, S, E);
    }
    SEAM(10);
    if (IN(11)) { LOADP(); IDS();
        if (!IN(10)) moe_tables(p, pref, cntl, tid);
        phase8(p, pref, lane, gw, NGW);
    }
#undef IN
#undef SEAM
}

extern "C" void kernel_launch(void* const* d_in, const int* in_sizes, int n_in, void* d_out, int out_size, void* d_ws, size_t ws_size, hipStream_t stream) {
    static int grid = 0;
    if (grid == 0) {
        if (n_in != 24 || in_sizes[0] != T * DM || out_size != T * DM || ws_size < WS_END) {
            fprintf(stderr, "kernel_launch: unexpected shapes (n_in %d, in0 %d, out %d, ws %zu); nothing launched\n", n_in, n_in > 0 ? in_sizes[0] : -1, out_size, ws_size); grid = -1; return; }
        int dev = 0, cus = 0, per_cu = 0;
        hipGetDevice(&dev); hipDeviceGetAttribute(&cus, hipDeviceAttributeMultiprocessorCount, dev);
        if (hipFuncSetAttribute((const void*)fwd_kernel, hipFuncAttributeMaxDynamicSharedMemorySize, LDS_BYTES) != hipSuccess) { fprintf(stderr, "kernel_launch: hipFuncSetAttribute failed\n"); grid = -1; return; }
        if (hipOccupancyMaxActiveBlocksPerMultiprocessor(&per_cu, (const void*)fwd_kernel, NTHREADS, LDS_BYTES) != hipSuccess || per_cu < 1) { fprintf(stderr, "kernel_launch: occupancy query says %d blocks per CU\n", per_cu); grid = -1; return; }
        (void)hipGetLastError();
        grid = cus;
    }
    if (grid < 0) return;
    hipMemsetAsync((char*)d_ws + WS_CTL, 0, CTL_ZERO_BYTES, stream);
    Params p{};
    p.x = (const float*)d_in[0]; p.c = (const float*)d_in[1]; p.pos = (const int*)d_in[2]; p.w_ada = (const float*)d_in[3]; p.b_ada = (const float*)d_in[4];
    p.g_mix_pre = (const float*)d_in[5]; p.g_mix_post = (const float*)d_in[6]; p.g_ffn_pre = (const float*)d_in[7]; p.g_ffn_post = (const float*)d_in[8];
    p.w_in = (const float*)d_in[9]; p.conv_w = (const float*)d_in[10]; p.a_log = (const float*)d_in[11]; p.dt_bias = (const float*)d_in[12]; p.dn_gain = (const float*)d_in[13];
    p.w_bm = (const float*)d_in[14]; p.w_bd = (const float*)d_in[15]; p.w_out = (const float*)d_in[16];
    p.w_rg = (const float*)d_in[17]; p.b_rg = (const float*)d_in[18]; p.w_re = (const float*)d_in[19]; p.b_re = (const float*)d_in[20];
    p.w_gate = (const float*)d_in[21]; p.w_up = (const float*)d_in[22]; p.w_down = (const float*)d_in[23];
    p.out = (float*)d_out; p.ws = (unsigned char*)d_ws;
    for (int li = 0; li < MK_N_LAUNCHES; ++li) {
        p.ph_lo = (MK_N_LAUNCHES == 1) ? 0 : li; p.ph_hi = (MK_N_LAUNCHES == 1) ? N_PHASES : li + 1;
        void* args[] = {&p};
        hipError_t e = hipLaunchCooperativeKernel((const void*)fwd_kernel, dim3(grid), dim3(NTHREADS), args, LDS_BYTES, stream);
        if (e != hipSuccess) { fprintf(stderr, "kernel_launch: cooperative launch failed: %s (grid %d)\n", hipGetErrorString(e), grid); break; }
    }
}
```

```cpp
#include <hip/hip_runtime.h>
#include <hip/hip_cooperative_groups.h>
#include <cstdio>
#include <cstdint>
namespace cg = cooperative_groups;

#define LAS __attribute__((address_space(3)))
#define DI __device__ __forceinline__
typedef unsigned short bf16_t;
typedef short bf16x8 __attribute__((ext_vector_type(8)));
typedef short s16x4 __attribute__((ext_vector_type(4)));
typedef float f32x2 __attribute__((ext_vector_type(2)));
typedef float f32x4 __attribute__((ext_vector_type(4)));
typedef float f32x16 __attribute__((ext_vector_type(16)));
typedef unsigned u32x2 __attribute__((ext_vector_type(2)));
typedef unsigned u32x4 __attribute__((ext_vector_type(4)));
typedef __bf16 bf16x2_t __attribute__((ext_vector_type(2)));

constexpr int NB = 8, SEQ = 2048, T = NB * SEQ, DM = 2048;
constexpr int NHEAD = 8, HD = 128;
constexpr int PP = 11264;
constexpr int NPROJ = 11520;
constexpr int C_Q = 0, C_K = 1024, C_V = 2048, C_DN = 3072, C_Z = 6144, C_GA = 7168, C_GB = 9216;
constexpr int NEXP = 32, FF = 512, ECAP = 16384;
constexpr float EPS = 1e-6f;

constexpr size_t MiB = 1u << 20;
constexpr size_t WS_CTL = 0, CTL_ZERO_BYTES = 1 * MiB;
constexpr size_t WS_MOD = 1 * MiB;
constexpr size_t WS_CS = 2 * MiB;
constexpr size_t WS_KMEAN = 4 * MiB;
constexpr size_t WS_WR = 4 * MiB + 512 * 1024;
constexpr size_t WS_BA = 5 * MiB;
constexpr size_t WS_REC = 6 * MiB;
constexpr size_t WS_RTOK = 7 * MiB;
constexpr size_t WS_WMD = 10 * MiB;
constexpr size_t WS_WOUT = 18 * MiB;
constexpr size_t WS_A = 26 * MiB;
constexpr size_t WS_B = 90 * MiB;
constexpr size_t WS_C = 442 * MiB;
constexpr size_t WS_D = 588 * MiB;
constexpr size_t WS_END = 652 * MiB;
constexpr size_t WS_OUTMIX = WS_B, WS_WGU = WS_B + 128 * MiB, WS_WDN = WS_B + 256 * MiB, WS_YBUF = WS_B;
constexpr size_t WS_WIN = WS_C, WS_DNP = WS_C, WS_MERGED = WS_C, WS_H = WS_C + 64 * MiB;
constexpr int CW_CNT = 64;
constexpr int CW_BAR = 4096;
constexpr int DN_U = 0, DN_W = 16384, DN_QD = 32768, DN_KT = 49152, DN_QK = 65536, DN_SC = 73728, DN_STRIDE = 73984;

struct Params {
    const float* x; const float* c; const int* pos; const float* w_ada; const float* b_ada;
    const float* g_mix_pre; const float* g_mix_post; const float* g_ffn_pre; const float* g_ffn_post;
    const float* w_in; const float* conv_w; const float* a_log; const float* dt_bias; const float* dn_gain;
    const float* w_bm; const float* w_bd; const float* w_out;
    const float* w_rg; const float* b_rg; const float* w_re; const float* b_re;
    const float* w_gate; const float* w_up; const float* w_down;
    float* out; unsigned char* ws;
    int ph_lo, ph_hi;
};

DI unsigned cvtpk(float lo, float hi) { f32x2 v = {lo, hi}; bf16x2_t b = __builtin_convertvector(v, bf16x2_t); return __builtin_bit_cast(unsigned, b); }
DI float bflo(unsigned w) { return __uint_as_float(w << 16); }
DI float bfhi(unsigned w) { return __uint_as_float(w & 0xffff0000u); }
DI float bf2f(bf16_t b) { return __uint_as_float((unsigned)b << 16); }
DI bf16_t f2bf(float f) { return (bf16_t)(cvtpk(f, 0.f) & 0xffffu); }
DI float wave_sum(float v) {
#pragma unroll
    for (int o = 1; o < 64; o <<= 1) v += __shfl_xor(v, o);
    return v;
}
DI float sigmoidf_(float x) { return __builtin_amdgcn_rcpf(1.f + __expf(-x)); }
DI float siluf_(float x) { return x * __builtin_amdgcn_rcpf(1.f + __expf(-x)); }
DI float rsqrt_(float x) { return __builtin_amdgcn_rsqf(x); }
DI float siluf_acc(float x) { return x / (1.f + expf(-x)); }
constexpr float SCALE_Q = 0.08838834764831845f;
DI int perm16(int p) { return (p & 3) | ((p & 4) << 1) | ((p & 8) >> 1); }
DI int crow(int r, int hi) { return (r & 3) + 8 * (r >> 2) + 4 * hi; }
#define MFMA32(a, b, c) __builtin_amdgcn_mfma_f32_32x32x16_bf16((a), (b), (c), 0, 0, 0)
#define MFMA16(a, b, c) __builtin_amdgcn_mfma_f32_16x16x32_bf16((a), (b), (c), 0, 0, 0)

namespace pg8 {
constexpr int BM = 256, BK = 64, HALF = 128, HTB = HALF * BK * 2, STAGE_BYTES = 8 * HTB, NXCD = 8, WGM = 8;
DI int lds_byte(int r, int c) { const int st = (r >> 4) * 2 + (c >> 5), rr = r & 15, cc = c & 31, ob = rr * 64 + cc * 2; return st * 1024 + (ob ^ (((ob >> 9) & 1) << 5)); }
DI void stage_rc(int b, int& R, int& C) { const int st = b / 1024, sb = b % 1024, swz = sb ^ (((sb >> 9) & 1) << 5); R = (st >> 1) * 16 + swz / 64; C = (st & 1) * 32 + (swz % 64) / 2; }
DI int perm32(int rho) { const int n = rho >> 4, i = rho & 15; return 8 * (i >> 2) + 4 * n + (i & 3); }

struct Unit { int pm, pn, ga, gn; };
struct Gemm { const bf16_t* A; const bf16_t* Bt; int K; const int* gidx; };

struct StaticOrder {
    int nM, nN, nwg, G, c;
    DI void init(int M, int N, int G_, int c_) { nM = M / BM; nN = N / BM; nwg = nM * nN; G = G_; c = c_; }
    DI bool next(int i, Unit& u) const {
        const long L = (long)i * G + c; if (L >= nwg) return false;
        int wgid = (int)L; { const int q = nwg / NXCD, r = nwg % NXCD, xcd = wgid % NXCD, off = wgid / NXCD; wgid = (xcd < r ? xcd * (q + 1) : r * (q + 1) + (xcd - r) * q) + off; }
        const int nig = WGM * nN, gid = wgid / nig, fm = gid * WGM, gsz = (nM - fm) < WGM ? (nM - fm) : WGM;
        u.pm = fm + ((wgid % nig) % gsz); u.pn = (wgid % nig) / gsz; u.ga = 0; u.gn = 0; return true;
    }
};

typedef f32x4 Acc[2][2][4][2];

template <class Epi, class Sched, bool ALIGN_EPI, bool GATHER>
DI void gemm_phase(LAS unsigned char* lds, const Gemm g, const Sched& S, const Epi& E) {
    const int tid = threadIdx.x, wid = __builtin_amdgcn_readfirstlane(tid >> 6), lane = tid & 63, wr = wid >> 2, wc = wid & 3, fr = lane & 15, fq = lane >> 4;
    const int K = g.K, nt = K / BK;
    unsigned voffA[2], voffB[2]; int gR[2], gC[2];
#pragma unroll
    for (int i = 0; i < 2; ++i) { int R, C; stage_rc(tid * 16 + i * 8192, R, C); const int Rb = (R & ~31) + perm32(R & 31);
        voffA[i] = (unsigned)(R * K + C) * 2u; voffB[i] = (unsigned)(Rb * K + C) * 2u; gR[i] = R; gC[i] = C; }
    const size_t kstep = (size_t)(BK * 2);
    const size_t hstep = (size_t)HALF * K * 2;
    const size_t tstep = 2 * hstep;
    const unsigned ldsw = (unsigned)wid * 1024u;
    const int aoff = lds_byte(wr * 64 + fr, fq * 8), boff = lds_byte(wc * 32 + fr, fq * 8);
#define PG8_SA(b, h) (((b) * 2 + (h)) * HTB)
#define PG8_SB(b, h) ((4 + (b) * 2 + (h)) * HTB)
#define PG8_STAGE(bufoff, gbase, voff) do { _Pragma("unroll") for (int _i = 0; _i < 2; ++_i) \
        __builtin_amdgcn_global_load_lds((const unsigned*)((const char*)(gbase) + (voff)[_i]), (LAS unsigned*)(lds + (bufoff) + ldsw + _i * 8192), 16, 0, 0); } while (0)
#define PG8_LDA(dst, b, h) do { _Pragma("unroll") for (int m = 0; m < 4; ++m) _Pragma("unroll") for (int k = 0; k < 2; ++k) dst[m][k] = *(const LAS bf16x8*)(lds + PG8_SA(b, h) + aoff + m * 2048 + k * 1024); } while (0)
#define PG8_LDB(dst, b, h) do { _Pragma("unroll") for (int n = 0; n < 2; ++n) _Pragma("unroll") for (int k = 0; k < 2; ++k) dst[n][k] = *(const LAS bf16x8*)(lds + PG8_SB(b, h) + boff + n * 2048 + k * 1024); } while (0)
#define PG8_MMA(ai, bj, At, Bt) do { __builtin_amdgcn_s_setprio(1); _Pragma("unroll") for (int m = 0; m < 4; ++m) _Pragma("unroll") for (int n = 0; n < 2; ++n) _Pragma("unroll") for (int k = 0; k < 2; ++k) \
        acc[ai][bj][m][n] = __builtin_amdgcn_mfma_f32_16x16x32_bf16(Bt[n][k], At[m][k], acc[ai][bj][m][n], 0, 0, 0); __builtin_amdgcn_s_setprio(0); } while (0)
#define PG8_WAIT_V(n) asm volatile("s_waitcnt vmcnt(" #n ")" ::: "memory")
#define PG8_WAIT_L(n) asm volatile("s_waitcnt lgkmcnt(" #n ")" ::: "memory")
#define PG8_BAR __builtin_amdgcn_s_barrier()
#define PG8_SCHED __builtin_amdgcn_sched_barrier(0)
    Unit cur, nxt; int ui = 0;
    if (!S.next(0, cur)) return;
    Acc acc;
#pragma unroll
    for (int a = 0; a < 2; ++a)
#pragma unroll
        for (int b = 0; b < 2; ++b)
#pragma unroll
            for (int m = 0; m < 4; ++m)
#pragma unroll
                for (int n = 0; n < 2; ++n) acc[a][b][m][n] = (f32x4){0.f, 0.f, 0.f, 0.f};
    bf16x8 At[4][2], B0[2][2], B1[2][2];
    unsigned vA0[2], vA1[2];
#define PG8_SET_VOFF(u) do { if constexpr (GATHER) { _Pragma("unroll") for (int _i = 0; _i < 2; ++_i) { \
                const int _r0 = gR[_i], _r1 = HALF + gR[_i]; \
                const int _t0 = _r0 < (u).gn ? g.gidx[(u).ga + _r0] : 0, _t1 = _r1 < (u).gn ? g.gidx[(u).ga + _r1] : 0; \
                vA0[_i] = (unsigned)(_t0 * K + gC[_i]) * 2u; vA1[_i] = (unsigned)(_t1 * K + gC[_i]) * 2u; } \
        } else { vA0[0] = voffA[0]; vA0[1] = voffA[1]; vA1[0] = voffA[0] + (unsigned)hstep; vA1[1] = voffA[1] + (unsigned)hstep; } } while (0)
    PG8_SET_VOFF(cur);
    const char* cA = GATHER ? (const char*)g.A : (const char*)g.A + (size_t)cur.pm * tstep; const char* cB = (const char*)g.Bt + (size_t)cur.pn * tstep;
    PG8_STAGE(PG8_SB(0, 0), cB, voffB); PG8_STAGE(PG8_SB(0, 1), cB + hstep, voffB); PG8_STAGE(PG8_SA(0, 0), cA, vA0); PG8_STAGE(PG8_SA(0, 1), cA, vA1);
    if (wr == 1) PG8_BAR;
    PG8_WAIT_V(2); PG8_BAR;
    PG8_STAGE(PG8_SB(1, 0), cB + kstep, voffB); PG8_STAGE(PG8_SA(1, 0), cA + kstep, vA0); PG8_STAGE(PG8_SB(1, 1), cB + hstep + kstep, voffB);
    PG8_WAIT_V(6); PG8_BAR;
    for (;;) {
        const bool has_next = S.next(ui + 1, nxt);
        const char* nA = GATHER ? (const char*)g.A : (has_next ? (const char*)g.A + (size_t)nxt.pm * tstep : cA);
        const char* nB = has_next ? (const char*)g.Bt + (size_t)nxt.pn * tstep : cB;
#define PG8_KTRIP(t) do { \
            const bool last = (t == nt - 2); \
            const char* a1 = cA + (size_t)(t + 1) * kstep; \
            const char* a2 = last ? nA : cA + (size_t)(t + 2) * kstep; const char* b2 = last ? nB : cB + (size_t)(t + 2) * kstep; \
            const char* a3 = a2 + kstep; const char* b3 = b2 + kstep; \
            PG8_LDB(B0, 0, 0); PG8_LDB(B1, 0, 1); PG8_SCHED; PG8_LDA(At, 0, 0); PG8_STAGE(PG8_SA(1, 1), a1, vA1); \
            PG8_WAIT_V(8); PG8_WAIT_L(0); PG8_BAR; PG8_MMA(0, 0, At, B0); PG8_MMA(0, 1, At, B1); PG8_BAR; PG8_SCHED; \
            if constexpr (GATHER) { if (last && has_next) PG8_SET_VOFF(nxt); } \
            PG8_LDA(At, 0, 1); PG8_STAGE(PG8_SB(0, 0), b2, voffB); PG8_STAGE(PG8_SB(0, 1), b2 + hstep, voffB); PG8_STAGE(PG8_SA(0, 0), a2, vA0); \
            PG8_WAIT_V(8); PG8_WAIT_L(0); PG8_BAR; PG8_MMA(1, 0, At, B0); PG8_MMA(1, 1, At, B1); PG8_BAR; PG8_SCHED; \
            PG8_LDB(B0, 1, 0); PG8_LDB(B1, 1, 1); PG8_SCHED; PG8_LDA(At, 1, 0); PG8_STAGE(PG8_SA(0, 1), a2, vA1); \
            PG8_WAIT_V(8); PG8_WAIT_L(0); PG8_BAR; PG8_MMA(0, 0, At, B0); PG8_MMA(0, 1, At, B1); PG8_BAR; PG8_SCHED; \
            PG8_LDA(At, 1, 1); PG8_STAGE(PG8_SB(1, 0), b3, voffB); PG8_STAGE(PG8_SB(1, 1), b3 + hstep, voffB); PG8_STAGE(PG8_SA(1, 0), a3, vA0); \
            PG8_WAIT_V(8); PG8_WAIT_L(0); PG8_BAR; PG8_MMA(1, 0, At, B0); PG8_MMA(1, 1, At, B1); PG8_BAR; PG8_SCHED; \
        } while (0)
        if constexpr (Epi::HAS_MID) {
            for (int t = 0; t < (nt >> 1); t += 2) PG8_KTRIP(t);
            E.mid(acc, cur, wr, wc, fr, fq);
            for (int t = (nt >> 1); t < nt; t += 2) PG8_KTRIP(t);
        } else {
            for (int t = 0; t < nt; t += 2) PG8_KTRIP(t);
        }
#undef PG8_KTRIP
        if constexpr (ALIGN_EPI) { if (wr == 0) PG8_BAR; }
        E(acc, cur, wr, wc, fr, fq);
        if (!has_next) break;
#pragma unroll
        for (int a = 0; a < 2; ++a)
#pragma unroll
            for (int b = 0; b < 2; ++b)
#pragma unroll
                for (int m = 0; m < 4; ++m)
#pragma unroll
                    for (int n = 0; n < 2; ++n) acc[a][b][m][n] = (f32x4){0.f, 0.f, 0.f, 0.f};
        cur = nxt; cA = nA; cB = nB; ++ui;
        if constexpr (ALIGN_EPI) { if (wr == 1) PG8_BAR; }
    }
    PG8_WAIT_V(0);
    if constexpr (!ALIGN_EPI) { if (wr == 0) PG8_BAR; }
    PG8_BAR;
#undef PG8_SET_VOFF
#undef PG8_SA
#undef PG8_SB
#undef PG8_STAGE
#undef PG8_LDA
#undef PG8_LDB
#undef PG8_MMA
#undef PG8_WAIT_V
#undef PG8_WAIT_L
#undef PG8_BAR
#undef PG8_SCHED
}

struct EpiStore {
    static constexpr bool HAS_MID = false;
    bf16_t* O; int ldc; int ntn;
    DI void operator()(const Acc& acc, const Unit& u, int wr, int wc, int fr, int fq) const {
        const int row0 = u.pm * BM + wr * 64 + fr, col0 = (u.pn % ntn) * BM + wc * 32 + 8 * fq;
#pragma unroll
        for (int ai = 0; ai < 2; ++ai)
#pragma unroll
            for (int m = 0; m < 4; ++m) { bf16_t* rowp = O + (size_t)(row0 + ai * HALF + m * 16) * ldc + col0;
#pragma unroll
                for (int bj = 0; bj < 2; ++bj) { const f32x4 v0 = acc[ai][bj][m][0], v1 = acc[ai][bj][m][1];
                    u32x4 w; w.x = cvtpk(v0[0], v0[1]); w.y = cvtpk(v0[2], v0[3]); w.z = cvtpk(v1[0], v1[1]); w.w = cvtpk(v1[2], v1[3]);
                    *(u32x4*)(rowp + bj * HALF) = w; } }
    }
};
struct EpiProj {
    static constexpr bool HAS_MID = false;
    bf16_t* O; float* BA;
    DI void operator()(const Acc& acc, const Unit& u, int wr, int wc, int fr, int fq) const {
        const int row0 = u.pm * BM + wr * 64 + fr;
        if (u.pn < 44) {
            const int col0 = u.pn * BM + wc * 32 + 8 * fq;
#pragma unroll
            for (int ai = 0; ai < 2; ++ai)
#pragma unroll
                for (int m = 0; m < 4; ++m) { bf16_t* rowp = O + (size_t)(row0 + ai * HALF + m * 16) * PP + col0;
#pragma unroll
                    for (int bj = 0; bj < 2; ++bj) { const f32x4 v0 = acc[ai][bj][m][0], v1 = acc[ai][bj][m][1];
                        u32x4 w; w.x = cvtpk(v0[0], v0[1]); w.y = cvtpk(v0[2], v0[3]); w.z = cvtpk(v1[0], v1[1]); w.w = cvtpk(v1[2], v1[3]);
                        *(u32x4*)(rowp + bj * HALF) = w; } }
        } else if (wc == 0 && fq < 2) {
#pragma unroll
            for (int ai = 0; ai < 2; ++ai)
#pragma unroll
                for (int m = 0; m < 4; ++m) { float* rowp = BA + (size_t)(row0 + ai * HALF + m * 16) * 16 + 8 * fq;
                    *(f32x4*)rowp = acc[ai][0][m][0]; *(f32x4*)(rowp + 4) = acc[ai][0][m][1]; }
        }
    }
};
struct EpiMerged {
    static constexpr bool HAS_MID = true;
    const bf16_t* P; bf16_t* O;
    DI void mid(Acc& acc, const Unit& u, int wr, int wc, int fr, int fq) const {
        const unsigned ro = (unsigned)((u.pm * BM + wr * 64 + fr) * PP + u.pn * BM + wc * 32 + 8 * fq);
#pragma unroll
        for (int ai = 0; ai < 2; ++ai)
#pragma unroll
            for (int m = 0; m < 4; ++m) {
#pragma unroll
                for (int bj = 0; bj < 2; ++bj) { const unsigned off = ro + (unsigned)((ai * HALF + m * 16) * PP + bj * HALF);
                    const u32x4 a = *(const u32x4*)(P + off + C_GA), b = *(const u32x4*)(P + off + C_GB);
                    float ga[8] = {bflo(a.x), bfhi(a.x), bflo(a.y), bfhi(a.y), bflo(a.z), bfhi(a.z), bflo(a.w), bfhi(a.w)};
                    float gb[8] = {bflo(b.x), bfhi(b.x), bflo(b.y), bfhi(b.y), bflo(b.z), bfhi(b.z), bflo(b.w), bfhi(b.w)};
#pragma unroll
                    for (int n = 0; n < 2; ++n)
#pragma unroll
                        for (int j = 0; j < 4; ++j) { const float r = (1.f + __expf(-gb[4 * n + j])) * __builtin_amdgcn_rcpf(1.f + __expf(-ga[4 * n + j])); acc[ai][bj][m][n][j] *= r; } }
                asm volatile("" ::: "memory"); __builtin_amdgcn_sched_barrier(0); }
    }
    DI void operator()(const Acc& acc, const Unit& u, int wr, int wc, int fr, int fq) const {
        const unsigned ro = (unsigned)((u.pm * BM + wr * 64 + fr) * PP + u.pn * BM + wc * 32 + 8 * fq);
        const unsigned oo = (unsigned)((u.pm * BM + wr * 64 + fr) * DM + u.pn * BM + wc * 32 + 8 * fq);
#pragma unroll
        for (int ai = 0; ai < 2; ++ai)
#pragma unroll
            for (int m = 0; m < 4; ++m) {
#pragma unroll
                for (int bj = 0; bj < 2; ++bj) { const u32x4 b = *(const u32x4*)(P + ro + (unsigned)((ai * HALF + m * 16) * PP + bj * HALF) + C_GB);
                    float gb[8] = {bflo(b.x), bfhi(b.x), bflo(b.y), bfhi(b.y), bflo(b.z), bfhi(b.z), bflo(b.w), bfhi(b.w)};
                    float v[8];
#pragma unroll
                    for (int n = 0; n < 2; ++n)
#pragma unroll
                        for (int j = 0; j < 4; ++j) v[4 * n + j] = acc[ai][bj][m][n][j] * __builtin_amdgcn_rcpf(1.f + __expf(-gb[4 * n + j]));
                    u32x4 w; w.x = cvtpk(v[0], v[1]); w.y = cvtpk(v[2], v[3]); w.z = cvtpk(v[4], v[5]); w.w = cvtpk(v[6], v[7]);
                    *(u32x4*)(O + oo + (unsigned)((ai * HALF + m * 16) * DM + bj * HALF)) = w; }
                asm volatile("" ::: "memory"); __builtin_amdgcn_sched_barrier(0); }
    }
};
struct EpiGU {
    static constexpr bool HAS_MID = false;
    bf16_t* H;
    DI void operator()(const Acc& acc, const Unit& u, int wr, int wc, int fr, int fq) const {
        const int row0 = u.pm * BM + wr * 64 + fr, col0 = (u.pn & 3) * HALF + wc * 32 + 8 * fq;
#pragma unroll
        for (int ai = 0; ai < 2; ++ai)
#pragma unroll
            for (int m = 0; m < 4; ++m) { float v[8];
#pragma unroll
                for (int n = 0; n < 2; ++n)
#pragma unroll
                    for (int j = 0; j < 4; ++j) v[4 * n + j] = siluf_(acc[ai][0][m][n][j]) * acc[ai][1][m][n][j];
                u32x4 w; w.x = cvtpk(v[0], v[1]); w.y = cvtpk(v[2], v[3]); w.z = cvtpk(v[4], v[5]); w.w = cvtpk(v[6], v[7]);
                *(u32x4*)(H + (size_t)(row0 + ai * HALF + m * 16) * FF + col0) = w; }
    }
};
}

namespace moba {
constexpr int NW = 8, QBLK = 32, KVBLK = 64, QB = NW * QBLK, D = 128;
constexpr int RS = PP;
constexpr int RSO = DM;
constexpr float SCALE = 0.08838834764831845f;
constexpr float THR = 8.f;
constexpr int SHM_V = KVBLK * D * 2, SHM_K = KVBLK * D * 2;
constexpr int LDS_BYTES = 2 * SHM_V + 2 * SHM_K + NW * 64 * 4;
typedef bf16_t bf16;
#define KSWZ(row, colB) ((row) * 256 + ((colB) ^ (((row) & 7) << 4)))
#define SBAR() __builtin_amdgcn_sched_barrier(0)
DI int v_st(int k, int c) { const int kk = (k & ~0xC) | ((k & 4) << 1) | ((k & 8) >> 1); return ((kk >> 3) * 4 + (c >> 5)) * 512 + ((kk & 7) * 32 + (c & 31)) * 2; }
DI int v_rd_base(int lane) { return ((lane & 3) << 3) | (((lane >> 2) & 3) << 6) | (((lane >> 4) & 1) << 5) | (((lane >> 5) & 1) << 8); }
constexpr int v_rd_off(int d0, int ks, int half) { return d0 * 512 + ks * 4096 + half * 2048; }
DI bf16x8 load8(const bf16* p) { return *reinterpret_cast<const bf16x8*>(p); }
DI void mask_tile(f32x16& p0, f32x16& p1, int dq) {
    const float NEG = -__builtin_inff();
#pragma unroll
    for (int r = 0; r < 16; ++r) {
        const int c = (r & 3) + 8 * (r >> 2);
        if (dq - c < 0) p0[r] = NEG;
        if (dq - c - 32 < 0) p1[r] = NEG;
    }
}
DI void mask_all(f32x16& p0, f32x16& p1, bool kill) {
    const float NEG = -__builtin_inff();
#pragma unroll
    for (int r = 0; r < 16; ++r) { if (kill) p0[r] = NEG; if (kill) p1[r] = NEG; }
}
DI void partialSM(f32x16& p0, f32x16& p1, float& m_reg, float& mn, float& alpha) {
    float pmax = p0[0];
#pragma unroll
    for (int r = 1; r < 16; ++r) pmax = fmaxf(pmax, p0[r]);
#pragma unroll
    for (int r = 0; r < 16; ++r) pmax = fmaxf(pmax, p1[r]);
    { auto rr = __builtin_amdgcn_permlane32_swap(__float_as_uint(pmax), __float_as_uint(pmax), false, false);
      pmax = fmaxf(__uint_as_float(rr[0]), __uint_as_float(rr[1])); }
    constexpr float C2 = 1.4426950408889634f * SCALE;
    if (__builtin_expect(__all((pmax - m_reg) * SCALE <= THR), 1)) { mn = m_reg; alpha = 1.f; }
    else { mn = fmaxf(m_reg, pmax); alpha = __builtin_amdgcn_exp2f((m_reg - mn) * C2); m_reg = mn; }
    const float mnL = -mn * C2;
#pragma unroll
    for (int r = 0; r < 16; ++r) p0[r] = fmaf(p0[r], C2, mnL);
#pragma unroll
    for (int r = 0; r < 16; ++r) p1[r] = fmaf(p1[r], C2, mnL);
#pragma unroll
    for (int r = 0; r < 16; ++r) p0[r] = __builtin_amdgcn_exp2f(p0[r]);
}
DI void finishSM(f32x16& p0, f32x16& p1, float alpha, float& l_reg, bf16x8& pa0, bf16x8& pa1, bf16x8& pa2, bf16x8& pa3) {
#pragma unroll
    for (int r = 0; r < 16; ++r) p1[r] = __builtin_amdgcn_exp2f(p1[r]);
    float ps = 0;
#pragma unroll
    for (int r = 0; r < 16; ++r) ps += p0[r];
#pragma unroll
    for (int r = 0; r < 16; ++r) ps += p1[r];
    { auto rr = __builtin_amdgcn_permlane32_swap(__float_as_uint(ps), __float_as_uint(ps), false, false);
      ps = __uint_as_float(rr[0]) + __uint_as_float(rr[1]); }
    l_reg = l_reg * alpha + ps;
#define PK4(P, B_, OUT) do { unsigned a0 = cvtpk(P[B_+0], P[B_+1]), a1 = cvtpk(P[B_+2], P[B_+3]);                          \
        unsigned b0 = cvtpk(P[B_+4], P[B_+5]), b1 = cvtpk(P[B_+6], P[B_+7]);                                             \
        auto r0 = __builtin_amdgcn_permlane32_swap(a0, b0, false, false); auto r1 = __builtin_amdgcn_permlane32_swap(a1, b1, false, false); \
        u32x4 w = {r0[0], r1[0], r0[1], r1[1]}; OUT = __builtin_bit_cast(bf16x8, w); } while (0)
    PK4(p0, 0, pa0); PK4(p0, 8, pa1); PK4(p1, 0, pa2); PK4(p1, 8, pa3);
#undef PK4
}
template <int KB>
DI void qkt(f32x16& p0, f32x16& p1, const char* K_lds, int r32, int hi, const bf16x8* qr) {
    p0 = f32x16{}; p1 = f32x16{};
    const char* kb[4];
#pragma unroll
    for (int dd = 0; dd < 4; ++dd) kb[dd] = K_lds + KB * SHM_K + KSWZ(r32, (dd * 16 + hi * 8) * 2);
#pragma unroll
    for (int d0 = 0; d0 < 8; ++d0) { const char* a = kb[d0 & 3] + (d0 >> 2) * 128;
        bf16x8 b0 = *reinterpret_cast<const bf16x8*>(a);
        bf16x8 b1 = *reinterpret_cast<const bf16x8*>(a + 32 * 256);
        p0 = MFMA32(b0, qr[d0], p0);
        p1 = MFMA32(b1, qr[d0], p1); }
}
template <int VB>
DI void pv_tile(f32x16* o, int vb0, bf16x8 pa0, bf16x8 pa1, bf16x8 pa2, bf16x8 pa3) {
#define TRRD(dst, off) asm volatile("ds_read_b64_tr_b16 %0, %1 offset:%2" : "=&v"(dst) : "v"(vb0), "i"(off) : "memory")
#define PV_D0(d0) do { s16x4 l0, l1, l2, l3, h0, h1, h2, h3; constexpr int b_ = VB * SHM_V + v_rd_off(d0, 0, 0); \
        TRRD(l0, b_); TRRD(h0, b_ + 2048); TRRD(l1, b_ + 4096); TRRD(h1, b_ + 6144); TRRD(l2, b_ + 8192); TRRD(h2, b_ + 10240); TRRD(l3, b_ + 12288); TRRD(h3, b_ + 14336); \
        asm volatile("s_waitcnt lgkmcnt(0)" ::: "memory"); SBAR();   \
        o[d0] = MFMA32(pa0, ((bf16x8){l0[0], l0[1], l0[2], l0[3], h0[0], h0[1], h0[2], h0[3]}), o[d0]);   \
        o[d0] = MFMA32(pa1, ((bf16x8){l1[0], l1[1], l1[2], l1[3], h1[0], h1[1], h1[2], h1[3]}), o[d0]);   \
        o[d0] = MFMA32(pa2, ((bf16x8){l2[0], l2[1], l2[2], l2[3], h2[0], h2[1], h2[2], h2[3]}), o[d0]);   \
        o[d0] = MFMA32(pa3, ((bf16x8){l3[0], l3[1], l3[2], l3[3], h3[0], h3[1], h3[2], h3[3]}), o[d0]); } while (0)
    PV_D0(0); PV_D0(1); PV_D0(2); PV_D0(3);
#undef PV_D0
#undef TRRD
}

struct BlockRef { const bf16* Q; const bf16* K; const bf16* V; bf16* O; const bf16* KM; int P0; };
struct Seam { bf16x8 qr[8]; bf16x8 st_v0, st_v1, st_k0, st_k1; };
#define VMW() asm volatile("s_waitcnt vmcnt(0)" ::: "memory")
#define VMWN(n) asm volatile("s_waitcnt vmcnt(%0)" :: "i"(n) : "memory")
#define SLOAD_H(Kp, Vp, k0) do { const bf16* kb__ = (Kp) + (size_t)(k0) * RS; const bf16* vb__ = (Vp) + (size_t)(k0) * RS;              \
                         S.st_v0 = load8(vb__ + goff); S.st_v1 = load8(vb__ + 32 * RS + goff);              \
                         S.st_k0 = load8(kb__ + goff); S.st_k1 = load8(kb__ + 32 * RS + goff); } while (0)
#define SWRITE_HK(bf) do { *(bf16x8*)(K_lds + (bf) * SHM_K + kws) = S.st_k0; *(bf16x8*)(K_lds + (bf) * SHM_K + kws + 32 * 256) = S.st_k1; } while (0)
#define SWRITE_HV(bf) do { *(bf16x8*)(V_lds + (bf) * SHM_V + vst0) = S.st_v0; *(bf16x8*)(V_lds + (bf) * SHM_V + vst1) = S.st_v1; } while (0)
#define SWRITE_H(bf) do { SWRITE_HV(bf); SWRITE_HK(bf); } while (0)
DI void prime(const BlockRef& cur, char* lds, Seam& S) {
    const int tid = threadIdx.x, wid = __builtin_amdgcn_readfirstlane(tid >> 6), lane = tid & 63, r32 = lane & 31, hi = lane >> 5;
    const int sr = tid >> 4, sc = (tid & 15) * 8, kws = KSWZ(sr, sc * 2); char* K_lds = lds + 2 * SHM_V;
    const unsigned goff = (unsigned)(sr * RS + sc), qoff = (unsigned)(r32 * RS + hi * 8);
    { const bf16* qb__ = cur.Q + (size_t)(wid * QBLK) * RS;
#pragma unroll
    for (int d0 = 0; d0 < 8; ++d0) S.qr[d0] = load8(qb__ + qoff + d0 * 16); }
    SLOAD_H(cur.K, cur.V, 0); VMW(); SWRITE_HK(0);
    __syncthreads();
}
DI void block(const BlockRef& cur, const BlockRef& nxt, char* lds, Seam& S) {
    int tid_ = threadIdx.x; asm volatile("" : "+v"(tid_));
    const int tid = tid_, wid = __builtin_amdgcn_readfirstlane(tid >> 6), lane = tid & 63, r32 = lane & 31, hi = lane >> 5;
    const int NT = (cur.P0 + QB) / KVBLK;
    const int qb = cur.P0 / QB;
    const int qlo = cur.P0 + wid * QBLK, qm = qlo + r32 - 4 * hi;
    char* V_lds = lds; char* K_lds = lds + 2 * SHM_V;
    float* ws = (float*)(lds + 2 * SHM_V + 2 * SHM_K) + wid * 64; float* li_l = ws, * al_l = ws + 32;
    unsigned selmask = (1u << qb) - 1u;
    if (qb > 3) {
        f32x16 g0 = f32x16{};
#pragma unroll
        for (int d0 = 0; d0 < 8; ++d0) {
            bf16x8 a = (bf16x8){0, 0, 0, 0, 0, 0, 0, 0};
            if (r32 < 8) a = load8(cur.KM + r32 * D + d0 * 16 + hi * 8);
            g0 = MFMA32(a, S.qr[d0], g0);
        }
        float gt[8];
#pragma unroll
        for (int j = 0; j < 4; ++j) { const float mine = g0[j], oth = __shfl_xor(mine, 32); gt[j] = hi ? oth : mine; gt[4 + j] = hi ? mine : oth; }
        selmask = 0u;
#pragma unroll
        for (int i = 0; i < 8; ++i) { int rank = 0;
#pragma unroll
            for (int j = 0; j < 8; ++j) { if (j != i) { const bool beats = (gt[j] > gt[i]) || (gt[j] == gt[i] && j < i); rank += (j < qb && beats) ? 1 : 0; } }
            if (i < qb && rank < 3) selmask |= (1u << i); }
    }
    float m_reg = -1e30f, l_reg = 0; f32x16 o[4] = {};
    const int sr = tid >> 4, sc = (tid & 15) * 8, vst0 = v_st(sr, sc), vst1 = v_st(32 + sr, sc), kws = KSWZ(sr, sc * 2);
    const unsigned goff = (unsigned)(sr * RS + sc), qoff = (unsigned)(r32 * RS + hi * 8);
    const int vb0 = (int)(uintptr_t)V_lds + v_rd_base(lane);
    const bf16* Kh = cur.K; const bf16* Vh = cur.V;
#define RESC(a) do { if (__any((a) < 1.f)) { if (hi == 0) al_l[r32] = (a); asm volatile("s_waitcnt lgkmcnt(0)" ::: "memory");              \
                     _Pragma("unroll") for (int d_ = 0; d_ < 4; ++d_) _Pragma("unroll") for (int r = 0; r < 16; ++r) o[d_][r] *= al_l[crow(r, hi)]; } } while (0)
#define KBASE(t) ((t) * KVBLK)
#define MASKT(P0_, P1_, t) do { const int kb_ = KBASE(t); const int kblk_ = (t) >> 2; \
        if (kblk_ < qb) { if (qb > 3) mask_all(P0_, P1_, ((selmask >> kblk_) & 1u) == 0u); } \
        else if (kb_ + KVBLK - 1 > qlo) mask_tile(P0_, P1_, qm - kb_); } while (0)
    constexpr int NQL = 8;
#define SEAM_K0() do { VMWN(NQL); SWRITE_HK(0); SBAR(); } while (0)
    f32x16 pA0, pA1, pB0, pB1; float mnA, mnB, alA, alB; bf16x8 pa0, pa1, pa2, pa3;
    SWRITE_HV(0); SBAR();
    if (NT > 1) { SLOAD_H(Kh, Vh, KBASE(1)); }
    SBAR(); qkt<0>(pA0, pA1, K_lds, r32, hi, S.qr);
    MASKT(pA0, pA1, 0); partialSM(pA0, pA1, m_reg, mnA, alA);
    if (NT > 1) { VMW(); SWRITE_H(1); }
    __syncthreads();
#define HALF_STEP(PX0, PX1, mnX, alX, PY0, PY1, alY, t, KB, VB, SB) do {                                                      \
        SBAR(); qkt<KB>(PX0, PX1, K_lds, r32, hi, S.qr);                                             \
        finishSM(PY0, PY1, alY, l_reg, pa0, pa1, pa2, pa3); SBAR();                                                           \
        if ((t) + 1 < NT) { SLOAD_H(Kh, Vh, KBASE((t) + 1)); SBAR(); }                                               \
        pv_tile<VB>(o, vb0, pa0, pa1, pa2, pa3); MASKT(PX0, PX1, (t)); partialSM(PX0, PX1, m_reg, mnX, alX);                                        \
        __syncthreads();                                                                                                      \
        if ((t) + 1 < NT) { VMW(); SWRITE_H(SB); }                                                                          \
        RESC(alX); __syncthreads(); } while (0)
    for (int t = 1; t + 1 < NT; t += 2) {
        HALF_STEP(pB0, pB1, mnB, alB, pA0, pA1, alA, t, 1, 0, 0);
        HALF_STEP(pA0, pA1, mnA, alA, pB0, pB1, alB, t + 1, 0, 1, 1);
    }
    const bool even = (NT & 1) == 0;
    if (even) { SBAR(); qkt<1>(pB0, pB1, K_lds, r32, hi, S.qr); SBAR(); }
    { SLOAD_H(nxt.K, nxt.V, 0); SBAR();
      const bf16* qb__ = nxt.Q + (size_t)(wid * QBLK) * RS;
#pragma unroll
      for (int d0 = 0; d0 < 8; ++d0) S.qr[d0] = load8(qb__ + qoff + d0 * 16); }
    SBAR();
    finishSM(pA0, pA1, alA, l_reg, pa0, pa1, pa2, pa3); SBAR();
    pv_tile<0>(o, vb0, pa0, pa1, pa2, pa3);
    if (even) { MASKT(pB0, pB1, NT - 1); partialSM(pB0, pB1, m_reg, mnB, alB); __syncthreads(); RESC(alB);
        finishSM(pB0, pB1, alB, l_reg, pa0, pa1, pa2, pa3); SBAR(); pv_tile<1>(o, vb0, pa0, pa1, pa2, pa3); }
    SBAR(); SEAM_K0();
    if (hi == 0) li_l[r32] = l_reg; asm volatile("s_waitcnt lgkmcnt(0)" ::: "memory");
    float rli[16];
#pragma unroll
    for (int r = 0; r < 16; ++r) rli[r] = __builtin_amdgcn_rcpf(li_l[crow(r, hi)]);
    bf16* Ow = cur.O + (size_t)(wid * QBLK) * RSO;
    const unsigned ooff = (unsigned)(4 * hi * RSO + r32);
#pragma unroll
    for (int r = 0; r < 16; ++r) { const int orow0 = (r & 3) + 8 * (r >> 2);
#pragma unroll
        for (int d0 = 0; d0 < 4; ++d0) { const float v = o[d0][r] * rli[r];
            const float vn = __shfl_xor(v, 1);
            if ((r32 & 1) == 0) *(unsigned*)(Ow + ooff + (unsigned)(orow0 * RSO + d0 * 32)) = cvtpk(v, vn); } }
    __syncthreads();
#undef RESC
#undef KBASE
#undef MASKT
#undef SEAM_K0
#undef HALF_STEP
}
#undef VMW
#undef VMWN
#undef SLOAD_H
#undef SWRITE_HK
#undef SWRITE_HV
#undef SWRITE_H
#undef KSWZ
#undef SBAR
}

namespace dn {
#ifndef DBL
#define DBL -1
#endif
#define REPS(k) for (int rep_ = 0; rep_ < ((DBL == (k)) ? 2 : 1); ++rep_)
constexpr int L_QB = 0, L_KB = 17408, L_KT = 34816, L_VT = 53248, L_LM = 71680, L_TB = 89088, L_GV = 107520;
constexpr int RQ = 272, LMS = 68, RT = 144;

struct Raw { unsigned v[33]; float br, ar; };
DI void prep_load(const Params& p, int item, Raw& R, int lane, int wave) {
    const int bh = item >> 5, n = item & 31, b = bh >> 3, h = bh & 7, i0 = wave * 8, c0 = 2 * lane;
    const bf16_t* PROJ = (const bf16_t*)(p.ws + WS_B);
#pragma unroll
    for (int seg = 0; seg < 3; ++seg)
#pragma unroll
        for (int jj = 0; jj < 11; ++jj) {
            const int sp = n * 64 + i0 - 3 + jj;
            unsigned v = 0u;
            if (sp >= 0) v = *(const unsigned*)(PROJ + (size_t)(b * SEQ + sp) * PP + C_DN + seg * 1024 + h * HD + c0);
            R.v[seg * 11 + jj] = v;
        }
    R.br = 0.f; R.ar = 0.f;
    if (wave == 0) { const float* BA = (const float*)(p.ws + WS_BA); const size_t t = (size_t)(b * SEQ + n * 64 + lane);
        R.br = BA[t * 16 + h]; R.ar = BA[t * 16 + 8 + h]; }
}
#define DN_BAR() do { asm volatile("s_waitcnt lgkmcnt(0)" ::: "memory"); __builtin_amdgcn_s_barrier(); asm volatile("" ::: "memory"); } while (0)
DI void prep_chunk(const Params& p, LAS unsigned char* lds, int item, int nitem, Raw& R, int tid, int lane, int wave) {
    asm volatile("" : "+v"(tid), "+v"(lane));
    const int bh = item >> 5, n = item & 31, b = bh >> 3, h = bh & 7;
    unsigned char* rec = p.ws + WS_DNP + (size_t)item * DN_STRIDE;
    LAS float* LM = (LAS float*)(lds + L_LM);
    LAS float* GV = (LAS float*)(lds + L_GV);
    REPS(31) {
        const int i0 = wave * 8, c0 = 2 * lane;
#pragma unroll
        for (int seg = 0; seg < 3; ++seg) {
            const int chan = seg * 1024 + h * HD + c0;
            float w0[4], w1[4];
#pragma unroll
            for (int j = 0; j < 4; ++j) { const f32x2 wv = *(const f32x2*)(p.conv_w + j * 3072 + chan); w0[j] = wv.x; w1[j] = wv.y; }
            float r0[11], r1[11];
#pragma unroll
            for (int jj = 0; jj < 11; ++jj) { const unsigned v = R.v[seg * 11 + jj]; r0[jj] = bflo(v); r1[jj] = bfhi(v); }
            float ya[8], yb[8];
#pragma unroll
            for (int i = 0; i < 8; ++i) {
                float y0 = 0.f, y1 = 0.f;
#pragma unroll
                for (int j = 0; j < 4; ++j) { y0 += w0[j] * r0[i + j]; y1 += w1[j] * r1[i + j]; }
                y0 = siluf_(y0); y1 = siluf_(y1);
                if (seg < 2) {
                    const float ss = wave_sum(y0 * y0 + y1 * y1);
                    const float rn = (seg == 0 ? SCALE_Q : 1.0f) * rsqrt_(ss + EPS);
                    y0 *= rn; y1 *= rn;
                    *(LAS unsigned*)(lds + (seg == 0 ? L_QB : L_KB) + (i0 + i) * RQ + c0 * 2) = cvtpk(y0, y1);
                }
                ya[i] = y0; yb[i] = y1;
            }
            if (seg >= 1) {
                LAS unsigned char* tb = lds + (seg == 1 ? L_KT : L_VT) + c0 * RT + i0 * 2;
                u32x4 o0, o1;
                o0.x = cvtpk(ya[0], ya[1]); o0.y = cvtpk(ya[2], ya[3]); o0.z = cvtpk(ya[4], ya[5]); o0.w = cvtpk(ya[6], ya[7]);
                o1.x = cvtpk(yb[0], yb[1]); o1.y = cvtpk(yb[2], yb[3]); o1.z = cvtpk(yb[4], yb[5]); o1.w = cvtpk(yb[6], yb[7]);
                *(LAS u32x4*)tb = o0; *(LAS u32x4*)(tb + RT) = o1;
            }
        }
        if (wave == 0) {
            const float br = R.br, ar = R.ar;
            const float beta = sigmoidf_(br);
            const float xs = ar + p.dt_bias[h];
            const float sp = xs > 20.f ? xs : log1pf(expf(xs));
            float g = -expf(p.a_log[h]) * sp;
#pragma unroll
            for (int o = 1; o < 64; o <<= 1) { const float u = __shfl_up(g, o); if (lane >= o) g += u; }
            const float g63 = __shfl(g, 63);
            GV[lane] = g; GV[64 + lane] = beta; GV[128 + lane] = expf(g); GV[192 + lane] = expf(g63 - g);
        }
    }
    if (nitem >= 0) prep_load(p, nitem, R, lane, wave);
    DN_BAR();
    REPS(32) {
        const int mt = wave >> 1, nt = wave & 1, r = lane & 31, hi = lane >> 5;
        if (mt < 2) {
            const LAS unsigned char* Ab = lds + L_KB + (32 * nt + r) * RQ, * Bb = lds + L_QB + (32 * mt + r) * RQ;
            f32x16 acc = f32x16{};
#pragma unroll
            for (int ks = 0; ks < 8; ++ks) acc = MFMA32(*(const LAS bf16x8*)(Ab + (16 * ks + 8 * hi) * 2), *(const LAS bf16x8*)(Bb + (16 * ks + 8 * hi) * 2), acc);
            const int i = 32 * mt + r; const float Gi = GV[i];
            float v[16];
#pragma unroll
            for (int q = 0; q < 16; ++q) { const int j = 32 * nt + crow(q, hi); v[q] = i >= j ? acc[q] * __expf(Gi - GV[j]) : 0.f; }
            u32x4* QKf = (u32x4*)(rec + DN_QK) + ((mt * 4 + 2 * nt) * 64 + lane);
            u32x4 o0, o1;
            o0.x = cvtpk(v[0], v[1]); o0.y = cvtpk(v[2], v[3]); o0.z = cvtpk(v[4], v[5]); o0.w = cvtpk(v[6], v[7]);
            o1.x = cvtpk(v[8], v[9]); o1.y = cvtpk(v[10], v[11]); o1.z = cvtpk(v[12], v[13]); o1.w = cvtpk(v[14], v[15]);
            QKf[0] = o0; QKf[64] = o1;
        } else {
            const LAS unsigned char* Ab = lds + L_KB + (32 * (mt - 2) + r) * RQ, * Bb = lds + L_KB + (32 * nt + r) * RQ;
            f32x16 acc = f32x16{};
#pragma unroll
            for (int ks = 0; ks < 8; ++ks) acc = MFMA32(*(const LAS bf16x8*)(Ab + (16 * ks + 8 * hi) * 2), *(const LAS bf16x8*)(Bb + (16 * ks + 8 * hi) * 2), acc);
            const int j = 32 * nt + r; const float Gj = GV[j];
#pragma unroll
            for (int q = 0; q < 16; ++q) { const int row = 32 * (mt - 2) + crow(q, hi);
                const float e = row > j ? GV[64 + row] * __expf(GV[row] - Gj) : 0.f;
                LM[row * LMS + j] = acc[q] * e; }
        }
    }
    DN_BAR();
    REPS(33) {
        float Lr[64];
#pragma unroll
        for (int jq = 0; jq < 16; ++jq) { const f32x4 l = *(const LAS f32x4*)(LM + lane * LMS + 4 * jq); Lr[4 * jq] = l.x; Lr[4 * jq + 1] = l.y; Lr[4 * jq + 2] = l.z; Lr[4 * jq + 3] = l.w; }
        float xv[8];
#pragma unroll
        for (int q = 0; q < 8; ++q) xv[q] = (lane == 8 * wave + q) ? 1.0f : 0.0f;
#pragma unroll
        for (int j = 0; j < 63; ++j) {
#pragma unroll
            for (int q = 0; q < 8; ++q) { const float xj = __int_as_float(__builtin_amdgcn_readlane(__float_as_int(xv[q]), j)); xv[q] -= Lr[j] * xj; }
        }
        float t1[8], t2[8];
#pragma unroll
        for (int q = 0; q < 8; ++q) { const float bc = GV[64 + 8 * wave + q]; t1[q] = xv[q] * bc; t2[q] = t1[q] * GV[128 + 8 * wave + q]; }
        u32x4 o1, o2;
        o1.x = cvtpk(t1[0], t1[1]); o1.y = cvtpk(t1[2], t1[3]); o1.z = cvtpk(t1[4], t1[5]); o1.w = cvtpk(t1[6], t1[7]);
        o2.x = cvtpk(t2[0], t2[1]); o2.y = cvtpk(t2[2], t2[3]); o2.z = cvtpk(t2[4], t2[5]); o2.w = cvtpk(t2[6], t2[7]);
        *(LAS u32x4*)(lds + L_TB + lane * RT + wave * 16) = o1; *(LAS u32x4*)(lds + L_TB + 64 * RT + lane * RT + wave * 16) = o2;
    }
    DN_BAR();
    REPS(34) {
        const int r = lane & 31, hi = lane >> 5;
#pragma unroll
        for (int half = 0; half < 2; ++half) {
            const int tix = wave * 2 + half;
            f32x16 acc = f32x16{};
            if (tix < 8) {
                const int mt = tix >> 2, nt = tix & 3;
                const LAS unsigned char* Ab = lds + L_TB + (32 * mt + r) * RT + 16 * hi, * Bb = lds + L_VT + (32 * nt + r) * RT + 16 * hi;
#pragma unroll
                for (int ks = 0; ks < 4; ++ks) acc = MFMA32(*(const LAS bf16x8*)(Ab + 32 * ks), *(const LAS bf16x8*)(Bb + 32 * ks), acc);
                u32x4* Uf = (u32x4*)(rec + DN_U) + ((mt * 4 + nt) * 64 + lane) * 2;
                u32x4 o0, o1;
                o0.x = cvtpk(acc[0], acc[1]); o0.y = cvtpk(acc[2], acc[3]); o0.z = cvtpk(acc[4], acc[5]); o0.w = cvtpk(acc[6], acc[7]);
                o1.x = cvtpk(acc[8], acc[9]); o1.y = cvtpk(acc[10], acc[11]); o1.z = cvtpk(acc[12], acc[13]); o1.w = cvtpk(acc[14], acc[15]);
                Uf[0] = o0; Uf[1] = o1;
            } else {
                const int ntp = (tix - 8) >> 1, mt = tix & 1;
                const LAS unsigned char* Ab = lds + L_KT + (32 * ntp + r) * RT + 16 * hi, * Bb = lds + L_TB + 64 * RT + (32 * mt + r) * RT + 16 * hi;
#pragma unroll
                for (int ks = 0; ks < 4; ++ks) acc = MFMA32(*(const LAS bf16x8*)(Ab + 32 * ks), *(const LAS bf16x8*)(Bb + 32 * ks), acc);
                u32x4* Wf = (u32x4*)(rec + DN_W) + ((mt * 8 + 2 * ntp) * 64 + lane);
                u32x4 o0, o1;
                o0.x = cvtpk(-acc[0], -acc[1]); o0.y = cvtpk(-acc[2], -acc[3]); o0.z = cvtpk(-acc[4], -acc[5]); o0.w = cvtpk(-acc[6], -acc[7]);
                o1.x = cvtpk(-acc[8], -acc[9]); o1.y = cvtpk(-acc[10], -acc[11]); o1.z = cvtpk(-acc[12], -acc[13]); o1.w = cvtpk(-acc[14], -acc[15]);
                Wf[0] = o0; Wf[64] = o1;
            }
        }
#pragma unroll
        for (int rep = 0; rep < 2; ++rep) {
            const int f = tid + 512 * rep, mt = f >> 9, ks = (f >> 6) & 7, fr = f & 31, fh = (f >> 5) & 1, i = 32 * mt + fr;
            const LAS unsigned char* qp = lds + L_QB + i * RQ + (16 * ks + 4 * fh) * 2;
            const u32x2 a = *(const LAS u32x2*)qp, c = *(const LAS u32x2*)(qp + 16);
            const float e = GV[128 + i];
            u32x4 o; o.x = cvtpk(bflo(a.x) * e, bfhi(a.x) * e); o.y = cvtpk(bflo(a.y) * e, bfhi(a.y) * e); o.z = cvtpk(bflo(c.x) * e, bfhi(c.x) * e); o.w = cvtpk(bflo(c.y) * e, bfhi(c.y) * e);
            ((u32x4*)(rec + DN_QD))[f] = o;
        }
#pragma unroll
        for (int rep = 0; rep < 2; ++rep) {
            const int f = tid + 512 * rep, a4 = f >> 8, ks = (f >> 6) & 3, fr = f & 31, fh = (f >> 5) & 1, d = 32 * a4 + fr;
            const LAS unsigned char* kp = lds + L_KT + d * RT + (16 * ks + 4 * fh) * 2;
            const u32x2 a = *(const LAS u32x2*)kp, c = *(const LAS u32x2*)(kp + 16);
            const LAS float* eg = GV + 192 + 16 * ks + 4 * fh;
            u32x4 o; o.x = cvtpk(bflo(a.x) * eg[0], bfhi(a.x) * eg[1]); o.y = cvtpk(bflo(a.y) * eg[2], bfhi(a.y) * eg[3]);
            o.z = cvtpk(bflo(c.x) * eg[8], bfhi(c.x) * eg[9]); o.w = cvtpk(bflo(c.y) * eg[10], bfhi(c.y) * eg[11]);
            ((u32x4*)(rec + DN_KT))[f] = o;
        }
        if (tid == 0) *(float*)(rec + DN_SC) = GV[128 + 63];
    }
    DN_BAR();
}

DI bf16x8 pack_step(const f32x16& x, int s) {
    u32x4 w;
    if (s == 0) { w.x = cvtpk(x[0], x[1]); w.y = cvtpk(x[2], x[3]); w.z = cvtpk(x[4], x[5]); w.w = cvtpk(x[6], x[7]); }
    else { w.x = cvtpk(x[8], x[9]); w.y = cvtpk(x[10], x[11]); w.z = cvtpk(x[12], x[13]); w.w = cvtpk(x[14], x[15]); }
    return __builtin_bit_cast(bf16x8, w);
}

constexpr int RB = 57344;
DI void recur(const Params& p, LAS unsigned char* lds, int bh, int tid, int lane, int wave) {
    asm volatile("" : "+v"(tid), "+v"(lane));
    const int r = lane & 31, hi = lane >> 5, b = bh >> 3, h = bh & 7;
    const unsigned char* rec0 = p.ws + WS_DNP + (size_t)(bh * 32) * DN_STRIDE;
    if (wave >= 4) {
        const int lt = tid - 256;
        u32x4 v[14];
        {   const u32x4* src = (const u32x4*)(rec0 + DN_W) + lt;
#pragma unroll
            for (int k = 0; k < 14; ++k) v[k] = src[k * 256];
#pragma unroll
            for (int k = 0; k < 14; ++k) *(LAS u32x4*)(lds + (k * 256 + lt) * 16) = v[k]; }
        DN_BAR();
        for (int n = 0; n < 32; ++n) {
            if (n + 1 < 32) { const u32x4* src = (const u32x4*)(rec0 + (size_t)(n + 1) * DN_STRIDE + DN_W) + lt;
#pragma unroll
                for (int k = 0; k < 14; ++k) v[k] = src[k * 256];
                LAS unsigned char* dst = lds + ((n + 1) & 1) * RB;
#pragma unroll
                for (int k = 0; k < 14; ++k) *(LAS u32x4*)(dst + (k * 256 + lt) * 16) = v[k]; }
            DN_BAR();
        }
    } else {
        const int slice = wave, dv0 = slice * 32;
        float* ODN = (float*)(p.ws + WS_D);
        f32x16 St[4];
#pragma unroll
        for (int a = 0; a < 4; ++a) St[a] = f32x16{};
        u32x4 un[2][2];
#pragma unroll
        for (int mt = 0; mt < 2; ++mt) { const u32x4* up = (const u32x4*)(rec0 + DN_U) + ((mt * 4 + slice) * 64 + lane) * 2; un[mt][0] = up[0]; un[mt][1] = up[1]; }
        DN_BAR();
        for (int n = 0; n < 32; ++n) {
            const unsigned char* rec = rec0 + (size_t)n * DN_STRIDE;
            const LAS unsigned char* buf = lds + (n & 1) * RB;
            const float eg = *(const float*)(rec + DN_SC);
            f32x16 Vn[2], O[2];
#pragma unroll
            for (int mt = 0; mt < 2; ++mt) { const u32x4 a = un[mt][0], c = un[mt][1];
                Vn[mt][0] = bflo(a.x); Vn[mt][1] = bfhi(a.x); Vn[mt][2] = bflo(a.y); Vn[mt][3] = bfhi(a.y); Vn[mt][4] = bflo(a.z); Vn[mt][5] = bfhi(a.z); Vn[mt][6] = bflo(a.w); Vn[mt][7] = bfhi(a.w);
                Vn[mt][8] = bflo(c.x); Vn[mt][9] = bfhi(c.x); Vn[mt][10] = bflo(c.y); Vn[mt][11] = bfhi(c.y); Vn[mt][12] = bflo(c.z); Vn[mt][13] = bfhi(c.z); Vn[mt][14] = bflo(c.w); Vn[mt][15] = bfhi(c.w); }
            if (n + 1 < 32) {
#pragma unroll
                for (int mt = 0; mt < 2; ++mt) { const u32x4* up = (const u32x4*)(rec + DN_STRIDE + DN_U) + ((mt * 4 + slice) * 64 + lane) * 2; un[mt][0] = up[0]; un[mt][1] = up[1]; } }
            bf16x8 Sf[8];
#pragma unroll
            for (int a = 0; a < 4; ++a) { Sf[2 * a] = pack_step(St[a], 0); Sf[2 * a + 1] = pack_step(St[a], 1); }
#pragma unroll
            for (int mt = 0; mt < 2; ++mt)
#pragma unroll
                for (int ks = 0; ks < 8; ++ks) Vn[mt] = MFMA32(*(const LAS bf16x8*)(buf + ((mt * 8 + ks) * 64 + lane) * 16), Sf[ks], Vn[mt]);
#pragma unroll
            for (int mt = 0; mt < 2; ++mt) { O[mt] = f32x16{};
#pragma unroll
                for (int ks = 0; ks < 8; ++ks) O[mt] = MFMA32(*(const LAS bf16x8*)(buf + 16384 + ((mt * 8 + ks) * 64 + lane) * 16), Sf[ks], O[mt]); }
            bf16x8 Vf[4];
#pragma unroll
            for (int mt = 0; mt < 2; ++mt) { Vf[2 * mt] = pack_step(Vn[mt], 0); Vf[2 * mt + 1] = pack_step(Vn[mt], 1); }
#pragma unroll
            for (int mt = 0; mt < 2; ++mt)
#pragma unroll
                for (int ks = 0; ks < 4; ++ks) O[mt] = MFMA32(*(const LAS bf16x8*)(buf + 49152 + ((mt * 4 + ks) * 64 + lane) * 16), Vf[ks], O[mt]);
#pragma unroll
            for (int a = 0; a < 4; ++a) {
                St[a] = St[a] * eg;
#pragma unroll
                for (int ks = 0; ks < 4; ++ks) St[a] = MFMA32(*(const LAS bf16x8*)(buf + 32768 + ((a * 4 + ks) * 64 + lane) * 16), Vf[ks], St[a]);
            }
            float* orow = ODN + (size_t)(b * SEQ + n * 64) * 1024 + h * HD + dv0 + r;
#pragma unroll
            for (int mt = 0; mt < 2; ++mt)
#pragma unroll
                for (int i = 0; i < 16; ++i) orow[(size_t)(32 * mt + crow(i, hi)) * 1024] = O[mt][i];
            DN_BAR();
        }
    }
}
}

DI void transpose_tile(const float* W, int N, int k0, int sn0, bf16_t* WT, int dpitch, int drow0, int dk0, int nvalid, LAS float* scr, int lane) {
#pragma unroll 8
    for (int i = 0; i < 32; ++i) { const int kk = 2 * i + (lane >> 5); scr[kk * 33 + (lane & 31)] = W[(size_t)(k0 + kk) * N + sn0 + (lane & 31)]; }
    asm volatile("s_waitcnt lgkmcnt(0)" ::: "memory");
    const int c = lane & 7;
#pragma unroll
    for (int j = 0; j < 4; ++j) { const int n = (lane >> 3) + 8 * j; const LAS float* s = scr + (8 * c) * 33 + n;
        u32x4 o; o.x = cvtpk(s[0 * 33], s[1 * 33]); o.y = cvtpk(s[2 * 33], s[3 * 33]); o.z = cvtpk(s[4 * 33], s[5 * 33]); o.w = cvtpk(s[6 * 33], s[7 * 33]);
        if (n < nvalid) *(u32x4*)(WT + (size_t)(drow0 + n) * dpitch + dk0 + k0 + 8 * c) = o; }
    asm volatile("s_waitcnt lgkmcnt(0)" ::: "memory");
}

DI void phase0(const Params& p, LAS unsigned char* lds, int tid, int lane, int wave, int bid, int G) {
    float* MOD = (float*)(p.ws + WS_MOD);
    if (bid < 192) {
        LAS float* sc = (LAS float*)lds;
        LAS float* red = (LAS float*)(lds + 65536);
        for (int i = tid; i < 8 * 2048; i += 512) { const int bb = i >> 11, k = i & 2047; sc[k * 8 + bb] = siluf_acc(p.c[i]); }
        __syncthreads();
        const int n0 = bid * 64;
        const int ksub = lane >> 4, cg = lane & 15;
        f32x4 acc[8];
#pragma unroll
        for (int bb = 0; bb < 8; ++bb) acc[bb] = (f32x4){0.f, 0.f, 0.f, 0.f};
        const float* wp = p.w_ada + (size_t)(wave * 256 + ksub) * 12288 + n0 + 4 * cg;
#pragma unroll 8
        for (int it = 0; it < 64; ++it) {
            const f32x4 wv = *(const f32x4*)(wp + (size_t)(4 * it) * 12288);
            const LAS float* sp = sc + (wave * 256 + 4 * it + ksub) * 8;
            const f32x4 s0 = *(const LAS f32x4*)sp, s1 = *(const LAS f32x4*)(sp + 4);
            acc[0] += wv * s0.x; acc[1] += wv * s0.y; acc[2] += wv * s0.z; acc[3] += wv * s0.w;
            acc[4] += wv * s1.x; acc[5] += wv * s1.y; acc[6] += wv * s1.z; acc[7] += wv * s1.w;
        }
#pragma unroll
        for (int bb = 0; bb < 8; ++bb) {
#pragma unroll
            for (int e = 0; e < 4; ++e) { float v = acc[bb][e]; v += __shfl_xor(v, 16); v += __shfl_xor(v, 32); acc[bb][e] = v; }
            if (ksub == 0) *(LAS f32x4*)(red + (wave * 8 + bb) * 64 + 4 * cg) = acc[bb];
        }
        __syncthreads();
        { const int bb = tid >> 6, col = tid & 63; float s = 0.f;
#pragma unroll
          for (int w = 0; w < 8; ++w) s += red[(w * 8 + bb) * 64 + col];
          MOD[bb * 12288 + n0 + col] = s + p.b_ada[n0 + col]; }
        __syncthreads();
    } else {
        f32x2* CS = (f32x2*)(p.ws + WS_CS);
        for (int i = (bid - 192) * 512 + tid; i < T * 16; i += (G - 192) * 512) {
            const int t = i >> 4, f = i & 15;
            const float inv = powf(500000.0f, -(float)f * (2.0f / 32.0f));
            const float ang = (float)p.pos[t] * inv;
            float sn, cs; sincosf(ang, &sn, &cs);
            CS[i] = (f32x2){cs, sn};
        }
    }
    LAS float* scr = (LAS float*)(lds + wave * 8448);
    const int gw = bid * 8 + wave, NGW = G * 8;
    bf16_t* WIN = (bf16_t*)(p.ws + WS_WIN); bf16_t* WMD = (bf16_t*)(p.ws + WS_WMD); bf16_t* WOUT = (bf16_t*)(p.ws + WS_WOUT); bf16_t* WR = (bf16_t*)(p.ws + WS_WR);
    constexpr int I_A = 32 * 224, I_B = 32 * 128, I_C = 32, I_M = 16 * 64, I_O = 32 * 64, I_RG = 32, I_RE = 32;
    constexpr int NITEMS = I_A + I_B + I_C + 2 * I_M + I_O + I_RG + I_RE;
    for (int it = gw; it < NITEMS; it += NGW) {
        int r = it;
        if (r < I_A) { const int kb = r / 224, nb = r % 224; transpose_tile(p.w_in, 11280, 64 * kb, 32 * nb, WIN, DM, 32 * nb, 0, 32, scr, lane); continue; } r -= I_A;
        if (r < I_B) { const int kb = r / 128, nb = r % 128; transpose_tile(p.w_in, 11280, 64 * kb, 7184 + 32 * nb, WIN, DM, 7168 + 32 * nb, 0, 32, scr, lane); continue; } r -= I_B;
        if (r < I_C) { transpose_tile(p.w_in, 11280, 64 * r, 7168, WIN, DM, 11264, 0, 16, scr, lane); continue; } r -= I_C;
        if (r < I_M) { const int kb = r / 64, nb = r % 64; transpose_tile(p.w_bm, DM, 64 * kb, 32 * nb, WMD, DM, 32 * nb, 0, 32, scr, lane); continue; } r -= I_M;
        if (r < I_M) { const int kb = r / 64, nb = r % 64; transpose_tile(p.w_bd, DM, 64 * kb, 32 * nb, WMD, DM, 32 * nb, 1024, 32, scr, lane); continue; } r -= I_M;
        if (r < I_O) { const int kb = r / 64, nb = r % 64; transpose_tile(p.w_out, DM, 64 * kb, 32 * nb, WOUT, DM, 32 * nb, 0, 32, scr, lane); continue; } r -= I_O;
        if (r < I_RG) {
            const int k = r * 64 + lane;
#pragma unroll
            for (int e = 0; e < 4; ++e) WR[e * DM + k] = f2bf(p.w_rg[k * 4 + e]);
#pragma unroll
            for (int e = 36; e < 48; ++e) WR[e * DM + k] = 0;
            continue; } r -= I_RG;
        { transpose_tile(p.w_re, 32, 64 * r, 0, WR, DM, 4, 0, 32, scr, lane); }
    }
    { u32x4* z = (u32x4*)(WIN + (size_t)11280 * DM); const int nz = 240 * DM * 2 / 16;
      for (int i = bid * 512 + tid; i < nz; i += G * 512) z[i] = (u32x4){0u, 0u, 0u, 0u}; }
}

DI void phase_u1(const Params& p, int lane, int gw, int NGW) {
    const float* MOD = (const float*)(p.ws + WS_MOD); bf16_t* U1 = (bf16_t*)(p.ws + WS_A);
    for (int m = gw; m < T; m += NGW) {
        const int b = m >> 11;
        const f32x4* xr = (const f32x4*)(p.x + (size_t)m * DM) + lane;
        f32x4 v[8]; float s = 0.f;
#pragma unroll
        for (int j = 0; j < 8; ++j) { v[j] = xr[64 * j]; s += (v[j].x * v[j].x + v[j].y * v[j].y) + (v[j].z * v[j].z + v[j].w * v[j].w); }
        const float rstd = rsqrt_(wave_sum(s) * (1.0f / DM) + EPS);
        const float* sh = MOD + b * 12288; const float* scl = sh + 2048;
        u32x2* o8 = (u32x2*)(U1 + (size_t)m * DM) + lane;
#pragma unroll
        for (int j = 0; j < 8; ++j) { const int col = 4 * (lane + 64 * j);
            const f32x4 g = *(const f32x4*)(p.g_mix_pre + col), a = *(const f32x4*)(scl + col), c = *(const f32x4*)(sh + col);
            const f32x4 u = (v[j] * rstd * g) * (a + 1.0f) + c;
            o8[64 * j] = (u32x2){cvtpk(u.x, u.y), cvtpk(u.z, u.w)}; }
    }
}

DI void rotary_item(const Params& p, int item, int lane) {
    const int which = item & 1, h = (item >> 1) & 7, blk = (item >> 4) & 7, b = item >> 7;
    bf16_t* PROJ = (bf16_t*)(p.ws + WS_B);
    const f32x2* CS = (const f32x2*)(p.ws + WS_CS);
    const int tok0 = b * SEQ + blk * 256; const int colb = (which ? C_K : C_Q) + h * HD;
    float s0 = 0.f, s1 = 0.f;
    if (which) {
#pragma unroll 8
        for (int rr = 0; rr < 256; ++rr) { const unsigned v = *(const unsigned*)(PROJ + (size_t)(tok0 + rr) * PP + colb + 2 * lane); s0 += bflo(v); s1 += bfhi(v); }
    }
    const int rsub = lane >> 4, i = lane & 15;
    float a0 = 0.f, a1 = 0.f;
#pragma unroll 4
    for (int it = 0; it < 64; ++it) {
        const int t = tok0 + it * 4 + rsub;
        bf16_t* ptr = PROJ + (size_t)t * PP + colb + i;
        const float x1 = bf2f(ptr[0]), x2 = bf2f(ptr[16]);
        const f32x2 cs = CS[t * 16 + i];
        const unsigned w = cvtpk(x1 * cs.x - x2 * cs.y, x2 * cs.x + x1 * cs.y);
        ptr[0] = (bf16_t)(w & 0xffffu); ptr[16] = (bf16_t)(w >> 16);
        a0 += bflo(w); a1 += bfhi(w);
    }
    if (which) {
        a0 += __shfl_xor(a0, 16); a0 += __shfl_xor(a0, 32); a1 += __shfl_xor(a1, 16); a1 += __shfl_xor(a1, 32);
        bf16_t* KM = (bf16_t*)(p.ws + WS_KMEAN) + ((size_t)(b * 8 + h) * 8 + blk) * HD;
        if (lane >= 16) { *(unsigned*)(KM + 2 * lane) = cvtpk(s0 * (1.0f / 256.0f), s1 * (1.0f / 256.0f)); }
        else { KM[lane] = f2bf(a0 * (1.0f / 256.0f)); KM[16 + lane] = f2bf(a1 * (1.0f / 256.0f)); }
    }
}

DI void phase_dn_final(const Params& p, int lane, int gw, int NGW) {
    const float* ODN = (const float*)(p.ws + WS_D); const bf16_t* PROJ = (const bf16_t*)(p.ws + WS_B); bf16_t* YAB = (bf16_t*)(p.ws + WS_A);
    const int d0 = (lane & 7) * 16;
    for (int m = gw; m < T; m += NGW) {
        const float* op = ODN + (size_t)m * 1024 + lane * 16;
        f32x4 v[4]; float s = 0.f;
#pragma unroll
        for (int j = 0; j < 4; ++j) { v[j] = *(const f32x4*)(op + 4 * j); s += (v[j].x * v[j].x + v[j].y * v[j].y) + (v[j].z * v[j].z + v[j].w * v[j].w); }
        s += __shfl_xor(s, 1); s += __shfl_xor(s, 2); s += __shfl_xor(s, 4);
        const float rstd = rsqrt_(s * (1.0f / HD) + EPS);
        const u32x4 z0 = *(const u32x4*)(PROJ + (size_t)m * PP + C_Z + lane * 16), z1 = *(const u32x4*)(PROJ + (size_t)m * PP + C_Z + lane * 16 + 8);
        const float zz[16] = {bflo(z0.x), bfhi(z0.x), bflo(z0.y), bfhi(z0.y), bflo(z0.z), bfhi(z0.z), bflo(z0.w), bfhi(z0.w),
                              bflo(z1.x), bfhi(z1.x), bflo(z1.y), bfhi(z1.y), bflo(z1.z), bfhi(z1.z), bflo(z1.w), bfhi(z1.w)};
        float y[16];
#pragma unroll
        for (int j = 0; j < 4; ++j) { const f32x4 g = *(const f32x4*)(p.dn_gain + d0 + 4 * j);
            y[4 * j + 0] = v[j].x * rstd * g.x * siluf_(zz[4 * j + 0]); y[4 * j + 1] = v[j].y * rstd * g.y * siluf_(zz[4 * j + 1]);
            y[4 * j + 2] = v[j].z * rstd * g.z * siluf_(zz[4 * j + 2]); y[4 * j + 3] = v[j].w * rstd * g.w * siluf_(zz[4 * j + 3]); }
        u32x4 o0, o1;
        o0.x = cvtpk(y[0], y[1]); o0.y = cvtpk(y[2], y[3]); o0.z = cvtpk(y[4], y[5]); o0.w = cvtpk(y[6], y[7]);
        o1.x = cvtpk(y[8], y[9]); o1.y = cvtpk(y[10], y[11]); o1.z = cvtpk(y[12], y[13]); o1.w = cvtpk(y[14], y[15]);
        bf16_t* yp = YAB + (size_t)m * DM + 1024 + lane * 16;
        *(u32x4*)yp = o0; *(u32x4*)(yp + 8) = o1;
    }
}

constexpr int L5_LG = 0;
constexpr int L5_HIST = 12288;
constexpr int L5_TOK = 12288 + 256;
DI void phase5_item(const Params& p, LAS unsigned char* lds, int item, int tid, int lane, int wave) {
    const float* MOD = (const float*)(p.ws + WS_MOD); const bf16_t* OM = (const bf16_t*)(p.ws + WS_OUTMIX); bf16_t* U2 = (bf16_t*)(p.ws + WS_A);
    const bf16_t* WR = (const bf16_t*)(p.ws + WS_WR);
    LAS unsigned* hist = (LAS unsigned*)(lds + L5_HIST); LAS unsigned* tokw = (LAS unsigned*)(lds + L5_TOK);
    if (tid < 64) hist[tid] = 0u;
    const int tokb = item * 64;
    for (int rr = 0; rr < 8; ++rr) {
        const int m = tokb + wave * 8 + rr, b = m >> 11;
        const float* mod = MOD + b * 12288;
        float om[32], xv[32];
        float s = 0.f;
#pragma unroll
        for (int j = 0; j < 4; ++j) { const int col = 8 * (lane + 64 * j);
            const u32x4 w = *(const u32x4*)(OM + (size_t)m * DM + col);
            om[8 * j + 0] = bflo(w.x); om[8 * j + 1] = bfhi(w.x); om[8 * j + 2] = bflo(w.y); om[8 * j + 3] = bfhi(w.y);
            om[8 * j + 4] = bflo(w.z); om[8 * j + 5] = bfhi(w.z); om[8 * j + 6] = bflo(w.w); om[8 * j + 7] = bfhi(w.w);
            const f32x4 x0 = *(const f32x4*)(p.x + (size_t)m * DM + col), x1 = *(const f32x4*)(p.x + (size_t)m * DM + col + 4);
            xv[8 * j + 0] = x0.x; xv[8 * j + 1] = x0.y; xv[8 * j + 2] = x0.z; xv[8 * j + 3] = x0.w; xv[8 * j + 4] = x1.x; xv[8 * j + 5] = x1.y; xv[8 * j + 6] = x1.z; xv[8 * j + 7] = x1.w;
#pragma unroll
            for (int e = 0; e < 8; ++e) s += om[8 * j + e] * om[8 * j + e]; }
        const float r1 = rsqrt_(wave_sum(s) * (1.0f / DM) + EPS);
        float s2 = 0.f;
#pragma unroll
        for (int j = 0; j < 4; ++j) { const int col = 8 * (lane + 64 * j);
#pragma unroll
            for (int q = 0; q < 2; ++q) { const f32x4 g = *(const f32x4*)(p.g_mix_post + col + 4 * q), gt = *(const f32x4*)(mod + 4096 + col + 4 * q);
                f32x4 o;
                o.x = xv[8 * j + 4 * q + 0] + gt.x * (om[8 * j + 4 * q + 0] * r1 * g.x); o.y = xv[8 * j + 4 * q + 1] + gt.y * (om[8 * j + 4 * q + 1] * r1 * g.y);
                o.z = xv[8 * j + 4 * q + 2] + gt.z * (om[8 * j + 4 * q + 2] * r1 * g.z); o.w = xv[8 * j + 4 * q + 3] + gt.w * (om[8 * j + 4 * q + 3] * r1 * g.w);
                *(f32x4*)(p.out + (size_t)m * DM + col + 4 * q) = o;
                xv[8 * j + 4 * q + 0] = o.x; xv[8 * j + 4 * q + 1] = o.y; xv[8 * j + 4 * q + 2] = o.z; xv[8 * j + 4 * q + 3] = o.w;
                s2 += (o.x * o.x + o.y * o.y) + (o.z * o.z + o.w * o.w); } }
        const float r2 = rsqrt_(wave_sum(s2) * (1.0f / DM) + EPS);
#pragma unroll
        for (int j = 0; j < 4; ++j) { const int col = 8 * (lane + 64 * j); float u[8];
#pragma unroll
            for (int q = 0; q < 2; ++q) { const f32x4 g = *(const f32x4*)(p.g_ffn_pre + col + 4 * q), sc = *(const f32x4*)(mod + 5 * 2048 - 2048 + col + 4 * q), sh = *(const f32x4*)(mod + 3 * 2048 + col + 4 * q);
                u[4 * q + 0] = (xv[8 * j + 4 * q + 0] * r2 * g.x) * (1.0f + sc.x) + sh.x; u[4 * q + 1] = (xv[8 * j + 4 * q + 1] * r2 * g.y) * (1.0f + sc.y) + sh.y;
                u[4 * q + 2] = (xv[8 * j + 4 * q + 2] * r2 * g.z) * (1.0f + sc.z) + sh.z; u[4 * q + 3] = (xv[8 * j + 4 * q + 3] * r2 * g.w) * (1.0f + sc.w) + sh.w; }
            u32x4 w; w.x = cvtpk(u[0], u[1]); w.y = cvtpk(u[2], u[3]); w.z = cvtpk(u[4], u[5]); w.w = cvtpk(u[6], u[7]);
            *(u32x4*)(U2 + (size_t)m * DM + col) = w; }
    }
    __syncthreads();
    if (wave < 4) {
        const int tl = lane & 15, kg = lane >> 4;
        const bf16_t* up = U2 + (size_t)(tokb + wave * 16 + tl) * DM + 8 * kg;
        const bf16_t* wp = WR + (size_t)tl * DM + 8 * kg;
        f32x4 a0 = {0.f, 0.f, 0.f, 0.f}, a1 = a0, a2 = a0;
#pragma unroll 4
        for (int s = 0; s < 64; ++s) {
            const bf16x8 bu = *(const bf16x8*)(up + 32 * s);
            const bf16x8 w0 = *(const bf16x8*)(wp + 32 * s), w1 = *(const bf16x8*)(wp + 16 * DM + 32 * s), w2 = *(const bf16x8*)(wp + 32 * DM + 32 * s);
            a0 = MFMA16(w0, bu, a0); a1 = MFMA16(w1, bu, a1); a2 = MFMA16(w2, bu, a2);
        }
        LAS float* lg = (LAS float*)(lds + L5_LG) + wave * 768 + tl * 48 + 4 * kg;
#pragma unroll
        for (int r = 0; r < 4; ++r) { lg[r] = a0[r]; lg[16 + r] = a1[r]; lg[32 + r] = a2[r]; }
        asm volatile("s_waitcnt lgkmcnt(0)" ::: "memory");
        if (lane < 16) {
            const LAS float* l = (const LAS float*)(lds + L5_LG) + wave * 768 + lane * 48;
            float gl[4]; int gs = 0; float gm;
#pragma unroll
            for (int i = 0; i < 4; ++i) gl[i] = l[i] + p.b_rg[i];
            gm = gl[0];
#pragma unroll
            for (int i = 1; i < 4; ++i) if (gl[i] > gm) { gm = gl[i]; gs = i; }
            float gsum = 0.f;
#pragma unroll
            for (int i = 0; i < 4; ++i) gsum += expf(gl[i] - gm);
            const float pg = 1.0f / gsum;
            float el[8]; float em = -3.0e38f;
#pragma unroll
            for (int i = 0; i < 8; ++i) { const float v = l[4 + 8 * gs + i] + p.b_re[8 * gs + i]; el[i] = v; em = fmaxf(em, v); }
            float pe[8]; float esum = 0.f;
#pragma unroll
            for (int i = 0; i < 8; ++i) { pe[i] = expf(el[i] - em); esum += pe[i]; }
            int i0 = 0; float p0 = pe[0];
#pragma unroll
            for (int i = 1; i < 8; ++i) if (pe[i] > p0) { p0 = pe[i]; i0 = i; }
            int i1 = -1; float p1 = -1.f;
#pragma unroll
            for (int i = 0; i < 8; ++i) if (i != i0 && pe[i] > p1) { p1 = pe[i]; i1 = i; }
            const float w0 = pg * p0 / (p0 + p1), w1 = pg * p1 / (p0 + p1);
            const int e0 = 8 * gs + i0, e1 = 8 * gs + i1;
            const unsigned lr0 = __hip_atomic_fetch_add(hist + e0, 1u, __ATOMIC_RELAXED, __HIP_MEMORY_SCOPE_WORKGROUP), lr1 = __hip_atomic_fetch_add(hist + e1, 1u, __ATOMIC_RELAXED, __HIP_MEMORY_SCOPE_WORKGROUP);
            LAS unsigned* tw = tokw + (wave * 16 + lane) * 6;
            tw[0] = (unsigned)e0; tw[1] = (unsigned)e1; tw[2] = lr0; tw[3] = lr1; tw[4] = __float_as_uint(w0); tw[5] = __float_as_uint(w1);
        }
    }
    __syncthreads();
    if (tid < 32) { unsigned* cnt = (unsigned*)(p.ws + WS_CTL) + CW_CNT; const unsigned hcount = hist[tid];
        hist[32 + tid] = hcount ? __hip_atomic_fetch_add(cnt + tid, hcount, __ATOMIC_RELAXED, __HIP_MEMORY_SCOPE_AGENT) : 0u; }
    __syncthreads();
    if (tid < 64) {
        const LAS unsigned* tw = tokw + tid * 6; const int tok = tokb + tid;
        const unsigned e0 = tw[0], e1 = tw[1], q0 = hist[32 + e0] + tw[2], q1 = hist[32 + e1] + tw[3];
        int* RT = (int*)(p.ws + WS_RTOK); RT[e0 * ECAP + q0] = tok; RT[e1 * ECAP + q1] = tok;
        u32x4* rec = (u32x4*)(p.ws + WS_REC) + (size_t)tok * 2;
        rec[0] = (u32x4){e0, e1, q0, q1}; rec[1] = (u32x4){tw[4], tw[5], 0u, 0u};
    }
    __syncthreads();
}
DI void expert_copy_item(const Params& p, int it, LAS float* scr, int lane) {
    const int e = it / 1536, r = it % 1536;
    bf16_t* WGU = (bf16_t*)(p.ws + WS_WGU); bf16_t* WDN = (bf16_t*)(p.ws + WS_WDN);
    if (r < 1024) { const int up = r >> 9, q = r & 511, kb = q >> 4, nb = q & 15, n0 = 32 * nb;
        const float* W = (up ? p.w_up : p.w_gate) + (size_t)e * DM * FF;
        transpose_tile(W, FF, 64 * kb, n0, WGU, DM, e * 1024 + (n0 >> 7) * 256 + (n0 & 127) + up * 128, 0, 32, scr, lane);
    } else { const int q = r - 1024, kb = q >> 6, nb = q & 63;
        transpose_tile(p.w_down + (size_t)e * FF * DM, DM, 64 * kb, 32 * nb, WDN, FF, e * DM + 32 * nb, 0, 32, scr, lane); }
}

struct MoeOrder {
    const LAS int* pref; const LAS int* cnt; int ntn, G, c;
    DI bool next(int i, pg8::Unit& u) const {
        const int L = i * G + c; const int total = pref[32] * ntn; if (L >= total) return false;
        const int tile = L / ntn, pnl = L - tile * ntn;
        int e = 0;
        for (int q = 1; q < 32; ++q) if (tile >= pref[q]) e = q;
        const int m = tile - pref[e];
        u.pm = tile; u.pn = e * ntn + pnl; u.ga = e * ECAP + m * 256; u.gn = cnt[e] - m * 256; return true;
    }
};
DI void moe_tables(const Params& p, LAS int* pref, LAS int* cntl, int tid) {
    if (tid == 0) { const unsigned* cnt = (const unsigned*)(p.ws + WS_CTL) + CW_CNT; int acc = 0;
        for (int e = 0; e < 32; ++e) { const int c = (int)__hip_atomic_load(cnt + e, __ATOMIC_RELAXED, __HIP_MEMORY_SCOPE_AGENT); pref[e] = acc; cntl[e] = c; acc += (c + 255) >> 8; }
        pref[32] = acc; }
    __syncthreads();
}

DI void phase8(const Params& p, const LAS int* pref, int lane, int gw, int NGW) {
    const float* MOD = (const float*)(p.ws + WS_MOD); const bf16_t* YB = (const bf16_t*)(p.ws + WS_YBUF);
    for (int m = gw; m < T; m += NGW) {
        const int b = m >> 11; const float* gt2 = MOD + b * 12288 + 5 * 2048;
        const u32x4* rec = (const u32x4*)(p.ws + WS_REC) + (size_t)m * 2;
        const u32x4 r0 = rec[0], r1 = rec[1];
        const size_t row0 = (size_t)(pref[r0.x] * 256 + (int)r0.z), row1 = (size_t)(pref[r0.y] * 256 + (int)r0.w);
        const float w0 = __uint_as_float(r1.x), w1 = __uint_as_float(r1.y);
        float y[32]; float s = 0.f;
#pragma unroll
        for (int j = 0; j < 4; ++j) { const int col = 8 * (lane + 64 * j);
            const u32x4 a = *(const u32x4*)(YB + row0 * DM + col), c = *(const u32x4*)(YB + row1 * DM + col);
            y[8 * j + 0] = w0 * bflo(a.x) + w1 * bflo(c.x); y[8 * j + 1] = w0 * bfhi(a.x) + w1 * bfhi(c.x);
            y[8 * j + 2] = w0 * bflo(a.y) + w1 * bflo(c.y); y[8 * j + 3] = w0 * bfhi(a.y) + w1 * bfhi(c.y);
            y[8 * j + 4] = w0 * bflo(a.z) + w1 * bflo(c.z); y[8 * j + 5] = w0 * bfhi(a.z) + w1 * bfhi(c.z);
            y[8 * j + 6] = w0 * bflo(a.w) + w1 * bflo(c.w); y[8 * j + 7] = w0 * bfhi(a.w) + w1 * bfhi(c.w);
#pragma unroll
            for (int e = 0; e < 8; ++e) s += y[8 * j + e] * y[8 * j + e]; }
        const float rs = rsqrt_(wave_sum(s) * (1.0f / DM) + EPS);
#pragma unroll
        for (int j = 0; j < 4; ++j) { const int col = 8 * (lane + 64 * j);
#pragma unroll
            for (int q = 0; q < 2; ++q) { float* op = p.out + (size_t)m * DM + col + 4 * q;
                const f32x4 x1 = *(const f32x4*)op, g = *(const f32x4*)(p.g_ffn_post + col + 4 * q), gt = *(const f32x4*)(gt2 + col + 4 * q);
                f32x4 o;
                o.x = x1.x + gt.x * (y[8 * j + 4 * q + 0] * rs * g.x); o.y = x1.y + gt.y * (y[8 * j + 4 * q + 1] * rs * g.y);
                o.z = x1.z + gt.z * (y[8 * j + 4 * q + 2] * rs * g.z); o.w = x1.w + gt.w * (y[8 * j + 4 * q + 3] * rs * g.w);
                *(f32x4*)op = o; } }
    }
}

#define XB_TMO      128
#define XB_XCNT(j)  (256  + 64 * (j))
#define XB_XSUB(j)  (1280 + 64 * (j))
#define XB_XGEN(j)  (2304 + 64 * (j))
#define XB_TOP      3328
#define XB_TOPGEN   3392
#define XCD_BAR_WORDS 3456
#define XB_SPIN_CAP (1u << 18)
DI unsigned xb_ld(unsigned* p)              { return __hip_atomic_load(p, __ATOMIC_RELAXED, __HIP_MEMORY_SCOPE_AGENT); }
DI unsigned xb_add(unsigned* p, unsigned v) { return __hip_atomic_fetch_add(p, v, __ATOMIC_RELAXED, __HIP_MEMORY_SCOPE_AGENT); }
DI unsigned xb_xcc_id() { return (unsigned)__builtin_amdgcn_s_getreg((3 << 11) | 20) & 0xFu; }
#define XB_SPIN(cond, bar) do { unsigned _sp = 0; while (cond) { __builtin_amdgcn_s_sleep(1); \
    if ((++_sp & 255u) == 0u) { if (xb_ld(&(bar)[XB_TMO])) break; if (_sp > XB_SPIN_CAP) { atomicAdd(&(bar)[XB_TMO], 1u); break; } } } } while (0)
struct XcdBarrier { unsigned* bar; unsigned x; volatile LAS unsigned* st; };
DI XcdBarrier xcd_barrier_post(unsigned* bar, volatile LAS unsigned* st) {
    XcdBarrier b; b.bar = bar; b.x = xb_xcc_id(); b.st = st;
    if (threadIdx.x == 0) (void)xb_add(&bar[XB_XCNT(b.x)], 1u);
    return b;
}
DI void xcd_barrier_complete(unsigned* bar, unsigned x, unsigned& nloc, unsigned& nx) {
    const unsigned G = gridDim.x * gridDim.y * gridDim.z;
    unsigned sum, cnt, mine, sp = 0u;
    for (;;) {
        sum = 0u; cnt = 0u; mine = 0u;
#pragma unroll
        for (unsigned j = 0; j < 16; ++j) { const unsigned c = xb_ld(&bar[XB_XCNT(j)]); sum += c; cnt += (c > 0u) ? 1u : 0u; mine = (j == x) ? c : mine; }
        if (sum == G) break;
        __builtin_amdgcn_s_sleep(1);
        if ((++sp & 255u) == 0u) { if (xb_ld(&bar[XB_TMO])) break; if (sp > XB_SPIN_CAP) { atomicAdd(&bar[XB_TMO], 1u); break; } }
    }
    nloc = mine > 0u ? mine : 1u; nx = cnt > 0u ? cnt : 1u;
}
DI void xcd_barrier(const XcdBarrier& b) {
    asm volatile("s_waitcnt vmcnt(0)" ::: "memory");
    __syncthreads();
    if (threadIdx.x == 0) {
        unsigned* bar = b.bar;
        __builtin_amdgcn_s_waitcnt(0);
        unsigned nloc = b.st[0], nx = b.st[1];
        if (nloc == 0u) { xcd_barrier_complete(bar, b.x, nloc, nx); b.st[0] = nloc; b.st[1] = nx; }
        const unsigned old = xb_add(&bar[XB_XSUB(b.x)], 1u);
        const unsigned gen = old / nloc;
        if (old + 1u == (gen + 1u) * nloc) {
            __builtin_amdgcn_fence(__ATOMIC_RELEASE, "agent");
            asm volatile("s_waitcnt vmcnt(0)" ::: "memory");
            const unsigned og = xb_add(&bar[XB_TOP], 1u);
            const unsigned tg = og / nx;
            if (og + 1u == (tg + 1u) * nx) xb_add(&bar[XB_TOPGEN], 1u);
            else XB_SPIN(xb_ld(&bar[XB_TOPGEN]) == tg, bar);
            __builtin_amdgcn_fence(__ATOMIC_ACQUIRE, "agent");
            xb_add(&bar[XB_XGEN(b.x)], 1u);
            asm volatile("s_waitcnt vmcnt(0)" ::: "memory");
        } else {
            XB_SPIN(xb_ld(&bar[XB_XGEN(b.x)]) == gen, bar);
            __builtin_amdgcn_fence(__ATOMIC_ACQUIRE, "agent");
            asm volatile("s_waitcnt vmcnt(0)" ::: "memory");
        }
    }
    __syncthreads();
}

constexpr int NWAVES = 8, NTHREADS = 512;
constexpr int LDS_GEMM = 131072, LDS_TAB = LDS_GEMM, LDS_BYTES = LDS_GEMM + 1024;
constexpr int N_PHASES = 12;
#ifndef DBL
#define DBL -1
#endif
#define REP(k) for (int rep_ = 0; rep_ < ((DBL == (k)) ? 2 : 1); ++rep_)
#ifndef MK_N_LAUNCHES
#define MK_N_LAUNCHES 1
#endif

DI moba::BlockRef attn_ref(const Params& p, int bh, int qb) {
    const int b = bh >> 3, h = bh & 7;
    const bf16_t* PROJ = (const bf16_t*)(p.ws + WS_B);
    moba::BlockRef r;
    r.Q = PROJ + (size_t)(b * SEQ + qb * 256) * PP + C_Q + h * HD;
    r.K = PROJ + (size_t)(b * SEQ) * PP + C_K + h * HD;
    r.V = PROJ + (size_t)(b * SEQ) * PP + C_V + h * HD;
    r.O = (bf16_t*)(p.ws + WS_A) + (size_t)(b * SEQ + qb * 256) * DM + h * HD;
    r.KM = (const bf16_t*)(p.ws + WS_KMEAN) + (size_t)bh * 8 * HD;
    r.P0 = qb * 256;
    return r;
}

typedef const __attribute__((address_space(4))) Params* KParams;
#if defined(__HIP_DEVICE_COMPILE__)
#define LOADP() KParams kq_ = kp_; asm volatile("" : "+s"(kq_)); const Params p = *kq_
#else
#define LOADP() const Params p = p_unused
#endif
__global__ void __launch_bounds__(NTHREADS, 2) fwd_kernel(Params p_unused) {
#if defined(__HIP_DEVICE_COMPILE__)
    const KParams kp_ = (KParams)__builtin_amdgcn_kernarg_segment_ptr();
#else
    const Params* kp_ = &p_unused;
#endif
    extern __shared__ __attribute__((aligned(16))) unsigned char lds_raw[];
    LAS unsigned char* lds = (LAS unsigned char*)lds_raw;
    const int bid = blockIdx.x, G = gridDim.x, NGW = G * NWAVES;
#define IDS() int tid_ = threadIdx.x; asm volatile("" : "+v"(tid_)); const int tid = tid_, lane = tid & 63, wave = __builtin_amdgcn_readfirstlane(tid >> 6), gw = bid * NWAVES + wave; (void)lane; (void)gw; (void)wave
    const int vcu = (G % 8 == 0) ? (bid % 8) * (G / 8) + bid / 8 : bid;
    const int lo = kp_->ph_lo, hi = kp_->ph_hi;
#ifdef ONLY
#define IN(k) ((k) == ONLY && lo <= (k) && (k) < hi)
#else
#define IN(k) (lo <= (k) && (k) < hi)
#endif
    { volatile LAS unsigned* st0 = (volatile LAS unsigned*)(lds + LDS_TAB + 512); if (threadIdx.x < 2) st0[threadIdx.x] = 0u; __syncthreads(); }
    const XcdBarrier xbar = xcd_barrier_post((unsigned*)(kp_->ws + WS_CTL) + CW_BAR, (volatile LAS unsigned*)(lds + LDS_TAB + 512));
#define SEAM(k) do { if (IN(k) && IN((k) + 1)) { if ((k) == 0) cg::this_grid().sync(); else xcd_barrier(xbar); } } while (0)

    if (IN(0)) { LOADP(); IDS(); REP(0) phase0(p, lds, tid, lane, wave, bid, G); }
    SEAM(0);
    if (IN(1)) { LOADP(); IDS(); REP(1) phase_u1(p, lane, gw, NGW); }
    SEAM(1);
    if (IN(2)) { LOADP(); IDS();
        pg8::Gemm g{(const bf16_t*)(p.ws + WS_A), (const bf16_t*)(p.ws + WS_WIN), DM, nullptr};
        pg8::StaticOrder S; S.init(T, NPROJ, G, bid);
        pg8::EpiProj E{(bf16_t*)(p.ws + WS_B), (float*)(p.ws + WS_BA)};
        pg8::gemm_phase<pg8::EpiProj, pg8::StaticOrder, true, false>(lds, g, S, E);
#if DBL == 2
        pg8::gemm_phase<pg8::EpiProj, pg8::StaticOrder, true, false>(lds, g, S, E);
#endif
    }
    SEAM(2);
    if (IN(3)) { LOADP(); IDS();
        for (int it = gw; it < 1024; it += NGW) rotary_item(p, it, lane);
        REP(30) { dn::Raw R; if (bid < 64 * 32) dn::prep_load(p, bid, R, lane, wave);
            for (int it = bid; it < 64 * 32; it += G) dn::prep_chunk(p, lds, it, (it + G < 64 * 32) ? it + G : -1, R, tid, lane, wave); }
    }
    SEAM(3);
    if (IN(4)) { LOADP(); IDS();
#ifndef NO_ATTN
        REP(40) for (int L = vcu; L < 256; L += G) {
            const int bh = L >> 2, x = L & 3;
            moba::Seam S;
            const moba::BlockRef r0 = attn_ref(p, bh, x), r1 = attn_ref(p, bh, 7 - x);
            moba::prime(r0, (char*)lds_raw, S);
            moba::block(r0, r1, (char*)lds_raw, S);
            moba::block(r1, r1, (char*)lds_raw, S);
        }
#endif
#ifndef NO_RECUR
        REP(41) { for (int it = bid; it < 64; it += G) dn::recur(p, lds, it, tid, lane, wave); }
#endif
    }
    SEAM(4);
    if (IN(5)) { LOADP(); IDS(); REP(5) phase_dn_final(p, lane, gw, NGW); }
    SEAM(5);
    if (IN(6)) { LOADP(); IDS();
        pg8::Gemm g{(const bf16_t*)(p.ws + WS_A), (const bf16_t*)(p.ws + WS_WMD), DM, nullptr};
        pg8::StaticOrder S; S.init(T, DM, G, bid);
        pg8::EpiMerged E{(const bf16_t*)(p.ws + WS_B), (bf16_t*)(p.ws + WS_MERGED)};
        pg8::gemm_phase<pg8::EpiMerged, pg8::StaticOrder, true, false>(lds, g, S, E);
#if DBL == 6
        pg8::gemm_phase<pg8::EpiMerged, pg8::StaticOrder, true, false>(lds, g, S, E);
#endif
    }
    SEAM(6);
    if (IN(7)) { LOADP(); IDS();
        pg8::Gemm g{(const bf16_t*)(p.ws + WS_MERGED), (const bf16_t*)(p.ws + WS_WOUT), DM, nullptr};
        pg8::StaticOrder S; S.init(T, DM, G, bid);
        pg8::EpiStore E{(bf16_t*)(p.ws + WS_OUTMIX), DM, 8};
        pg8::gemm_phase<pg8::EpiStore, pg8::StaticOrder, true, false>(lds, g, S, E);
#if DBL == 7
        pg8::gemm_phase<pg8::EpiStore, pg8::StaticOrder, true, false>(lds, g, S, E);
#endif
    }
    SEAM(7);
    if (IN(8)) { LOADP(); IDS();
        for (int it = bid; it < T / 64; it += G) phase5_item(p, lds, it, tid, lane, wave);
        LAS float* scr = (LAS float*)(lds + 16384 + wave * 8448);
        REP(81) for (int it = gw; it < 32 * 1536; it += NGW) expert_copy_item(p, it, scr, lane);
    }
    SEAM(8);
    LAS int* pref = (LAS int*)(lds + LDS_TAB); LAS int* cntl = pref + 64;
    if (IN(9)) { LOADP(); IDS();
        moe_tables(p, pref, cntl, tid);
        pg8::Gemm g{(const bf16_t*)(p.ws + WS_A), (const bf16_t*)(p.ws + WS_WGU), DM, (const int*)(p.ws + WS_RTOK)};
        MoeOrder S{pref, cntl, 4, G, bid};
        pg8::EpiGU E{(bf16_t*)(p.ws + WS_H)};
        pg8::gemm_phase<pg8::EpiGU, MoeOrder, true, true>(lds, g, S, E);
#if DBL == 9
        pg8::gemm_phase<pg8::EpiGU, MoeOrder, true, true>(lds, g, S, E);
#endif
    }
    SEAM(9);
    if (IN(10)) { LOADP(); IDS();
        if (!IN(9)) moe_tables(p, pref, cntl, tid);
        pg8::Gemm g{(const bf16_t*)(p.ws + WS_H), (const bf16_t*)(p.ws + WS_WDN), FF, nullptr};
        MoeOrder S{pref, cntl, 8, G, bid};
        pg8::EpiStore E{(bf16_t*)(p.ws + WS_YBUF), DM, 8};
        pg8::gemm_phase<pg8::EpiStore, MoeOrder, true, false>(lds, g, S, E);
#if DBL == 10
        pg8::gemm_phase<pg8::EpiStore, MoeOrder, true, false>(lds, g, S, E);
#endif
    }
    SEAM(10);
    if (IN(11)) { LOADP(); IDS();
        if (!IN(10)) moe_tables(p, pref, cntl, tid);
        phase8(p, pref, lane, gw, NGW);
    }
#undef IN
#undef SEAM
}

extern "C" void kernel_launch(void* const* d_in, const int* in_sizes, int n_in, void* d_out, int out_size, void* d_ws, size_t ws_size, hipStream_t stream) {
    static int grid = 0;
    if (grid == 0) {
        if (n_in != 24 || in_sizes[0] != T * DM || out_size != T * DM || ws_size < WS_END) {
            fprintf(stderr, "kernel_launch: unexpected shapes (n_in %d, in0 %d, out %d, ws %zu); nothing launched\n", n_in, n_in > 0 ? in_sizes[0] : -1, out_size, ws_size); grid = -1; return; }
        int dev = 0, cus = 0, per_cu = 0;
        hipGetDevice(&dev); hipDeviceGetAttribute(&cus, hipDeviceAttributeMultiprocessorCount, dev);
        if (hipFuncSetAttribute((const void*)fwd_kernel, hipFuncAttributeMaxDynamicSharedMemorySize, LDS_BYTES) != hipSuccess) { fprintf(stderr, "kernel_launch: hipFuncSetAttribute failed\n"); grid = -1; return; }
        if (hipOccupancyMaxActiveBlocksPerMultiprocessor(&per_cu, (const void*)fwd_kernel, NTHREADS, LDS_BYTES) != hipSuccess || per_cu < 1) { fprintf(stderr, "kernel_launch: occupancy query says %d blocks per CU\n", per_cu); grid = -1; return; }
        (void)hipGetLastError();
        grid = cus;
    }
    if (grid < 0) return;
    hipMemsetAsync((char*)d_ws + WS_CTL, 0, CTL_ZERO_BYTES, stream);
    Params p{};
    p.x = (const float*)d_in[0]; p.c = (const float*)d_in[1]; p.pos = (const int*)d_in[2]; p.w_ada = (const float*)d_in[3]; p.b_ada = (const float*)d_in[4];
    p.g_mix_pre = (const float*)d_in[5]; p.g_mix_post = (const float*)d_in[6]; p.g_ffn_pre = (const float*)d_in[7]; p.g_ffn_post = (const float*)d_in[8];
    p.w_in = (const float*)d_in[9]; p.conv_w = (const float*)d_in[10]; p.a_log = (const float*)d_in[11]; p.dt_bias = (const float*)d_in[12]; p.dn_gain = (const float*)d_in[13];
    p.w_bm = (const float*)d_in[14]; p.w_bd = (const float*)d_in[15]; p.w_out = (const float*)d_in[16];
    p.w_rg = (const float*)d_in[17]; p.b_rg = (const float*)d_in[18]; p.w_re = (const float*)d_in[19]; p.b_re = (const float*)d_in[20];
    p.w_gate = (const float*)d_in[21]; p.w_up = (const float*)d_in[22]; p.w_down = (const float*)d_in[23];
    p.out = (float*)d_out; p.ws = (unsigned char*)d_ws;
    for (int li = 0; li < MK_N_LAUNCHES; ++li) {
        p.ph_lo = (MK_N_LAUNCHES == 1) ? 0 : li; p.ph_hi = (MK_N_LAUNCHES == 1) ? N_PHASES : li + 1;
        void* args[] = {&p};
        hipError_t e = hipLaunchCooperativeKernel((const void*)fwd_kernel, dim3(grid), dim3(NTHREADS), args, LDS_BYTES, stream);
        if (e != hipSuccess) { fprintf(stderr, "kernel_launch: cooperative launch failed: %s (grid %d)\n", hipGetErrorString(e), grid); break; }
    }
}
```

```cpp
#include <hip/hip_runtime.h>
#include <hip/hip_cooperative_groups.h>
#include <cstdio>
#include <cstdint>
namespace cg = cooperative_groups;

#define LAS __attribute__((address_space(3)))
#define DI __device__ __forceinline__
typedef unsigned short bf16_t;
typedef short bf16x8 __attribute__((ext_vector_type(8)));
typedef short s16x4 __attribute__((ext_vector_type(4)));
typedef float f32x2 __attribute__((ext_vector_type(2)));
typedef float f32x4 __attribute__((ext_vector_type(4)));
typedef float f32x16 __attribute__((ext_vector_type(16)));
typedef unsigned u32x2 __attribute__((ext_vector_type(2)));
typedef unsigned u32x4 __attribute__((ext_vector_type(4)));
typedef __bf16 bf16x2_t __attribute__((ext_vector_type(2)));

constexpr int NB = 8, SEQ = 2048, T = NB * SEQ, DM = 2048;
constexpr int NHEAD = 8, HD = 128;
constexpr int PP = 11264;
constexpr int NPROJ = 11264;
constexpr int C_Q = 0, C_K = 1024, C_V = 2048, C_DN = 3072, C_Z = 6144, C_GA = 7168, C_GB = 9216;
constexpr int NEXP = 32, FF = 512, ECAP = 16384;
constexpr float EPS = 1e-6f;

constexpr size_t MiB = 1u << 20;
constexpr size_t WS_CTL = 0, CTL_ZERO_BYTES = 1 * MiB;
constexpr size_t WS_MOD = 1 * MiB;
constexpr size_t WS_CS = 2 * MiB;
constexpr size_t WS_KMEAN = 4 * MiB;
constexpr size_t WS_WR = 4 * MiB + 512 * 1024;
constexpr size_t WS_WBA = 4 * MiB + 768 * 1024;
constexpr size_t WS_BA = 5 * MiB;
constexpr size_t WS_REC = 6 * MiB;
constexpr size_t WS_RTOK = 7 * MiB;
constexpr size_t WS_WMD = 10 * MiB;
constexpr size_t WS_WOUT = 18 * MiB;
constexpr size_t WS_A = 26 * MiB;
constexpr size_t WS_B = 90 * MiB;
constexpr size_t WS_C = 442 * MiB;
constexpr size_t WS_D = 588 * MiB;
constexpr size_t WS_END = 652 * MiB;
constexpr size_t WS_OUTMIX = WS_B, WS_WGU = WS_B + 128 * MiB, WS_WDN = WS_B + 256 * MiB, WS_YBUF = WS_B;
constexpr size_t WS_WIN = WS_C, WS_DNP = WS_C, WS_MERGED = WS_C, WS_H = WS_C + 64 * MiB;
constexpr int CW_CNT = 64;
constexpr int CW_BAR = 4096;
constexpr int DN_U = 0, DN_W = 16384, DN_QD = 32768, DN_KT = 49152, DN_QK = 65536, DN_SC = 73728, DN_STRIDE = 73984;

struct Params {
    const float* x; const float* c; const int* pos; const float* w_ada; const float* b_ada;
    const float* g_mix_pre; const float* g_mix_post; const float* g_ffn_pre; const float* g_ffn_post;
    const float* w_in; const float* conv_w; const float* a_log; const float* dt_bias; const float* dn_gain;
    const float* w_bm; const float* w_bd; const float* w_out;
    const float* w_rg; const float* b_rg; const float* w_re; const float* b_re;
    const float* w_gate; const float* w_up; const float* w_down;
    float* out; unsigned char* ws;
    int ph_lo, ph_hi;
};

DI unsigned cvtpk(float lo, float hi) { f32x2 v = {lo, hi}; bf16x2_t b = __builtin_convertvector(v, bf16x2_t); return __builtin_bit_cast(unsigned, b); }
DI float bflo(unsigned w) { return __uint_as_float(w << 16); }
DI float bfhi(unsigned w) { return __uint_as_float(w & 0xffff0000u); }
DI float bf2f(bf16_t b) { return __uint_as_float((unsigned)b << 16); }
DI bf16_t f2bf(float f) { return (bf16_t)(cvtpk(f, 0.f) & 0xffffu); }
DI float wave_sum(float v) {
#pragma unroll
    for (int o = 1; o < 64; o <<= 1) v += __shfl_xor(v, o);
    return v;
}
DI float sigmoidf_(float x) { return __builtin_amdgcn_rcpf(1.f + __expf(-x)); }
DI float siluf_(float x) { return x * __builtin_amdgcn_rcpf(1.f + __expf(-x)); }
DI float rsqrt_(float x) { return __builtin_amdgcn_rsqf(x); }
DI float siluf_acc(float x) { return x / (1.f + expf(-x)); }
constexpr float SCALE_Q = 0.08838834764831845f;
DI int perm16(int p) { return (p & 3) | ((p & 4) << 1) | ((p & 8) >> 1); }
DI int crow(int r, int hi) { return (r & 3) + 8 * (r >> 2) + 4 * hi; }
#define MFMA32(a, b, c) __builtin_amdgcn_mfma_f32_32x32x16_bf16((a), (b), (c), 0, 0, 0)
#define MFMA16(a, b, c) __builtin_amdgcn_mfma_f32_16x16x32_bf16((a), (b), (c), 0, 0, 0)

namespace pg8 {
constexpr int BM = 256, BK = 64, HALF = 128, HTB = HALF * BK * 2, STAGE_BYTES = 8 * HTB, NXCD = 8, WGM = 8;
DI int lds_byte(int r, int c) { const int st = (r >> 4) * 2 + (c >> 5), rr = r & 15, cc = c & 31, ob = rr * 64 + cc * 2; return st * 1024 + (ob ^ (((ob >> 9) & 1) << 5)); }
DI void stage_rc(int b, int& R, int& C) { const int st = b / 1024, sb = b % 1024, swz = sb ^ (((sb >> 9) & 1) << 5); R = (st >> 1) * 16 + swz / 64; C = (st & 1) * 32 + (swz % 64) / 2; }
DI int perm32(int rho) { const int n = rho >> 4, i = rho & 15; return 8 * (i >> 2) + 4 * n + (i & 3); }

struct Unit { int pm, pn, ga, gn; };
struct Gemm { const bf16_t* A; const bf16_t* Bt; int K; const int* gidx; };

struct StaticOrder {
    int nM, nN, nwg, G, c;
    DI void init(int M, int N, int G_, int c_) { nM = M / BM; nN = N / BM; nwg = nM * nN; G = G_; c = c_; }
    DI bool next(int i, Unit& u) const {
        const long L = (long)i * G + c; if (L >= nwg) return false;
        int wgid = (int)L; { const int q = nwg / NXCD, r = nwg % NXCD, xcd = wgid % NXCD, off = wgid / NXCD; wgid = (xcd < r ? xcd * (q + 1) : r * (q + 1) + (xcd - r) * q) + off; }
        const int nig = WGM * nN, gid = wgid / nig, fm = gid * WGM, gsz = (nM - fm) < WGM ? (nM - fm) : WGM;
        u.pm = fm + ((wgid % nig) % gsz); u.pn = (wgid % nig) / gsz; u.ga = 0; u.gn = 0; return true;
    }
};

typedef f32x4 Acc[2][2][4][2];

template <class Epi, class Sched, bool ALIGN_EPI, bool GATHER>
DI void gemm_phase(LAS unsigned char* lds, const Gemm g, const Sched& S, const Epi& E) {
    const int tid = threadIdx.x, wid = __builtin_amdgcn_readfirstlane(tid >> 6), lane = tid & 63, wr = wid >> 2, wc = wid & 3, fr = lane & 15, fq = lane >> 4;
    const int K = g.K, nt = K / BK;
    unsigned voffA[2], voffB[2]; int gR[2], gC[2];
#pragma unroll
    for (int i = 0; i < 2; ++i) { int R, C; stage_rc(tid * 16 + i * 8192, R, C); const int Rb = (R & ~31) + perm32(R & 31);
        voffA[i] = (unsigned)(R * K + C) * 2u; voffB[i] = (unsigned)(Rb * K + C) * 2u; gR[i] = R; gC[i] = C; }
    const size_t kstep = (size_t)(BK * 2);
    const size_t hstep = (size_t)HALF * K * 2;
    const size_t tstep = 2 * hstep;
    const unsigned ldsw = (unsigned)wid * 1024u;
    const int aoff = lds_byte(wr * 64 + fr, fq * 8), boff = lds_byte(wc * 32 + fr, fq * 8);
#define PG8_SA(b, h) (((b) * 2 + (h)) * HTB)
#define PG8_SB(b, h) ((4 + (b) * 2 + (h)) * HTB)
#define PG8_STAGE(bufoff, gbase, voff) do { _Pragma("unroll") for (int _i = 0; _i < 2; ++_i) \
        __builtin_amdgcn_global_load_lds((const unsigned*)((const char*)(gbase) + (voff)[_i]), (LAS unsigned*)(lds + (bufoff) + ldsw + _i * 8192), 16, 0, 0); } while (0)
#define PG8_LDA(dst, b, h) do { _Pragma("unroll") for (int m = 0; m < 4; ++m) _Pragma("unroll") for (int k = 0; k < 2; ++k) dst[m][k] = *(const LAS bf16x8*)(lds + PG8_SA(b, h) + aoff + m * 2048 + k * 1024); } while (0)
#define PG8_LDB(dst, b, h) do { _Pragma("unroll") for (int n = 0; n < 2; ++n) _Pragma("unroll") for (int k = 0; k < 2; ++k) dst[n][k] = *(const LAS bf16x8*)(lds + PG8_SB(b, h) + boff + n * 2048 + k * 1024); } while (0)
#define PG8_MMA(ai, bj, At, Bt) do { __builtin_amdgcn_s_setprio(1); _Pragma("unroll") for (int m = 0; m < 4; ++m) _Pragma("unroll") for (int n = 0; n < 2; ++n) _Pragma("unroll") for (int k = 0; k < 2; ++k) \
        acc[ai][bj][m][n] = __builtin_amdgcn_mfma_f32_16x16x32_bf16(Bt[n][k], At[m][k], acc[ai][bj][m][n], 0, 0, 0); __builtin_amdgcn_s_setprio(0); } while (0)
#define PG8_WAIT_V(n) asm volatile("s_waitcnt vmcnt(" #n ")" ::: "memory")
#define PG8_WAIT_L(n) asm volatile("s_waitcnt lgkmcnt(" #n ")" ::: "memory")
#define PG8_BAR __builtin_amdgcn_s_barrier()
#define PG8_SCHED __builtin_amdgcn_sched_barrier(0)
    Unit cur, nxt; int ui = 0;
    if (!S.next(0, cur)) return;
    Acc acc;
#pragma unroll
    for (int a = 0; a < 2; ++a)
#pragma unroll
        for (int b = 0; b < 2; ++b)
#pragma unroll
            for (int m = 0; m < 4; ++m)
#pragma unroll
                for (int n = 0; n < 2; ++n) acc[a][b][m][n] = (f32x4){0.f, 0.f, 0.f, 0.f};
    bf16x8 At[4][2], B0[2][2], B1[2][2];
    unsigned vA0[2], vA1[2];
#define PG8_SET_VOFF(u) do { if constexpr (GATHER) { _Pragma("unroll") for (int _i = 0; _i < 2; ++_i) { \
                const int _r0 = gR[_i], _r1 = HALF + gR[_i]; \
                const int _t0 = _r0 < (u).gn ? g.gidx[(u).ga + _r0] : 0, _t1 = _r1 < (u).gn ? g.gidx[(u).ga + _r1] : 0; \
                vA0[_i] = (unsigned)(_t0 * K + gC[_i]) * 2u; vA1[_i] = (unsigned)(_t1 * K + gC[_i]) * 2u; } \
        } else { vA0[0] = voffA[0]; vA0[1] = voffA[1]; vA1[0] = voffA[0] + (unsigned)hstep; vA1[1] = voffA[1] + (unsigned)hstep; } } while (0)
    PG8_SET_VOFF(cur);
    const char* cA = GATHER ? (const char*)g.A : (const char*)g.A + (size_t)cur.pm * tstep; const char* cB = (const char*)g.Bt + (size_t)cur.pn * tstep;
    PG8_STAGE(PG8_SB(0, 0), cB, voffB); PG8_STAGE(PG8_SB(0, 1), cB + hstep, voffB); PG8_STAGE(PG8_SA(0, 0), cA, vA0); PG8_STAGE(PG8_SA(0, 1), cA, vA1);
    if (wr == 1) PG8_BAR;
    PG8_WAIT_V(2); PG8_BAR;
    PG8_STAGE(PG8_SB(1, 0), cB + kstep, voffB); PG8_STAGE(PG8_SA(1, 0), cA + kstep, vA0); PG8_STAGE(PG8_SB(1, 1), cB + hstep + kstep, voffB);
    PG8_WAIT_V(6); PG8_BAR;
    for (;;) {
        const bool has_next = S.next(ui + 1, nxt);
        const char* nA = GATHER ? (const char*)g.A : (has_next ? (const char*)g.A + (size_t)nxt.pm * tstep : cA);
        const char* nB = has_next ? (const char*)g.Bt + (size_t)nxt.pn * tstep : cB;
#define PG8_KTRIP(t) do { \
            const bool last = (t == nt - 2); \
            const char* a1 = cA + (size_t)(t + 1) * kstep; \
            const char* a2 = last ? nA : cA + (size_t)(t + 2) * kstep; const char* b2 = last ? nB : cB + (size_t)(t + 2) * kstep; \
            const char* a3 = a2 + kstep; const char* b3 = b2 + kstep; \
            PG8_LDB(B0, 0, 0); PG8_LDB(B1, 0, 1); PG8_SCHED; PG8_LDA(At, 0, 0); PG8_STAGE(PG8_SA(1, 1), a1, vA1); \
            PG8_WAIT_V(8); PG8_WAIT_L(0); PG8_BAR; PG8_MMA(0, 0, At, B0); PG8_MMA(0, 1, At, B1); PG8_BAR; PG8_SCHED; \
            if constexpr (GATHER) { if (last && has_next) PG8_SET_VOFF(nxt); } \
            PG8_LDA(At, 0, 1); PG8_STAGE(PG8_SB(0, 0), b2, voffB); PG8_STAGE(PG8_SB(0, 1), b2 + hstep, voffB); PG8_STAGE(PG8_SA(0, 0), a2, vA0); \
            PG8_WAIT_V(8); PG8_WAIT_L(0); PG8_BAR; PG8_MMA(1, 0, At, B0); PG8_MMA(1, 1, At, B1); PG8_BAR; PG8_SCHED; \
            PG8_LDB(B0, 1, 0); PG8_LDB(B1, 1, 1); PG8_SCHED; PG8_LDA(At, 1, 0); PG8_STAGE(PG8_SA(0, 1), a2, vA1); \
            PG8_WAIT_V(8); PG8_WAIT_L(0); PG8_BAR; PG8_MMA(0, 0, At, B0); PG8_MMA(0, 1, At, B1); PG8_BAR; PG8_SCHED; \
            PG8_LDA(At, 1, 1); PG8_STAGE(PG8_SB(1, 0), b3, voffB); PG8_STAGE(PG8_SB(1, 1), b3 + hstep, voffB); PG8_STAGE(PG8_SA(1, 0), a3, vA0); \
            PG8_WAIT_V(8); PG8_WAIT_L(0); PG8_BAR; PG8_MMA(1, 0, At, B0); PG8_MMA(1, 1, At, B1); PG8_BAR; PG8_SCHED; \
        } while (0)
        if constexpr (Epi::HAS_MID) {
            for (int t = 0; t < (nt >> 1); t += 2) PG8_KTRIP(t);
            E.mid(acc, cur, wr, wc, fr, fq);
            for (int t = (nt >> 1); t < nt; t += 2) PG8_KTRIP(t);
        } else {
            for (int t = 0; t < nt; t += 2) PG8_KTRIP(t);
        }
#undef PG8_KTRIP
        if constexpr (ALIGN_EPI) { if (wr == 0) PG8_BAR; }
        E(acc, cur, wr, wc, fr, fq);
#if defined(DBL) && DBL == 20
        E(acc, cur, wr, wc, fr, fq);
#endif
        if (!has_next) break;
#pragma unroll
        for (int a = 0; a < 2; ++a)
#pragma unroll
            for (int b = 0; b < 2; ++b)
#pragma unroll
                for (int m = 0; m < 4; ++m)
#pragma unroll
                    for (int n = 0; n < 2; ++n) acc[a][b][m][n] = (f32x4){0.f, 0.f, 0.f, 0.f};
        cur = nxt; cA = nA; cB = nB; ++ui;
        if constexpr (ALIGN_EPI) { if (wr == 1) PG8_BAR; }
    }
    PG8_WAIT_V(0);
    if constexpr (!ALIGN_EPI) { if (wr == 0) PG8_BAR; }
    PG8_BAR;
#undef PG8_SET_VOFF
#undef PG8_SA
#undef PG8_SB
#undef PG8_STAGE
#undef PG8_LDA
#undef PG8_LDB
#undef PG8_MMA
#undef PG8_WAIT_V
#undef PG8_WAIT_L
#undef PG8_BAR
#undef PG8_SCHED
}

struct EpiStore {
    static constexpr bool HAS_MID = false;
    bf16_t* O; int ldc; int ntn;
    DI void operator()(const Acc& acc, const Unit& u, int wr, int wc, int fr, int fq) const {
        const int row0 = u.pm * BM + wr * 64 + fr, col0 = (u.pn % ntn) * BM + wc * 32 + 8 * fq;
#pragma unroll
        for (int ai = 0; ai < 2; ++ai)
#pragma unroll
            for (int m = 0; m < 4; ++m) { bf16_t* rowp = O + (size_t)(row0 + ai * HALF + m * 16) * ldc + col0;
#pragma unroll
                for (int bj = 0; bj < 2; ++bj) { const f32x4 v0 = acc[ai][bj][m][0], v1 = acc[ai][bj][m][1];
                    u32x4 w; w.x = cvtpk(v0[0], v0[1]); w.y = cvtpk(v0[2], v0[3]); w.z = cvtpk(v1[0], v1[1]); w.w = cvtpk(v1[2], v1[3]);
                    *(u32x4*)(rowp + bj * HALF) = w; } }
    }
};
struct EpiMerged {
    static constexpr bool HAS_MID = true;
    const bf16_t* P; bf16_t* O;
    DI void mid(Acc& acc, const Unit& u, int wr, int wc, int fr, int fq) const {
        const unsigned ro = (unsigned)((u.pm * BM + wr * 64 + fr) * PP + u.pn * BM + wc * 32 + 8 * fq);
#pragma unroll
        for (int ai = 0; ai < 2; ++ai)
#pragma unroll
            for (int m = 0; m < 4; ++m) {
#pragma unroll
                for (int bj = 0; bj < 2; ++bj) { const unsigned off = ro + (unsigned)((ai * HALF + m * 16) * PP + bj * HALF);
                    const u32x4 a = *(const u32x4*)(P + off + C_GA), b = *(const u32x4*)(P + off + C_GB);
                    float ga[8] = {bflo(a.x), bfhi(a.x), bflo(a.y), bfhi(a.y), bflo(a.z), bfhi(a.z), bflo(a.w), bfhi(a.w)};
                    float gb[8] = {bflo(b.x), bfhi(b.x), bflo(b.y), bfhi(b.y), bflo(b.z), bfhi(b.z), bflo(b.w), bfhi(b.w)};
#pragma unroll
                    for (int n = 0; n < 2; ++n)
#pragma unroll
                        for (int j = 0; j < 4; ++j) { const float r = (1.f + __expf(-gb[4 * n + j])) * __builtin_amdgcn_rcpf(1.f + __expf(-ga[4 * n + j])); acc[ai][bj][m][n][j] *= r; } }
                asm volatile("" ::: "memory"); __builtin_amdgcn_sched_barrier(0); }
    }
    DI void operator()(const Acc& acc, const Unit& u, int wr, int wc, int fr, int fq) const {
        const unsigned ro = (unsigned)((u.pm * BM + wr * 64 + fr) * PP + u.pn * BM + wc * 32 + 8 * fq);
        const unsigned oo = (unsigned)((u.pm * BM + wr * 64 + fr) * DM + u.pn * BM + wc * 32 + 8 * fq);
#pragma unroll
        for (int ai = 0; ai < 2; ++ai)
#pragma unroll
            for (int m = 0; m < 4; ++m) {
#pragma unroll
                for (int bj = 0; bj < 2; ++bj) { const u32x4 b = *(const u32x4*)(P + ro + (unsigned)((ai * HALF + m * 16) * PP + bj * HALF) + C_GB);
                    float gb[8] = {bflo(b.x), bfhi(b.x), bflo(b.y), bfhi(b.y), bflo(b.z), bfhi(b.z), bflo(b.w), bfhi(b.w)};
                    float v[8];
#pragma unroll
                    for (int n = 0; n < 2; ++n)
#pragma unroll
                        for (int j = 0; j < 4; ++j) v[4 * n + j] = acc[ai][bj][m][n][j] * __builtin_amdgcn_rcpf(1.f + __expf(-gb[4 * n + j]));
                    u32x4 w; w.x = cvtpk(v[0], v[1]); w.y = cvtpk(v[2], v[3]); w.z = cvtpk(v[4], v[5]); w.w = cvtpk(v[6], v[7]);
                    *(u32x4*)(O + oo + (unsigned)((ai * HALF + m * 16) * DM + bj * HALF)) = w; }
                asm volatile("" ::: "memory"); __builtin_amdgcn_sched_barrier(0); }
    }
};
struct EpiGU {
    static constexpr bool HAS_MID = false;
    bf16_t* H;
    DI void operator()(const Acc& acc, const Unit& u, int wr, int wc, int fr, int fq) const {
        const int row0 = u.pm * BM + wr * 64 + fr, col0 = (u.pn & 3) * HALF + wc * 32 + 8 * fq;
#pragma unroll
        for (int ai = 0; ai < 2; ++ai)
#pragma unroll
            for (int m = 0; m < 4; ++m) { float v[8];
#pragma unroll
                for (int n = 0; n < 2; ++n)
#pragma unroll
                    for (int j = 0; j < 4; ++j) v[4 * n + j] = siluf_(acc[ai][0][m][n][j]) * acc[ai][1][m][n][j];
                u32x4 w; w.x = cvtpk(v[0], v[1]); w.y = cvtpk(v[2], v[3]); w.z = cvtpk(v[4], v[5]); w.w = cvtpk(v[6], v[7]);
                *(u32x4*)(H + (size_t)(row0 + ai * HALF + m * 16) * FF + col0) = w; }
    }
};
}

namespace moba {
constexpr int NW = 8, QBLK = 32, KVBLK = 64, QB = NW * QBLK, D = 128;
constexpr int RS = PP;
constexpr int RSO = DM;
constexpr float SCALE = 0.08838834764831845f;
constexpr float THR = 8.f;
constexpr int SHM_V = KVBLK * D * 2, SHM_K = KVBLK * D * 2;
constexpr int LDS_BYTES = 2 * SHM_V + 2 * SHM_K + NW * 64 * 4;
typedef bf16_t bf16;
#define KSWZ(row, colB) ((row) * 256 + ((colB) ^ (((row) & 7) << 4)))
#define SBAR() __builtin_amdgcn_sched_barrier(0)
DI int v_st(int k, int c) { const int kk = (k & ~0xC) | ((k & 4) << 1) | ((k & 8) >> 1); return ((kk >> 3) * 4 + (c >> 5)) * 512 + ((kk & 7) * 32 + (c & 31)) * 2; }
DI int v_rd_base(int lane) { return ((lane & 3) << 3) | (((lane >> 2) & 3) << 6) | (((lane >> 4) & 1) << 5) | (((lane >> 5) & 1) << 8); }
constexpr int v_rd_off(int d0, int ks, int half) { return d0 * 512 + ks * 4096 + half * 2048; }
DI bf16x8 load8(const bf16* p) { return *reinterpret_cast<const bf16x8*>(p); }
DI void mask_tile(f32x16& p0, f32x16& p1, int dq) {
    const float NEG = -__builtin_inff();
#pragma unroll
    for (int r = 0; r < 16; ++r) {
        const int c = (r & 3) + 8 * (r >> 2);
        if (dq - c < 0) p0[r] = NEG;
        if (dq - c - 32 < 0) p1[r] = NEG;
    }
}
DI void mask_all(f32x16& p0, f32x16& p1, bool kill) {
    const float NEG = -__builtin_inff();
#pragma unroll
    for (int r = 0; r < 16; ++r) { if (kill) p0[r] = NEG; if (kill) p1[r] = NEG; }
}
DI void partialSM(f32x16& p0, f32x16& p1, float& m_reg, float& mn, float& alpha) {
    float pmax = p0[0];
#pragma unroll
    for (int r = 1; r < 16; ++r) pmax = fmaxf(pmax, p0[r]);
#pragma unroll
    for (int r = 0; r < 16; ++r) pmax = fmaxf(pmax, p1[r]);
    { auto rr = __builtin_amdgcn_permlane32_swap(__float_as_uint(pmax), __float_as_uint(pmax), false, false);
      pmax = fmaxf(__uint_as_float(rr[0]), __uint_as_float(rr[1])); }
    constexpr float C2 = 1.4426950408889634f * SCALE;
    if (__builtin_expect(__all((pmax - m_reg) * SCALE <= THR), 1)) { mn = m_reg; alpha = 1.f; }
    else { mn = fmaxf(m_reg, pmax); alpha = __builtin_amdgcn_exp2f((m_reg - mn) * C2); m_reg = mn; }
    const float mnL = -mn * C2;
#pragma unroll
    for (int r = 0; r < 16; ++r) p0[r] = fmaf(p0[r], C2, mnL);
#pragma unroll
    for (int r = 0; r < 16; ++r) p1[r] = fmaf(p1[r], C2, mnL);
#pragma unroll
    for (int r = 0; r < 16; ++r) p0[r] = __builtin_amdgcn_exp2f(p0[r]);
}
DI void finishSM(f32x16& p0, f32x16& p1, float alpha, float& l_reg, bf16x8& pa0, bf16x8& pa1, bf16x8& pa2, bf16x8& pa3) {
#pragma unroll
    for (int r = 0; r < 16; ++r) p1[r] = __builtin_amdgcn_exp2f(p1[r]);
    float ps = 0;
#pragma unroll
    for (int r = 0; r < 16; ++r) ps += p0[r];
#pragma unroll
    for (int r = 0; r < 16; ++r) ps += p1[r];
    { auto rr = __builtin_amdgcn_permlane32_swap(__float_as_uint(ps), __float_as_uint(ps), false, false);
      ps = __uint_as_float(rr[0]) + __uint_as_float(rr[1]); }
    l_reg = l_reg * alpha + ps;
#define PK4(P, B_, OUT) do { unsigned a0 = cvtpk(P[B_+0], P[B_+1]), a1 = cvtpk(P[B_+2], P[B_+3]);                          \
        unsigned b0 = cvtpk(P[B_+4], P[B_+5]), b1 = cvtpk(P[B_+6], P[B_+7]);                                             \
        auto r0 = __builtin_amdgcn_permlane32_swap(a0, b0, false, false); auto r1 = __builtin_amdgcn_permlane32_swap(a1, b1, false, false); \
        u32x4 w = {r0[0], r1[0], r0[1], r1[1]}; OUT = __builtin_bit_cast(bf16x8, w); } while (0)
    PK4(p0, 0, pa0); PK4(p0, 8, pa1); PK4(p1, 0, pa2); PK4(p1, 8, pa3);
#undef PK4
}
template <int KB>
DI void qkt(f32x16& p0, f32x16& p1, const char* K_lds, int r32, int hi, const bf16x8* qr) {
    p0 = f32x16{}; p1 = f32x16{};
    const char* kb[4];
#pragma unroll
    for (int dd = 0; dd < 4; ++dd) kb[dd] = K_lds + KB * SHM_K + KSWZ(r32, (dd * 16 + hi * 8) * 2);
#pragma unroll
    for (int d0 = 0; d0 < 8; ++d0) { const char* a = kb[d0 & 3] + (d0 >> 2) * 128;
        bf16x8 b0 = *reinterpret_cast<const bf16x8*>(a);
        bf16x8 b1 = *reinterpret_cast<const bf16x8*>(a + 32 * 256);
        p0 = MFMA32(b0, qr[d0], p0);
        p1 = MFMA32(b1, qr[d0], p1); }
}
template <int VB>
DI void pv_tile(f32x16* o, int vb0, bf16x8 pa0, bf16x8 pa1, bf16x8 pa2, bf16x8 pa3) {
#define TRRD(dst, off) asm volatile("ds_read_b64_tr_b16 %0, %1 offset:%2" : "=&v"(dst) : "v"(vb0), "i"(off) : "memory")
#define PV_D0(d0) do { s16x4 l0, l1, l2, l3, h0, h1, h2, h3; constexpr int b_ = VB * SHM_V + v_rd_off(d0, 0, 0); \
        TRRD(l0, b_); TRRD(h0, b_ + 2048); TRRD(l1, b_ + 4096); TRRD(h1, b_ + 6144); TRRD(l2, b_ + 8192); TRRD(h2, b_ + 10240); TRRD(l3, b_ + 12288); TRRD(h3, b_ + 14336); \
        asm volatile("s_waitcnt lgkmcnt(0)" ::: "memory"); SBAR();   \
        o[d0] = MFMA32(pa0, ((bf16x8){l0[0], l0[1], l0[2], l0[3], h0[0], h0[1], h0[2], h0[3]}), o[d0]);   \
        o[d0] = MFMA32(pa1, ((bf16x8){l1[0], l1[1], l1[2], l1[3], h1[0], h1[1], h1[2], h1[3]}), o[d0]);   \
        o[d0] = MFMA32(pa2, ((bf16x8){l2[0], l2[1], l2[2], l2[3], h2[0], h2[1], h2[2], h2[3]}), o[d0]);   \
        o[d0] = MFMA32(pa3, ((bf16x8){l3[0], l3[1], l3[2], l3[3], h3[0], h3[1], h3[2], h3[3]}), o[d0]); } while (0)
    PV_D0(0); PV_D0(1); PV_D0(2); PV_D0(3);
#undef PV_D0
#undef TRRD
}

struct BlockRef { const bf16* Q; const bf16* K; const bf16* V; bf16* O; const bf16* KM; int P0; };
struct Seam { bf16x8 qr[8]; bf16x8 st_v0, st_v1, st_k0, st_k1; };
#define VMW() asm volatile("s_waitcnt vmcnt(0)" ::: "memory")
#define VMWN(n) asm volatile("s_waitcnt vmcnt(%0)" :: "i"(n) : "memory")
#define SLOAD_H(Kp, Vp, k0) do { const bf16* kb__ = (Kp) + (size_t)(k0) * RS; const bf16* vb__ = (Vp) + (size_t)(k0) * RS;              \
                         S.st_v0 = load8(vb__ + goff); S.st_v1 = load8(vb__ + 32 * RS + goff);              \
                         S.st_k0 = load8(kb__ + goff); S.st_k1 = load8(kb__ + 32 * RS + goff); } while (0)
#define SWRITE_HK(bf) do { *(bf16x8*)(K_lds + (bf) * SHM_K + kws) = S.st_k0; *(bf16x8*)(K_lds + (bf) * SHM_K + kws + 32 * 256) = S.st_k1; } while (0)
#define SWRITE_HV(bf) do { *(bf16x8*)(V_lds + (bf) * SHM_V + vst0) = S.st_v0; *(bf16x8*)(V_lds + (bf) * SHM_V + vst1) = S.st_v1; } while (0)
#define SWRITE_H(bf) do { SWRITE_HV(bf); SWRITE_HK(bf); } while (0)
DI void prime(const BlockRef& cur, char* lds, Seam& S) {
    const int tid = threadIdx.x, wid = __builtin_amdgcn_readfirstlane(tid >> 6), lane = tid & 63, r32 = lane & 31, hi = lane >> 5;
    const int sr = tid >> 4, sc = (tid & 15) * 8, kws = KSWZ(sr, sc * 2); char* K_lds = lds + 2 * SHM_V;
    const unsigned goff = (unsigned)(sr * RS + sc), qoff = (unsigned)(r32 * RS + hi * 8);
    { const bf16* qb__ = cur.Q + (size_t)(wid * QBLK) * RS;
#pragma unroll
    for (int d0 = 0; d0 < 8; ++d0) S.qr[d0] = load8(qb__ + qoff + d0 * 16); }
    SLOAD_H(cur.K, cur.V, 0); VMW(); SWRITE_HK(0);
    __syncthreads();
}
DI void block(const BlockRef& cur, const BlockRef& nxt, char* lds, Seam& S) {
    int tid_ = threadIdx.x; asm volatile("" : "+v"(tid_));
    const int tid = tid_, wid = __builtin_amdgcn_readfirstlane(tid >> 6), lane = tid & 63, r32 = lane & 31, hi = lane >> 5;
    const int NT = (cur.P0 + QB) / KVBLK;
    const int qb = cur.P0 / QB;
    const int qlo = cur.P0 + wid * QBLK, qm = qlo + r32 - 4 * hi;
    char* V_lds = lds; char* K_lds = lds + 2 * SHM_V;
    float* ws = (float*)(lds + 2 * SHM_V + 2 * SHM_K) + wid * 64; float* li_l = ws, * al_l = ws + 32;
    unsigned selmask = (1u << qb) - 1u;
    if (qb > 3) {
        f32x16 g0 = f32x16{};
#pragma unroll
        for (int d0 = 0; d0 < 8; ++d0) {
            bf16x8 a = (bf16x8){0, 0, 0, 0, 0, 0, 0, 0};
            if (r32 < 8) a = load8(cur.KM + r32 * D + d0 * 16 + hi * 8);
            g0 = MFMA32(a, S.qr[d0], g0);
        }
        float gt[8];
#pragma unroll
        for (int j = 0; j < 4; ++j) { const float mine = g0[j], oth = __shfl_xor(mine, 32); gt[j] = hi ? oth : mine; gt[4 + j] = hi ? mine : oth; }
        selmask = 0u;
#pragma unroll
        for (int i = 0; i < 8; ++i) { int rank = 0;
#pragma unroll
            for (int j = 0; j < 8; ++j) { if (j != i) { const bool beats = (gt[j] > gt[i]) || (gt[j] == gt[i] && j < i); rank += (j < qb && beats) ? 1 : 0; } }
            if (i < qb && rank < 3) selmask |= (1u << i); }
    }
    float m_reg = -1e30f, l_reg = 0; f32x16 o[4] = {};
    const int sr = tid >> 4, sc = (tid & 15) * 8, vst0 = v_st(sr, sc), vst1 = v_st(32 + sr, sc), kws = KSWZ(sr, sc * 2);
    const unsigned goff = (unsigned)(sr * RS + sc), qoff = (unsigned)(r32 * RS + hi * 8);
    const int vb0 = (int)(uintptr_t)V_lds + v_rd_base(lane);
    const bf16* Kh = cur.K; const bf16* Vh = cur.V;
#define RESC(a) do { if (__any((a) < 1.f)) { if (hi == 0) al_l[r32] = (a); asm volatile("s_waitcnt lgkmcnt(0)" ::: "memory");              \
                     _Pragma("unroll") for (int d_ = 0; d_ < 4; ++d_) _Pragma("unroll") for (int r = 0; r < 16; ++r) o[d_][r] *= al_l[crow(r, hi)]; } } while (0)
#define KBASE(t) ((t) * KVBLK)
#define MASKT(P0_, P1_, t) do { const int kb_ = KBASE(t); const int kblk_ = (t) >> 2; \
        if (kblk_ < qb) { if (qb > 3) mask_all(P0_, P1_, ((selmask >> kblk_) & 1u) == 0u); } \
        else if (kb_ + KVBLK - 1 > qlo) mask_tile(P0_, P1_, qm - kb_); } while (0)
    constexpr int NQL = 8;
#define SEAM_K0() do { VMWN(NQL); SWRITE_HK(0); SBAR(); } while (0)
    f32x16 pA0, pA1, pB0, pB1; float mnA, mnB, alA, alB; bf16x8 pa0, pa1, pa2, pa3;
    SWRITE_HV(0); SBAR();
    if (NT > 1) { SLOAD_H(Kh, Vh, KBASE(1)); }
    SBAR(); qkt<0>(pA0, pA1, K_lds, r32, hi, S.qr);
    MASKT(pA0, pA1, 0); partialSM(pA0, pA1, m_reg, mnA, alA);
    if (NT > 1) { VMW(); SWRITE_H(1); }
    __syncthreads();
#define HALF_STEP(PX0, PX1, mnX, alX, PY0, PY1, alY, t, KB, VB, SB) do {                                                      \
        SBAR(); qkt<KB>(PX0, PX1, K_lds, r32, hi, S.qr);                                             \
        finishSM(PY0, PY1, alY, l_reg, pa0, pa1, pa2, pa3); SBAR();                                                           \
        if ((t) + 1 < NT) { SLOAD_H(Kh, Vh, KBASE((t) + 1)); SBAR(); }                                               \
        pv_tile<VB>(o, vb0, pa0, pa1, pa2, pa3); MASKT(PX0, PX1, (t)); partialSM(PX0, PX1, m_reg, mnX, alX);                                        \
        __syncthreads();                                                                                                      \
        if ((t) + 1 < NT) { VMW(); SWRITE_H(SB); }                                                                          \
        RESC(alX); __syncthreads(); } while (0)
    for (int t = 1; t + 1 < NT; t += 2) {
        HALF_STEP(pB0, pB1, mnB, alB, pA0, pA1, alA, t, 1, 0, 0);
        HALF_STEP(pA0, pA1, mnA, alA, pB0, pB1, alB, t + 1, 0, 1, 1);
    }
    const bool even = (NT & 1) == 0;
    if (even) { SBAR(); qkt<1>(pB0, pB1, K_lds, r32, hi, S.qr); SBAR(); }
    { SLOAD_H(nxt.K, nxt.V, 0); SBAR();
      const bf16* qb__ = nxt.Q + (size_t)(wid * QBLK) * RS;
#pragma unroll
      for (int d0 = 0; d0 < 8; ++d0) S.qr[d0] = load8(qb__ + qoff + d0 * 16); }
    SBAR();
    finishSM(pA0, pA1, alA, l_reg, pa0, pa1, pa2, pa3); SBAR();
    pv_tile<0>(o, vb0, pa0, pa1, pa2, pa3);
    if (even) { MASKT(pB0, pB1, NT - 1); partialSM(pB0, pB1, m_reg, mnB, alB); __syncthreads(); RESC(alB);
        finishSM(pB0, pB1, alB, l_reg, pa0, pa1, pa2, pa3); SBAR(); pv_tile<1>(o, vb0, pa0, pa1, pa2, pa3); }
    SBAR(); SEAM_K0();
    if (hi == 0) li_l[r32] = l_reg; asm volatile("s_waitcnt lgkmcnt(0)" ::: "memory");
    float rli[16];
#pragma unroll
    for (int r = 0; r < 16; ++r) rli[r] = __builtin_amdgcn_rcpf(li_l[crow(r, hi)]);
    bf16* Ow = cur.O + (size_t)(wid * QBLK) * RSO;
    const unsigned ooff = (unsigned)(4 * hi * RSO + r32);
#pragma unroll
    for (int r = 0; r < 16; ++r) { const int orow0 = (r & 3) + 8 * (r >> 2);
#pragma unroll
        for (int d0 = 0; d0 < 4; ++d0) { const float v = o[d0][r] * rli[r];
            const float vn = __shfl_xor(v, 1);
            if ((r32 & 1) == 0) *(unsigned*)(Ow + ooff + (unsigned)(orow0 * RSO + d0 * 32)) = cvtpk(v, vn); } }
    __syncthreads();
#undef RESC
#undef KBASE
#undef MASKT
#undef SEAM_K0
#undef HALF_STEP
}
#undef VMW
#undef VMWN
#undef SLOAD_H
#undef SWRITE_HK
#undef SWRITE_HV
#undef SWRITE_H
#undef KSWZ
#undef SBAR
}

namespace dn {
#ifndef DBL
#define DBL -1
#endif
#define REPS(k) for (int rep_ = 0; rep_ < ((DBL == (k)) ? 2 : 1); ++rep_)
constexpr int L_QB = 0, L_KB = 17408, L_KT = 34816, L_VT = 53248, L_LM = 71680, L_TB = 89088, L_GV = 107520;
constexpr int RQ = 272, LMS = 68, RT = 144;

struct Raw { unsigned v[33]; float br, ar; };
DI void prep_load(const Params& p, int item, Raw& R, int lane, int wave) {
    const int bh = item >> 5, n = item & 31, b = bh >> 3, h = bh & 7, i0 = wave * 8, c0 = 2 * lane;
    const bf16_t* PROJ = (const bf16_t*)(p.ws + WS_B);
#pragma unroll
    for (int seg = 0; seg < 3; ++seg)
#pragma unroll
        for (int jj = 0; jj < 11; ++jj) {
            const int sp = n * 64 + i0 - 3 + jj;
            unsigned v = 0u;
            if (sp >= 0) v = *(const unsigned*)(PROJ + (size_t)(b * SEQ + sp) * PP + C_DN + seg * 1024 + h * HD + c0);
            R.v[seg * 11 + jj] = v;
        }
    R.br = 0.f; R.ar = 0.f;
    if (wave == 0) { const float* BA = (const float*)(p.ws + WS_BA); const size_t t = (size_t)(b * SEQ + n * 64 + lane);
        R.br = BA[t * 16 + h]; R.ar = BA[t * 16 + 8 + h]; }
}
#define DN_BAR() do { asm volatile("s_waitcnt lgkmcnt(0)" ::: "memory"); __builtin_amdgcn_s_barrier(); asm volatile("" ::: "memory"); } while (0)
DI void prep_chunk(const Params& p, LAS unsigned char* lds, int item, int nitem, Raw& R, int tid, int lane, int wave) {
    asm volatile("" : "+v"(tid), "+v"(lane));
    const int bh = item >> 5, n = item & 31, b = bh >> 3, h = bh & 7;
    unsigned char* rec = p.ws + WS_DNP + (size_t)item * DN_STRIDE;
    LAS float* LM = (LAS float*)(lds + L_LM);
    LAS float* GV = (LAS float*)(lds + L_GV);
    REPS(31) {
        const int i0 = wave * 8, c0 = 2 * lane;
#pragma unroll
        for (int seg = 0; seg < 3; ++seg) {
            const int chan = seg * 1024 + h * HD + c0;
            float w0[4], w1[4];
#pragma unroll
            for (int j = 0; j < 4; ++j) { const f32x2 wv = *(const f32x2*)(p.conv_w + j * 3072 + chan); w0[j] = wv.x; w1[j] = wv.y; }
            float r0[11], r1[11];
#pragma unroll
            for (int jj = 0; jj < 11; ++jj) { const unsigned v = R.v[seg * 11 + jj]; r0[jj] = bflo(v); r1[jj] = bfhi(v); }
            float ya[8], yb[8];
#pragma unroll
            for (int i = 0; i < 8; ++i) {
                float y0 = 0.f, y1 = 0.f;
#pragma unroll
                for (int j = 0; j < 4; ++j) { y0 += w0[j] * r0[i + j]; y1 += w1[j] * r1[i + j]; }
                y0 = siluf_(y0); y1 = siluf_(y1);
                if (seg < 2) {
                    const float ss = wave_sum(y0 * y0 + y1 * y1);
                    const float rn = (seg == 0 ? SCALE_Q : 1.0f) * rsqrt_(ss + EPS);
                    y0 *= rn; y1 *= rn;
                    *(LAS unsigned*)(lds + (seg == 0 ? L_QB : L_KB) + (i0 + i) * RQ + c0 * 2) = cvtpk(y0, y1);
                }
                ya[i] = y0; yb[i] = y1;
            }
            if (seg >= 1) {
                LAS unsigned char* tb = lds + (seg == 1 ? L_KT : L_VT) + c0 * RT + i0 * 2;
                u32x4 o0, o1;
                o0.x = cvtpk(ya[0], ya[1]); o0.y = cvtpk(ya[2], ya[3]); o0.z = cvtpk(ya[4], ya[5]); o0.w = cvtpk(ya[6], ya[7]);
                o1.x = cvtpk(yb[0], yb[1]); o1.y = cvtpk(yb[2], yb[3]); o1.z = cvtpk(yb[4], yb[5]); o1.w = cvtpk(yb[6], yb[7]);
                *(LAS u32x4*)tb = o0; *(LAS u32x4*)(tb + RT) = o1;
            }
        }
        if (wave == 0) {
            const float br = R.br, ar = R.ar;
            const float beta = sigmoidf_(br);
            const float xs = ar + p.dt_bias[h];
            const float sp = xs > 20.f ? xs : log1pf(expf(xs));
            float g = -expf(p.a_log[h]) * sp;
#pragma unroll
            for (int o = 1; o < 64; o <<= 1) { const float u = __shfl_up(g, o); if (lane >= o) g += u; }
            const float g63 = __shfl(g, 63);
            GV[lane] = g; GV[64 + lane] = beta; GV[128 + lane] = expf(g); GV[192 + lane] = expf(g63 - g);
        }
    }
    if (nitem >= 0) prep_load(p, nitem, R, lane, wave);
    DN_BAR();
    REPS(32) {
        const int mt = wave >> 1, nt = wave & 1, r = lane & 31, hi = lane >> 5;
        if (mt < 2) {
            const LAS unsigned char* Ab = lds + L_KB + (32 * nt + r) * RQ, * Bb = lds + L_QB + (32 * mt + r) * RQ;
            f32x16 acc = f32x16{};
#pragma unroll
            for (int ks = 0; ks < 8; ++ks) acc = MFMA32(*(const LAS bf16x8*)(Ab + (16 * ks + 8 * hi) * 2), *(const LAS bf16x8*)(Bb + (16 * ks + 8 * hi) * 2), acc);
            const int i = 32 * mt + r; const float Gi = GV[i];
            float v[16];
#pragma unroll
            for (int q = 0; q < 16; ++q) { const int j = 32 * nt + crow(q, hi); v[q] = i >= j ? acc[q] * __expf(Gi - GV[j]) : 0.f; }
            u32x4* QKf = (u32x4*)(rec + DN_QK) + ((mt * 4 + 2 * nt) * 64 + lane);
            u32x4 o0, o1;
            o0.x = cvtpk(v[0], v[1]); o0.y = cvtpk(v[2], v[3]); o0.z = cvtpk(v[4], v[5]); o0.w = cvtpk(v[6], v[7]);
            o1.x = cvtpk(v[8], v[9]); o1.y = cvtpk(v[10], v[11]); o1.z = cvtpk(v[12], v[13]); o1.w = cvtpk(v[14], v[15]);
            QKf[0] = o0; QKf[64] = o1;
        } else {
            const LAS unsigned char* Ab = lds + L_KB + (32 * (mt - 2) + r) * RQ, * Bb = lds + L_KB + (32 * nt + r) * RQ;
            f32x16 acc = f32x16{};
#pragma unroll
            for (int ks = 0; ks < 8; ++ks) acc = MFMA32(*(const LAS bf16x8*)(Ab + (16 * ks + 8 * hi) * 2), *(const LAS bf16x8*)(Bb + (16 * ks + 8 * hi) * 2), acc);
            const int j = 32 * nt + r; const float Gj = GV[j];
#pragma unroll
            for (int q = 0; q < 16; ++q) { const int row = 32 * (mt - 2) + crow(q, hi);
                const float e = row > j ? GV[64 + row] * __expf(GV[row] - Gj) : 0.f;
                LM[row * LMS + j] = acc[q] * e; }
        }
    }
    DN_BAR();
    REPS(33) {
        float Lr[64];
#pragma unroll
        for (int jq = 0; jq < 16; ++jq) { const f32x4 l = *(const LAS f32x4*)(LM + lane * LMS + 4 * jq); Lr[4 * jq] = l.x; Lr[4 * jq + 1] = l.y; Lr[4 * jq + 2] = l.z; Lr[4 * jq + 3] = l.w; }
        float xv[8];
#pragma unroll
        for (int q = 0; q < 8; ++q) xv[q] = (lane == 8 * wave + q) ? 1.0f : 0.0f;
#pragma unroll
        for (int j = 0; j < 63; ++j) {
#pragma unroll
            for (int q = 0; q < 8; ++q) { const float xj = __int_as_float(__builtin_amdgcn_readlane(__float_as_int(xv[q]), j)); xv[q] -= Lr[j] * xj; }
        }
        float t1[8], t2[8];
#pragma unroll
        for (int q = 0; q < 8; ++q) { const float bc = GV[64 + 8 * wave + q]; t1[q] = xv[q] * bc; t2[q] = t1[q] * GV[128 + 8 * wave + q]; }
        u32x4 o1, o2;
        o1.x = cvtpk(t1[0], t1[1]); o1.y = cvtpk(t1[2], t1[3]); o1.z = cvtpk(t1[4], t1[5]); o1.w = cvtpk(t1[6], t1[7]);
        o2.x = cvtpk(t2[0], t2[1]); o2.y = cvtpk(t2[2], t2[3]); o2.z = cvtpk(t2[4], t2[5]); o2.w = cvtpk(t2[6], t2[7]);
        *(LAS u32x4*)(lds + L_TB + lane * RT + wave * 16) = o1; *(LAS u32x4*)(lds + L_TB + 64 * RT + lane * RT + wave * 16) = o2;
    }
    DN_BAR();
    REPS(34) {
        const int r = lane & 31, hi = lane >> 5;
#pragma unroll
        for (int half = 0; half < 2; ++half) {
            const int tix = wave * 2 + half;
            f32x16 acc = f32x16{};
            if (tix < 8) {
                const int mt = tix >> 2, nt = tix & 3;
                const LAS unsigned char* Ab = lds + L_TB + (32 * mt + r) * RT + 16 * hi, * Bb = lds + L_VT + (32 * nt + r) * RT + 16 * hi;
#pragma unroll
                for (int ks = 0; ks < 4; ++ks) acc = MFMA32(*(const LAS bf16x8*)(Ab + 32 * ks), *(const LAS bf16x8*)(Bb + 32 * ks), acc);
                u32x4* Uf = (u32x4*)(rec + DN_U) + ((mt * 4 + nt) * 64 + lane) * 2;
                u32x4 o0, o1;
                o0.x = cvtpk(acc[0], acc[1]); o0.y = cvtpk(acc[2], acc[3]); o0.z = cvtpk(acc[4], acc[5]); o0.w = cvtpk(acc[6], acc[7]);
                o1.x = cvtpk(acc[8], acc[9]); o1.y = cvtpk(acc[10], acc[11]); o1.z = cvtpk(acc[12], acc[13]); o1.w = cvtpk(acc[14], acc[15]);
                Uf[0] = o0; Uf[1] = o1;
            } else {
                const int ntp = (tix - 8) >> 1, mt = tix & 1;
                const LAS unsigned char* Ab = lds + L_KT + (32 * ntp + r) * RT + 16 * hi, * Bb = lds + L_TB + 64 * RT + (32 * mt + r) * RT + 16 * hi;
#pragma unroll
                for (int ks = 0; ks < 4; ++ks) acc = MFMA32(*(const LAS bf16x8*)(Ab + 32 * ks), *(const LAS bf16x8*)(Bb + 32 * ks), acc);
                u32x4* Wf = (u32x4*)(rec + DN_W) + ((mt * 8 + 2 * ntp) * 64 + lane);
                u32x4 o0, o1;
                o0.x = cvtpk(-acc[0], -acc[1]); o0.y = cvtpk(-acc[2], -acc[3]); o0.z = cvtpk(-acc[4], -acc[5]); o0.w = cvtpk(-acc[6], -acc[7]);
                o1.x = cvtpk(-acc[8], -acc[9]); o1.y = cvtpk(-acc[10], -acc[11]); o1.z = cvtpk(-acc[12], -acc[13]); o1.w = cvtpk(-acc[14], -acc[15]);
                Wf[0] = o0; Wf[64] = o1;
            }
        }
#pragma unroll
        for (int rep = 0; rep < 2; ++rep) {
            const int f = tid + 512 * rep, mt = f >> 9, ks = (f >> 6) & 7, fr = f & 31, fh = (f >> 5) & 1, i = 32 * mt + fr;
            const LAS unsigned char* qp = lds + L_QB + i * RQ + (16 * ks + 4 * fh) * 2;
            const u32x2 a = *(const LAS u32x2*)qp, c = *(const LAS u32x2*)(qp + 16);
            const float e = GV[128 + i];
            u32x4 o; o.x = cvtpk(bflo(a.x) * e, bfhi(a.x) * e); o.y = cvtpk(bflo(a.y) * e, bfhi(a.y) * e); o.z = cvtpk(bflo(c.x) * e, bfhi(c.x) * e); o.w = cvtpk(bflo(c.y) * e, bfhi(c.y) * e);
            ((u32x4*)(rec + DN_QD))[f] = o;
        }
#pragma unroll
        for (int rep = 0; rep < 2; ++rep) {
            const int f = tid + 512 * rep, a4 = f >> 8, ks = (f >> 6) & 3, fr = f & 31, fh = (f >> 5) & 1, d = 32 * a4 + fr;
            const LAS unsigned char* kp = lds + L_KT + d * RT + (16 * ks + 4 * fh) * 2;
            const u32x2 a = *(const LAS u32x2*)kp, c = *(const LAS u32x2*)(kp + 16);
            const LAS float* eg = GV + 192 + 16 * ks + 4 * fh;
            u32x4 o; o.x = cvtpk(bflo(a.x) * eg[0], bfhi(a.x) * eg[1]); o.y = cvtpk(bflo(a.y) * eg[2], bfhi(a.y) * eg[3]);
            o.z = cvtpk(bflo(c.x) * eg[8], bfhi(c.x) * eg[9]); o.w = cvtpk(bflo(c.y) * eg[10], bfhi(c.y) * eg[11]);
            ((u32x4*)(rec + DN_KT))[f] = o;
        }
        if (tid == 0) *(float*)(rec + DN_SC) = GV[128 + 63];
    }
    DN_BAR();
}

DI bf16x8 pack_step(const f32x16& x, int s) {
    u32x4 w;
    if (s == 0) { w.x = cvtpk(x[0], x[1]); w.y = cvtpk(x[2], x[3]); w.z = cvtpk(x[4], x[5]); w.w = cvtpk(x[6], x[7]); }
    else { w.x = cvtpk(x[8], x[9]); w.y = cvtpk(x[10], x[11]); w.z = cvtpk(x[12], x[13]); w.w = cvtpk(x[14], x[15]); }
    return __builtin_bit_cast(bf16x8, w);
}

constexpr int RB = 57344;
DI void recur(const Params& p, LAS unsigned char* lds, int bh, int tid, int lane, int wave) {
    asm volatile("" : "+v"(tid), "+v"(lane));
    const int r = lane & 31, hi = lane >> 5, b = bh >> 3, h = bh & 7;
    const unsigned char* rec0 = p.ws + WS_DNP + (size_t)(bh * 32) * DN_STRIDE;
    if (wave >= 4) {
        const int lt = tid - 256;
        u32x4 v[14];
        {   const u32x4* src = (const u32x4*)(rec0 + DN_W) + lt;
#pragma unroll
            for (int k = 0; k < 14; ++k) v[k] = src[k * 256];
#pragma unroll
            for (int k = 0; k < 14; ++k) *(LAS u32x4*)(lds + (k * 256 + lt) * 16) = v[k]; }
        DN_BAR();
        for (int n = 0; n < 32; ++n) {
            if (n + 1 < 32) { const u32x4* src = (const u32x4*)(rec0 + (size_t)(n + 1) * DN_STRIDE + DN_W) + lt;
#pragma unroll
                for (int k = 0; k < 14; ++k) v[k] = src[k * 256];
                LAS unsigned char* dst = lds + ((n + 1) & 1) * RB;
#pragma unroll
                for (int k = 0; k < 14; ++k) *(LAS u32x4*)(dst + (k * 256 + lt) * 16) = v[k]; }
            DN_BAR();
        }
    } else {
        const int slice = wave, dv0 = slice * 32;
        float* ODN = (float*)(p.ws + WS_D);
        f32x16 St[4];
#pragma unroll
        for (int a = 0; a < 4; ++a) St[a] = f32x16{};
        u32x4 un[2][2];
#pragma unroll
        for (int mt = 0; mt < 2; ++mt) { const u32x4* up = (const u32x4*)(rec0 + DN_U) + ((mt * 4 + slice) * 64 + lane) * 2; un[mt][0] = up[0]; un[mt][1] = up[1]; }
        DN_BAR();
        for (int n = 0; n < 32; ++n) {
            const unsigned char* rec = rec0 + (size_t)n * DN_STRIDE;
            const LAS unsigned char* buf = lds + (n & 1) * RB;
            const float eg = *(const float*)(rec + DN_SC);
            f32x16 Vn[2], O[2];
#pragma unroll
            for (int mt = 0; mt < 2; ++mt) { const u32x4 a = un[mt][0], c = un[mt][1];
                Vn[mt][0] = bflo(a.x); Vn[mt][1] = bfhi(a.x); Vn[mt][2] = bflo(a.y); Vn[mt][3] = bfhi(a.y); Vn[mt][4] = bflo(a.z); Vn[mt][5] = bfhi(a.z); Vn[mt][6] = bflo(a.w); Vn[mt][7] = bfhi(a.w);
                Vn[mt][8] = bflo(c.x); Vn[mt][9] = bfhi(c.x); Vn[mt][10] = bflo(c.y); Vn[mt][11] = bfhi(c.y); Vn[mt][12] = bflo(c.z); Vn[mt][13] = bfhi(c.z); Vn[mt][14] = bflo(c.w); Vn[mt][15] = bfhi(c.w); }
            if (n + 1 < 32) {
#pragma unroll
                for (int mt = 0; mt < 2; ++mt) { const u32x4* up = (const u32x4*)(rec + DN_STRIDE + DN_U) + ((mt * 4 + slice) * 64 + lane) * 2; un[mt][0] = up[0]; un[mt][1] = up[1]; } }
            bf16x8 Sf[8];
#pragma unroll
            for (int a = 0; a < 4; ++a) { Sf[2 * a] = pack_step(St[a], 0); Sf[2 * a + 1] = pack_step(St[a], 1); }
#pragma unroll
            for (int mt = 0; mt < 2; ++mt)
#pragma unroll
                for (int ks = 0; ks < 8; ++ks) Vn[mt] = MFMA32(*(const LAS bf16x8*)(buf + ((mt * 8 + ks) * 64 + lane) * 16), Sf[ks], Vn[mt]);
#pragma unroll
            for (int mt = 0; mt < 2; ++mt) { O[mt] = f32x16{};
#pragma unroll
                for (int ks = 0; ks < 8; ++ks) O[mt] = MFMA32(*(const LAS bf16x8*)(buf + 16384 + ((mt * 8 + ks) * 64 + lane) * 16), Sf[ks], O[mt]); }
            bf16x8 Vf[4];
#pragma unroll
            for (int mt = 0; mt < 2; ++mt) { Vf[2 * mt] = pack_step(Vn[mt], 0); Vf[2 * mt + 1] = pack_step(Vn[mt], 1); }
#pragma unroll
            for (int mt = 0; mt < 2; ++mt)
#pragma unroll
                for (int ks = 0; ks < 4; ++ks) O[mt] = MFMA32(*(const LAS bf16x8*)(buf + 49152 + ((mt * 4 + ks) * 64 + lane) * 16), Vf[ks], O[mt]);
#pragma unroll
            for (int a = 0; a < 4; ++a) {
                St[a] = St[a] * eg;
#pragma unroll
                for (int ks = 0; ks < 4; ++ks) St[a] = MFMA32(*(const LAS bf16x8*)(buf + 32768 + ((a * 4 + ks) * 64 + lane) * 16), Vf[ks], St[a]);
            }
            float* orow = ODN + (size_t)(b * SEQ + n * 64) * 1024 + h * HD + dv0 + r;
#pragma unroll
            for (int mt = 0; mt < 2; ++mt)
#pragma unroll
                for (int i = 0; i < 16; ++i) orow[(size_t)(32 * mt + crow(i, hi)) * 1024] = O[mt][i];
            DN_BAR();
        }
    }
}
}

DI void transpose_tile(const float* W, int N, int k0, int sn0, bf16_t* WT, int dpitch, int drow0, int dk0, int nvalid, LAS float* scr, int lane) {
#pragma unroll 8
    for (int i = 0; i < 32; ++i) { const int kk = 2 * i + (lane >> 5); scr[kk * 33 + (lane & 31)] = W[(size_t)(k0 + kk) * N + sn0 + (lane & 31)]; }
    asm volatile("s_waitcnt lgkmcnt(0)" ::: "memory");
    const int c = lane & 7;
#pragma unroll
    for (int j = 0; j < 4; ++j) { const int n = (lane >> 3) + 8 * j; const LAS float* s = scr + (8 * c) * 33 + n;
        u32x4 o; o.x = cvtpk(s[0 * 33], s[1 * 33]); o.y = cvtpk(s[2 * 33], s[3 * 33]); o.z = cvtpk(s[4 * 33], s[5 * 33]); o.w = cvtpk(s[6 * 33], s[7 * 33]);
        if (n < nvalid) *(u32x4*)(WT + (size_t)(drow0 + n) * dpitch + dk0 + k0 + 8 * c) = o; }
    asm volatile("s_waitcnt lgkmcnt(0)" ::: "memory");
}

DI void phase0(const Params& p, LAS unsigned char* lds, int tid, int lane, int wave, int bid, int G) {
    float* MOD = (float*)(p.ws + WS_MOD);
    if (bid < 192) {
        LAS float* sc = (LAS float*)lds;
        LAS float* red = (LAS float*)(lds + 65536);
        for (int i = tid; i < 8 * 2048; i += 512) { const int bb = i >> 11, k = i & 2047; sc[k * 8 + bb] = siluf_acc(p.c[i]); }
        __syncthreads();
        const int n0 = bid * 64;
        const int ksub = lane >> 4, cg = lane & 15;
        f32x4 acc[8];
#pragma unroll
        for (int bb = 0; bb < 8; ++bb) acc[bb] = (f32x4){0.f, 0.f, 0.f, 0.f};
        const float* wp = p.w_ada + (size_t)(wave * 256 + ksub) * 12288 + n0 + 4 * cg;
#pragma unroll 8
        for (int it = 0; it < 64; ++it) {
            const f32x4 wv = *(const f32x4*)(wp + (size_t)(4 * it) * 12288);
            const LAS float* sp = sc + (wave * 256 + 4 * it + ksub) * 8;
            const f32x4 s0 = *(const LAS f32x4*)sp, s1 = *(const LAS f32x4*)(sp + 4);
            acc[0] += wv * s0.x; acc[1] += wv * s0.y; acc[2] += wv * s0.z; acc[3] += wv * s0.w;
            acc[4] += wv * s1.x; acc[5] += wv * s1.y; acc[6] += wv * s1.z; acc[7] += wv * s1.w;
        }
#pragma unroll
        for (int bb = 0; bb < 8; ++bb) {
#pragma unroll
            for (int e = 0; e < 4; ++e) { float v = acc[bb][e]; v += __shfl_xor(v, 16); v += __shfl_xor(v, 32); acc[bb][e] = v; }
            if (ksub == 0) *(LAS f32x4*)(red + (wave * 8 + bb) * 64 + 4 * cg) = acc[bb];
        }
        __syncthreads();
        { const int bb = tid >> 6, col = tid & 63; float s = 0.f;
#pragma unroll
          for (int w = 0; w < 8; ++w) s += red[(w * 8 + bb) * 64 + col];
          MOD[bb * 12288 + n0 + col] = s + p.b_ada[n0 + col]; }
        __syncthreads();
    } else {
        f32x2* CS = (f32x2*)(p.ws + WS_CS);
        for (int i = (bid - 192) * 512 + tid; i < T * 16; i += (G - 192) * 512) {
            const int t = i >> 4, f = i & 15;
            const float inv = powf(500000.0f, -(float)f * (2.0f / 32.0f));
            const float ang = (float)p.pos[t] * inv;
            float sn, cs; sincosf(ang, &sn, &cs);
            CS[i] = (f32x2){cs, sn};
        }
    }
    LAS float* scr = (LAS float*)(lds + wave * 8448);
    const int gw = bid * 8 + wave, NGW = G * 8;
    bf16_t* WIN = (bf16_t*)(p.ws + WS_WIN); bf16_t* WMD = (bf16_t*)(p.ws + WS_WMD); bf16_t* WOUT = (bf16_t*)(p.ws + WS_WOUT); bf16_t* WR = (bf16_t*)(p.ws + WS_WR);
    constexpr int I_A = 32 * 224, I_B = 32 * 128, I_C = 32, I_M = 16 * 64, I_O = 32 * 64, I_RG = 32, I_RE = 32;
    constexpr int NITEMS = I_A + I_B + I_C + 2 * I_M + I_O + I_RG + I_RE;
    for (int it = gw; it < NITEMS; it += NGW) {
        int r = it;
        if (r < I_A) { const int kb = r / 224, nb = r % 224; transpose_tile(p.w_in, 11280, 64 * kb, 32 * nb, WIN, DM, 32 * nb, 0, 32, scr, lane); continue; } r -= I_A;
        if (r < I_B) { const int kb = r / 128, nb = r % 128; transpose_tile(p.w_in, 11280, 64 * kb, 7184 + 32 * nb, WIN, DM, 7168 + 32 * nb, 0, 32, scr, lane); continue; } r -= I_B;
        if (r < I_C) { transpose_tile(p.w_in, 11280, 64 * r, 7168, (bf16_t*)(p.ws + WS_WBA), DM, 0, 0, 16, scr, lane); continue; } r -= I_C;
        if (r < I_M) { const int kb = r / 64, nb = r % 64; transpose_tile(p.w_bm, DM, 64 * kb, 32 * nb, WMD, DM, 32 * nb, 0, 32, scr, lane); continue; } r -= I_M;
        if (r < I_M) { const int kb = r / 64, nb = r % 64; transpose_tile(p.w_bd, DM, 64 * kb, 32 * nb, WMD, DM, 32 * nb, 1024, 32, scr, lane); continue; } r -= I_M;
        if (r < I_O) { const int kb = r / 64, nb = r % 64; transpose_tile(p.w_out, DM, 64 * kb, 32 * nb, WOUT, DM, 32 * nb, 0, 32, scr, lane); continue; } r -= I_O;
        if (r < I_RG) {
            const int k = r * 64 + lane;
#pragma unroll
            for (int e = 0; e < 4; ++e) WR[e * DM + k] = f2bf(p.w_rg[k * 4 + e]);
#pragma unroll
            for (int e = 36; e < 48; ++e) WR[e * DM + k] = 0;
            continue; } r -= I_RG;
        { transpose_tile(p.w_re, 32, 64 * r, 0, WR, DM, 4, 0, 32, scr, lane); }
    }
}

DI void phase_u1_item(const Params& p, int item, int tid, int lane, int wave) {
    const float* MOD = (const float*)(p.ws + WS_MOD); bf16_t* U1 = (bf16_t*)(p.ws + WS_A);
    const int tokb = item * 64;
    for (int rr = 0; rr < 8; ++rr) {
        const int m = tokb + wave * 8 + rr, b = m >> 11;
        const f32x4* xr = (const f32x4*)(p.x + (size_t)m * DM) + lane;
        f32x4 v[8]; float s = 0.f;
#pragma unroll
        for (int j = 0; j < 8; ++j) { v[j] = xr[64 * j]; s += (v[j].x * v[j].x + v[j].y * v[j].y) + (v[j].z * v[j].z + v[j].w * v[j].w); }
        const float rstd = rsqrt_(wave_sum(s) * (1.0f / DM) + EPS);
        const float* sh = MOD + b * 12288; const float* scl = sh + 2048;
        u32x2* o8 = (u32x2*)(U1 + (size_t)m * DM) + lane;
#pragma unroll
        for (int j = 0; j < 8; ++j) { const int col = 4 * (lane + 64 * j);
            const f32x4 g = *(const f32x4*)(p.g_mix_pre + col), a = *(const f32x4*)(scl + col), c = *(const f32x4*)(sh + col);
            const f32x4 u = (v[j] * rstd * g) * (a + 1.0f) + c;
            o8[64 * j] = (u32x2){cvtpk(u.x, u.y), cvtpk(u.z, u.w)}; }
    }
    __syncthreads();
    if (wave < 4) {
        const int tl = lane & 15, kg = lane >> 4;
        const bf16_t* up = U1 + (size_t)(tokb + wave * 16 + tl) * DM + 8 * kg;
        const bf16_t* wp = (const bf16_t*)(p.ws + WS_WBA) + (size_t)tl * DM + 8 * kg;
        f32x4 a0 = {0.f, 0.f, 0.f, 0.f}, a1 = a0;
#pragma unroll 8
        for (int s = 0; s < 64; s += 2) {
            a0 = MFMA16(*(const bf16x8*)(wp + 32 * s), *(const bf16x8*)(up + 32 * s), a0);
            a1 = MFMA16(*(const bf16x8*)(wp + 32 * s + 32), *(const bf16x8*)(up + 32 * s + 32), a1);
        }
        float* BA = (float*)(p.ws + WS_BA);
        *(f32x4*)(BA + (size_t)(tokb + wave * 16 + tl) * 16 + 4 * kg) = a0 + a1;
    }
}

DI void rotary_item(const Params& p, int item, int lane) {
    const int which = item & 1, h = (item >> 1) & 7, blk = (item >> 4) & 7, b = item >> 7;
    bf16_t* PROJ = (bf16_t*)(p.ws + WS_B);
    const f32x2* CS = (const f32x2*)(p.ws + WS_CS);
    const int tok0 = b * SEQ + blk * 256; const int colb = (which ? C_K : C_Q) + h * HD;
    float s0 = 0.f, s1 = 0.f;
    if (which) {
#pragma unroll 8
        for (int rr = 0; rr < 256; ++rr) { const unsigned v = *(const unsigned*)(PROJ + (size_t)(tok0 + rr) * PP + colb + 2 * lane); s0 += bflo(v); s1 += bfhi(v); }
    }
    const int rsub = lane >> 4, i = lane & 15;
    float a0 = 0.f, a1 = 0.f;
#pragma unroll 4
    for (int it = 0; it < 64; ++it) {
        const int t = tok0 + it * 4 + rsub;
        bf16_t* ptr = PROJ + (size_t)t * PP + colb + i;
        const float x1 = bf2f(ptr[0]), x2 = bf2f(ptr[16]);
        const f32x2 cs = CS[t * 16 + i];
        const unsigned w = cvtpk(x1 * cs.x - x2 * cs.y, x2 * cs.x + x1 * cs.y);
        ptr[0] = (bf16_t)(w & 0xffffu); ptr[16] = (bf16_t)(w >> 16);
        a0 += bflo(w); a1 += bfhi(w);
    }
    if (which) {
        a0 += __shfl_xor(a0, 16); a0 += __shfl_xor(a0, 32); a1 += __shfl_xor(a1, 16); a1 += __shfl_xor(a1, 32);
        bf16_t* KM = (bf16_t*)(p.ws + WS_KMEAN) + ((size_t)(b * 8 + h) * 8 + blk) * HD;
        if (lane >= 16) { *(unsigned*)(KM + 2 * lane) = cvtpk(s0 * (1.0f / 256.0f), s1 * (1.0f / 256.0f)); }
        else { KM[lane] = f2bf(a0 * (1.0f / 256.0f)); KM[16 + lane] = f2bf(a1 * (1.0f / 256.0f)); }
    }
}

DI void phase_dn_final(const Params& p, int lane, int gw, int NGW) {
    const float* ODN = (const float*)(p.ws + WS_D); const bf16_t* PROJ = (const bf16_t*)(p.ws + WS_B); bf16_t* YAB = (bf16_t*)(p.ws + WS_A);
    const int d0 = (lane & 7) * 16;
    for (int m = gw; m < T; m += NGW) {
        const float* op = ODN + (size_t)m * 1024 + lane * 16;
        f32x4 v[4]; float s = 0.f;
#pragma unroll
        for (int j = 0; j < 4; ++j) { v[j] = *(const f32x4*)(op + 4 * j); s += (v[j].x * v[j].x + v[j].y * v[j].y) + (v[j].z * v[j].z + v[j].w * v[j].w); }
        s += __shfl_xor(s, 1); s += __shfl_xor(s, 2); s += __shfl_xor(s, 4);
        const float rstd = rsqrt_(s * (1.0f / HD) + EPS);
        const u32x4 z0 = *(const u32x4*)(PROJ + (size_t)m * PP + C_Z + lane * 16), z1 = *(const u32x4*)(PROJ + (size_t)m * PP + C_Z + lane * 16 + 8);
        const float zz[16] = {bflo(z0.x), bfhi(z0.x), bflo(z0.y), bfhi(z0.y), bflo(z0.z), bfhi(z0.z), bflo(z0.w), bfhi(z0.w),
                              bflo(z1.x), bfhi(z1.x), bflo(z1.y), bfhi(z1.y), bflo(z1.z), bfhi(z1.z), bflo(z1.w), bfhi(z1.w)};
        float y[16];
#pragma unroll
        for (int j = 0; j < 4; ++j) { const f32x4 g = *(const f32x4*)(p.dn_gain + d0 + 4 * j);
            y[4 * j + 0] = v[j].x * rstd * g.x * siluf_(zz[4 * j + 0]); y[4 * j + 1] = v[j].y * rstd * g.y * siluf_(zz[4 * j + 1]);
            y[4 * j + 2] = v[j].z * rstd * g.z * siluf_(zz[4 * j + 2]); y[4 * j + 3] = v[j].w * rstd * g.w * siluf_(zz[4 * j + 3]); }
        u32x4 o0, o1;
        o0.x = cvtpk(y[0], y[1]); o0.y = cvtpk(y[2], y[3]); o0.z = cvtpk(y[4], y[5]); o0.w = cvtpk(y[6], y[7]);
        o1.x = cvtpk(y[8], y[9]); o1.y = cvtpk(y[10], y[11]); o1.z = cvtpk(y[12], y[13]); o1.w = cvtpk(y[14], y[15]);
        bf16_t* yp = YAB + (size_t)m * DM + 1024 + lane * 16;
        *(u32x4*)yp = o0; *(u32x4*)(yp + 8) = o1;
    }
}

constexpr int L5_LG = 0;
constexpr int L5_HIST = 12288;
constexpr int L5_TOK = 12288 + 256;
DI void phase5_item(const Params& p, LAS unsigned char* lds, int item, int tid, int lane, int wave) {
    const float* MOD = (const float*)(p.ws + WS_MOD); const bf16_t* OM = (const bf16_t*)(p.ws + WS_OUTMIX); bf16_t* U2 = (bf16_t*)(p.ws + WS_A);
    const bf16_t* WR = (const bf16_t*)(p.ws + WS_WR);
    LAS unsigned* hist = (LAS unsigned*)(lds + L5_HIST); LAS unsigned* tokw = (LAS unsigned*)(lds + L5_TOK);
    if (tid < 64) hist[tid] = 0u;
    const int tokb = item * 64;
    for (int rr = 0; rr < 8; ++rr) {
        const int m = tokb + wave * 8 + rr, b = m >> 11;
        const float* mod = MOD + b * 12288;
        float om[32], xv[32];
        float s = 0.f;
#pragma unroll
        for (int j = 0; j < 4; ++j) { const int col = 8 * (lane + 64 * j);
            const u32x4 w = *(const u32x4*)(OM + (size_t)m * DM + col);
            om[8 * j + 0] = bflo(w.x); om[8 * j + 1] = bfhi(w.x); om[8 * j + 2] = bflo(w.y); om[8 * j + 3] = bfhi(w.y);
            om[8 * j + 4] = bflo(w.z); om[8 * j + 5] = bfhi(w.z); om[8 * j + 6] = bflo(w.w); om[8 * j + 7] = bfhi(w.w);
            const f32x4 x0 = *(const f32x4*)(p.x + (size_t)m * DM + col), x1 = *(const f32x4*)(p.x + (size_t)m * DM + col + 4);
            xv[8 * j + 0] = x0.x; xv[8 * j + 1] = x0.y; xv[8 * j + 2] = x0.z; xv[8 * j + 3] = x0.w; xv[8 * j + 4] = x1.x; xv[8 * j + 5] = x1.y; xv[8 * j + 6] = x1.z; xv[8 * j + 7] = x1.w;
#pragma unroll
            for (int e = 0; e < 8; ++e) s += om[8 * j + e] * om[8 * j + e]; }
        const float r1 = rsqrt_(wave_sum(s) * (1.0f / DM) + EPS);
        float s2 = 0.f;
#pragma unroll
        for (int j = 0; j < 4; ++j) { const int col = 8 * (lane + 64 * j);
#pragma unroll
            for (int q = 0; q < 2; ++q) { const f32x4 g = *(const f32x4*)(p.g_mix_post + col + 4 * q), gt = *(const f32x4*)(mod + 4096 + col + 4 * q);
                f32x4 o;
                o.x = xv[8 * j + 4 * q + 0] + gt.x * (om[8 * j + 4 * q + 0] * r1 * g.x); o.y = xv[8 * j + 4 * q + 1] + gt.y * (om[8 * j + 4 * q + 1] * r1 * g.y);
                o.z = xv[8 * j + 4 * q + 2] + gt.z * (om[8 * j + 4 * q + 2] * r1 * g.z); o.w = xv[8 * j + 4 * q + 3] + gt.w * (om[8 * j + 4 * q + 3] * r1 * g.w);
                *(f32x4*)(p.out + (size_t)m * DM + col + 4 * q) = o;
                xv[8 * j + 4 * q + 0] = o.x; xv[8 * j + 4 * q + 1] = o.y; xv[8 * j + 4 * q + 2] = o.z; xv[8 * j + 4 * q + 3] = o.w;
                s2 += (o.x * o.x + o.y * o.y) + (o.z * o.z + o.w * o.w); } }
        const float r2 = rsqrt_(wave_sum(s2) * (1.0f / DM) + EPS);
#pragma unroll
        for (int j = 0; j < 4; ++j) { const int col = 8 * (lane + 64 * j); float u[8];
#pragma unroll
            for (int q = 0; q < 2; ++q) { const f32x4 g = *(const f32x4*)(p.g_ffn_pre + col + 4 * q), sc = *(const f32x4*)(mod + 5 * 2048 - 2048 + col + 4 * q), sh = *(const f32x4*)(mod + 3 * 2048 + col + 4 * q);
                u[4 * q + 0] = (xv[8 * j + 4 * q + 0] * r2 * g.x) * (1.0f + sc.x) + sh.x; u[4 * q + 1] = (xv[8 * j + 4 * q + 1] * r2 * g.y) * (1.0f + sc.y) + sh.y;
                u[4 * q + 2] = (xv[8 * j + 4 * q + 2] * r2 * g.z) * (1.0f + sc.z) + sh.z; u[4 * q + 3] = (xv[8 * j + 4 * q + 3] * r2 * g.w) * (1.0f + sc.w) + sh.w; }
            u32x4 w; w.x = cvtpk(u[0], u[1]); w.y = cvtpk(u[2], u[3]); w.z = cvtpk(u[4], u[5]); w.w = cvtpk(u[6], u[7]);
            *(u32x4*)(U2 + (size_t)m * DM + col) = w; }
    }
    __syncthreads();
    if (wave < 4) {
        const int tl = lane & 15, kg = lane >> 4;
        const bf16_t* up = U2 + (size_t)(tokb + wave * 16 + tl) * DM + 8 * kg;
        const bf16_t* wp = WR + (size_t)tl * DM + 8 * kg;
        f32x4 a0 = {0.f, 0.f, 0.f, 0.f}, a1 = a0, a2 = a0;
#pragma unroll 4
        for (int s = 0; s < 64; ++s) {
            const bf16x8 bu = *(const bf16x8*)(up + 32 * s);
            const bf16x8 w0 = *(const bf16x8*)(wp + 32 * s), w1 = *(const bf16x8*)(wp + 16 * DM + 32 * s), w2 = *(const bf16x8*)(wp + 32 * DM + 32 * s);
            a0 = MFMA16(w0, bu, a0); a1 = MFMA16(w1, bu, a1); a2 = MFMA16(w2, bu, a2);
        }
        LAS float* lg = (LAS float*)(lds + L5_LG) + wave * 768 + tl * 48 + 4 * kg;
#pragma unroll
        for (int r = 0; r < 4; ++r) { lg[r] = a0[r]; lg[16 + r] = a1[r]; lg[32 + r] = a2[r]; }
        asm volatile("s_waitcnt lgkmcnt(0)" ::: "memory");
        if (lane < 16) {
            const LAS float* l = (const LAS float*)(lds + L5_LG) + wave * 768 + lane * 48;
            float gl[4]; int gs = 0; float gm;
#pragma unroll
            for (int i = 0; i < 4; ++i) gl[i] = l[i] + p.b_rg[i];
            gm = gl[0];
#pragma unroll
            for (int i = 1; i < 4; ++i) if (gl[i] > gm) { gm = gl[i]; gs = i; }
            float gsum = 0.f;
#pragma unroll
            for (int i = 0; i < 4; ++i) gsum += expf(gl[i] - gm);
            const float pg = 1.0f / gsum;
            float el[8]; float em = -3.0e38f;
#pragma unroll
            for (int i = 0; i < 8; ++i) { const float v = l[4 + 8 * gs + i] + p.b_re[8 * gs + i]; el[i] = v; em = fmaxf(em, v); }
            float pe[8]; float esum = 0.f;
#pragma unroll
            for (int i = 0; i < 8; ++i) { pe[i] = expf(el[i] - em); esum += pe[i]; }
            int i0 = 0; float p0 = pe[0];
#pragma unroll
            for (int i = 1; i < 8; ++i) if (pe[i] > p0) { p0 = pe[i]; i0 = i; }
            int i1 = -1; float p1 = -1.f;
#pragma unroll
            for (int i = 0; i < 8; ++i) if (i != i0 && pe[i] > p1) { p1 = pe[i]; i1 = i; }
            const float w0 = pg * p0 / (p0 + p1), w1 = pg * p1 / (p0 + p1);
            const int e0 = 8 * gs + i0, e1 = 8 * gs + i1;
            const unsigned lr0 = __hip_atomic_fetch_add(hist + e0, 1u, __ATOMIC_RELAXED, __HIP_MEMORY_SCOPE_WORKGROUP), lr1 = __hip_atomic_fetch_add(hist + e1, 1u, __ATOMIC_RELAXED, __HIP_MEMORY_SCOPE_WORKGROUP);
            LAS unsigned* tw = tokw + (wave * 16 + lane) * 6;
            tw[0] = (unsigned)e0; tw[1] = (unsigned)e1; tw[2] = lr0; tw[3] = lr1; tw[4] = __float_as_uint(w0); tw[5] = __float_as_uint(w1);
        }
    }
    __syncthreads();
    if (tid < 32) { unsigned* cnt = (unsigned*)(p.ws + WS_CTL) + CW_CNT; const unsigned hcount = hist[tid];
        hist[32 + tid] = hcount ? __hip_atomic_fetch_add(cnt + tid, hcount, __ATOMIC_RELAXED, __HIP_MEMORY_SCOPE_AGENT) : 0u; }
    __syncthreads();
    if (tid < 64) {
        const LAS unsigned* tw = tokw + tid * 6; const int tok = tokb + tid;
        const unsigned e0 = tw[0], e1 = tw[1], q0 = hist[32 + e0] + tw[2], q1 = hist[32 + e1] + tw[3];
        int* RT = (int*)(p.ws + WS_RTOK); RT[e0 * ECAP + q0] = tok; RT[e1 * ECAP + q1] = tok;
        u32x4* rec = (u32x4*)(p.ws + WS_REC) + (size_t)tok * 2;
        rec[0] = (u32x4){e0, e1, q0, q1}; rec[1] = (u32x4){tw[4], tw[5], 0u, 0u};
    }
    __syncthreads();
}
DI void expert_copy_item(const Params& p, int it, LAS float* scr, int lane) {
    const int e = it / 1536, r = it % 1536;
    bf16_t* WGU = (bf16_t*)(p.ws + WS_WGU); bf16_t* WDN = (bf16_t*)(p.ws + WS_WDN);
    if (r < 1024) { const int up = r >> 9, q = r & 511, kb = q >> 4, nb = q & 15, n0 = 32 * nb;
        const float* W = (up ? p.w_up : p.w_gate) + (size_t)e * DM * FF;
        transpose_tile(W, FF, 64 * kb, n0, WGU, DM, e * 1024 + (n0 >> 7) * 256 + (n0 & 127) + up * 128, 0, 32, scr, lane);
    } else { const int q = r - 1024, kb = q >> 6, nb = q & 63;
        transpose_tile(p.w_down + (size_t)e * FF * DM, DM, 64 * kb, 32 * nb, WDN, FF, e * DM + 32 * nb, 0, 32, scr, lane); }
}

struct MoeOrder {
    const LAS int* pref; const LAS int* cnt; int ntn, G, c;
    DI bool next(int i, pg8::Unit& u) const {
        const int L = i * G + c; const int total = pref[32] * ntn; if (L >= total) return false;
        const int tile = L / ntn, pnl = L - tile * ntn;
        int e = 0;
        for (int q = 1; q < 32; ++q) if (tile >= pref[q]) e = q;
        const int m = tile - pref[e];
        u.pm = tile; u.pn = e * ntn + pnl; u.ga = e * ECAP + m * 256; u.gn = cnt[e] - m * 256; return true;
    }
};
DI void moe_tables(const Params& p, LAS int* pref, LAS int* cntl, int tid) {
    if (tid == 0) { const unsigned* cnt = (const unsigned*)(p.ws + WS_CTL) + CW_CNT; int acc = 0;
        for (int e = 0; e < 32; ++e) { const int c = (int)__hip_atomic_load(cnt + e, __ATOMIC_RELAXED, __HIP_MEMORY_SCOPE_AGENT); pref[e] = acc; cntl[e] = c; acc += (c + 255) >> 8; }
        pref[32] = acc; }
    __syncthreads();
}

DI void phase8(const Params& p, const LAS int* pref, int lane, int gw, int NGW) {
    const float* MOD = (const float*)(p.ws + WS_MOD); const bf16_t* YB = (const bf16_t*)(p.ws + WS_YBUF);
    for (int m = gw; m < T; m += NGW) {
        const int b = m >> 11; const float* gt2 = MOD + b * 12288 + 5 * 2048;
        const u32x4* rec = (const u32x4*)(p.ws + WS_REC) + (size_t)m * 2;
        const u32x4 r0 = rec[0], r1 = rec[1];
        const size_t row0 = (size_t)(pref[r0.x] * 256 + (int)r0.z), row1 = (size_t)(pref[r0.y] * 256 + (int)r0.w);
        const float w0 = __uint_as_float(r1.x), w1 = __uint_as_float(r1.y);
        float y[32]; float s = 0.f;
#pragma unroll
        for (int j = 0; j < 4; ++j) { const int col = 8 * (lane + 64 * j);
            const u32x4 a = *(const u32x4*)(YB + row0 * DM + col), c = *(const u32x4*)(YB + row1 * DM + col);
            y[8 * j + 0] = w0 * bflo(a.x) + w1 * bflo(c.x); y[8 * j + 1] = w0 * bfhi(a.x) + w1 * bfhi(c.x);
            y[8 * j + 2] = w0 * bflo(a.y) + w1 * bflo(c.y); y[8 * j + 3] = w0 * bfhi(a.y) + w1 * bfhi(c.y);
            y[8 * j + 4] = w0 * bflo(a.z) + w1 * bflo(c.z); y[8 * j + 5] = w0 * bfhi(a.z) + w1 * bfhi(c.z);
            y[8 * j + 6] = w0 * bflo(a.w) + w1 * bflo(c.w); y[8 * j + 7] = w0 * bfhi(a.w) + w1 * bfhi(c.w);
#pragma unroll
            for (int e = 0; e < 8; ++e) s += y[8 * j + e] * y[8 * j + e]; }
        const float rs = rsqrt_(wave_sum(s) * (1.0f / DM) + EPS);
#pragma unroll
        for (int j = 0; j < 4; ++j) { const int col = 8 * (lane + 64 * j);
#pragma unroll
            for (int q = 0; q < 2; ++q) { float* op = p.out + (size_t)m * DM + col + 4 * q;
                const f32x4 x1 = *(const f32x4*)op, g = *(const f32x4*)(p.g_ffn_post + col + 4 * q), gt = *(const f32x4*)(gt2 + col + 4 * q);
                f32x4 o;
                o.x = x1.x + gt.x * (y[8 * j + 4 * q + 0] * rs * g.x); o.y = x1.y + gt.y * (y[8 * j + 4 * q + 1] * rs * g.y);
                o.z = x1.z + gt.z * (y[8 * j + 4 * q + 2] * rs * g.z); o.w = x1.w + gt.w * (y[8 * j + 4 * q + 3] * rs * g.w);
                *(f32x4*)op = o; } }
    }
}

#define XB_TMO      128
#define XB_XCNT(j)  (256  + 64 * (j))
#define XB_XSUB(j)  (1280 + 64 * (j))
#define XB_XGEN(j)  (2304 + 64 * (j))
#define XB_TOP      3328
#define XB_TOPGEN   3392
#define XCD_BAR_WORDS 3456
#define XB_SPIN_CAP (1u << 18)
DI unsigned xb_ld(unsigned* p)              { return __hip_atomic_load(p, __ATOMIC_RELAXED, __HIP_MEMORY_SCOPE_AGENT); }
DI unsigned xb_add(unsigned* p, unsigned v) { return __hip_atomic_fetch_add(p, v, __ATOMIC_RELAXED, __HIP_MEMORY_SCOPE_AGENT); }
DI unsigned xb_xcc_id() { return (unsigned)__builtin_amdgcn_s_getreg((3 << 11) | 20) & 0xFu; }
#define XB_SPIN(cond, bar) do { unsigned _sp = 0; while (cond) { __builtin_amdgcn_s_sleep(1); \
    if ((++_sp & 255u) == 0u) { if (xb_ld(&(bar)[XB_TMO])) break; if (_sp > XB_SPIN_CAP) { atomicAdd(&(bar)[XB_TMO], 1u); break; } } } } while (0)
struct XcdBarrier { unsigned* bar; unsigned x; volatile LAS unsigned* st; };
DI XcdBarrier xcd_barrier_post(unsigned* bar, volatile LAS unsigned* st) {
    XcdBarrier b; b.bar = bar; b.x = xb_xcc_id(); b.st = st;
    if (threadIdx.x == 0) (void)xb_add(&bar[XB_XCNT(b.x)], 1u);
    return b;
}
DI void xcd_barrier_complete(unsigned* bar, unsigned x, unsigned& nloc, unsigned& nx) {
    const unsigned G = gridDim.x * gridDim.y * gridDim.z;
    unsigned sum, cnt, mine, sp = 0u;
    for (;;) {
        sum = 0u; cnt = 0u; mine = 0u;
#pragma unroll
        for (unsigned j = 0; j < 16; ++j) { const unsigned c = xb_ld(&bar[XB_XCNT(j)]); sum += c; cnt += (c > 0u) ? 1u : 0u; mine = (j == x) ? c : mine; }
        if (sum == G) break;
        __builtin_amdgcn_s_sleep(1);
        if ((++sp & 255u) == 0u) { if (xb_ld(&bar[XB_TMO])) break; if (sp > XB_SPIN_CAP) { atomicAdd(&bar[XB_TMO], 1u); break; } }
    }
    nloc = mine > 0u ? mine : 1u; nx = cnt > 0u ? cnt : 1u;
}
DI void xcd_barrier(const XcdBarrier& b) {
    asm volatile("s_waitcnt vmcnt(0)" ::: "memory");
    __syncthreads();
    if (threadIdx.x == 0) {
        unsigned* bar = b.bar;
        __builtin_amdgcn_s_waitcnt(0);
        unsigned nloc = b.st[0], nx = b.st[1];
        if (nloc == 0u) { xcd_barrier_complete(bar, b.x, nloc, nx); b.st[0] = nloc; b.st[1] = nx; }
        const unsigned old = xb_add(&bar[XB_XSUB(b.x)], 1u);
        const unsigned gen = old / nloc;
        if (old + 1u == (gen + 1u) * nloc) {
            __builtin_amdgcn_fence(__ATOMIC_RELEASE, "agent");
            asm volatile("s_waitcnt vmcnt(0)" ::: "memory");
            const unsigned og = xb_add(&bar[XB_TOP], 1u);
            const unsigned tg = og / nx;
            if (og + 1u == (tg + 1u) * nx) xb_add(&bar[XB_TOPGEN], 1u);
            else XB_SPIN(xb_ld(&bar[XB_TOPGEN]) == tg, bar);
            __builtin_amdgcn_fence(__ATOMIC_ACQUIRE, "agent");
            xb_add(&bar[XB_XGEN(b.x)], 1u);
            asm volatile("s_waitcnt vmcnt(0)" ::: "memory");
        } else {
            XB_SPIN(xb_ld(&bar[XB_XGEN(b.x)]) == gen, bar);
            __builtin_amdgcn_fence(__ATOMIC_ACQUIRE, "agent");
            asm volatile("s_waitcnt vmcnt(0)" ::: "memory");
        }
    }
    __syncthreads();
}

constexpr int NWAVES = 8, NTHREADS = 512;
constexpr int LDS_GEMM = 131072, LDS_TAB = LDS_GEMM, LDS_BYTES = LDS_GEMM + 1024;
constexpr int N_PHASES = 12;
#ifndef DBL
#define DBL -1
#endif
#define REP(k) for (int rep_ = 0; rep_ < ((DBL == (k)) ? 2 : 1); ++rep_)
#ifndef MK_N_LAUNCHES
#define MK_N_LAUNCHES 1
#endif

DI moba::BlockRef attn_ref(const Params& p, int bh, int qb) {
    const int b = bh >> 3, h = bh & 7;
    const bf16_t* PROJ = (const bf16_t*)(p.ws + WS_B);
    moba::BlockRef r;
    r.Q = PROJ + (size_t)(b * SEQ + qb * 256) * PP + C_Q + h * HD;
    r.K = PROJ + (size_t)(b * SEQ) * PP + C_K + h * HD;
    r.V = PROJ + (size_t)(b * SEQ) * PP + C_V + h * HD;
    r.O = (bf16_t*)(p.ws + WS_A) + (size_t)(b * SEQ + qb * 256) * DM + h * HD;
    r.KM = (const bf16_t*)(p.ws + WS_KMEAN) + (size_t)bh * 8 * HD;
    r.P0 = qb * 256;
    return r;
}

typedef const __attribute__((address_space(4))) Params* KParams;
#if defined(__HIP_DEVICE_COMPILE__)
#define LOADP() KParams kq_ = kp_; asm volatile("" : "+s"(kq_)); const Params p = *kq_
#else
#define LOADP() const Params p = p_unused
#endif
__global__ void __launch_bounds__(NTHREADS, 2) fwd_kernel(Params p_unused) {
#if defined(__HIP_DEVICE_COMPILE__)
    const KParams kp_ = (KParams)__builtin_amdgcn_kernarg_segment_ptr();
#else
    const Params* kp_ = &p_unused;
#endif
    extern __shared__ __attribute__((aligned(16))) unsigned char lds_raw[];
    LAS unsigned char* lds = (LAS unsigned char*)lds_raw;
    const int bid = blockIdx.x, G = gridDim.x, NGW = G * NWAVES;
#define IDS() int tid_ = threadIdx.x; asm volatile("" : "+v"(tid_)); const int tid = tid_, lane = tid & 63, wave = __builtin_amdgcn_readfirstlane(tid >> 6), gw = bid * NWAVES + wave; (void)lane; (void)gw; (void)wave
    const int vcu = (G % 8 == 0) ? (bid % 8) * (G / 8) + bid / 8 : bid;
    const int lo = kp_->ph_lo, hi = kp_->ph_hi;
#ifdef ONLY
#define IN(k) ((k) == ONLY && lo <= (k) && (k) < hi)
#else
#define IN(k) (lo <= (k) && (k) < hi)
#endif
    { volatile LAS unsigned* st0 = (volatile LAS unsigned*)(lds + LDS_TAB + 512); if (threadIdx.x < 2) st0[threadIdx.x] = 0u; __syncthreads(); }
    const XcdBarrier xbar = xcd_barrier_post((unsigned*)(kp_->ws + WS_CTL) + CW_BAR, (volatile LAS unsigned*)(lds + LDS_TAB + 512));
#define SEAM(k) do { if (IN(k) && IN((k) + 1)) { if ((k) == 0) cg::this_grid().sync(); else xcd_barrier(xbar); } } while (0)

    if (IN(0)) { LOADP(); IDS(); REP(0) phase0(p, lds, tid, lane, wave, bid, G); }
    SEAM(0);
    if (IN(1)) { LOADP(); IDS(); REP(1) for (int it = bid; it < T / 64; it += G) phase_u1_item(p, it, tid, lane, wave); }
    SEAM(1);
    if (IN(2)) { LOADP(); IDS();
        pg8::Gemm g{(const bf16_t*)(p.ws + WS_A), (const bf16_t*)(p.ws + WS_WIN), DM, nullptr};
        pg8::StaticOrder S; S.init(T, NPROJ, G, bid);
        pg8::EpiStore E{(bf16_t*)(p.ws + WS_B), PP, 64};
        pg8::gemm_phase<pg8::EpiStore, pg8::StaticOrder, true, false>(lds, g, S, E);
#if DBL == 2
        pg8::gemm_phase<pg8::EpiStore, pg8::StaticOrder, true, false>(lds, g, S, E);
#endif
    }
    SEAM(2);
    if (IN(3)) { LOADP(); IDS();
        for (int it = gw; it < 1024; it += NGW) rotary_item(p, it, lane);
        REP(30) { dn::Raw R; if (bid < 64 * 32) dn::prep_load(p, bid, R, lane, wave);
            for (int it = bid; it < 64 * 32; it += G) dn::prep_chunk(p, lds, it, (it + G < 64 * 32) ? it + G : -1, R, tid, lane, wave); }
    }
    SEAM(3);
    if (IN(4)) { LOADP(); IDS();
        const int x = bid & 7, ci = bid >> 3, grp = ci >> 3, bhA = 8 * x + 7 - (ci & 7);
        REP(41) { if (grp == 0) dn::recur(p, lds, 8 * x + ci, tid, lane, wave); }
#ifndef NO_ATTN
        REP(40) {
            const int nblk = grp == 0 ? 1 : (grp == 2 ? 3 : 2);
#define QSEL(i) (grp == 0 ? 4 : grp == 1 ? ((i) == 0 ? 7 : 1) : grp == 2 ? ((i) == 0 ? 6 : ((i) == 1 ? 2 : 0)) : ((i) == 0 ? 5 : 3))
            moba::Seam S;
            moba::BlockRef cur = attn_ref(p, bhA, QSEL(0));
            moba::prime(cur, (char*)lds_raw, S);
            for (int i = 0; i < nblk; ++i) {
                const int in = (i + 1 < nblk) ? i + 1 : i;
                const moba::BlockRef nxt = attn_ref(p, bhA, QSEL(in));
                moba::block(cur, nxt, (char*)lds_raw, S);
                cur = nxt;
            }
#undef QSEL
        }
#endif
    }
    SEAM(4);
    if (IN(5)) { LOADP(); IDS(); REP(5) phase_dn_final(p, lane, gw, NGW); }
    SEAM(5);
    if (IN(6)) { LOADP(); IDS();
        pg8::Gemm g{(const bf16_t*)(p.ws + WS_A), (const bf16_t*)(p.ws + WS_WMD), DM, nullptr};
        pg8::StaticOrder S; S.init(T, DM, G, bid);
        pg8::EpiMerged E{(const bf16_t*)(p.ws + WS_B), (bf16_t*)(p.ws + WS_MERGED)};
        pg8::gemm_phase<pg8::EpiMerged, pg8::StaticOrder, true, false>(lds, g, S, E);
#if DBL == 6
        pg8::gemm_phase<pg8::EpiMerged, pg8::StaticOrder, true, false>(lds, g, S, E);
#endif
    }
    SEAM(6);
    if (IN(7)) { LOADP(); IDS();
        const bool copy_first = ((bid >> 3) & 1) == 0;
        LAS float* scr = (LAS float*)(lds + wave * 8448);
        if (copy_first) { REP(81) for (int it = gw; it < 32 * 1536; it += NGW) expert_copy_item(p, it, scr, lane); __syncthreads(); }
        {
        pg8::Gemm g{(const bf16_t*)(p.ws + WS_MERGED), (const bf16_t*)(p.ws + WS_WOUT), DM, nullptr};
        pg8::StaticOrder S; S.init(T, DM, G, bid);
        pg8::EpiStore E{(bf16_t*)(p.ws + WS_OUTMIX), DM, 8};
        pg8::gemm_phase<pg8::EpiStore, pg8::StaticOrder, true, false>(lds, g, S, E);
#if DBL == 7
        pg8::gemm_phase<pg8::EpiStore, pg8::StaticOrder, true, false>(lds, g, S, E);
#endif
        }
        if (!copy_first) { REP(81) for (int it = gw; it < 32 * 1536; it += NGW) expert_copy_item(p, it, scr, lane); }
    }
    SEAM(7);
    if (IN(8)) { LOADP(); IDS();
        for (int it = bid; it < T / 64; it += G) phase5_item(p, lds, it, tid, lane, wave);
    }
    SEAM(8);
    LAS int* pref = (LAS int*)(lds + LDS_TAB); LAS int* cntl = pref + 64;
    if (IN(9)) { LOADP(); IDS();
        moe_tables(p, pref, cntl, tid);
        pg8::Gemm g{(const bf16_t*)(p.ws + WS_A), (const bf16_t*)(p.ws + WS_WGU), DM, (const int*)(p.ws + WS_RTOK)};
        MoeOrder S{pref, cntl, 4, G, bid};
        pg8::EpiGU E{(bf16_t*)(p.ws + WS_H)};
        pg8::gemm_phase<pg8::EpiGU, MoeOrder, true, true>(lds, g, S, E);
#if DBL == 9
        pg8::gemm_phase<pg8::EpiGU, MoeOrder, true, true>(lds, g, S, E);
#endif
    }
    SEAM(9);
    if (IN(10)) { LOADP(); IDS();
        if (!IN(9)) moe_tables(p, pref, cntl, tid);
        pg8::Gemm g{(const bf16_t*)(p.ws + WS_H), (const bf16_t*)(p.ws + WS_WDN), FF, nullptr};
        MoeOrder S{pref, cntl, 8, G, bid};
        pg8::EpiStore E{(bf16_t*)(p.ws + WS_YBUF), DM, 8};
        pg8::gemm_phase<pg8::EpiStore, MoeOrder, true, false>(lds, g, S, E);
#if DBL == 10
        pg8::gemm_phase<pg8::EpiStore, MoeOrder, true, false>(lds, g, S, E);
#endif
    }
    SEAM(10);
    if (IN(11)) { LOADP(); IDS();
        if (!IN(10)) moe_tables(p, pref, cntl, tid);
        phase8(p, pref, lane, gw, NGW);
    }
#undef IN
#undef SEAM
}

extern "C" void kernel_launch(void* const* d_in, const int* in_sizes, int n_in, void* d_out, int out_size, void* d_ws, size_t ws_size, hipStream_t stream) {
    static int grid = 0;
    if (grid == 0) {
        if (n_in != 24 || in_sizes[0] != T * DM || out_size != T * DM || ws_size < WS_END) {
            fprintf(stderr, "kernel_launch: unexpected shapes (n_in %d, in0 %d, out %d, ws %zu); nothing launched\n", n_in, n_in > 0 ? in_sizes[0] : -1, out_size, ws_size); grid = -1; return; }
        int dev = 0, cus = 0, per_cu = 0;
        hipGetDevice(&dev); hipDeviceGetAttribute(&cus, hipDeviceAttributeMultiprocessorCount, dev);
        if (hipFuncSetAttribute((const void*)fwd_kernel, hipFuncAttributeMaxDynamicSharedMemorySize, LDS_BYTES) != hipSuccess) { fprintf(stderr, "kernel_launch: hipFuncSetAttribute failed\n"); grid = -1; return; }
        if (hipOccupancyMaxActiveBlocksPerMultiprocessor(&per_cu, (const void*)fwd_kernel, NTHREADS, LDS_BYTES) != hipSuccess || per_cu < 1) { fprintf(stderr, "kernel_launch: occupancy query says %d blocks per CU\n", per_cu); grid = -1; return; }
        (void)hipGetLastError();
        grid = cus;
        if (cus != 256) { fprintf(stderr, "kernel_launch: built for a 256-CU device (static phase schedules), found %d CUs; nothing launched\n", cus); grid = -1; return; }
    }
    if (grid < 0) return;
    hipMemsetAsync((char*)d_ws + WS_CTL, 0, CTL_ZERO_BYTES, stream);
    Params p{};
    p.x = (const float*)d_in[0]; p.c = (const float*)d_in[1]; p.pos = (const int*)d_in[2]; p.w_ada = (const float*)d_in[3]; p.b_ada = (const float*)d_in[4];
    p.g_mix_pre = (const float*)d_in[5]; p.g_mix_post = (const float*)d_in[6]; p.g_ffn_pre = (const float*)d_in[7]; p.g_ffn_post = (const float*)d_in[8];
    p.w_in = (const float*)d_in[9]; p.conv_w = (const float*)d_in[10]; p.a_log = (const float*)d_in[11]; p.dt_bias = (const float*)d_in[12]; p.dn_gain = (const float*)d_in[13];
    p.w_bm = (const float*)d_in[14]; p.w_bd = (const float*)d_in[15]; p.w_out = (const float*)d_in[16];
    p.w_rg = (const float*)d_in[17]; p.b_rg = (const float*)d_in[18]; p.w_re = (const float*)d_in[19]; p.b_re = (const float*)d_in[20];
    p.w_gate = (const float*)d_in[21]; p.w_up = (const float*)d_in[22]; p.w_down = (const float*)d_in[23];
    p.out = (float*)d_out; p.ws = (unsigned char*)d_ws;
    for (int li = 0; li < MK_N_LAUNCHES; ++li) {
        p.ph_lo = (MK_N_LAUNCHES == 1) ? 0 : li; p.ph_hi = (MK_N_LAUNCHES == 1) ? N_PHASES : li + 1;
        void* args[] = {&p};
        hipError_t e = hipLaunchCooperativeKernel((const void*)fwd_kernel, dim3(grid), dim3(NTHREADS), args, LDS_BYTES, stream);
        if (e != hipSuccess) { fprintf(stderr, "kernel_launch: cooperative launch failed: %s (grid %d)\n", hipGetErrorString(e), grid); break; }
    }
}
```

```cpp
#include <hip/hip_runtime.h>
#include <hip/hip_cooperative_groups.h>
#include <cstdio>
#include <cstdint>
namespace cg = cooperative_groups;

#define LAS __attribute__((address_space(3)))
#define DI __device__ __forceinline__
typedef unsigned short bf16_t;
typedef short bf16x8 __attribute__((ext_vector_type(8)));
typedef short s16x4 __attribute__((ext_vector_type(4)));
typedef float f32x2 __attribute__((ext_vector_type(2)));
typedef float f32x4 __attribute__((ext_vector_type(4)));
typedef float f32x16 __attribute__((ext_vector_type(16)));
typedef unsigned u32x2 __attribute__((ext_vector_type(2)));
typedef unsigned u32x4 __attribute__((ext_vector_type(4)));
typedef __bf16 bf16x2_t __attribute__((ext_vector_type(2)));

constexpr int NB = 8, SEQ = 2048, T = NB * SEQ, DM = 2048;
constexpr int NHEAD = 8, HD = 128;
constexpr int PP = 11264;
constexpr int NPROJ = 11264;
constexpr int C_Q = 0, C_K = 1024, C_V = 2048, C_DN = 3072, C_Z = 6144, C_GA = 7168, C_GB = 9216;
constexpr int NEXP = 32, FF = 512, ECAP = 16384;
constexpr float EPS = 1e-6f;

constexpr size_t MiB = 1u << 20;
constexpr size_t WS_CTL = 0, CTL_ZERO_BYTES = 1 * MiB;
constexpr size_t WS_MOD = 1 * MiB;
constexpr size_t WS_CS = 2 * MiB;
constexpr size_t WS_KMEAN = 4 * MiB;
constexpr size_t WS_WR = 4 * MiB + 512 * 1024;
constexpr size_t WS_WBA = 4 * MiB + 768 * 1024;
constexpr size_t WS_BA = 5 * MiB;
constexpr size_t WS_REC = 6 * MiB;
constexpr size_t WS_RTOK = 7 * MiB;
constexpr size_t WS_WMD = 10 * MiB;
constexpr size_t WS_WOUT = 18 * MiB;
constexpr size_t WS_A = 26 * MiB;
constexpr size_t WS_B = 90 * MiB;
constexpr size_t WS_C = 442 * MiB;
constexpr size_t WS_D = 588 * MiB;
constexpr size_t WS_END = 652 * MiB;
constexpr size_t WS_OUTMIX = WS_B, WS_WGU = WS_B + 128 * MiB, WS_WDN = WS_B + 256 * MiB, WS_YBUF = WS_B;
constexpr size_t WS_WIN = WS_C, WS_DNP = WS_C, WS_MERGED = WS_C, WS_H = WS_C + 64 * MiB;
constexpr int CW_CNT = 64;
constexpr int CW_BAR = 4096;
constexpr int DN_U = 0, DN_W = 16384, DN_QD = 32768, DN_KT = 49152, DN_QK = 65536, DN_SC = 73728, DN_STRIDE = 73984;

struct Params {
    const float* x; const float* c; const int* pos; const float* w_ada; const float* b_ada;
    const float* g_mix_pre; const float* g_mix_post; const float* g_ffn_pre; const float* g_ffn_post;
    const float* w_in; const float* conv_w; const float* a_log; const float* dt_bias; const float* dn_gain;
    const float* w_bm; const float* w_bd; const float* w_out;
    const float* w_rg; const float* b_rg; const float* w_re; const float* b_re;
    const float* w_gate; const float* w_up; const float* w_down;
    float* out; unsigned char* ws;
    int ph_lo, ph_hi;
};

DI unsigned cvtpk(float lo, float hi) { f32x2 v = {lo, hi}; bf16x2_t b = __builtin_convertvector(v, bf16x2_t); return __builtin_bit_cast(unsigned, b); }
DI float bflo(unsigned w) { return __uint_as_float(w << 16); }
DI float bfhi(unsigned w) { return __uint_as_float(w & 0xffff0000u); }
DI float bf2f(bf16_t b) { return __uint_as_float((unsigned)b << 16); }
DI bf16_t f2bf(float f) { return (bf16_t)(cvtpk(f, 0.f) & 0xffffu); }
DI float wave_sum(float v) {
#pragma unroll
    for (int o = 1; o < 64; o <<= 1) v += __shfl_xor(v, o);
    return v;
}
DI float sigmoidf_(float x) { return __builtin_amdgcn_rcpf(1.f + __expf(-x)); }
DI float siluf_(float x) { return x * __builtin_amdgcn_rcpf(1.f + __expf(-x)); }
DI float rsqrt_(float x) { return __builtin_amdgcn_rsqf(x); }
DI float siluf_acc(float x) { return x / (1.f + expf(-x)); }
constexpr float SCALE_Q = 0.08838834764831845f;
DI int perm16(int p) { return (p & 3) | ((p & 4) << 1) | ((p & 8) >> 1); }
DI int crow(int r, int hi) { return (r & 3) + 8 * (r >> 2) + 4 * hi; }
#define MFMA32(a, b, c) __builtin_amdgcn_mfma_f32_32x32x16_bf16((a), (b), (c), 0, 0, 0)
#define MFMA16(a, b, c) __builtin_amdgcn_mfma_f32_16x16x32_bf16((a), (b), (c), 0, 0, 0)

namespace pg8 {
constexpr int BM = 256, BK = 64, HALF = 128, HTB = HALF * BK * 2, STAGE_BYTES = 8 * HTB, NXCD = 8, WGM = 8;
DI int lds_byte(int r, int c) { const int st = (r >> 4) * 2 + (c >> 5), rr = r & 15, cc = c & 31, ob = rr * 64 + cc * 2; return st * 1024 + (ob ^ (((ob >> 9) & 1) << 5)); }
DI void stage_rc(int b, int& R, int& C) { const int st = b / 1024, sb = b % 1024, swz = sb ^ (((sb >> 9) & 1) << 5); R = (st >> 1) * 16 + swz / 64; C = (st & 1) * 32 + (swz % 64) / 2; }
DI int perm32(int rho) { const int n = rho >> 4, i = rho & 15; return 8 * (i >> 2) + 4 * n + (i & 3); }

struct Unit { int pm, pn, ga, gn; };
struct Gemm { const bf16_t* A; const bf16_t* Bt; int K; const int* gidx; };

struct StaticOrder {
    int nM, nN, nwg, G, c;
    DI void init(int M, int N, int G_, int c_) { nM = M / BM; nN = N / BM; nwg = nM * nN; G = G_; c = c_; }
    DI bool next(int i, Unit& u) const {
        const long L = (long)i * G + c; if (L >= nwg) return false;
        int wgid = (int)L; { const int q = nwg / NXCD, r = nwg % NXCD, xcd = wgid % NXCD, off = wgid / NXCD; wgid = (xcd < r ? xcd * (q + 1) : r * (q + 1) + (xcd - r) * q) + off; }
        const int nig = WGM * nN, gid = wgid / nig, fm = gid * WGM, gsz = (nM - fm) < WGM ? (nM - fm) : WGM;
        u.pm = fm + ((wgid % nig) % gsz); u.pn = (wgid % nig) / gsz; u.ga = 0; u.gn = 0; return true;
    }
};

typedef f32x4 Acc[2][2][4][2];

template <class Epi, class Sched, bool ALIGN_EPI, bool GATHER>
DI void gemm_phase(LAS unsigned char* lds, const Gemm g, const Sched& S, const Epi& E) {
    const int tid = threadIdx.x, wid = __builtin_amdgcn_readfirstlane(tid >> 6), lane = tid & 63, wr = wid >> 2, wc = wid & 3, fr = lane & 15, fq = lane >> 4;
    const int K = g.K, nt = K / BK;
    unsigned voffA[2], voffB[2]; int gR[2], gC[2];
#pragma unroll
    for (int i = 0; i < 2; ++i) { int R, C; stage_rc(tid * 16 + i * 8192, R, C); const int Rb = (R & ~31) + perm32(R & 31);
        voffA[i] = (unsigned)(R * K + C) * 2u; voffB[i] = (unsigned)(Rb * K + C) * 2u; gR[i] = R; gC[i] = C; }
    const size_t kstep = (size_t)(BK * 2);
    const size_t hstep = (size_t)HALF * K * 2;
    const size_t tstep = 2 * hstep;
    const unsigned ldsw = (unsigned)wid * 1024u;
    const int aoff = lds_byte(wr * 64 + fr, fq * 8), boff = lds_byte(wc * 32 + fr, fq * 8);
#define PG8_SA(b, h) (((b) * 2 + (h)) * HTB)
#define PG8_SB(b, h) ((4 + (b) * 2 + (h)) * HTB)
#define PG8_STAGE(bufoff, gbase, voff) do { _Pragma("unroll") for (int _i = 0; _i < 2; ++_i) \
        __builtin_amdgcn_global_load_lds((const unsigned*)((const char*)(gbase) + (voff)[_i]), (LAS unsigned*)(lds + (bufoff) + ldsw + _i * 8192), 16, 0, 0); } while (0)
#define PG8_LDA(dst, b, h) do { _Pragma("unroll") for (int m = 0; m < 4; ++m) _Pragma("unroll") for (int k = 0; k < 2; ++k) dst[m][k] = *(const LAS bf16x8*)(lds + PG8_SA(b, h) + aoff + m * 2048 + k * 1024); } while (0)
#define PG8_LDB(dst, b, h) do { _Pragma("unroll") for (int n = 0; n < 2; ++n) _Pragma("unroll") for (int k = 0; k < 2; ++k) dst[n][k] = *(const LAS bf16x8*)(lds + PG8_SB(b, h) + boff + n * 2048 + k * 1024); } while (0)
#define PG8_MMA(ai, bj, At, Bt) do { __builtin_amdgcn_s_setprio(1); _Pragma("unroll") for (int m = 0; m < 4; ++m) _Pragma("unroll") for (int n = 0; n < 2; ++n) _Pragma("unroll") for (int k = 0; k < 2; ++k) \
        acc[ai][bj][m][n] = __builtin_amdgcn_mfma_f32_16x16x32_bf16(Bt[n][k], At[m][k], acc[ai][bj][m][n], 0, 0, 0); __builtin_amdgcn_s_setprio(0); } while (0)
#define PG8_WAIT_V(n) asm volatile("s_waitcnt vmcnt(" #n ")" ::: "memory")
#define PG8_WAIT_L(n) asm volatile("s_waitcnt lgkmcnt(" #n ")" ::: "memory")
#define PG8_BAR __builtin_amdgcn_s_barrier()
#define PG8_SCHED __builtin_amdgcn_sched_barrier(0)
    Unit cur, nxt; int ui = 0;
    if (!S.next(0, cur)) return;
    Acc acc;
#pragma unroll
    for (int a = 0; a < 2; ++a)
#pragma unroll
        for (int b = 0; b < 2; ++b)
#pragma unroll
            for (int m = 0; m < 4; ++m)
#pragma unroll
                for (int n = 0; n < 2; ++n) acc[a][b][m][n] = (f32x4){0.f, 0.f, 0.f, 0.f};
    bf16x8 At[4][2], B0[2][2], B1[2][2];
    unsigned vA0[2], vA1[2];
#define PG8_SET_VOFF(u) do { if constexpr (GATHER) { _Pragma("unroll") for (int _i = 0; _i < 2; ++_i) { \
                const int _r0 = gR[_i], _r1 = HALF + gR[_i]; \
                const int _t0 = _r0 < (u).gn ? g.gidx[(u).ga + _r0] : 0, _t1 = _r1 < (u).gn ? g.gidx[(u).ga + _r1] : 0; \
                vA0[_i] = (unsigned)(_t0 * K + gC[_i]) * 2u; vA1[_i] = (unsigned)(_t1 * K + gC[_i]) * 2u; } \
        } else { vA0[0] = voffA[0]; vA0[1] = voffA[1]; vA1[0] = voffA[0] + (unsigned)hstep; vA1[1] = voffA[1] + (unsigned)hstep; } } while (0)
    PG8_SET_VOFF(cur);
    const char* cA = GATHER ? (const char*)g.A : (const char*)g.A + (size_t)cur.pm * tstep; const char* cB = (const char*)g.Bt + (size_t)cur.pn * tstep;
    PG8_STAGE(PG8_SB(0, 0), cB, voffB); PG8_STAGE(PG8_SB(0, 1), cB + hstep, voffB); PG8_STAGE(PG8_SA(0, 0), cA, vA0); PG8_STAGE(PG8_SA(0, 1), cA, vA1);
    if (wr == 1) PG8_BAR;
    PG8_WAIT_V(2); PG8_BAR;
    PG8_STAGE(PG8_SB(1, 0), cB + kstep, voffB); PG8_STAGE(PG8_SA(1, 0), cA + kstep, vA0); PG8_STAGE(PG8_SB(1, 1), cB + hstep + kstep, voffB);
    PG8_WAIT_V(6); PG8_BAR;
    for (;;) {
        const bool has_next = S.next(ui + 1, nxt);
        const char* nA = GATHER ? (const char*)g.A : (has_next ? (const char*)g.A + (size_t)nxt.pm * tstep : cA);
        const char* nB = has_next ? (const char*)g.Bt + (size_t)nxt.pn * tstep : cB;
#define PG8_KTRIP(t) do { \
            const bool last = (t == nt - 2); \
            const char* a1 = cA + (size_t)(t + 1) * kstep; \
            const char* a2 = last ? nA : cA + (size_t)(t + 2) * kstep; const char* b2 = last ? nB : cB + (size_t)(t + 2) * kstep; \
            const char* a3 = a2 + kstep; const char* b3 = b2 + kstep; \
            PG8_LDB(B0, 0, 0); PG8_LDB(B1, 0, 1); PG8_SCHED; PG8_LDA(At, 0, 0); PG8_STAGE(PG8_SA(1, 1), a1, vA1); \
            PG8_WAIT_V(8); PG8_WAIT_L(0); PG8_BAR; PG8_MMA(0, 0, At, B0); PG8_MMA(0, 1, At, B1); PG8_BAR; PG8_SCHED; \
            if constexpr (GATHER) { if (last && has_next) PG8_SET_VOFF(nxt); } \
            PG8_LDA(At, 0, 1); PG8_STAGE(PG8_SB(0, 0), b2, voffB); PG8_STAGE(PG8_SB(0, 1), b2 + hstep, voffB); PG8_STAGE(PG8_SA(0, 0), a2, vA0); \
            PG8_WAIT_V(8); PG8_WAIT_L(0); PG8_BAR; PG8_MMA(1, 0, At, B0); PG8_MMA(1, 1, At, B1); PG8_BAR; PG8_SCHED; \
            PG8_LDB(B0, 1, 0); PG8_LDB(B1, 1, 1); PG8_SCHED; PG8_LDA(At, 1, 0); PG8_STAGE(PG8_SA(0, 1), a2, vA1); \
            PG8_WAIT_V(8); PG8_WAIT_L(0); PG8_BAR; PG8_MMA(0, 0, At, B0); PG8_MMA(0, 1, At, B1); PG8_BAR; PG8_SCHED; \
            PG8_LDA(At, 1, 1); PG8_STAGE(PG8_SB(1, 0), b3, voffB); PG8_STAGE(PG8_SB(1, 1), b3 + hstep, voffB); PG8_STAGE(PG8_SA(1, 0), a3, vA0); \
            PG8_WAIT_V(8); PG8_WAIT_L(0); PG8_BAR; PG8_MMA(1, 0, At, B0); PG8_MMA(1, 1, At, B1); PG8_BAR; PG8_SCHED; \
        } while (0)
        if constexpr (Epi::HAS_MID) {
            for (int t = 0; t < (nt >> 1); t += 2) PG8_KTRIP(t);
            E.mid(acc, cur, wr, wc, fr, fq);
            for (int t = (nt >> 1); t < nt; t += 2) PG8_KTRIP(t);
        } else {
            for (int t = 0; t < nt; t += 2) PG8_KTRIP(t);
        }
#undef PG8_KTRIP
        if constexpr (ALIGN_EPI) { if (wr == 0) PG8_BAR; }
        E(acc, cur, wr, wc, fr, fq);
#if defined(DBL) && DBL == 20
        E(acc, cur, wr, wc, fr, fq);
#endif
        if (!has_next) break;
#pragma unroll
        for (int a = 0; a < 2; ++a)
#pragma unroll
            for (int b = 0; b < 2; ++b)
#pragma unroll
                for (int m = 0; m < 4; ++m)
#pragma unroll
                    for (int n = 0; n < 2; ++n) acc[a][b][m][n] = (f32x4){0.f, 0.f, 0.f, 0.f};
        cur = nxt; cA = nA; cB = nB; ++ui;
        if constexpr (ALIGN_EPI) { if (wr == 1) PG8_BAR; }
    }
    PG8_WAIT_V(0);
    if constexpr (!ALIGN_EPI) { if (wr == 0) PG8_BAR; }
    PG8_BAR;
#undef PG8_SET_VOFF
#undef PG8_SA
#undef PG8_SB
#undef PG8_STAGE
#undef PG8_LDA
#undef PG8_LDB
#undef PG8_MMA
#undef PG8_WAIT_V
#undef PG8_WAIT_L
#undef PG8_BAR
#undef PG8_SCHED
}

struct EpiStore {
    static constexpr bool HAS_MID = false;
    bf16_t* O; int ldc; int ntn;
    DI void operator()(const Acc& acc, const Unit& u, int wr, int wc, int fr, int fq) const {
        const int row0 = u.pm * BM + wr * 64 + fr, col0 = (u.pn % ntn) * BM + wc * 32 + 8 * fq;
#pragma unroll
        for (int ai = 0; ai < 2; ++ai)
#pragma unroll
            for (int m = 0; m < 4; ++m) { bf16_t* rowp = O + (size_t)(row0 + ai * HALF + m * 16) * ldc + col0;
#pragma unroll
                for (int bj = 0; bj < 2; ++bj) { const f32x4 v0 = acc[ai][bj][m][0], v1 = acc[ai][bj][m][1];
                    u32x4 w; w.x = cvtpk(v0[0], v0[1]); w.y = cvtpk(v0[2], v0[3]); w.z = cvtpk(v1[0], v1[1]); w.w = cvtpk(v1[2], v1[3]);
                    *(u32x4*)(rowp + bj * HALF) = w; } }
    }
};
struct EpiMerged {
    static constexpr bool HAS_MID = true;
    const bf16_t* P; bf16_t* O;
    DI void mid(Acc& acc, const Unit& u, int wr, int wc, int fr, int fq) const {
        const unsigned ro = (unsigned)((u.pm * BM + wr * 64 + fr) * PP + u.pn * BM + wc * 32 + 8 * fq);
#pragma unroll
        for (int ai = 0; ai < 2; ++ai)
#pragma unroll
            for (int m = 0; m < 4; ++m) {
#pragma unroll
                for (int bj = 0; bj < 2; ++bj) { const unsigned off = ro + (unsigned)((ai * HALF + m * 16) * PP + bj * HALF);
                    const u32x4 a = *(const u32x4*)(P + off + C_GA), b = *(const u32x4*)(P + off + C_GB);
                    float ga[8] = {bflo(a.x), bfhi(a.x), bflo(a.y), bfhi(a.y), bflo(a.z), bfhi(a.z), bflo(a.w), bfhi(a.w)};
                    float gb[8] = {bflo(b.x), bfhi(b.x), bflo(b.y), bfhi(b.y), bflo(b.z), bfhi(b.z), bflo(b.w), bfhi(b.w)};
#pragma unroll
                    for (int n = 0; n < 2; ++n)
#pragma unroll
                        for (int j = 0; j < 4; ++j) { const float r = (1.f + __expf(-gb[4 * n + j])) * __builtin_amdgcn_rcpf(1.f + __expf(-ga[4 * n + j])); acc[ai][bj][m][n][j] *= r; } }
                asm volatile("" ::: "memory"); __builtin_amdgcn_sched_barrier(0); }
    }
    DI void operator()(const Acc& acc, const Unit& u, int wr, int wc, int fr, int fq) const {
        const unsigned ro = (unsigned)((u.pm * BM + wr * 64 + fr) * PP + u.pn * BM + wc * 32 + 8 * fq);
        const unsigned oo = (unsigned)((u.pm * BM + wr * 64 + fr) * DM + u.pn * BM + wc * 32 + 8 * fq);
#pragma unroll
        for (int ai = 0; ai < 2; ++ai)
#pragma unroll
            for (int m = 0; m < 4; ++m) {
#pragma unroll
                for (int bj = 0; bj < 2; ++bj) { const u32x4 b = *(const u32x4*)(P + ro + (unsigned)((ai * HALF + m * 16) * PP + bj * HALF) + C_GB);
                    float gb[8] = {bflo(b.x), bfhi(b.x), bflo(b.y), bfhi(b.y), bflo(b.z), bfhi(b.z), bflo(b.w), bfhi(b.w)};
                    float v[8];
#pragma unroll
                    for (int n = 0; n < 2; ++n)
#pragma unroll
                        for (int j = 0; j < 4; ++j) v[4 * n + j] = acc[ai][bj][m][n][j] * __builtin_amdgcn_rcpf(1.f + __expf(-gb[4 * n + j]));
                    u32x4 w; w.x = cvtpk(v[0], v[1]); w.y = cvtpk(v[2], v[3]); w.z = cvtpk(v[4], v[5]); w.w = cvtpk(v[6], v[7]);
                    *(u32x4*)(O + oo + (unsigned)((ai * HALF + m * 16) * DM + bj * HALF)) = w; }
                asm volatile("" ::: "memory"); __builtin_amdgcn_sched_barrier(0); }
    }
};
struct EpiGU {
    static constexpr bool HAS_MID = false;
    bf16_t* H;
    DI void operator()(const Acc& acc, const Unit& u, int wr, int wc, int fr, int fq) const {
        const int row0 = u.pm * BM + wr * 64 + fr, col0 = (u.pn & 3) * HALF + wc * 32 + 8 * fq;
#pragma unroll
        for (int ai = 0; ai < 2; ++ai)
#pragma unroll
            for (int m = 0; m < 4; ++m) { float v[8];
#pragma unroll
                for (int n = 0; n < 2; ++n)
#pragma unroll
                    for (int j = 0; j < 4; ++j) v[4 * n + j] = siluf_(acc[ai][0][m][n][j]) * acc[ai][1][m][n][j];
                u32x4 w; w.x = cvtpk(v[0], v[1]); w.y = cvtpk(v[2], v[3]); w.z = cvtpk(v[4], v[5]); w.w = cvtpk(v[6], v[7]);
                *(u32x4*)(H + (size_t)(row0 + ai * HALF + m * 16) * FF + col0) = w; }
    }
};
}

namespace moba {
constexpr int NW = 8, QBLK = 32, KVBLK = 64, QB = NW * QBLK, D = 128;
constexpr int RS = PP;
constexpr int RSO = DM;
constexpr float SCALE = 0.08838834764831845f;
constexpr float THR = 8.f;
constexpr int SHM_V = KVBLK * D * 2, SHM_K = KVBLK * D * 2;
constexpr int LDS_BYTES = 2 * SHM_V + 2 * SHM_K + NW * 64 * 4;
typedef bf16_t bf16;
#define KSWZ(row, colB) ((row) * 256 + ((colB) ^ (((row) & 7) << 4)))
#define SBAR() __builtin_amdgcn_sched_barrier(0)
DI int v_st(int k, int c) { const int kk = (k & ~0xC) | ((k & 4) << 1) | ((k & 8) >> 1); return ((kk >> 3) * 4 + (c >> 5)) * 512 + ((kk & 7) * 32 + (c & 31)) * 2; }
DI int v_rd_base(int lane) { return ((lane & 3) << 3) | (((lane >> 2) & 3) << 6) | (((lane >> 4) & 1) << 5) | (((lane >> 5) & 1) << 8); }
constexpr int v_rd_off(int d0, int ks, int half) { return d0 * 512 + ks * 4096 + half * 2048; }
DI bf16x8 load8(const bf16* p) { return *reinterpret_cast<const bf16x8*>(p); }
DI void mask_tile(f32x16& p0, f32x16& p1, int dq) {
    const float NEG = -__builtin_inff();
#pragma unroll
    for (int r = 0; r < 16; ++r) {
        const int c = (r & 3) + 8 * (r >> 2);
        if (dq - c < 0) p0[r] = NEG;
        if (dq - c - 32 < 0) p1[r] = NEG;
    }
}
DI void mask_all(f32x16& p0, f32x16& p1, bool kill) {
    const float NEG = -__builtin_inff();
#pragma unroll
    for (int r = 0; r < 16; ++r) { if (kill) p0[r] = NEG; if (kill) p1[r] = NEG; }
}
DI void partialSM(f32x16& p0, f32x16& p1, float& m_reg, float& mn, float& alpha) {
    float pmax = p0[0];
#pragma unroll
    for (int r = 1; r < 16; ++r) pmax = fmaxf(pmax, p0[r]);
#pragma unroll
    for (int r = 0; r < 16; ++r) pmax = fmaxf(pmax, p1[r]);
    { auto rr = __builtin_amdgcn_permlane32_swap(__float_as_uint(pmax), __float_as_uint(pmax), false, false);
      pmax = fmaxf(__uint_as_float(rr[0]), __uint_as_float(rr[1])); }
    constexpr float C2 = 1.4426950408889634f * SCALE;
    if (__builtin_expect(__all((pmax - m_reg) * SCALE <= THR), 1)) { mn = m_reg; alpha = 1.f; }
    else { mn = fmaxf(m_reg, pmax); alpha = __builtin_amdgcn_exp2f((m_reg - mn) * C2); m_reg = mn; }
    const float mnL = -mn * C2;
#pragma unroll
    for (int r = 0; r < 16; ++r) p0[r] = fmaf(p0[r], C2, mnL);
#pragma unroll
    for (int r = 0; r < 16; ++r) p1[r] = fmaf(p1[r], C2, mnL);
#pragma unroll
    for (int r = 0; r < 16; ++r) p0[r] = __builtin_amdgcn_exp2f(p0[r]);
}
DI void finishSM(f32x16& p0, f32x16& p1, float alpha, float& l_reg, bf16x8& pa0, bf16x8& pa1, bf16x8& pa2, bf16x8& pa3) {
#pragma unroll
    for (int r = 0; r < 16; ++r) p1[r] = __builtin_amdgcn_exp2f(p1[r]);
    float ps = 0;
#pragma unroll
    for (int r = 0; r < 16; ++r) ps += p0[r];
#pragma unroll
    for (int r = 0; r < 16; ++r) ps += p1[r];
    { auto rr = __builtin_amdgcn_permlane32_swap(__float_as_uint(ps), __float_as_uint(ps), false, false);
      ps = __uint_as_float(rr[0]) + __uint_as_float(rr[1]); }
    l_reg = l_reg * alpha + ps;
#define PK4(P, B_, OUT) do { unsigned a0 = cvtpk(P[B_+0], P[B_+1]), a1 = cvtpk(P[B_+2], P[B_+3]);                          \
        unsigned b0 = cvtpk(P[B_+4], P[B_+5]), b1 = cvtpk(P[B_+6], P[B_+7]);                                             \
        auto r0 = __builtin_amdgcn_permlane32_swap(a0, b0, false, false); auto r1 = __builtin_amdgcn_permlane32_swap(a1, b1, false, false); \
        u32x4 w = {r0[0], r1[0], r0[1], r1[1]}; OUT = __builtin_bit_cast(bf16x8, w); } while (0)
    PK4(p0, 0, pa0); PK4(p0, 8, pa1); PK4(p1, 0, pa2); PK4(p1, 8, pa3);
#undef PK4
}
template <int KB>
DI void qkt(f32x16& p0, f32x16& p1, const char* K_lds, int r32, int hi, const bf16x8* qr) {
    p0 = f32x16{}; p1 = f32x16{};
    const char* kb[4];
#pragma unroll
    for (int dd = 0; dd < 4; ++dd) kb[dd] = K_lds + KB * SHM_K + KSWZ(r32, (dd * 16 + hi * 8) * 2);
#pragma unroll
    for (int d0 = 0; d0 < 8; ++d0) { const char* a = kb[d0 & 3] + (d0 >> 2) * 128;
        bf16x8 b0 = *reinterpret_cast<const bf16x8*>(a);
        bf16x8 b1 = *reinterpret_cast<const bf16x8*>(a + 32 * 256);
        p0 = MFMA32(b0, qr[d0], p0);
        p1 = MFMA32(b1, qr[d0], p1); }
}
template <int VB>
DI void pv_tile(f32x16* o, int vb0, bf16x8 pa0, bf16x8 pa1, bf16x8 pa2, bf16x8 pa3) {
#define TRRD(dst, off) asm volatile("ds_read_b64_tr_b16 %0, %1 offset:%2" : "=&v"(dst) : "v"(vb0), "i"(off) : "memory")
#define PV_D0(d0) do { s16x4 l0, l1, l2, l3, h0, h1, h2, h3; constexpr int b_ = VB * SHM_V + v_rd_off(d0, 0, 0); \
        TRRD(l0, b_); TRRD(h0, b_ + 2048); TRRD(l1, b_ + 4096); TRRD(h1, b_ + 6144); TRRD(l2, b_ + 8192); TRRD(h2, b_ + 10240); TRRD(l3, b_ + 12288); TRRD(h3, b_ + 14336); \
        asm volatile("s_waitcnt lgkmcnt(0)" ::: "memory"); SBAR();   \
        o[d0] = MFMA32(pa0, ((bf16x8){l0[0], l0[1], l0[2], l0[3], h0[0], h0[1], h0[2], h0[3]}), o[d0]);   \
        o[d0] = MFMA32(pa1, ((bf16x8){l1[0], l1[1], l1[2], l1[3], h1[0], h1[1], h1[2], h1[3]}), o[d0]);   \
        o[d0] = MFMA32(pa2, ((bf16x8){l2[0], l2[1], l2[2], l2[3], h2[0], h2[1], h2[2], h2[3]}), o[d0]);   \
        o[d0] = MFMA32(pa3, ((bf16x8){l3[0], l3[1], l3[2], l3[3], h3[0], h3[1], h3[2], h3[3]}), o[d0]); } while (0)
    PV_D0(0); PV_D0(1); PV_D0(2); PV_D0(3);
#undef PV_D0
#undef TRRD
}

struct BlockRef { const bf16* Q; const bf16* K; const bf16* V; bf16* O; const bf16* KM; int P0; };
struct Seam { bf16x8 qr[8]; bf16x8 st_v0, st_v1, st_k0, st_k1; };
#define VMW() asm volatile("s_waitcnt vmcnt(0)" ::: "memory")
#define VMWN(n) asm volatile("s_waitcnt vmcnt(%0)" :: "i"(n) : "memory")
#define SLOAD_H(Kp, Vp, k0) do { const bf16* kb__ = (Kp) + (size_t)(k0) * RS; const bf16* vb__ = (Vp) + (size_t)(k0) * RS;              \
                         S.st_v0 = load8(vb__ + goff); S.st_v1 = load8(vb__ + 32 * RS + goff);              \
                         S.st_k0 = load8(kb__ + goff); S.st_k1 = load8(kb__ + 32 * RS + goff); } while (0)
#define SWRITE_HK(bf) do { *(bf16x8*)(K_lds + (bf) * SHM_K + kws) = S.st_k0; *(bf16x8*)(K_lds + (bf) * SHM_K + kws + 32 * 256) = S.st_k1; } while (0)
#define SWRITE_HV(bf) do { *(bf16x8*)(V_lds + (bf) * SHM_V + vst0) = S.st_v0; *(bf16x8*)(V_lds + (bf) * SHM_V + vst1) = S.st_v1; } while (0)
#define SWRITE_H(bf) do { SWRITE_HV(bf); SWRITE_HK(bf); } while (0)
DI void prime(const BlockRef& cur, char* lds, Seam& S) {
    const int tid = threadIdx.x, wid = __builtin_amdgcn_readfirstlane(tid >> 6), lane = tid & 63, r32 = lane & 31, hi = lane >> 5;
    const int sr = tid >> 4, sc = (tid & 15) * 8, kws = KSWZ(sr, sc * 2); char* K_lds = lds + 2 * SHM_V;
    const unsigned goff = (unsigned)(sr * RS + sc), qoff = (unsigned)(r32 * RS + hi * 8);
    { const bf16* qb__ = cur.Q + (size_t)(wid * QBLK) * RS;
#pragma unroll
    for (int d0 = 0; d0 < 8; ++d0) S.qr[d0] = load8(qb__ + qoff + d0 * 16); }
    SLOAD_H(cur.K, cur.V, 0); VMW(); SWRITE_HK(0);
    __syncthreads();
}
DI void block(const BlockRef& cur, const BlockRef& nxt, char* lds, Seam& S) {
    int tid_ = threadIdx.x; asm volatile("" : "+v"(tid_));
    const int tid = tid_, wid = __builtin_amdgcn_readfirstlane(tid >> 6), lane = tid & 63, r32 = lane & 31, hi = lane >> 5;
    const int NT = (cur.P0 + QB) / KVBLK;
    const int qb = cur.P0 / QB;
    const int qlo = cur.P0 + wid * QBLK, qm = qlo + r32 - 4 * hi;
    char* V_lds = lds; char* K_lds = lds + 2 * SHM_V;
    float* ws = (float*)(lds + 2 * SHM_V + 2 * SHM_K) + wid * 64; float* li_l = ws, * al_l = ws + 32;
    unsigned selmask = (1u << qb) - 1u;
    if (qb > 3) {
        f32x16 g0 = f32x16{};
#pragma unroll
        for (int d0 = 0; d0 < 8; ++d0) {
            bf16x8 a = (bf16x8){0, 0, 0, 0, 0, 0, 0, 0};
            if (r32 < 8) a = load8(cur.KM + r32 * D + d0 * 16 + hi * 8);
            g0 = MFMA32(a, S.qr[d0], g0);
        }
        float gt[8];
#pragma unroll
        for (int j = 0; j < 4; ++j) { const float mine = g0[j], oth = __shfl_xor(mine, 32); gt[j] = hi ? oth : mine; gt[4 + j] = hi ? mine : oth; }
        selmask = 0u;
#pragma unroll
        for (int i = 0; i < 8; ++i) { int rank = 0;
#pragma unroll
            for (int j = 0; j < 8; ++j) { if (j != i) { const bool beats = (gt[j] > gt[i]) || (gt[j] == gt[i] && j < i); rank += (j < qb && beats) ? 1 : 0; } }
            if (i < qb && rank < 3) selmask |= (1u << i); }
    }
    float m_reg = -1e30f, l_reg = 0; f32x16 o[4] = {};
    const int sr = tid >> 4, sc = (tid & 15) * 8, vst0 = v_st(sr, sc), vst1 = v_st(32 + sr, sc), kws = KSWZ(sr, sc * 2);
    const unsigned goff = (unsigned)(sr * RS + sc), qoff = (unsigned)(r32 * RS + hi * 8);
    const int vb0 = (int)(uintptr_t)V_lds + v_rd_base(lane);
    const bf16* Kh = cur.K; const bf16* Vh = cur.V;
#define RESC(a) do { if (__any((a) < 1.f)) { if (hi == 0) al_l[r32] = (a); asm volatile("s_waitcnt lgkmcnt(0)" ::: "memory");              \
                     _Pragma("unroll") for (int d_ = 0; d_ < 4; ++d_) _Pragma("unroll") for (int r = 0; r < 16; ++r) o[d_][r] *= al_l[crow(r, hi)]; } } while (0)
#define KBASE(t) ((t) * KVBLK)
#define MASKT(P0_, P1_, t) do { const int kb_ = KBASE(t); const int kblk_ = (t) >> 2; \
        if (kblk_ < qb) { if (qb > 3) mask_all(P0_, P1_, ((selmask >> kblk_) & 1u) == 0u); } \
        else if (kb_ + KVBLK - 1 > qlo) mask_tile(P0_, P1_, qm - kb_); } while (0)
    constexpr int NQL = 8;
#define SEAM_K0() do { VMWN(NQL); SWRITE_HK(0); SBAR(); } while (0)
    f32x16 pA0, pA1, pB0, pB1; float mnA, mnB, alA, alB; bf16x8 pa0, pa1, pa2, pa3;
    SWRITE_HV(0); SBAR();
    if (NT > 1) { SLOAD_H(Kh, Vh, KBASE(1)); }
    SBAR(); qkt<0>(pA0, pA1, K_lds, r32, hi, S.qr);
    MASKT(pA0, pA1, 0); partialSM(pA0, pA1, m_reg, mnA, alA);
    if (NT > 1) { VMW(); SWRITE_H(1); }
    __syncthreads();
#define HALF_STEP(PX0, PX1, mnX, alX, PY0, PY1, alY, t, KB, VB, SB) do {                                                      \
        SBAR(); qkt<KB>(PX0, PX1, K_lds, r32, hi, S.qr);                                             \
        finishSM(PY0, PY1, alY, l_reg, pa0, pa1, pa2, pa3); SBAR();                                                           \
        if ((t) + 1 < NT) { SLOAD_H(Kh, Vh, KBASE((t) + 1)); SBAR(); }                                               \
        pv_tile<VB>(o, vb0, pa0, pa1, pa2, pa3); MASKT(PX0, PX1, (t)); partialSM(PX0, PX1, m_reg, mnX, alX);                                        \
        __syncthreads();                                                                                                      \
        if ((t) + 1 < NT) { VMW(); SWRITE_H(SB); }                                                                          \
        RESC(alX); __syncthreads(); } while (0)
    for (int t = 1; t + 1 < NT; t += 2) {
        HALF_STEP(pB0, pB1, mnB, alB, pA0, pA1, alA, t, 1, 0, 0);
        HALF_STEP(pA0, pA1, mnA, alA, pB0, pB1, alB, t + 1, 0, 1, 1);
    }
    const bool even = (NT & 1) == 0;
    if (even) { SBAR(); qkt<1>(pB0, pB1, K_lds, r32, hi, S.qr); SBAR(); }
    { SLOAD_H(nxt.K, nxt.V, 0); SBAR();
      const bf16* qb__ = nxt.Q + (size_t)(wid * QBLK) * RS;
#pragma unroll
      for (int d0 = 0; d0 < 8; ++d0) S.qr[d0] = load8(qb__ + qoff + d0 * 16); }
    SBAR();
    finishSM(pA0, pA1, alA, l_reg, pa0, pa1, pa2, pa3); SBAR();
    pv_tile<0>(o, vb0, pa0, pa1, pa2, pa3);
    if (even) { MASKT(pB0, pB1, NT - 1); partialSM(pB0, pB1, m_reg, mnB, alB); __syncthreads(); RESC(alB);
        finishSM(pB0, pB1, alB, l_reg, pa0, pa1, pa2, pa3); SBAR(); pv_tile<1>(o, vb0, pa0, pa1, pa2, pa3); }
    SBAR(); SEAM_K0();
    if (hi == 0) li_l[r32] = l_reg; asm volatile("s_waitcnt lgkmcnt(0)" ::: "memory");
    float rli[16];
#pragma unroll
    for (int r = 0; r < 16; ++r) rli[r] = __builtin_amdgcn_rcpf(li_l[crow(r, hi)]);
    bf16* Ow = cur.O + (size_t)(wid * QBLK) * RSO;
    const unsigned ooff = (unsigned)(4 * hi * RSO + r32);
#pragma unroll
    for (int r = 0; r < 16; ++r) { const int orow0 = (r & 3) + 8 * (r >> 2);
#pragma unroll
        for (int d0 = 0; d0 < 4; ++d0) { const float v = o[d0][r] * rli[r];
            const float vn = __shfl_xor(v, 1);
            if ((r32 & 1) == 0) *(unsigned*)(Ow + ooff + (unsigned)(orow0 * RSO + d0 * 32)) = cvtpk(v, vn); } }
    __syncthreads();
#undef RESC
#undef KBASE
#undef MASKT
#undef SEAM_K0
#undef HALF_STEP
}
#undef VMW
#undef VMWN
#undef SLOAD_H
#undef SWRITE_HK
#undef SWRITE_HV
#undef SWRITE_H
#undef KSWZ
#undef SBAR
}

namespace dn {
#ifndef DBL
#define DBL -1
#endif
#define REPS(k) for (int rep_ = 0; rep_ < ((DBL == (k)) ? 2 : 1); ++rep_)
constexpr int L_QB = 0, L_KB = 17408, L_KT = 34816, L_VT = 53248, L_LM = 71680, L_TB = 89088, L_GV = 107520;
constexpr int RQ = 272, LMS = 68, RT = 144;

struct Raw { unsigned v[33]; float br, ar; };
DI void prep_load(const Params& p, int item, Raw& R, int lane, int wave) {
    const int bh = item >> 5, n = item & 31, b = bh >> 3, h = bh & 7, i0 = wave * 8, c0 = 2 * lane;
    const bf16_t* PROJ = (const bf16_t*)(p.ws + WS_B);
#pragma unroll
    for (int seg = 0; seg < 3; ++seg)
#pragma unroll
        for (int jj = 0; jj < 11; ++jj) {
            const int sp = n * 64 + i0 - 3 + jj;
            unsigned v = 0u;
            if (sp >= 0) v = *(const unsigned*)(PROJ + (size_t)(b * SEQ + sp) * PP + C_DN + seg * 1024 + h * HD + c0);
            R.v[seg * 11 + jj] = v;
        }
    R.br = 0.f; R.ar = 0.f;
    if (wave == 0) { const float* BA = (const float*)(p.ws + WS_BA); const size_t t = (size_t)(b * SEQ + n * 64 + lane);
        R.br = BA[t * 16 + h]; R.ar = BA[t * 16 + 8 + h]; }
}
#define DN_BAR() do { asm volatile("s_waitcnt lgkmcnt(0)" ::: "memory"); __builtin_amdgcn_s_barrier(); asm volatile("" ::: "memory"); } while (0)
DI void prep_chunk(const Params& p, LAS unsigned char* lds, int item, int nitem, Raw& R, int tid, int lane, int wave) {
    asm volatile("" : "+v"(tid), "+v"(lane));
    const int bh = item >> 5, n = item & 31, b = bh >> 3, h = bh & 7;
    unsigned char* rec = p.ws + WS_DNP + (size_t)item * DN_STRIDE;
    LAS float* LM = (LAS float*)(lds + L_LM);
    LAS float* GV = (LAS float*)(lds + L_GV);
    REPS(31) {
        const int i0 = wave * 8, c0 = 2 * lane;
#pragma unroll
        for (int seg = 0; seg < 3; ++seg) {
            const int chan = seg * 1024 + h * HD + c0;
            float w0[4], w1[4];
#pragma unroll
            for (int j = 0; j < 4; ++j) { const f32x2 wv = *(const f32x2*)(p.conv_w + j * 3072 + chan); w0[j] = wv.x; w1[j] = wv.y; }
            float r0[11], r1[11];
#pragma unroll
            for (int jj = 0; jj < 11; ++jj) { const unsigned v = R.v[seg * 11 + jj]; r0[jj] = bflo(v); r1[jj] = bfhi(v); }
            float ya[8], yb[8];
#pragma unroll
            for (int i = 0; i < 8; ++i) {
                float y0 = 0.f, y1 = 0.f;
#pragma unroll
                for (int j = 0; j < 4; ++j) { y0 += w0[j] * r0[i + j]; y1 += w1[j] * r1[i + j]; }
                y0 = siluf_(y0); y1 = siluf_(y1);
                if (seg < 2) {
                    const float ss = wave_sum(y0 * y0 + y1 * y1);
                    const float rn = (seg == 0 ? SCALE_Q : 1.0f) * rsqrt_(ss + EPS);
                    y0 *= rn; y1 *= rn;
                    *(LAS unsigned*)(lds + (seg == 0 ? L_QB : L_KB) + (i0 + i) * RQ + c0 * 2) = cvtpk(y0, y1);
                }
                ya[i] = y0; yb[i] = y1;
            }
            if (seg >= 1) {
                LAS unsigned char* tb = lds + (seg == 1 ? L_KT : L_VT) + c0 * RT + i0 * 2;
                u32x4 o0, o1;
                o0.x = cvtpk(ya[0], ya[1]); o0.y = cvtpk(ya[2], ya[3]); o0.z = cvtpk(ya[4], ya[5]); o0.w = cvtpk(ya[6], ya[7]);
                o1.x = cvtpk(yb[0], yb[1]); o1.y = cvtpk(yb[2], yb[3]); o1.z = cvtpk(yb[4], yb[5]); o1.w = cvtpk(yb[6], yb[7]);
                *(LAS u32x4*)tb = o0; *(LAS u32x4*)(tb + RT) = o1;
            }
        }
        if (wave == 0) {
            const float br = R.br, ar = R.ar;
            const float beta = sigmoidf_(br);
            const float xs = ar + p.dt_bias[h];
            const float sp = xs > 20.f ? xs : log1pf(expf(xs));
            float g = -expf(p.a_log[h]) * sp;
#pragma unroll
            for (int o = 1; o < 64; o <<= 1) { const float u = __shfl_up(g, o); if (lane >= o) g += u; }
            const float g63 = __shfl(g, 63);
            GV[lane] = g; GV[64 + lane] = beta; GV[128 + lane] = expf(g); GV[192 + lane] = expf(g63 - g);
        }
    }
    if (nitem >= 0) prep_load(p, nitem, R, lane, wave);
    DN_BAR();
    REPS(32) {
        const int mt = wave >> 1, nt = wave & 1, r = lane & 31, hi = lane >> 5;
        if (mt < 2) {
            const LAS unsigned char* Ab = lds + L_KB + (32 * nt + r) * RQ, * Bb = lds + L_QB + (32 * mt + r) * RQ;
            f32x16 acc = f32x16{};
#pragma unroll
            for (int ks = 0; ks < 8; ++ks) acc = MFMA32(*(const LAS bf16x8*)(Ab + (16 * ks + 8 * hi) * 2), *(const LAS bf16x8*)(Bb + (16 * ks + 8 * hi) * 2), acc);
            const int i = 32 * mt + r; const float Gi = GV[i];
            float v[16];
#pragma unroll
            for (int q = 0; q < 16; ++q) { const int j = 32 * nt + crow(q, hi); v[q] = i >= j ? acc[q] * __expf(Gi - GV[j]) : 0.f; }
            u32x4* QKf = (u32x4*)(rec + DN_QK) + ((mt * 4 + 2 * nt) * 64 + lane);
            u32x4 o0, o1;
            o0.x = cvtpk(v[0], v[1]); o0.y = cvtpk(v[2], v[3]); o0.z = cvtpk(v[4], v[5]); o0.w = cvtpk(v[6], v[7]);
            o1.x = cvtpk(v[8], v[9]); o1.y = cvtpk(v[10], v[11]); o1.z = cvtpk(v[12], v[13]); o1.w = cvtpk(v[14], v[15]);
            QKf[0] = o0; QKf[64] = o1;
        } else {
            const LAS unsigned char* Ab = lds + L_KB + (32 * (mt - 2) + r) * RQ, * Bb = lds + L_KB + (32 * nt + r) * RQ;
            f32x16 acc = f32x16{};
#pragma unroll
            for (int ks = 0; ks < 8; ++ks) acc = MFMA32(*(const LAS bf16x8*)(Ab + (16 * ks + 8 * hi) * 2), *(const LAS bf16x8*)(Bb + (16 * ks + 8 * hi) * 2), acc);
            const int j = 32 * nt + r; const float Gj = GV[j];
#pragma unroll
            for (int q = 0; q < 16; ++q) { const int row = 32 * (mt - 2) + crow(q, hi);
                const float e = row > j ? GV[64 + row] * __expf(GV[row] - Gj) : 0.f;
                LM[row * LMS + j] = acc[q] * e; }
        }
    }
    DN_BAR();
    REPS(33) {
        float Lr[64];
#pragma unroll
        for (int jq = 0; jq < 16; ++jq) { const f32x4 l = *(const LAS f32x4*)(LM + lane * LMS + 4 * jq); Lr[4 * jq] = l.x; Lr[4 * jq + 1] = l.y; Lr[4 * jq + 2] = l.z; Lr[4 * jq + 3] = l.w; }
        float xv[8];
#pragma unroll
        for (int q = 0; q < 8; ++q) xv[q] = (lane == 8 * wave + q) ? 1.0f : 0.0f;
#pragma unroll
        for (int j = 0; j < 63; ++j) {
#pragma unroll
            for (int q = 0; q < 8; ++q) { const float xj = __int_as_float(__builtin_amdgcn_readlane(__float_as_int(xv[q]), j)); xv[q] -= Lr[j] * xj; }
        }
        float t1[8], t2[8];
#pragma unroll
        for (int q = 0; q < 8; ++q) { const float bc = GV[64 + 8 * wave + q]; t1[q] = xv[q] * bc; t2[q] = t1[q] * GV[128 + 8 * wave + q]; }
        u32x4 o1, o2;
        o1.x = cvtpk(t1[0], t1[1]); o1.y = cvtpk(t1[2], t1[3]); o1.z = cvtpk(t1[4], t1[5]); o1.w = cvtpk(t1[6], t1[7]);
        o2.x = cvtpk(t2[0], t2[1]); o2.y = cvtpk(t2[2], t2[3]); o2.z = cvtpk(t2[4], t2[5]); o2.w = cvtpk(t2[6], t2[7]);
        *(LAS u32x4*)(lds + L_TB + lane * RT + wave * 16) = o1; *(LAS u32x4*)(lds + L_TB + 64 * RT + lane * RT + wave * 16) = o2;
    }
    DN_BAR();
    REPS(34) {
        const int r = lane & 31, hi = lane >> 5;
#pragma unroll
        for (int half = 0; half < 2; ++half) {
            const int tix = wave * 2 + half;
            f32x16 acc = f32x16{};
            if (tix < 8) {
                const int mt = tix >> 2, nt = tix & 3;
                const LAS unsigned char* Ab = lds + L_TB + (32 * mt + r) * RT + 16 * hi, * Bb = lds + L_VT + (32 * nt + r) * RT + 16 * hi;
#pragma unroll
                for (int ks = 0; ks < 4; ++ks) acc = MFMA32(*(const LAS bf16x8*)(Ab + 32 * ks), *(const LAS bf16x8*)(Bb + 32 * ks), acc);
                u32x4* Uf = (u32x4*)(rec + DN_U) + ((mt * 4 + nt) * 64 + lane) * 2;
                u32x4 o0, o1;
                o0.x = cvtpk(acc[0], acc[1]); o0.y = cvtpk(acc[2], acc[3]); o0.z = cvtpk(acc[4], acc[5]); o0.w = cvtpk(acc[6], acc[7]);
                o1.x = cvtpk(acc[8], acc[9]); o1.y = cvtpk(acc[10], acc[11]); o1.z = cvtpk(acc[12], acc[13]); o1.w = cvtpk(acc[14], acc[15]);
                Uf[0] = o0; Uf[1] = o1;
            } else {
                const int ntp = (tix - 8) >> 1, mt = tix & 1;
                const LAS unsigned char* Ab = lds + L_KT + (32 * ntp + r) * RT + 16 * hi, * Bb = lds + L_TB + 64 * RT + (32 * mt + r) * RT + 16 * hi;
#pragma unroll
                for (int ks = 0; ks < 4; ++ks) acc = MFMA32(*(const LAS bf16x8*)(Ab + 32 * ks), *(const LAS bf16x8*)(Bb + 32 * ks), acc);
                u32x4* Wf = (u32x4*)(rec + DN_W) + ((mt * 8 + 2 * ntp) * 64 + lane);
                u32x4 o0, o1;
                o0.x = cvtpk(-acc[0], -acc[1]); o0.y = cvtpk(-acc[2], -acc[3]); o0.z = cvtpk(-acc[4], -acc[5]); o0.w = cvtpk(-acc[6], -acc[7]);
                o1.x = cvtpk(-acc[8], -acc[9]); o1.y = cvtpk(-acc[10], -acc[11]); o1.z = cvtpk(-acc[12], -acc[13]); o1.w = cvtpk(-acc[14], -acc[15]);
                Wf[0] = o0; Wf[64] = o1;
            }
        }
#pragma unroll
        for (int rep = 0; rep < 2; ++rep) {
            const int f = tid + 512 * rep, mt = f >> 9, ks = (f >> 6) & 7, fr = f & 31, fh = (f >> 5) & 1, i = 32 * mt + fr;
            const LAS unsigned char* qp = lds + L_QB + i * RQ + (16 * ks + 4 * fh) * 2;
            const u32x2 a = *(const LAS u32x2*)qp, c = *(const LAS u32x2*)(qp + 16);
            const float e = GV[128 + i];
            u32x4 o; o.x = cvtpk(bflo(a.x) * e, bfhi(a.x) * e); o.y = cvtpk(bflo(a.y) * e, bfhi(a.y) * e); o.z = cvtpk(bflo(c.x) * e, bfhi(c.x) * e); o.w = cvtpk(bflo(c.y) * e, bfhi(c.y) * e);
            ((u32x4*)(rec + DN_QD))[f] = o;
        }
#pragma unroll
        for (int rep = 0; rep < 2; ++rep) {
            const int f = tid + 512 * rep, a4 = f >> 8, ks = (f >> 6) & 3, fr = f & 31, fh = (f >> 5) & 1, d = 32 * a4 + fr;
            const LAS unsigned char* kp = lds + L_KT + d * RT + (16 * ks + 4 * fh) * 2;
            const u32x2 a = *(const LAS u32x2*)kp, c = *(const LAS u32x2*)(kp + 16);
            const LAS float* eg = GV + 192 + 16 * ks + 4 * fh;
            u32x4 o; o.x = cvtpk(bflo(a.x) * eg[0], bfhi(a.x) * eg[1]); o.y = cvtpk(bflo(a.y) * eg[2], bfhi(a.y) * eg[3]);
            o.z = cvtpk(bflo(c.x) * eg[8], bfhi(c.x) * eg[9]); o.w = cvtpk(bflo(c.y) * eg[10], bfhi(c.y) * eg[11]);
            ((u32x4*)(rec + DN_KT))[f] = o;
        }
        if (tid == 0) *(float*)(rec + DN_SC) = GV[128 + 63];
    }
    DN_BAR();
}

DI bf16x8 pack_step(const f32x16& x, int s) {
    u32x4 w;
    if (s == 0) { w.x = cvtpk(x[0], x[1]); w.y = cvtpk(x[2], x[3]); w.z = cvtpk(x[4], x[5]); w.w = cvtpk(x[6], x[7]); }
    else { w.x = cvtpk(x[8], x[9]); w.y = cvtpk(x[10], x[11]); w.z = cvtpk(x[12], x[13]); w.w = cvtpk(x[14], x[15]); }
    return __builtin_bit_cast(bf16x8, w);
}

constexpr int RB = 57344;
constexpr int ORS = 272, OB = 64 * ORS;
DI void recur(const Params& p, LAS unsigned char* lds, int bh, int tid, int lane, int wave) {
    asm volatile("" : "+v"(tid), "+v"(lane));
    const int r = lane & 31, hi = lane >> 5, b = bh >> 3, h = bh & 7;
    const unsigned char* rec0 = p.ws + WS_DNP + (size_t)(bh * 32) * DN_STRIDE;
    if (wave >= 4) {
        const int lt = tid - 256;
        const int fg = lt & 7, fr2 = lt >> 3;
        const bf16_t* PROJ = (const bf16_t*)(p.ws + WS_B); bf16_t* YAB = (bf16_t*)(p.ws + WS_A);
        f32x4 g4[4];
#pragma unroll
        for (int j = 0; j < 4; ++j) g4[j] = *(const f32x4*)(p.dn_gain + fg * 16 + 4 * j);
        const bf16_t* zb = PROJ + (size_t)(b * SEQ) * PP + C_Z + h * HD + fg * 16; bf16_t* yb = YAB + (size_t)(b * SEQ) * DM + 1024 + h * HD + fg * 16;
        u32x4 zr[2][2];
#define DN_ZLOAD(n_) do { _Pragma("unroll") for (int ps = 0; ps < 2; ++ps) { const bf16_t* zp = zb + (size_t)((n_) * 64 + fr2 + 32 * ps) * PP; zr[ps][0] = *(const u32x4*)zp; zr[ps][1] = *(const u32x4*)(zp + 8); } } while (0)
#define DN_FINAL(n_) do { const LAS unsigned char* ob = lds + 2 * RB + ((n_) & 1) * OB; \
        _Pragma("unroll") for (int ps = 0; ps < 2; ++ps) { const int row = fr2 + 32 * ps; \
            const u32x4 o0 = *(const LAS u32x4*)(ob + row * ORS + fg * 32), o1 = *(const LAS u32x4*)(ob + row * ORS + fg * 32 + 16); \
            float ov[16] = {bflo(o0.x), bfhi(o0.x), bflo(o0.y), bfhi(o0.y), bflo(o0.z), bfhi(o0.z), bflo(o0.w), bfhi(o0.w), bflo(o1.x), bfhi(o1.x), bflo(o1.y), bfhi(o1.y), bflo(o1.z), bfhi(o1.z), bflo(o1.w), bfhi(o1.w)}; \
            float ss = 0.f; _Pragma("unroll") for (int e = 0; e < 16; ++e) ss += ov[e] * ov[e]; \
            ss += __shfl_xor(ss, 1); ss += __shfl_xor(ss, 2); ss += __shfl_xor(ss, 4); \
            const float rstd = rsqrt_(ss * (1.0f / HD) + EPS); \
            const u32x4 z0 = zr[ps][0], z1 = zr[ps][1]; \
            const float zz[16] = {bflo(z0.x), bfhi(z0.x), bflo(z0.y), bfhi(z0.y), bflo(z0.z), bfhi(z0.z), bflo(z0.w), bfhi(z0.w), bflo(z1.x), bfhi(z1.x), bflo(z1.y), bfhi(z1.y), bflo(z1.z), bfhi(z1.z), bflo(z1.w), bfhi(z1.w)}; \
            float y[16]; _Pragma("unroll") for (int e = 0; e < 16; ++e) y[e] = ov[e] * rstd * g4[e >> 2][e & 3] * siluf_(zz[e]); \
            u32x4 w0, w1; w0.x = cvtpk(y[0], y[1]); w0.y = cvtpk(y[2], y[3]); w0.z = cvtpk(y[4], y[5]); w0.w = cvtpk(y[6], y[7]); \
            w1.x = cvtpk(y[8], y[9]); w1.y = cvtpk(y[10], y[11]); w1.z = cvtpk(y[12], y[13]); w1.w = cvtpk(y[14], y[15]); \
            bf16_t* yp = yb + (size_t)((n_) * 64 + row) * DM; *(u32x4*)yp = w0; *(u32x4*)(yp + 8) = w1; } } while (0)
        u32x4 v[14];
        {   const u32x4* src = (const u32x4*)(rec0 + DN_W) + lt;
#pragma unroll
            for (int k = 0; k < 14; ++k) v[k] = src[k * 256];
#pragma unroll
            for (int k = 0; k < 14; ++k) *(LAS u32x4*)(lds + (k * 256 + lt) * 16) = v[k];
            const u32x4* src1 = (const u32x4*)(rec0 + DN_STRIDE + DN_W) + lt;
#pragma unroll
            for (int k = 0; k < 14; ++k) v[k] = src1[k * 256]; }
        DN_ZLOAD(0);
        DN_BAR();
        for (int n = 0; n < 32; ++n) {
            if (n + 1 < 32) { LAS unsigned char* dst = lds + ((n + 1) & 1) * RB;
#pragma unroll
                for (int k = 0; k < 14; ++k) *(LAS u32x4*)(dst + (k * 256 + lt) * 16) = v[k]; }
            if (n + 2 < 32) { const u32x4* src = (const u32x4*)(rec0 + (size_t)(n + 2) * DN_STRIDE + DN_W) + lt;
#pragma unroll
                for (int k = 0; k < 14; ++k) v[k] = src[k * 256]; }
            if (n >= 1) { DN_FINAL(n - 1); DN_ZLOAD(n); }
            DN_BAR();
        }
        DN_FINAL(31);
#undef DN_ZLOAD
#undef DN_FINAL
    } else {
        const int slice = wave, dv0 = slice * 32;
        f32x16 St[4];
#pragma unroll
        for (int a = 0; a < 4; ++a) St[a] = f32x16{};
        u32x4 un[2][2];
#pragma unroll
        for (int mt = 0; mt < 2; ++mt) { const u32x4* up = (const u32x4*)(rec0 + DN_U) + ((mt * 4 + slice) * 64 + lane) * 2; un[mt][0] = up[0]; un[mt][1] = up[1]; }
        DN_BAR();
        for (int n = 0; n < 32; ++n) {
            const unsigned char* rec = rec0 + (size_t)n * DN_STRIDE;
            const LAS unsigned char* buf = lds + (n & 1) * RB;
            const float eg = *(const float*)(rec + DN_SC);
            f32x16 Vn[2], O[2];
#pragma unroll
            for (int mt = 0; mt < 2; ++mt) { const u32x4 a = un[mt][0], c = un[mt][1];
                Vn[mt][0] = bflo(a.x); Vn[mt][1] = bfhi(a.x); Vn[mt][2] = bflo(a.y); Vn[mt][3] = bfhi(a.y); Vn[mt][4] = bflo(a.z); Vn[mt][5] = bfhi(a.z); Vn[mt][6] = bflo(a.w); Vn[mt][7] = bfhi(a.w);
                Vn[mt][8] = bflo(c.x); Vn[mt][9] = bfhi(c.x); Vn[mt][10] = bflo(c.y); Vn[mt][11] = bfhi(c.y); Vn[mt][12] = bflo(c.z); Vn[mt][13] = bfhi(c.z); Vn[mt][14] = bflo(c.w); Vn[mt][15] = bfhi(c.w); }
            if (n + 1 < 32) {
#pragma unroll
                for (int mt = 0; mt < 2; ++mt) { const u32x4* up = (const u32x4*)(rec + DN_STRIDE + DN_U) + ((mt * 4 + slice) * 64 + lane) * 2; un[mt][0] = up[0]; un[mt][1] = up[1]; } }
            bf16x8 Sf[8];
#pragma unroll
            for (int a = 0; a < 4; ++a) { Sf[2 * a] = pack_step(St[a], 0); Sf[2 * a + 1] = pack_step(St[a], 1); }
#pragma unroll
            for (int mt = 0; mt < 2; ++mt)
#pragma unroll
                for (int ks = 0; ks < 8; ++ks) Vn[mt] = MFMA32(*(const LAS bf16x8*)(buf + ((mt * 8 + ks) * 64 + lane) * 16), Sf[ks], Vn[mt]);
#pragma unroll
            for (int mt = 0; mt < 2; ++mt) { O[mt] = f32x16{};
#pragma unroll
                for (int ks = 0; ks < 8; ++ks) O[mt] = MFMA32(*(const LAS bf16x8*)(buf + 16384 + ((mt * 8 + ks) * 64 + lane) * 16), Sf[ks], O[mt]); }
            bf16x8 Vf[4];
#pragma unroll
            for (int mt = 0; mt < 2; ++mt) { Vf[2 * mt] = pack_step(Vn[mt], 0); Vf[2 * mt + 1] = pack_step(Vn[mt], 1); }
#pragma unroll
            for (int mt = 0; mt < 2; ++mt)
#pragma unroll
                for (int ks = 0; ks < 4; ++ks) O[mt] = MFMA32(*(const LAS bf16x8*)(buf + 49152 + ((mt * 4 + ks) * 64 + lane) * 16), Vf[ks], O[mt]);
#pragma unroll
            for (int a = 0; a < 4; ++a) {
                St[a] = St[a] * eg;
#pragma unroll
                for (int ks = 0; ks < 4; ++ks) St[a] = MFMA32(*(const LAS bf16x8*)(buf + 32768 + ((a * 4 + ks) * 64 + lane) * 16), Vf[ks], St[a]);
            }
            {   LAS unsigned char* ob = lds + 2 * RB + (n & 1) * OB + (dv0 + r) * 2;
#pragma unroll
                for (int mt = 0; mt < 2; ++mt)
#pragma unroll
                    for (int i = 0; i < 16; ++i) *(LAS bf16_t*)(ob + (32 * mt + crow(i, hi)) * ORS) = f2bf(O[mt][i]);
            }
            DN_BAR();
        }
    }
}
}

DI void transpose_tile(const float* W, int N, int k0, int sn0, bf16_t* WT, int dpitch, int drow0, int dk0, int nvalid, LAS float* scr, int lane) {
#pragma unroll 8
    for (int i = 0; i < 32; ++i) { const int kk = 2 * i + (lane >> 5); scr[kk * 33 + (lane & 31)] = W[(size_t)(k0 + kk) * N + sn0 + (lane & 31)]; }
    asm volatile("s_waitcnt lgkmcnt(0)" ::: "memory");
    const int c = lane & 7;
#pragma unroll
    for (int j = 0; j < 4; ++j) { const int n = (lane >> 3) + 8 * j; const LAS float* s = scr + (8 * c) * 33 + n;
        u32x4 o; o.x = cvtpk(s[0 * 33], s[1 * 33]); o.y = cvtpk(s[2 * 33], s[3 * 33]); o.z = cvtpk(s[4 * 33], s[5 * 33]); o.w = cvtpk(s[6 * 33], s[7 * 33]);
        if (n < nvalid) *(u32x4*)(WT + (size_t)(drow0 + n) * dpitch + dk0 + k0 + 8 * c) = o; }
    asm volatile("s_waitcnt lgkmcnt(0)" ::: "memory");
}

DI void phase0(const Params& p, LAS unsigned char* lds, int tid, int lane, int wave, int bid, int G) {
    float* MOD = (float*)(p.ws + WS_MOD);
#if defined(DBL) && DBL == 0
    __syncthreads();
#endif
    if (bid < 192) {
        LAS float* sc = (LAS float*)lds;
        LAS float* red = (LAS float*)(lds + 65536);
        for (int i = tid; i < 8 * 2048; i += 512) { const int bb = i >> 11, k = i & 2047; sc[k * 8 + bb] = siluf_acc(p.c[i]); }
        __syncthreads();
        const int n0 = bid * 64;
        const int ksub = lane >> 4, cg = lane & 15;
        f32x4 acc[8];
#pragma unroll
        for (int bb = 0; bb < 8; ++bb) acc[bb] = (f32x4){0.f, 0.f, 0.f, 0.f};
        const float* wp = p.w_ada + (size_t)(wave * 256 + ksub) * 12288 + n0 + 4 * cg;
#pragma unroll 8
        for (int it = 0; it < 64; ++it) {
            const f32x4 wv = *(const f32x4*)(wp + (size_t)(4 * it) * 12288);
            const LAS float* sp = sc + (wave * 256 + 4 * it + ksub) * 8;
            const f32x4 s0 = *(const LAS f32x4*)sp, s1 = *(const LAS f32x4*)(sp + 4);
            acc[0] += wv * s0.x; acc[1] += wv * s0.y; acc[2] += wv * s0.z; acc[3] += wv * s0.w;
            acc[4] += wv * s1.x; acc[5] += wv * s1.y; acc[6] += wv * s1.z; acc[7] += wv * s1.w;
        }
#pragma unroll
        for (int bb = 0; bb < 8; ++bb) {
#pragma unroll
            for (int e = 0; e < 4; ++e) { float v = acc[bb][e]; v += __shfl_xor(v, 16); v += __shfl_xor(v, 32); acc[bb][e] = v; }
            if (ksub == 0) *(LAS f32x4*)(red + (wave * 8 + bb) * 64 + 4 * cg) = acc[bb];
        }
        __syncthreads();
        { const int bb = tid >> 6, col = tid & 63; float s = 0.f;
#pragma unroll
          for (int w = 0; w < 8; ++w) s += red[(w * 8 + bb) * 64 + col];
          MOD[bb * 12288 + n0 + col] = s + p.b_ada[n0 + col]; }
        __syncthreads();
    } else {
        f32x2* CS = (f32x2*)(p.ws + WS_CS);
        for (int i = (bid - 192) * 512 + tid; i < T * 16; i += (G - 192) * 512) {
            const int t = i >> 4, f = i & 15;
            const float inv = powf(500000.0f, -(float)f * (2.0f / 32.0f));
            const float ang = (float)p.pos[t] * inv;
            float sn, cs; sincosf(ang, &sn, &cs);
            CS[i] = (f32x2){cs, sn};
        }
    }
    LAS float* scr = (LAS float*)(lds + wave * 8448);
    const int gw = bid * 8 + wave, NGW = G * 8;
    bf16_t* WIN = (bf16_t*)(p.ws + WS_WIN); bf16_t* WMD = (bf16_t*)(p.ws + WS_WMD); bf16_t* WOUT = (bf16_t*)(p.ws + WS_WOUT); bf16_t* WR = (bf16_t*)(p.ws + WS_WR);
    constexpr int I_A = 32 * 224, I_B = 32 * 128, I_C = 32, I_M = 16 * 64, I_O = 32 * 64, I_RG = 32, I_RE = 32;
    constexpr int NITEMS = I_A + I_B + I_C + 2 * I_M + I_O + I_RG + I_RE;
    for (int it = gw; it < NITEMS; it += NGW) {
        int r = it;
        if (r < I_A) { const int kb = r / 224, nb = r % 224; transpose_tile(p.w_in, 11280, 64 * kb, 32 * nb, WIN, DM, 32 * nb, 0, 32, scr, lane); continue; } r -= I_A;
        if (r < I_B) { const int kb = r / 128, nb = r % 128; transpose_tile(p.w_in, 11280, 64 * kb, 7184 + 32 * nb, WIN, DM, 7168 + 32 * nb, 0, 32, scr, lane); continue; } r -= I_B;
        if (r < I_C) { transpose_tile(p.w_in, 11280, 64 * r, 7168, (bf16_t*)(p.ws + WS_WBA), DM, 0, 0, 16, scr, lane); continue; } r -= I_C;
        if (r < I_M) { const int kb = r / 64, nb = r % 64; transpose_tile(p.w_bm, DM, 64 * kb, 32 * nb, WMD, DM, 32 * nb, 0, 32, scr, lane); continue; } r -= I_M;
        if (r < I_M) { const int kb = r / 64, nb = r % 64; transpose_tile(p.w_bd, DM, 64 * kb, 32 * nb, WMD, DM, 32 * nb, 1024, 32, scr, lane); continue; } r -= I_M;
        if (r < I_O) { const int kb = r / 64, nb = r % 64; transpose_tile(p.w_out, DM, 64 * kb, 32 * nb, WOUT, DM, 32 * nb, 0, 32, scr, lane); continue; } r -= I_O;
        if (r < I_RG) {
            const int k = r * 64 + lane;
#pragma unroll
            for (int e = 0; e < 4; ++e) WR[e * DM + k] = f2bf(p.w_rg[k * 4 + e]);
#pragma unroll
            for (int e = 36; e < 48; ++e) WR[e * DM + k] = 0;
            continue; } r -= I_RG;
        { transpose_tile(p.w_re, 32, 64 * r, 0, WR, DM, 4, 0, 32, scr, lane); }
    }
}

DI void phase_u1_item(const Params& p, int item, int tid, int lane, int wave) {
    const float* MOD = (const float*)(p.ws + WS_MOD); bf16_t* U1 = (bf16_t*)(p.ws + WS_A);
    const int tokb = item * 64;
    for (int rr = 0; rr < 8; ++rr) {
        const int m = tokb + wave * 8 + rr, b = m >> 11;
        const f32x4* xr = (const f32x4*)(p.x + (size_t)m * DM) + lane;
        f32x4 v[8]; float s = 0.f;
#pragma unroll
        for (int j = 0; j < 8; ++j) { v[j] = xr[64 * j]; s += (v[j].x * v[j].x + v[j].y * v[j].y) + (v[j].z * v[j].z + v[j].w * v[j].w); }
        const float rstd = rsqrt_(wave_sum(s) * (1.0f / DM) + EPS);
        const float* sh = MOD + b * 12288; const float* scl = sh + 2048;
        u32x2* o8 = (u32x2*)(U1 + (size_t)m * DM) + lane;
#pragma unroll
        for (int j = 0; j < 8; ++j) { const int col = 4 * (lane + 64 * j);
            const f32x4 g = *(const f32x4*)(p.g_mix_pre + col), a = *(const f32x4*)(scl + col), c = *(const f32x4*)(sh + col);
            const f32x4 u = (v[j] * rstd * g) * (a + 1.0f) + c;
            o8[64 * j] = (u32x2){cvtpk(u.x, u.y), cvtpk(u.z, u.w)}; }
    }
    __syncthreads();
    if (wave < 4) {
        const int tl = lane & 15, kg = lane >> 4;
        const bf16_t* up = U1 + (size_t)(tokb + wave * 16 + tl) * DM + 8 * kg;
        const bf16_t* wp = (const bf16_t*)(p.ws + WS_WBA) + (size_t)tl * DM + 8 * kg;
        f32x4 a0 = {0.f, 0.f, 0.f, 0.f}, a1 = a0;
#pragma unroll 8
        for (int s = 0; s < 64; s += 2) {
            a0 = MFMA16(*(const bf16x8*)(wp + 32 * s), *(const bf16x8*)(up + 32 * s), a0);
            a1 = MFMA16(*(const bf16x8*)(wp + 32 * s + 32), *(const bf16x8*)(up + 32 * s + 32), a1);
        }
        float* BA = (float*)(p.ws + WS_BA);
        *(f32x4*)(BA + (size_t)(tokb + wave * 16 + tl) * 16 + 4 * kg) = a0 + a1;
    }
}

DI void rotary_item(const Params& p, int item, int lane) {
    const int which = item & 1, h = (item >> 1) & 7, blk = (item >> 4) & 7, b = item >> 7;
    bf16_t* PROJ = (bf16_t*)(p.ws + WS_B);
    const f32x2* CS = (const f32x2*)(p.ws + WS_CS);
    const int tok0 = b * SEQ + blk * 256; const int colb = (which ? C_K : C_Q) + h * HD;
    float s0 = 0.f, s1 = 0.f;
    if (which) {
#pragma unroll 8
        for (int rr = 0; rr < 256; ++rr) { const unsigned v = *(const unsigned*)(PROJ + (size_t)(tok0 + rr) * PP + colb + 2 * lane); s0 += bflo(v); s1 += bfhi(v); }
    }
    const int rsub = lane >> 4, i = lane & 15;
    float a0 = 0.f, a1 = 0.f;
#pragma unroll 4
    for (int it = 0; it < 64; ++it) {
        const int t = tok0 + it * 4 + rsub;
        bf16_t* ptr = PROJ + (size_t)t * PP + colb + i;
        const float x1 = bf2f(ptr[0]), x2 = bf2f(ptr[16]);
        const f32x2 cs = CS[t * 16 + i];
        const unsigned w = cvtpk(x1 * cs.x - x2 * cs.y, x2 * cs.x + x1 * cs.y);
        ptr[0] = (bf16_t)(w & 0xffffu); ptr[16] = (bf16_t)(w >> 16);
        a0 += bflo(w); a1 += bfhi(w);
    }
    if (which) {
        a0 += __shfl_xor(a0, 16); a0 += __shfl_xor(a0, 32); a1 += __shfl_xor(a1, 16); a1 += __shfl_xor(a1, 32);
        bf16_t* KM = (bf16_t*)(p.ws + WS_KMEAN) + ((size_t)(b * 8 + h) * 8 + blk) * HD;
        if (lane >= 16) { *(unsigned*)(KM + 2 * lane) = cvtpk(s0 * (1.0f / 256.0f), s1 * (1.0f / 256.0f)); }
        else { KM[lane] = f2bf(a0 * (1.0f / 256.0f)); KM[16 + lane] = f2bf(a1 * (1.0f / 256.0f)); }
    }
}

DI void phase_dn_final(const Params& p, int lane, int gw, int NGW) {
    const float* ODN = (const float*)(p.ws + WS_D); const bf16_t* PROJ = (const bf16_t*)(p.ws + WS_B); bf16_t* YAB = (bf16_t*)(p.ws + WS_A);
    const int d0 = (lane & 7) * 16;
    for (int m = gw; m < T; m += NGW) {
        const float* op = ODN + (size_t)m * 1024 + lane * 16;
        f32x4 v[4]; float s = 0.f;
#pragma unroll
        for (int j = 0; j < 4; ++j) { v[j] = *(const f32x4*)(op + 4 * j); s += (v[j].x * v[j].x + v[j].y * v[j].y) + (v[j].z * v[j].z + v[j].w * v[j].w); }
        s += __shfl_xor(s, 1); s += __shfl_xor(s, 2); s += __shfl_xor(s, 4);
        const float rstd = rsqrt_(s * (1.0f / HD) + EPS);
        const u32x4 z0 = *(const u32x4*)(PROJ + (size_t)m * PP + C_Z + lane * 16), z1 = *(const u32x4*)(PROJ + (size_t)m * PP + C_Z + lane * 16 + 8);
        const float zz[16] = {bflo(z0.x), bfhi(z0.x), bflo(z0.y), bfhi(z0.y), bflo(z0.z), bfhi(z0.z), bflo(z0.w), bfhi(z0.w),
                              bflo(z1.x), bfhi(z1.x), bflo(z1.y), bfhi(z1.y), bflo(z1.z), bfhi(z1.z), bflo(z1.w), bfhi(z1.w)};
        float y[16];
#pragma unroll
        for (int j = 0; j < 4; ++j) { const f32x4 g = *(const f32x4*)(p.dn_gain + d0 + 4 * j);
            y[4 * j + 0] = v[j].x * rstd * g.x * siluf_(zz[4 * j + 0]); y[4 * j + 1] = v[j].y * rstd * g.y * siluf_(zz[4 * j + 1]);
            y[4 * j + 2] = v[j].z * rstd * g.z * siluf_(zz[4 * j + 2]); y[4 * j + 3] = v[j].w * rstd * g.w * siluf_(zz[4 * j + 3]); }
        u32x4 o0, o1;
        o0.x = cvtpk(y[0], y[1]); o0.y = cvtpk(y[2], y[3]); o0.z = cvtpk(y[4], y[5]); o0.w = cvtpk(y[6], y[7]);
        o1.x = cvtpk(y[8], y[9]); o1.y = cvtpk(y[10], y[11]); o1.z = cvtpk(y[12], y[13]); o1.w = cvtpk(y[14], y[15]);
        bf16_t* yp = YAB + (size_t)m * DM + 1024 + lane * 16;
        *(u32x4*)yp = o0; *(u32x4*)(yp + 8) = o1;
    }
}

constexpr int L5_LG = 0;
constexpr int L5_HIST = 24576;
constexpr int L5_TOK = 24576 + 256;
DI void phase5_item(const Params& p, LAS unsigned char* lds, int item, int tid, int lane, int wave) {
    const float* MOD = (const float*)(p.ws + WS_MOD); const bf16_t* OM = (const bf16_t*)(p.ws + WS_OUTMIX); bf16_t* U2 = (bf16_t*)(p.ws + WS_A);
    const bf16_t* WR = (const bf16_t*)(p.ws + WS_WR);
    LAS unsigned* hist = (LAS unsigned*)(lds + L5_HIST); LAS unsigned* tokw = (LAS unsigned*)(lds + L5_TOK);
    if (tid < 64) hist[tid] = 0u;
    const int tokb = item * 64;
    for (int rr = 0; rr < 8; rr += 2) {
        u32x4 wq[2][4]; f32x4 xa[2][4], xb[2][4];
#pragma unroll
        for (int u = 0; u < 2; ++u) { const int m = tokb + wave * 8 + rr + u;
#pragma unroll
            for (int j = 0; j < 4; ++j) { const int col = 8 * (lane + 64 * j);
                wq[u][j] = *(const u32x4*)(OM + (size_t)m * DM + col);
                xa[u][j] = *(const f32x4*)(p.x + (size_t)m * DM + col); xb[u][j] = *(const f32x4*)(p.x + (size_t)m * DM + col + 4); } }
#pragma unroll
        for (int u = 0; u < 2; ++u) {
        const int m = tokb + wave * 8 + rr + u, b = m >> 11;
        const float* mod = MOD + b * 12288;
        float om[32], xv[32];
        float s = 0.f;
#pragma unroll
        for (int j = 0; j < 4; ++j) {
            const u32x4 w = wq[u][j];
            om[8 * j + 0] = bflo(w.x); om[8 * j + 1] = bfhi(w.x); om[8 * j + 2] = bflo(w.y); om[8 * j + 3] = bfhi(w.y);
            om[8 * j + 4] = bflo(w.z); om[8 * j + 5] = bfhi(w.z); om[8 * j + 6] = bflo(w.w); om[8 * j + 7] = bfhi(w.w);
            const f32x4 x0 = xa[u][j], x1 = xb[u][j];
            xv[8 * j + 0] = x0.x; xv[8 * j + 1] = x0.y; xv[8 * j + 2] = x0.z; xv[8 * j + 3] = x0.w; xv[8 * j + 4] = x1.x; xv[8 * j + 5] = x1.y; xv[8 * j + 6] = x1.z; xv[8 * j + 7] = x1.w;
#pragma unroll
            for (int e = 0; e < 8; ++e) s += om[8 * j + e] * om[8 * j + e]; }
        const float r1 = rsqrt_(wave_sum(s) * (1.0f / DM) + EPS);
        float s2 = 0.f;
#pragma unroll
        for (int j = 0; j < 4; ++j) { const int col = 8 * (lane + 64 * j);
#pragma unroll
            for (int q = 0; q < 2; ++q) { const f32x4 g = *(const f32x4*)(p.g_mix_post + col + 4 * q), gt = *(const f32x4*)(mod + 4096 + col + 4 * q);
                f32x4 o;
                o.x = xv[8 * j + 4 * q + 0] + gt.x * (om[8 * j + 4 * q + 0] * r1 * g.x); o.y = xv[8 * j + 4 * q + 1] + gt.y * (om[8 * j + 4 * q + 1] * r1 * g.y);
                o.z = xv[8 * j + 4 * q + 2] + gt.z * (om[8 * j + 4 * q + 2] * r1 * g.z); o.w = xv[8 * j + 4 * q + 3] + gt.w * (om[8 * j + 4 * q + 3] * r1 * g.w);
                *(f32x4*)(p.out + (size_t)m * DM + col + 4 * q) = o;
                xv[8 * j + 4 * q + 0] = o.x; xv[8 * j + 4 * q + 1] = o.y; xv[8 * j + 4 * q + 2] = o.z; xv[8 * j + 4 * q + 3] = o.w;
                s2 += (o.x * o.x + o.y * o.y) + (o.z * o.z + o.w * o.w); } }
        const float r2 = rsqrt_(wave_sum(s2) * (1.0f / DM) + EPS);
#pragma unroll
        for (int j = 0; j < 4; ++j) { const int col = 8 * (lane + 64 * j); float u8[8];
#pragma unroll
            for (int q = 0; q < 2; ++q) { const f32x4 g = *(const f32x4*)(p.g_ffn_pre + col + 4 * q), sc = *(const f32x4*)(mod + 8192 + col + 4 * q), sh = *(const f32x4*)(mod + 6144 + col + 4 * q);
                u8[4 * q + 0] = (xv[8 * j + 4 * q + 0] * r2 * g.x) * (1.0f + sc.x) + sh.x; u8[4 * q + 1] = (xv[8 * j + 4 * q + 1] * r2 * g.y) * (1.0f + sc.y) + sh.y;
                u8[4 * q + 2] = (xv[8 * j + 4 * q + 2] * r2 * g.z) * (1.0f + sc.z) + sh.z; u8[4 * q + 3] = (xv[8 * j + 4 * q + 3] * r2 * g.w) * (1.0f + sc.w) + sh.w; }
            u32x4 w; w.x = cvtpk(u8[0], u8[1]); w.y = cvtpk(u8[2], u8[3]); w.z = cvtpk(u8[4], u8[5]); w.w = cvtpk(u8[6], u8[7]);
            *(u32x4*)(U2 + (size_t)m * DM + col) = w; }
        }
    }
    __syncthreads();
    {
        const int tl = lane & 15, kg = lane >> 4, tg = wave & 3, kh = wave >> 2;
        const bf16_t* up = U2 + (size_t)(tokb + tg * 16 + tl) * DM + kh * 1024 + 8 * kg;
        const bf16_t* wp = WR + (size_t)tl * DM + kh * 1024 + 8 * kg;
        f32x4 a0 = {0.f, 0.f, 0.f, 0.f}, a1 = a0, a2 = a0;
#pragma unroll 8
        for (int s = 0; s < 32; ++s) {
            const bf16x8 bu = *(const bf16x8*)(up + 32 * s);
            const bf16x8 w0 = *(const bf16x8*)(wp + 32 * s), w1 = *(const bf16x8*)(wp + 16 * DM + 32 * s), w2 = *(const bf16x8*)(wp + 32 * DM + 32 * s);
            a0 = MFMA16(w0, bu, a0); a1 = MFMA16(w1, bu, a1); a2 = MFMA16(w2, bu, a2);
        }
        LAS float* lg = (LAS float*)(lds + L5_LG) + (kh * 4 + tg) * 768 + tl * 48 + 4 * kg;
#pragma unroll
        for (int r = 0; r < 4; ++r) { lg[r] = a0[r]; lg[16 + r] = a1[r]; lg[32 + r] = a2[r]; }
    }
    __syncthreads();
    if (wave < 4) {
        if (lane < 16) {
            const LAS float* l = (const LAS float*)(lds + L5_LG) + wave * 768 + lane * 48; const LAS float* l2 = l + 4 * 768;
            float gl[4]; int gs = 0; float gm;
#pragma unroll
            for (int i = 0; i < 4; ++i) gl[i] = l[i] + l2[i] + p.b_rg[i];
            gm = gl[0];
#pragma unroll
            for (int i = 1; i < 4; ++i) if (gl[i] > gm) { gm = gl[i]; gs = i; }
            float gsum = 0.f;
#pragma unroll
            for (int i = 0; i < 4; ++i) gsum += expf(gl[i] - gm);
            const float pg = 1.0f / gsum;
            float el[8]; float em = -3.0e38f;
#pragma unroll
            for (int i = 0; i < 8; ++i) { const float v = l[4 + 8 * gs + i] + l2[4 + 8 * gs + i] + p.b_re[8 * gs + i]; el[i] = v; em = fmaxf(em, v); }
            float pe[8]; float esum = 0.f;
#pragma unroll
            for (int i = 0; i < 8; ++i) { pe[i] = expf(el[i] - em); esum += pe[i]; }
            int i0 = 0; float p0 = pe[0];
#pragma unroll
            for (int i = 1; i < 8; ++i) if (pe[i] > p0) { p0 = pe[i]; i0 = i; }
            int i1 = -1; float p1 = -1.f;
#pragma unroll
            for (int i = 0; i < 8; ++i) if (i != i0 && pe[i] > p1) { p1 = pe[i]; i1 = i; }
            const float w0 = pg * p0 / (p0 + p1), w1 = pg * p1 / (p0 + p1);
            const int e0 = 8 * gs + i0, e1 = 8 * gs + i1;
            const unsigned lr0 = __hip_atomic_fetch_add(hist + e0, 1u, __ATOMIC_RELAXED, __HIP_MEMORY_SCOPE_WORKGROUP), lr1 = __hip_atomic_fetch_add(hist + e1, 1u, __ATOMIC_RELAXED, __HIP_MEMORY_SCOPE_WORKGROUP);
            LAS unsigned* tw = tokw + (wave * 16 + lane) * 6;
            tw[0] = (unsigned)e0; tw[1] = (unsigned)e1; tw[2] = lr0; tw[3] = lr1; tw[4] = __float_as_uint(w0); tw[5] = __float_as_uint(w1);
        }
    }
    __syncthreads();
    if (tid < 32) { unsigned* cnt = (unsigned*)(p.ws + WS_CTL) + CW_CNT; const unsigned hcount = hist[tid];
        hist[32 + tid] = hcount ? __hip_atomic_fetch_add(cnt + tid, hcount, __ATOMIC_RELAXED, __HIP_MEMORY_SCOPE_AGENT) : 0u; }
    __syncthreads();
    if (tid < 64) {
        const LAS unsigned* tw = tokw + tid * 6; const int tok = tokb + tid;
        const unsigned e0 = tw[0], e1 = tw[1], q0 = hist[32 + e0] + tw[2], q1 = hist[32 + e1] + tw[3];
        int* RT = (int*)(p.ws + WS_RTOK); RT[e0 * ECAP + q0] = tok; RT[e1 * ECAP + q1] = tok;
        u32x4* rec = (u32x4*)(p.ws + WS_REC) + (size_t)tok * 2;
        rec[0] = (u32x4){e0, e1, q0, q1}; rec[1] = (u32x4){tw[4], tw[5], 0u, 0u};
    }
    __syncthreads();
}
DI void expert_copy_gu(const Params& p, int it, LAS float* scr, int lane) {
    const int e = it >> 10, r = it & 1023, up = r >> 9, q = r & 511, kb = q >> 4, nb = q & 15, n0 = 32 * nb;
    const float* W = (up ? p.w_up : p.w_gate) + (size_t)e * DM * FF;
    transpose_tile(W, FF, 64 * kb, n0, (bf16_t*)(p.ws + WS_WGU), DM, e * 1024 + (n0 >> 7) * 256 + (n0 & 127) + up * 128, 0, 32, scr, lane);
}
DI void expert_copy_dn(const Params& p, int it, LAS float* scr, int lane) {
    const int e = it >> 9, q = it & 511, kb = q >> 6, nb = q & 63;
    transpose_tile(p.w_down + (size_t)e * FF * DM, DM, 64 * kb, 32 * nb, (bf16_t*)(p.ws + WS_WDN), FF, e * DM + 32 * nb, 0, 32, scr, lane);
}

struct MoeOrder {
    const LAS int* pref; const LAS int* cnt; int ntn, G, c;
    DI bool next(int i, pg8::Unit& u) const {
        const int L = i * G + c; const int total = pref[32] * ntn; if (L >= total) return false;
        const int tile = L / ntn, pnl = L - tile * ntn;
        int e = 0;
        for (int q = 1; q < 32; ++q) if (tile >= pref[q]) e = q;
        const int m = tile - pref[e];
        u.pm = tile; u.pn = e * ntn + pnl; u.ga = e * ECAP + m * 256; u.gn = cnt[e] - m * 256; return true;
    }
};
DI void moe_tables(const Params& p, LAS int* pref, LAS int* cntl, int tid) {
    if (tid == 0) { const unsigned* cnt = (const unsigned*)(p.ws + WS_CTL) + CW_CNT; int acc = 0;
        for (int e = 0; e < 32; ++e) { const int c = (int)__hip_atomic_load(cnt + e, __ATOMIC_RELAXED, __HIP_MEMORY_SCOPE_AGENT); pref[e] = acc; cntl[e] = c; acc += (c + 255) >> 8; }
        pref[32] = acc; }
    __syncthreads();
}

DI void phase8(const Params& p, const LAS int* pref, int lane, int gw, int NGW) {
    const float* MOD = (const float*)(p.ws + WS_MOD); const bf16_t* YB = (const bf16_t*)(p.ws + WS_YBUF);
    for (int m = gw; m < T; m += NGW) {
        const int b = m >> 11; const float* gt2 = MOD + b * 12288 + 5 * 2048;
        const u32x4* rec = (const u32x4*)(p.ws + WS_REC) + (size_t)m * 2;
        const u32x4 r0 = rec[0], r1 = rec[1];
        const size_t row0 = (size_t)(pref[r0.x] * 256 + (int)r0.z), row1 = (size_t)(pref[r0.y] * 256 + (int)r0.w);
        const float w0 = __uint_as_float(r1.x), w1 = __uint_as_float(r1.y);
        float y[32]; float s = 0.f;
#pragma unroll
        for (int j = 0; j < 4; ++j) { const int col = 8 * (lane + 64 * j);
            const u32x4 a = *(const u32x4*)(YB + row0 * DM + col), c = *(const u32x4*)(YB + row1 * DM + col);
            y[8 * j + 0] = w0 * bflo(a.x) + w1 * bflo(c.x); y[8 * j + 1] = w0 * bfhi(a.x) + w1 * bfhi(c.x);
            y[8 * j + 2] = w0 * bflo(a.y) + w1 * bflo(c.y); y[8 * j + 3] = w0 * bfhi(a.y) + w1 * bfhi(c.y);
            y[8 * j + 4] = w0 * bflo(a.z) + w1 * bflo(c.z); y[8 * j + 5] = w0 * bfhi(a.z) + w1 * bfhi(c.z);
            y[8 * j + 6] = w0 * bflo(a.w) + w1 * bflo(c.w); y[8 * j + 7] = w0 * bfhi(a.w) + w1 * bfhi(c.w);
#pragma unroll
            for (int e = 0; e < 8; ++e) s += y[8 * j + e] * y[8 * j + e]; }
        const float rs = rsqrt_(wave_sum(s) * (1.0f / DM) + EPS);
#pragma unroll
        for (int j = 0; j < 4; ++j) { const int col = 8 * (lane + 64 * j);
#pragma unroll
            for (int q = 0; q < 2; ++q) { float* op = p.out + (size_t)m * DM + col + 4 * q;
                const f32x4 x1 = *(const f32x4*)op, g = *(const f32x4*)(p.g_ffn_post + col + 4 * q), gt = *(const f32x4*)(gt2 + col + 4 * q);
                f32x4 o;
                o.x = x1.x + gt.x * (y[8 * j + 4 * q + 0] * rs * g.x); o.y = x1.y + gt.y * (y[8 * j + 4 * q + 1] * rs * g.y);
                o.z = x1.z + gt.z * (y[8 * j + 4 * q + 2] * rs * g.z); o.w = x1.w + gt.w * (y[8 * j + 4 * q + 3] * rs * g.w);
                *(f32x4*)op = o; } }
    }
}

#define XB_TMO      128
#define XB_XCNT(j)  (256  + 64 * (j))
#define XB_XSUB(j)  (1280 + 64 * (j))
#define XB_XGEN(j)  (2304 + 64 * (j))
#define XB_TOP      3328
#define XB_TOPGEN   3392
#define XCD_BAR_WORDS 3456
#define XB_SPIN_CAP (1u << 18)
DI unsigned xb_ld(unsigned* p)              { return __hip_atomic_load(p, __ATOMIC_RELAXED, __HIP_MEMORY_SCOPE_AGENT); }
DI unsigned xb_add(unsigned* p, unsigned v) { return __hip_atomic_fetch_add(p, v, __ATOMIC_RELAXED, __HIP_MEMORY_SCOPE_AGENT); }
DI unsigned xb_xcc_id() { return (unsigned)__builtin_amdgcn_s_getreg((3 << 11) | 20) & 0xFu; }
#define XB_SPIN(cond, bar) do { unsigned _sp = 0; while (cond) { __builtin_amdgcn_s_sleep(1); \
    if ((++_sp & 255u) == 0u) { if (xb_ld(&(bar)[XB_TMO])) break; if (_sp > XB_SPIN_CAP) { atomicAdd(&(bar)[XB_TMO], 1u); break; } } } } while (0)
struct XcdBarrier { unsigned* bar; unsigned x; volatile LAS unsigned* st; };
DI XcdBarrier xcd_barrier_post(unsigned* bar, volatile LAS unsigned* st) {
    XcdBarrier b; b.bar = bar; b.x = xb_xcc_id(); b.st = st;
    if (threadIdx.x == 0) (void)xb_add(&bar[XB_XCNT(b.x)], 1u);
    return b;
}
DI void xcd_barrier_complete(unsigned* bar, unsigned x, unsigned& nloc, unsigned& nx) {
    const unsigned G = gridDim.x * gridDim.y * gridDim.z;
    unsigned sum, cnt, mine, sp = 0u;
    for (;;) {
        sum = 0u; cnt = 0u; mine = 0u;
#pragma unroll
        for (unsigned j = 0; j < 16; ++j) { const unsigned c = xb_ld(&bar[XB_XCNT(j)]); sum += c; cnt += (c > 0u) ? 1u : 0u; mine = (j == x) ? c : mine; }
        if (sum == G) break;
        __builtin_amdgcn_s_sleep(1);
        if ((++sp & 255u) == 0u) { if (xb_ld(&bar[XB_TMO])) break; if (sp > XB_SPIN_CAP) { atomicAdd(&bar[XB_TMO], 1u); break; } }
    }
    nloc = mine > 0u ? mine : 1u; nx = cnt > 0u ? cnt : 1u;
}
DI void xcd_barrier(const XcdBarrier& b) {
    asm volatile("s_waitcnt vmcnt(0)" ::: "memory");
    __syncthreads();
    if (threadIdx.x == 0) {
        unsigned* bar = b.bar;
        __builtin_amdgcn_s_waitcnt(0);
        unsigned nloc = b.st[0], nx = b.st[1];
        if (nloc == 0u) { xcd_barrier_complete(bar, b.x, nloc, nx); b.st[0] = nloc; b.st[1] = nx; }
        const unsigned old = xb_add(&bar[XB_XSUB(b.x)], 1u);
        const unsigned gen = old / nloc;
        if (old + 1u == (gen + 1u) * nloc) {
            __builtin_amdgcn_fence(__ATOMIC_RELEASE, "agent");
            asm volatile("s_waitcnt vmcnt(0)" ::: "memory");
            const unsigned og = xb_add(&bar[XB_TOP], 1u);
            const unsigned tg = og / nx;
            if (og + 1u == (tg + 1u) * nx) xb_add(&bar[XB_TOPGEN], 1u);
            else XB_SPIN(xb_ld(&bar[XB_TOPGEN]) == tg, bar);
            __builtin_amdgcn_fence(__ATOMIC_ACQUIRE, "agent");
            xb_add(&bar[XB_XGEN(b.x)], 1u);
            asm volatile("s_waitcnt vmcnt(0)" ::: "memory");
        } else {
            XB_SPIN(xb_ld(&bar[XB_XGEN(b.x)]) == gen, bar);
            __builtin_amdgcn_fence(__ATOMIC_ACQUIRE, "agent");
            asm volatile("s_waitcnt vmcnt(0)" ::: "memory");
        }
    }
    __syncthreads();
}

constexpr int NWAVES = 8, NTHREADS = 512;
constexpr int LDS_GEMM = 131072, LDS_TAB = 152576, LDS_BYTES = LDS_TAB + 1024;
constexpr int N_PHASES = 12;
#ifndef DBL
#define DBL -1
#endif
#define REP(k) for (int rep_ = 0; rep_ < ((DBL == (k)) ? 2 : 1); ++rep_)
#ifndef MK_N_LAUNCHES
#define MK_N_LAUNCHES 1
#endif

DI moba::BlockRef attn_ref(const Params& p, int bh, int qb) {
    const int b = bh >> 3, h = bh & 7;
    const bf16_t* PROJ = (const bf16_t*)(p.ws + WS_B);
    moba::BlockRef r;
    r.Q = PROJ + (size_t)(b * SEQ + qb * 256) * PP + C_Q + h * HD;
    r.K = PROJ + (size_t)(b * SEQ) * PP + C_K + h * HD;
    r.V = PROJ + (size_t)(b * SEQ) * PP + C_V + h * HD;
    r.O = (bf16_t*)(p.ws + WS_A) + (size_t)(b * SEQ + qb * 256) * DM + h * HD;
    r.KM = (const bf16_t*)(p.ws + WS_KMEAN) + (size_t)bh * 8 * HD;
    r.P0 = qb * 256;
    return r;
}

typedef const __attribute__((address_space(4))) Params* KParams;
#if defined(__HIP_DEVICE_COMPILE__)
#define LOADP() KParams kq_ = kp_; asm volatile("" : "+s"(kq_)); const Params p = *kq_
#else
#define LOADP() const Params p = p_unused
#endif
__global__ void __launch_bounds__(NTHREADS, 2) fwd_kernel(Params p_unused) {
#if defined(__HIP_DEVICE_COMPILE__)
    const KParams kp_ = (KParams)__builtin_amdgcn_kernarg_segment_ptr();
#else
    const Params* kp_ = &p_unused;
#endif
    extern __shared__ __attribute__((aligned(16))) unsigned char lds_raw[];
    LAS unsigned char* lds = (LAS unsigned char*)lds_raw;
    const int bid = blockIdx.x, G = gridDim.x, NGW = G * NWAVES;
#define IDS() int tid_ = threadIdx.x; asm volatile("" : "+v"(tid_)); const int tid = tid_, lane = tid & 63, wave = __builtin_amdgcn_readfirstlane(tid >> 6), gw = bid * NWAVES + wave; (void)lane; (void)gw; (void)wave
    const int vcu = (G % 8 == 0) ? (bid % 8) * (G / 8) + bid / 8 : bid;
    const int lo = kp_->ph_lo, hi = kp_->ph_hi;
#ifdef ONLY
#define IN(k) ((k) == ONLY && lo <= (k) && (k) < hi)
#else
#define IN(k) (lo <= (k) && (k) < hi)
#endif
    { volatile LAS unsigned* st0 = (volatile LAS unsigned*)(lds + LDS_TAB + 512); if (threadIdx.x < 2) st0[threadIdx.x] = 0u; __syncthreads(); }
    XcdBarrier xbar; xbar.bar = (unsigned*)(kp_->ws + WS_CTL) + CW_BAR; xbar.x = 0; xbar.st = (volatile LAS unsigned*)(lds + LDS_TAB + 512);
#define SEAM(k) do { if (IN(k) && IN((k) + 1)) { if ((k) == 0) { cg::this_grid().sync(); xbar = xcd_barrier_post((unsigned*)(kp_->ws + WS_CTL) + CW_BAR, (volatile LAS unsigned*)(lds + LDS_TAB + 512)); } else xcd_barrier(xbar); } } while (0)

    if (IN(0)) { LOADP(); IDS();
        if (bid == 0) { unsigned* ctl = (unsigned*)(p.ws + WS_CTL); for (int i = tid; i < 8192; i += NTHREADS) ctl[i] = 0u; }
        REP(0) phase0(p, lds, tid, lane, wave, bid, G); }
    SEAM(0);
    if (IN(1)) { LOADP(); IDS(); REP(1) for (int it = bid; it < T / 64; it += G) phase_u1_item(p, it, tid, lane, wave); }
    SEAM(1);
    if (IN(2)) { LOADP(); IDS();
        pg8::Gemm g{(const bf16_t*)(p.ws + WS_A), (const bf16_t*)(p.ws + WS_WIN), DM, nullptr};
        pg8::StaticOrder S; S.init(T, NPROJ, G, bid);
        pg8::EpiStore E{(bf16_t*)(p.ws + WS_B), PP, 64};
        pg8::gemm_phase<pg8::EpiStore, pg8::StaticOrder, true, false>(lds, g, S, E);
#if DBL == 2
        pg8::gemm_phase<pg8::EpiStore, pg8::StaticOrder, true, false>(lds, g, S, E);
#endif
    }
    SEAM(2);
    if (IN(3)) { LOADP(); IDS();
        for (int it = gw; it < 1024; it += NGW) rotary_item(p, it, lane);
        REP(30) { dn::Raw R; if (bid < 64 * 32) dn::prep_load(p, bid, R, lane, wave);
            for (int it = bid; it < 64 * 32; it += G) dn::prep_chunk(p, lds, it, (it + G < 64 * 32) ? it + G : -1, R, tid, lane, wave); }
    }
    SEAM(3);
    if (IN(4)) { LOADP(); IDS();
        const int x = bid & 7, ci = bid >> 3, grp = ci >> 3, bhA = 8 * x + 7 - (ci & 7);
        REP(41) { if (grp == 0) dn::recur(p, lds, 8 * x + ci, tid, lane, wave); }
#ifndef NO_ATTN
        REP(40) {
            const int nblk = grp == 0 ? 1 : (grp == 2 ? 3 : 2);
#define QSEL(i) (grp == 0 ? 4 : grp == 1 ? ((i) == 0 ? 7 : 1) : grp == 2 ? ((i) == 0 ? 6 : ((i) == 1 ? 2 : 0)) : ((i) == 0 ? 5 : 3))
            moba::Seam S;
            moba::BlockRef cur = attn_ref(p, bhA, QSEL(0));
            moba::prime(cur, (char*)lds_raw, S);
            for (int i = 0; i < nblk; ++i) {
                const int in = (i + 1 < nblk) ? i + 1 : i;
                const moba::BlockRef nxt = attn_ref(p, bhA, QSEL(in));
                moba::block(cur, nxt, (char*)lds_raw, S);
                cur = nxt;
            }
#undef QSEL
        }
#endif
    }
    SEAM(4);
    if (IN(6)) { LOADP(); IDS();
        pg8::Gemm g{(const bf16_t*)(p.ws + WS_A), (const bf16_t*)(p.ws + WS_WMD), DM, nullptr};
        pg8::StaticOrder S; S.init(T, DM, G, bid);
        pg8::EpiMerged E{(const bf16_t*)(p.ws + WS_B), (bf16_t*)(p.ws + WS_MERGED)};
        pg8::gemm_phase<pg8::EpiMerged, pg8::StaticOrder, true, false>(lds, g, S, E);
#if DBL == 6
        pg8::gemm_phase<pg8::EpiMerged, pg8::StaticOrder, true, false>(lds, g, S, E);
#endif
    }
    SEAM(6);
    if (IN(7)) { LOADP(); IDS();
        const bool copy_first = ((bid >> 3) & 1) == 0;
        LAS float* scr = (LAS float*)(lds + wave * 8448);
        if (copy_first) { REP(81) for (int it = gw; it < 32 * 1024; it += NGW) expert_copy_gu(p, it, scr, lane); __syncthreads(); }
        {
        pg8::Gemm g{(const bf16_t*)(p.ws + WS_MERGED), (const bf16_t*)(p.ws + WS_WOUT), DM, nullptr};
        pg8::StaticOrder S; S.init(T, DM, G, bid);
        pg8::EpiStore E{(bf16_t*)(p.ws + WS_OUTMIX), DM, 8};
        pg8::gemm_phase<pg8::EpiStore, pg8::StaticOrder, true, false>(lds, g, S, E);
#if DBL == 7
        pg8::gemm_phase<pg8::EpiStore, pg8::StaticOrder, true, false>(lds, g, S, E);
#endif
        }
        if (!copy_first) { REP(81) for (int it = gw; it < 32 * 1024; it += NGW) expert_copy_gu(p, it, scr, lane); }
    }
    SEAM(7);
    if (IN(8)) { LOADP(); IDS();
        for (int it = bid; it < T / 64; it += G) phase5_item(p, lds, it, tid, lane, wave);
    }
    SEAM(8);
    LAS int* pref = (LAS int*)(lds + LDS_TAB); LAS int* cntl = pref + 64;
    if (IN(9)) { LOADP(); IDS();
        moe_tables(p, pref, cntl, tid);
        pg8::Gemm g{(const bf16_t*)(p.ws + WS_A), (const bf16_t*)(p.ws + WS_WGU), DM, (const int*)(p.ws + WS_RTOK)};
        MoeOrder S{pref, cntl, 4, G, bid};
        pg8::EpiGU E{(bf16_t*)(p.ws + WS_H)};
        pg8::gemm_phase<pg8::EpiGU, MoeOrder, true, true>(lds, g, S, E);
#if DBL == 9
        pg8::gemm_phase<pg8::EpiGU, MoeOrder, true, true>(lds, g, S, E);
#endif
        {   const int total = pref[32] * 4, rem = total % G, ncw = rem ? G - rem : G, cw = rem ? bid - rem : bid;
            if (cw >= 0) { LAS float* scr = (LAS float*)(lds + wave * 8448);
                for (int it = cw * NWAVES + wave; it < 32 * 512; it += ncw * NWAVES) expert_copy_dn(p, it, scr, lane); }
        }
    }
    SEAM(9);
    if (IN(10)) { LOADP(); IDS();
        if (!IN(9)) moe_tables(p, pref, cntl, tid);
        pg8::Gemm g{(const bf16_t*)(p.ws + WS_H), (const bf16_t*)(p.ws + WS_WDN), FF, nullptr};
        MoeOrder S{pref, cntl, 8, G, bid};
        pg8::EpiStore E{(bf16_t*)(p.ws + WS_YBUF), DM, 8};
        pg8::gemm_phase<pg8::EpiStore, MoeOrder, true, false>(lds, g, S, E);
#if DBL == 10
        pg8::gemm_phase<pg8::EpiStore, MoeOrder, true, false>(lds, g, S, E);
#endif
    }
    SEAM(10);
    if (IN(11)) { LOADP(); IDS();
        if (!IN(10)) moe_tables(p, pref, cntl, tid);
        phase8(p, pref, lane, gw, NGW);
    }
#undef IN
#undef SEAM
}

extern "C" void kernel_launch(void* const* d_in, const int* in_sizes, int n_in, void* d_out, int out_size, void* d_ws, size_t ws_size, hipStream_t stream) {
    static int grid = 0;
    if (grid == 0) {
        if (n_in != 24 || in_sizes[0] != T * DM || out_size != T * DM || ws_size < WS_END) {
            fprintf(stderr, "kernel_launch: unexpected shapes (n_in %d, in0 %d, out %d, ws %zu); nothing launched\n", n_in, n_in > 0 ? in_sizes[0] : -1, out_size, ws_size); grid = -1; return; }
        int dev = 0, cus = 0, per_cu = 0;
        hipGetDevice(&dev); hipDeviceGetAttribute(&cus, hipDeviceAttributeMultiprocessorCount, dev);
        if (hipFuncSetAttribute((const void*)fwd_kernel, hipFuncAttributeMaxDynamicSharedMemorySize, LDS_BYTES) != hipSuccess) { fprintf(stderr, "kernel_launch: hipFuncSetAttribute failed\n"); grid = -1; return; }
        if (hipOccupancyMaxActiveBlocksPerMultiprocessor(&per_cu, (const void*)fwd_kernel, NTHREADS, LDS_BYTES) != hipSuccess || per_cu < 1) { fprintf(stderr, "kernel_launch: occupancy query says %d blocks per CU\n", per_cu); grid = -1; return; }
        (void)hipGetLastError();
        grid = cus;
        if (cus != 256) { fprintf(stderr, "kernel_launch: built for a 256-CU device (static phase schedules), found %d CUs; nothing launched\n", cus); grid = -1; return; }
    }
    if (grid < 0) return;
    Params p{};
    p.x = (const float*)d_in[0]; p.c = (const float*)d_in[1]; p.pos = (const int*)d_in[2]; p.w_ada = (const float*)d_in[3]; p.b_ada = (const float*)d_in[4];
    p.g_mix_pre = (const float*)d_in[5]; p.g_mix_post = (const float*)d_in[6]; p.g_ffn_pre = (const float*)d_in[7]; p.g_ffn_post = (const float*)d_in[8];
    p.w_in = (const float*)d_in[9]; p.conv_w = (const float*)d_in[10]; p.a_log = (const float*)d_in[11]; p.dt_bias = (const float*)d_in[12]; p.dn_gain = (const float*)d_in[13];
    p.w_bm = (const float*)d_in[14]; p.w_bd = (const float*)d_in[15]; p.w_out = (const float*)d_in[16];
    p.w_rg = (const float*)d_in[17]; p.b_rg = (const float*)d_in[18]; p.w_re = (const float*)d_in[19]; p.b_re = (const float*)d_in[20];
    p.w_gate = (const float*)d_in[21]; p.w_up = (const float*)d_in[22]; p.w_down = (const float*)d_in[23];
    p.out = (float*)d_out; p.ws = (unsigned char*)d_ws;
    for (int li = 0; li < MK_N_LAUNCHES; ++li) {
        p.ph_lo = (MK_N_LAUNCHES == 1) ? 0 : li; p.ph_hi = (MK_N_LAUNCHES == 1) ? N_PHASES : li + 1;
        void* args[] = {&p};
        hipError_t e = hipLaunchCooperativeKernel((const void*)fwd_kernel, dim3(grid), dim3(NTHREADS), args, LDS_BYTES, stream);
        if (e != hipSuccess) { fprintf(stderr, "kernel_launch: cooperative launch failed: %s (grid %d)\n", hipGetErrorString(e), grid); break; }
    }
}
```

```cpp
#include <hip/hip_runtime.h>
#include <hip/hip_cooperative_groups.h>
#include <cstdio>
#include <cstdint>
namespace cg = cooperative_groups;

#define LAS __attribute__((address_space(3)))
#define DI __device__ __forceinline__
typedef unsigned short bf16_t;
typedef short bf16x8 __attribute__((ext_vector_type(8)));
typedef short s16x4 __attribute__((ext_vector_type(4)));
typedef float f32x2 __attribute__((ext_vector_type(2)));
typedef float f32x4 __attribute__((ext_vector_type(4)));
typedef float f32x16 __attribute__((ext_vector_type(16)));
typedef unsigned u32x2 __attribute__((ext_vector_type(2)));
typedef unsigned u32x4 __attribute__((ext_vector_type(4)));
typedef __bf16 bf16x2_t __attribute__((ext_vector_type(2)));

constexpr int NB = 8, SEQ = 2048, T = NB * SEQ, DM = 2048;
constexpr int NHEAD = 8, HD = 128;
constexpr int PP = 11264;
constexpr int NPROJ = 11264;
constexpr int C_Q = 0, C_K = 1024, C_V = 2048, C_DN = 3072, C_Z = 6144, C_GA = 7168, C_GB = 9216;
constexpr int NEXP = 32, FF = 512, ECAP = 16384;
constexpr float EPS = 1e-6f;

constexpr size_t MiB = 1u << 20;
constexpr size_t WS_CTL = 0, CTL_ZERO_BYTES = 1 * MiB;
constexpr size_t WS_MOD = 1 * MiB;
constexpr size_t WS_CS = 2 * MiB;
constexpr size_t WS_KMEAN = 4 * MiB;
constexpr size_t WS_WR = 4 * MiB + 512 * 1024;
constexpr size_t WS_WBA = 4 * MiB + 768 * 1024;
constexpr size_t WS_BA = 5 * MiB;
constexpr size_t WS_REC = 6 * MiB;
constexpr size_t WS_RTOK = 7 * MiB;
constexpr size_t WS_WMD = 10 * MiB;
constexpr size_t WS_WOUT = 18 * MiB;
constexpr size_t WS_A = 26 * MiB;
constexpr size_t WS_B = 90 * MiB;
constexpr size_t WS_C = 442 * MiB;
constexpr size_t WS_D = 588 * MiB;
constexpr size_t WS_END = 652 * MiB;
constexpr size_t WS_OUTMIX = WS_B, WS_WGU = WS_B + 128 * MiB, WS_WDN = WS_B + 256 * MiB, WS_YBUF = WS_B;
constexpr size_t WS_WIN = WS_C, WS_DNP = WS_C, WS_MERGED = WS_C, WS_H = WS_C + 64 * MiB;
constexpr int CW_CNT = 64;
constexpr int CW_BAR = 4096;
constexpr int DN_U = 0, DN_W = 16384, DN_QD = 32768, DN_KT = 49152, DN_QK = 65536, DN_SC = 73728, DN_STRIDE = 73984;

struct Params {
    const float* x; const float* c; const int* pos; const float* w_ada; const float* b_ada;
    const float* g_mix_pre; const float* g_mix_post; const float* g_ffn_pre; const float* g_ffn_post;
    const float* w_in; const float* conv_w; const float* a_log; const float* dt_bias; const float* dn_gain;
    const float* w_bm; const float* w_bd; const float* w_out;
    const float* w_rg; const float* b_rg; const float* w_re; const float* b_re;
    const float* w_gate; const float* w_up; const float* w_down;
    float* out; unsigned char* ws;
    int ph_lo, ph_hi;
};

DI unsigned cvtpk(float lo, float hi) { f32x2 v = {lo, hi}; bf16x2_t b = __builtin_convertvector(v, bf16x2_t); return __builtin_bit_cast(unsigned, b); }
DI float bflo(unsigned w) { return __uint_as_float(w << 16); }
DI float bfhi(unsigned w) { return __uint_as_float(w & 0xffff0000u); }
DI float bf2f(bf16_t b) { return __uint_as_float((unsigned)b << 16); }
DI bf16_t f2bf(float f) { return (bf16_t)(cvtpk(f, 0.f) & 0xffffu); }
DI float wave_sum(float v) {
#pragma unroll
    for (int o = 1; o < 64; o <<= 1) v += __shfl_xor(v, o);
    return v;
}
DI float sigmoidf_(float x) { return __builtin_amdgcn_rcpf(1.f + __expf(-x)); }
DI float siluf_(float x) { return x * __builtin_amdgcn_rcpf(1.f + __expf(-x)); }
DI float rsqrt_(float x) { return __builtin_amdgcn_rsqf(x); }
DI float siluf_acc(float x) { return x / (1.f + expf(-x)); }
constexpr float SCALE_Q = 0.08838834764831845f;
DI int perm16(int p) { return (p & 3) | ((p & 4) << 1) | ((p & 8) >> 1); }
DI int crow(int r, int hi) { return (r & 3) + 8 * (r >> 2) + 4 * hi; }
#define MFMA32(a, b, c) __builtin_amdgcn_mfma_f32_32x32x16_bf16((a), (b), (c), 0, 0, 0)
#define MFMA16(a, b, c) __builtin_amdgcn_mfma_f32_16x16x32_bf16((a), (b), (c), 0, 0, 0)

namespace pg8 {
constexpr int BM = 256, BK = 64, HALF = 128, HTB = HALF * BK * 2, STAGE_BYTES = 8 * HTB, NXCD = 8, WGM = 8;
DI int lds_byte(int r, int c) { const int st = (r >> 4) * 2 + (c >> 5), rr = r & 15, cc = c & 31, ob = rr * 64 + cc * 2; return st * 1024 + (ob ^ (((ob >> 9) & 1) << 5)); }
DI void stage_rc(int b, int& R, int& C) { const int st = b / 1024, sb = b % 1024, swz = sb ^ (((sb >> 9) & 1) << 5); R = (st >> 1) * 16 + swz / 64; C = (st & 1) * 32 + (swz % 64) / 2; }
DI int perm32(int rho) { const int n = rho >> 4, i = rho & 15; return 8 * (i >> 2) + 4 * n + (i & 3); }

struct Unit { int pm, pn, ga, gn; };
struct Gemm { const bf16_t* A; const bf16_t* Bt; int K; const int* gidx; };

struct StaticOrder {
    int nM, nN, nwg, G, c;
    DI void init(int M, int N, int G_, int c_) { nM = M / BM; nN = N / BM; nwg = nM * nN; G = G_; c = c_; }
    DI bool next(int i, Unit& u) const {
        const long L = (long)i * G + c; if (L >= nwg) return false;
        int wgid = (int)L; { const int q = nwg / NXCD, r = nwg % NXCD, xcd = wgid % NXCD, off = wgid / NXCD; wgid = (xcd < r ? xcd * (q + 1) : r * (q + 1) + (xcd - r) * q) + off; }
        const int nig = WGM * nN, gid = wgid / nig, fm = gid * WGM, gsz = (nM - fm) < WGM ? (nM - fm) : WGM;
        u.pm = fm + ((wgid % nig) % gsz); u.pn = (wgid % nig) / gsz; u.ga = 0; u.gn = 0; return true;
    }
};

typedef f32x4 Acc[2][2][4][2];

template <class Epi, class Sched, bool ALIGN_EPI, bool GATHER>
DI void gemm_phase(LAS unsigned char* lds, const Gemm g, const Sched& S, const Epi& E) {
    const int tid = threadIdx.x, wid = __builtin_amdgcn_readfirstlane(tid >> 6), lane = tid & 63, wr = wid >> 2, wc = wid & 3, fr = lane & 15, fq = lane >> 4;
    const int K = g.K, nt = K / BK;
    unsigned voffA[2], voffB[2]; int gR[2], gC[2];
#pragma unroll
    for (int i = 0; i < 2; ++i) { int R, C; stage_rc(tid * 16 + i * 8192, R, C); const int Rb = (R & ~31) + perm32(R & 31);
        voffA[i] = (unsigned)(R * K + C) * 2u; voffB[i] = (unsigned)(Rb * K + C) * 2u; gR[i] = R; gC[i] = C; }
    const size_t kstep = (size_t)(BK * 2);
    const size_t hstep = (size_t)HALF * K * 2;
    const size_t tstep = 2 * hstep;
    const unsigned ldsw = (unsigned)wid * 1024u;
    const int aoff = lds_byte(wr * 64 + fr, fq * 8), boff = lds_byte(wc * 32 + fr, fq * 8);
#define PG8_SA(b, h) (((b) * 2 + (h)) * HTB)
#define PG8_SB(b, h) ((4 + (b) * 2 + (h)) * HTB)
#define PG8_STAGE(bufoff, gbase, voff) do { _Pragma("unroll") for (int _i = 0; _i < 2; ++_i) \
        __builtin_amdgcn_global_load_lds((const unsigned*)((const char*)(gbase) + (voff)[_i]), (LAS unsigned*)(lds + (bufoff) + ldsw + _i * 8192), 16, 0, 0); } while (0)
#define PG8_LDA(dst, b, h) do { _Pragma("unroll") for (int m = 0; m < 4; ++m) _Pragma("unroll") for (int k = 0; k < 2; ++k) dst[m][k] = *(const LAS bf16x8*)(lds + PG8_SA(b, h) + aoff + m * 2048 + k * 1024); } while (0)
#define PG8_LDB(dst, b, h) do { _Pragma("unroll") for (int n = 0; n < 2; ++n) _Pragma("unroll") for (int k = 0; k < 2; ++k) dst[n][k] = *(const LAS bf16x8*)(lds + PG8_SB(b, h) + boff + n * 2048 + k * 1024); } while (0)
#define PG8_MMA(ai, bj, At, Bt) do { __builtin_amdgcn_s_setprio(1); _Pragma("unroll") for (int m = 0; m < 4; ++m) _Pragma("unroll") for (int n = 0; n < 2; ++n) _Pragma("unroll") for (int k = 0; k < 2; ++k) \
        acc[ai][bj][m][n] = __builtin_amdgcn_mfma_f32_16x16x32_bf16(Bt[n][k], At[m][k], acc[ai][bj][m][n], 0, 0, 0); __builtin_amdgcn_s_setprio(0); } while (0)
#define PG8_WAIT_V(n) asm volatile("s_waitcnt vmcnt(" #n ")" ::: "memory")
#define PG8_WAIT_L(n) asm volatile("s_waitcnt lgkmcnt(" #n ")" ::: "memory")
#define PG8_BAR __builtin_amdgcn_s_barrier()
#define PG8_SCHED __builtin_amdgcn_sched_barrier(0)
    Unit cur, nxt; int ui = 0;
    if (!S.next(0, cur)) return;
    Acc acc;
#pragma unroll
    for (int a = 0; a < 2; ++a)
#pragma unroll
        for (int b = 0; b < 2; ++b)
#pragma unroll
            for (int m = 0; m < 4; ++m)
#pragma unroll
                for (int n = 0; n < 2; ++n) acc[a][b][m][n] = (f32x4){0.f, 0.f, 0.f, 0.f};
    bf16x8 At[4][2], B0[2][2], B1[2][2];
    unsigned vA0[2], vA1[2];
#define PG8_SET_VOFF(u) do { if constexpr (GATHER) { _Pragma("unroll") for (int _i = 0; _i < 2; ++_i) { \
                const int _r0 = gR[_i], _r1 = HALF + gR[_i]; \
                const int _t0 = _r0 < (u).gn ? g.gidx[(u).ga + _r0] : 0, _t1 = _r1 < (u).gn ? g.gidx[(u).ga + _r1] : 0; \
                vA0[_i] = (unsigned)(_t0 * K + gC[_i]) * 2u; vA1[_i] = (unsigned)(_t1 * K + gC[_i]) * 2u; } \
        } else { vA0[0] = voffA[0]; vA0[1] = voffA[1]; vA1[0] = voffA[0] + (unsigned)hstep; vA1[1] = voffA[1] + (unsigned)hstep; } } while (0)
    PG8_SET_VOFF(cur);
    const char* cA = GATHER ? (const char*)g.A : (const char*)g.A + (size_t)cur.pm * tstep; const char* cB = (const char*)g.Bt + (size_t)cur.pn * tstep;
    PG8_STAGE(PG8_SB(0, 0), cB, voffB); PG8_STAGE(PG8_SB(0, 1), cB + hstep, voffB); PG8_STAGE(PG8_SA(0, 0), cA, vA0); PG8_STAGE(PG8_SA(0, 1), cA, vA1);
    if (wr == 1) PG8_BAR;
    PG8_WAIT_V(2); PG8_BAR;
    PG8_STAGE(PG8_SB(1, 0), cB + kstep, voffB); PG8_STAGE(PG8_SA(1, 0), cA + kstep, vA0); PG8_STAGE(PG8_SB(1, 1), cB + hstep + kstep, voffB);
    PG8_WAIT_V(6); PG8_BAR;
    for (;;) {
        const bool has_next = S.next(ui + 1, nxt);
        const char* nA = GATHER ? (const char*)g.A : (has_next ? (const char*)g.A + (size_t)nxt.pm * tstep : cA);
        const char* nB = has_next ? (const char*)g.Bt + (size_t)nxt.pn * tstep : cB;
#define PG8_KTRIP(t) do { \
            const bool last = (t == nt - 2); \
            const char* a1 = cA + (size_t)(t + 1) * kstep; \
            const char* a2 = last ? nA : cA + (size_t)(t + 2) * kstep; const char* b2 = last ? nB : cB + (size_t)(t + 2) * kstep; \
            const char* a3 = a2 + kstep; const char* b3 = b2 + kstep; \
            PG8_LDB(B0, 0, 0); PG8_LDB(B1, 0, 1); PG8_SCHED; PG8_LDA(At, 0, 0); PG8_STAGE(PG8_SA(1, 1), a1, vA1); \
            PG8_WAIT_V(8); PG8_WAIT_L(0); PG8_BAR; PG8_MMA(0, 0, At, B0); PG8_MMA(0, 1, At, B1); PG8_BAR; PG8_SCHED; \
            if constexpr (GATHER) { if (last && has_next) PG8_SET_VOFF(nxt); } \
            PG8_LDA(At, 0, 1); PG8_STAGE(PG8_SB(0, 0), b2, voffB); PG8_STAGE(PG8_SB(0, 1), b2 + hstep, voffB); PG8_STAGE(PG8_SA(0, 0), a2, vA0); \
            PG8_WAIT_V(8); PG8_WAIT_L(0); PG8_BAR; PG8_MMA(1, 0, At, B0); PG8_MMA(1, 1, At, B1); PG8_BAR; PG8_SCHED; \
            PG8_LDB(B0, 1, 0); PG8_LDB(B1, 1, 1); PG8_SCHED; PG8_LDA(At, 1, 0); PG8_STAGE(PG8_SA(0, 1), a2, vA1); \
            PG8_WAIT_V(8); PG8_WAIT_L(0); PG8_BAR; PG8_MMA(0, 0, At, B0); PG8_MMA(0, 1, At, B1); PG8_BAR; PG8_SCHED; \
            PG8_LDA(At, 1, 1); PG8_STAGE(PG8_SB(1, 0), b3, voffB); PG8_STAGE(PG8_SB(1, 1), b3 + hstep, voffB); PG8_STAGE(PG8_SA(1, 0), a3, vA0); \
            PG8_WAIT_V(8); PG8_WAIT_L(0); PG8_BAR; PG8_MMA(1, 0, At, B0); PG8_MMA(1, 1, At, B1); PG8_BAR; PG8_SCHED; \
        } while (0)
        if constexpr (Epi::HAS_MID) {
            for (int t = 0; t < (nt >> 1); t += 2) PG8_KTRIP(t);
            E.mid(acc, cur, wr, wc, fr, fq);
            for (int t = (nt >> 1); t < nt; t += 2) PG8_KTRIP(t);
        } else {
            for (int t = 0; t < nt; t += 2) PG8_KTRIP(t);
        }
#undef PG8_KTRIP
        if constexpr (ALIGN_EPI) { if (wr == 0) PG8_BAR; }
        E(acc, cur, wr, wc, fr, fq);
#if defined(DBL) && DBL == 20
        E(acc, cur, wr, wc, fr, fq);
#endif
        if (!has_next) break;
#pragma unroll
        for (int a = 0; a < 2; ++a)
#pragma unroll
            for (int b = 0; b < 2; ++b)
#pragma unroll
                for (int m = 0; m < 4; ++m)
#pragma unroll
                    for (int n = 0; n < 2; ++n) acc[a][b][m][n] = (f32x4){0.f, 0.f, 0.f, 0.f};
        cur = nxt; cA = nA; cB = nB; ++ui;
        if constexpr (ALIGN_EPI) { if (wr == 1) PG8_BAR; }
    }
    PG8_WAIT_V(0);
    if constexpr (!ALIGN_EPI) { if (wr == 0) PG8_BAR; }
    PG8_BAR;
#undef PG8_SET_VOFF
#undef PG8_SA
#undef PG8_SB
#undef PG8_STAGE
#undef PG8_LDA
#undef PG8_LDB
#undef PG8_MMA
#undef PG8_WAIT_V
#undef PG8_WAIT_L
#undef PG8_BAR
#undef PG8_SCHED
}

struct EpiStore {
    static constexpr bool HAS_MID = false;
    bf16_t* O; int ldc; int ntn;
    DI void operator()(const Acc& acc, const Unit& u, int wr, int wc, int fr, int fq) const {
        const int row0 = u.pm * BM + wr * 64 + fr, col0 = (u.pn % ntn) * BM + wc * 32 + 8 * fq;
#pragma unroll
        for (int ai = 0; ai < 2; ++ai)
#pragma unroll
            for (int m = 0; m < 4; ++m) { bf16_t* rowp = O + (size_t)(row0 + ai * HALF + m * 16) * ldc + col0;
#pragma unroll
                for (int bj = 0; bj < 2; ++bj) { const f32x4 v0 = acc[ai][bj][m][0], v1 = acc[ai][bj][m][1];
                    u32x4 w; w.x = cvtpk(v0[0], v0[1]); w.y = cvtpk(v0[2], v0[3]); w.z = cvtpk(v1[0], v1[1]); w.w = cvtpk(v1[2], v1[3]);
                    *(u32x4*)(rowp + bj * HALF) = w; } }
    }
};
struct EpiMerged {
    static constexpr bool HAS_MID = true;
    const bf16_t* P; bf16_t* O;
    DI void mid(Acc& acc, const Unit& u, int wr, int wc, int fr, int fq) const {
        const unsigned ro = (unsigned)((u.pm * BM + wr * 64 + fr) * PP + u.pn * BM + wc * 32 + 8 * fq);
#pragma unroll
        for (int ai = 0; ai < 2; ++ai)
#pragma unroll
            for (int m = 0; m < 4; ++m) {
#pragma unroll
                for (int bj = 0; bj < 2; ++bj) { const unsigned off = ro + (unsigned)((ai * HALF + m * 16) * PP + bj * HALF);
                    const u32x4 a = *(const u32x4*)(P + off + C_GA), b = *(const u32x4*)(P + off + C_GB);
                    float ga[8] = {bflo(a.x), bfhi(a.x), bflo(a.y), bfhi(a.y), bflo(a.z), bfhi(a.z), bflo(a.w), bfhi(a.w)};
                    float gb[8] = {bflo(b.x), bfhi(b.x), bflo(b.y), bfhi(b.y), bflo(b.z), bfhi(b.z), bflo(b.w), bfhi(b.w)};
#pragma unroll
                    for (int n = 0; n < 2; ++n)
#pragma unroll
                        for (int j = 0; j < 4; ++j) { const float r = (1.f + __expf(-gb[4 * n + j])) * __builtin_amdgcn_rcpf(1.f + __expf(-ga[4 * n + j])); acc[ai][bj][m][n][j] *= r; } }
                asm volatile("" ::: "memory"); __builtin_amdgcn_sched_barrier(0); }
    }
    DI void operator()(const Acc& acc, const Unit& u, int wr, int wc, int fr, int fq) const {
        const unsigned ro = (unsigned)((u.pm * BM + wr * 64 + fr) * PP + u.pn * BM + wc * 32 + 8 * fq);
        const unsigned oo = (unsigned)((u.pm * BM + wr * 64 + fr) * DM + u.pn * BM + wc * 32 + 8 * fq);
#pragma unroll
        for (int ai = 0; ai < 2; ++ai)
#pragma unroll
            for (int m = 0; m < 4; ++m) {
#pragma unroll
                for (int bj = 0; bj < 2; ++bj) { const u32x4 b = *(const u32x4*)(P + ro + (unsigned)((ai * HALF + m * 16) * PP + bj * HALF) + C_GB);
                    float gb[8] = {bflo(b.x), bfhi(b.x), bflo(b.y), bfhi(b.y), bflo(b.z), bfhi(b.z), bflo(b.w), bfhi(b.w)};
                    float v[8];
#pragma unroll
                    for (int n = 0; n < 2; ++n)
#pragma unroll
                        for (int j = 0; j < 4; ++j) v[4 * n + j] = acc[ai][bj][m][n][j] * __builtin_amdgcn_rcpf(1.f + __expf(-gb[4 * n + j]));
                    u32x4 w; w.x = cvtpk(v[0], v[1]); w.y = cvtpk(v[2], v[3]); w.z = cvtpk(v[4], v[5]); w.w = cvtpk(v[6], v[7]);
                    *(u32x4*)(O + oo + (unsigned)((ai * HALF + m * 16) * DM + bj * HALF)) = w; }
                asm volatile("" ::: "memory"); __builtin_amdgcn_sched_barrier(0); }
    }
};
struct EpiGU {
    static constexpr bool HAS_MID = false;
    bf16_t* H;
    DI void operator()(const Acc& acc, const Unit& u, int wr, int wc, int fr, int fq) const {
        const int row0 = u.pm * BM + wr * 64 + fr, col0 = (u.pn & 3) * HALF + wc * 32 + 8 * fq;
#pragma unroll
        for (int ai = 0; ai < 2; ++ai)
#pragma unroll
            for (int m = 0; m < 4; ++m) { float v[8];
#pragma unroll
                for (int n = 0; n < 2; ++n)
#pragma unroll
                    for (int j = 0; j < 4; ++j) v[4 * n + j] = siluf_(acc[ai][0][m][n][j]) * acc[ai][1][m][n][j];
                u32x4 w; w.x = cvtpk(v[0], v[1]); w.y = cvtpk(v[2], v[3]); w.z = cvtpk(v[4], v[5]); w.w = cvtpk(v[6], v[7]);
                *(u32x4*)(H + (size_t)(row0 + ai * HALF + m * 16) * FF + col0) = w; }
    }
};
}

namespace moba {
constexpr int NW = 8, QBLK = 32, KVBLK = 64, QB = NW * QBLK, D = 128;
constexpr int RS = PP;
constexpr int RSO = DM;
constexpr float SCALE = 0.08838834764831845f;
constexpr float THR = 8.f;
constexpr int SHM_V = KVBLK * D * 2, SHM_K = KVBLK * D * 2;
constexpr int LDS_BYTES = 2 * SHM_V + 2 * SHM_K + NW * 64 * 4;
typedef bf16_t bf16;
#define KSWZ(row, colB) ((row) * 256 + ((colB) ^ (((row) & 7) << 4)))
#define SBAR() __builtin_amdgcn_sched_barrier(0)
DI int v_st(int k, int c) { const int kk = (k & ~0xC) | ((k & 4) << 1) | ((k & 8) >> 1); return ((kk >> 3) * 4 + (c >> 5)) * 512 + ((kk & 7) * 32 + (c & 31)) * 2; }
DI int v_rd_base(int lane) { return ((lane & 3) << 3) | (((lane >> 2) & 3) << 6) | (((lane >> 4) & 1) << 5) | (((lane >> 5) & 1) << 8); }
constexpr int v_rd_off(int d0, int ks, int half) { return d0 * 512 + ks * 4096 + half * 2048; }
DI bf16x8 load8(const bf16* p) { return *reinterpret_cast<const bf16x8*>(p); }
DI void mask_tile(f32x16& p0, f32x16& p1, int dq) {
    const float NEG = -__builtin_inff();
#pragma unroll
    for (int r = 0; r < 16; ++r) {
        const int c = (r & 3) + 8 * (r >> 2);
        if (dq - c < 0) p0[r] = NEG;
        if (dq - c - 32 < 0) p1[r] = NEG;
    }
}
DI void mask_all(f32x16& p0, f32x16& p1, bool kill) {
    const float NEG = -__builtin_inff();
#pragma unroll
    for (int r = 0; r < 16; ++r) { if (kill) p0[r] = NEG; if (kill) p1[r] = NEG; }
}
DI void partialSM(f32x16& p0, f32x16& p1, float& m_reg, float& mn, float& alpha) {
    float pmax = p0[0];
#pragma unroll
    for (int r = 1; r < 16; ++r) pmax = fmaxf(pmax, p0[r]);
#pragma unroll
    for (int r = 0; r < 16; ++r) pmax = fmaxf(pmax, p1[r]);
    { auto rr = __builtin_amdgcn_permlane32_swap(__float_as_uint(pmax), __float_as_uint(pmax), false, false);
      pmax = fmaxf(__uint_as_float(rr[0]), __uint_as_float(rr[1])); }
    constexpr float C2 = 1.4426950408889634f * SCALE;
    if (__builtin_expect(__all((pmax - m_reg) * SCALE <= THR), 1)) { mn = m_reg; alpha = 1.f; }
    else { mn = fmaxf(m_reg, pmax); alpha = __builtin_amdgcn_exp2f((m_reg - mn) * C2); m_reg = mn; }
    const float mnL = -mn * C2;
#pragma unroll
    for (int r = 0; r < 16; ++r) p0[r] = fmaf(p0[r], C2, mnL);
#pragma unroll
    for (int r = 0; r < 16; ++r) p1[r] = fmaf(p1[r], C2, mnL);
#pragma unroll
    for (int r = 0; r < 16; ++r) p0[r] = __builtin_amdgcn_exp2f(p0[r]);
}
DI void finishSM(f32x16& p0, f32x16& p1, float alpha, float& l_reg, bf16x8& pa0, bf16x8& pa1, bf16x8& pa2, bf16x8& pa3) {
#pragma unroll
    for (int r = 0; r < 16; ++r) p1[r] = __builtin_amdgcn_exp2f(p1[r]);
    float ps = 0;
#pragma unroll
    for (int r = 0; r < 16; ++r) ps += p0[r];
#pragma unroll
    for (int r = 0; r < 16; ++r) ps += p1[r];
    { auto rr = __builtin_amdgcn_permlane32_swap(__float_as_uint(ps), __float_as_uint(ps), false, false);
      ps = __uint_as_float(rr[0]) + __uint_as_float(rr[1]); }
    l_reg = l_reg * alpha + ps;
#define PK4(P, B_, OUT) do { unsigned a0 = cvtpk(P[B_+0], P[B_+1]), a1 = cvtpk(P[B_+2], P[B_+3]);                          \
        unsigned b0 = cvtpk(P[B_+4], P[B_+5]), b1 = cvtpk(P[B_+6], P[B_+7]);                                             \
        auto r0 = __builtin_amdgcn_permlane32_swap(a0, b0, false, false); auto r1 = __builtin_amdgcn_permlane32_swap(a1, b1, false, false); \
        u32x4 w = {r0[0], r1[0], r0[1], r1[1]}; OUT = __builtin_bit_cast(bf16x8, w); } while (0)
    PK4(p0, 0, pa0); PK4(p0, 8, pa1); PK4(p1, 0, pa2); PK4(p1, 8, pa3);
#undef PK4
}
template <int KB>
DI void qkt(f32x16& p0, f32x16& p1, const char* K_lds, int r32, int hi, const bf16x8* qr) {
    p0 = f32x16{}; p1 = f32x16{};
    const char* kb[4];
#pragma unroll
    for (int dd = 0; dd < 4; ++dd) kb[dd] = K_lds + KB * SHM_K + KSWZ(r32, (dd * 16 + hi * 8) * 2);
#pragma unroll
    for (int d0 = 0; d0 < 8; ++d0) { const char* a = kb[d0 & 3] + (d0 >> 2) * 128;
        bf16x8 b0 = *reinterpret_cast<const bf16x8*>(a);
        bf16x8 b1 = *reinterpret_cast<const bf16x8*>(a + 32 * 256);
        p0 = MFMA32(b0, qr[d0], p0);
        p1 = MFMA32(b1, qr[d0], p1); }
}
template <int VB>
DI void pv_tile(f32x16* o, int vb0, bf16x8 pa0, bf16x8 pa1, bf16x8 pa2, bf16x8 pa3) {
#define TRRD(dst, off) asm volatile("ds_read_b64_tr_b16 %0, %1 offset:%2" : "=&v"(dst) : "v"(vb0), "i"(off) : "memory")
#define PV_D0(d0) do { s16x4 l0, l1, l2, l3, h0, h1, h2, h3; constexpr int b_ = VB * SHM_V + v_rd_off(d0, 0, 0); \
        TRRD(l0, b_); TRRD(h0, b_ + 2048); TRRD(l1, b_ + 4096); TRRD(h1, b_ + 6144); TRRD(l2, b_ + 8192); TRRD(h2, b_ + 10240); TRRD(l3, b_ + 12288); TRRD(h3, b_ + 14336); \
        asm volatile("s_waitcnt lgkmcnt(0)" ::: "memory"); SBAR();   \
        o[d0] = MFMA32(pa0, ((bf16x8){l0[0], l0[1], l0[2], l0[3], h0[0], h0[1], h0[2], h0[3]}), o[d0]);   \
        o[d0] = MFMA32(pa1, ((bf16x8){l1[0], l1[1], l1[2], l1[3], h1[0], h1[1], h1[2], h1[3]}), o[d0]);   \
        o[d0] = MFMA32(pa2, ((bf16x8){l2[0], l2[1], l2[2], l2[3], h2[0], h2[1], h2[2], h2[3]}), o[d0]);   \
        o[d0] = MFMA32(pa3, ((bf16x8){l3[0], l3[1], l3[2], l3[3], h3[0], h3[1], h3[2], h3[3]}), o[d0]); } while (0)
    PV_D0(0); PV_D0(1); PV_D0(2); PV_D0(3);
#undef PV_D0
#undef TRRD
}

struct BlockRef { const bf16* Q; const bf16* K; const bf16* V; bf16* O; const bf16* KM; int P0; };
struct Seam { bf16x8 qr[8]; bf16x8 st_v0, st_v1, st_k0, st_k1; };
#define VMW() asm volatile("s_waitcnt vmcnt(0)" ::: "memory")
#define VMWN(n) asm volatile("s_waitcnt vmcnt(%0)" :: "i"(n) : "memory")
#define SLOAD_H(Kp, Vp, k0) do { const bf16* kb__ = (Kp) + (size_t)(k0) * RS; const bf16* vb__ = (Vp) + (size_t)(k0) * RS;              \
                         S.st_v0 = load8(vb__ + goff); S.st_v1 = load8(vb__ + 32 * RS + goff);              \
                         S.st_k0 = load8(kb__ + goff); S.st_k1 = load8(kb__ + 32 * RS + goff); } while (0)
#define SWRITE_HK(bf) do { *(bf16x8*)(K_lds + (bf) * SHM_K + kws) = S.st_k0; *(bf16x8*)(K_lds + (bf) * SHM_K + kws + 32 * 256) = S.st_k1; } while (0)
#define SWRITE_HV(bf) do { *(bf16x8*)(V_lds + (bf) * SHM_V + vst0) = S.st_v0; *(bf16x8*)(V_lds + (bf) * SHM_V + vst1) = S.st_v1; } while (0)
#define SWRITE_H(bf) do { SWRITE_HV(bf); SWRITE_HK(bf); } while (0)
DI void prime(const BlockRef& cur, char* lds, Seam& S) {
    const int tid = threadIdx.x, wid = __builtin_amdgcn_readfirstlane(tid >> 6), lane = tid & 63, r32 = lane & 31, hi = lane >> 5;
    const int sr = tid >> 4, sc = (tid & 15) * 8, kws = KSWZ(sr, sc * 2); char* K_lds = lds + 2 * SHM_V;
    const unsigned goff = (unsigned)(sr * RS + sc), qoff = (unsigned)(r32 * RS + hi * 8);
    { const bf16* qb__ = cur.Q + (size_t)(wid * QBLK) * RS;
#pragma unroll
    for (int d0 = 0; d0 < 8; ++d0) S.qr[d0] = load8(qb__ + qoff + d0 * 16); }
    SLOAD_H(cur.K, cur.V, 0); VMW(); SWRITE_HK(0);
    __syncthreads();
}
DI void block(const BlockRef& cur, const BlockRef& nxt, char* lds, Seam& S) {
    int tid_ = threadIdx.x; asm volatile("" : "+v"(tid_));
    const int tid = tid_, wid = __builtin_amdgcn_readfirstlane(tid >> 6), lane = tid & 63, r32 = lane & 31, hi = lane >> 5;
    const int NT = (cur.P0 + QB) / KVBLK;
    const int qb = cur.P0 / QB;
    const int qlo = cur.P0 + wid * QBLK, qm = qlo + r32 - 4 * hi;
    char* V_lds = lds; char* K_lds = lds + 2 * SHM_V;
    float* ws = (float*)(lds + 2 * SHM_V + 2 * SHM_K) + wid * 64; float* li_l = ws, * al_l = ws + 32;
    unsigned selmask = (1u << qb) - 1u;
    if (qb > 3) {
        f32x16 g0 = f32x16{};
#pragma unroll
        for (int d0 = 0; d0 < 8; ++d0) {
            bf16x8 a = (bf16x8){0, 0, 0, 0, 0, 0, 0, 0};
            if (r32 < 8) a = load8(cur.KM + r32 * D + d0 * 16 + hi * 8);
            g0 = MFMA32(a, S.qr[d0], g0);
        }
        float gt[8];
#pragma unroll
        for (int j = 0; j < 4; ++j) { const float mine = g0[j], oth = __shfl_xor(mine, 32); gt[j] = hi ? oth : mine; gt[4 + j] = hi ? mine : oth; }
        selmask = 0u;
#pragma unroll
        for (int i = 0; i < 8; ++i) { int rank = 0;
#pragma unroll
            for (int j = 0; j < 8; ++j) { if (j != i) { const bool beats = (gt[j] > gt[i]) || (gt[j] == gt[i] && j < i); rank += (j < qb && beats) ? 1 : 0; } }
            if (i < qb && rank < 3) selmask |= (1u << i); }
    }
    float m_reg = -1e30f, l_reg = 0; f32x16 o[4] = {};
    const int sr = tid >> 4, sc = (tid & 15) * 8, vst0 = v_st(sr, sc), vst1 = v_st(32 + sr, sc), kws = KSWZ(sr, sc * 2);
    const unsigned goff = (unsigned)(sr * RS + sc), qoff = (unsigned)(r32 * RS + hi * 8);
    const int vb0 = (int)(uintptr_t)V_lds + v_rd_base(lane);
    const bf16* Kh = cur.K; const bf16* Vh = cur.V;
#define RESC(a) do { if (__any((a) < 1.f)) { if (hi == 0) al_l[r32] = (a); asm volatile("s_waitcnt lgkmcnt(0)" ::: "memory");              \
                     _Pragma("unroll") for (int d_ = 0; d_ < 4; ++d_) _Pragma("unroll") for (int r = 0; r < 16; ++r) o[d_][r] *= al_l[crow(r, hi)]; } } while (0)
#define KBASE(t) ((t) * KVBLK)
#define MASKT(P0_, P1_, t) do { const int kb_ = KBASE(t); const int kblk_ = (t) >> 2; \
        if (kblk_ < qb) { if (qb > 3) mask_all(P0_, P1_, ((selmask >> kblk_) & 1u) == 0u); } \
        else if (kb_ + KVBLK - 1 > qlo) mask_tile(P0_, P1_, qm - kb_); } while (0)
    constexpr int NQL = 8;
#define SEAM_K0() do { VMWN(NQL); SWRITE_HK(0); SBAR(); } while (0)
    f32x16 pA0, pA1, pB0, pB1; float mnA, mnB, alA, alB; bf16x8 pa0, pa1, pa2, pa3;
    SWRITE_HV(0); SBAR();
    if (NT > 1) { SLOAD_H(Kh, Vh, KBASE(1)); }
    SBAR(); qkt<0>(pA0, pA1, K_lds, r32, hi, S.qr);
    MASKT(pA0, pA1, 0); partialSM(pA0, pA1, m_reg, mnA, alA);
    if (NT > 1) { VMW(); SWRITE_H(1); }
    __syncthreads();
#define HALF_STEP(PX0, PX1, mnX, alX, PY0, PY1, alY, t, KB, VB, SB) do {                                                      \
        SBAR(); qkt<KB>(PX0, PX1, K_lds, r32, hi, S.qr);                                             \
        finishSM(PY0, PY1, alY, l_reg, pa0, pa1, pa2, pa3); SBAR();                                                           \
        if ((t) + 1 < NT) { SLOAD_H(Kh, Vh, KBASE((t) + 1)); SBAR(); }                                               \
        pv_tile<VB>(o, vb0, pa0, pa1, pa2, pa3); MASKT(PX0, PX1, (t)); partialSM(PX0, PX1, m_reg, mnX, alX);                                        \
        __syncthreads();                                                                                                      \
        if ((t) + 1 < NT) { VMW(); SWRITE_H(SB); }                                                                          \
        RESC(alX); __syncthreads(); } while (0)
    for (int t = 1; t + 1 < NT; t += 2) {
        HALF_STEP(pB0, pB1, mnB, alB, pA0, pA1, alA, t, 1, 0, 0);
        HALF_STEP(pA0, pA1, mnA, alA, pB0, pB1, alB, t + 1, 0, 1, 1);
    }
    const bool even = (NT & 1) == 0;
    if (even) { SBAR(); qkt<1>(pB0, pB1, K_lds, r32, hi, S.qr); SBAR(); }
    { SLOAD_H(nxt.K, nxt.V, 0); SBAR();
      const bf16* qb__ = nxt.Q + (size_t)(wid * QBLK) * RS;
#pragma unroll
      for (int d0 = 0; d0 < 8; ++d0) S.qr[d0] = load8(qb__ + qoff + d0 * 16); }
    SBAR();
    finishSM(pA0, pA1, alA, l_reg, pa0, pa1, pa2, pa3); SBAR();
    pv_tile<0>(o, vb0, pa0, pa1, pa2, pa3);
    if (even) { MASKT(pB0, pB1, NT - 1); partialSM(pB0, pB1, m_reg, mnB, alB); __syncthreads(); RESC(alB);
        finishSM(pB0, pB1, alB, l_reg, pa0, pa1, pa2, pa3); SBAR(); pv_tile<1>(o, vb0, pa0, pa1, pa2, pa3); }
    SBAR(); SEAM_K0();
    if (hi == 0) li_l[r32] = l_reg; asm volatile("s_waitcnt lgkmcnt(0)" ::: "memory");
    float rli[16];
#pragma unroll
    for (int r = 0; r < 16; ++r) rli[r] = __builtin_amdgcn_rcpf(li_l[crow(r, hi)]);
    bf16* Ow = cur.O + (size_t)(wid * QBLK) * RSO;
    const unsigned ooff = (unsigned)(4 * hi * RSO + r32);
#pragma unroll
    for (int r = 0; r < 16; ++r) { const int orow0 = (r & 3) + 8 * (r >> 2);
#pragma unroll
        for (int d0 = 0; d0 < 4; ++d0) { const float v = o[d0][r] * rli[r];
            const float vn = __shfl_xor(v, 1);
            if ((r32 & 1) == 0) *(unsigned*)(Ow + ooff + (unsigned)(orow0 * RSO + d0 * 32)) = cvtpk(v, vn); } }
    __syncthreads();
#undef RESC
#undef KBASE
#undef MASKT
#undef SEAM_K0
#undef HALF_STEP
}
#undef VMW
#undef VMWN
#undef SLOAD_H
#undef SWRITE_HK
#undef SWRITE_HV
#undef SWRITE_H
#undef KSWZ
#undef SBAR
}

namespace dn {
#ifndef DBL
#define DBL -1
#endif
#define REPS(k) for (int rep_ = 0; rep_ < ((DBL == (k)) ? 2 : 1); ++rep_)
constexpr int L_QB = 0, L_KB = 17408, L_KT = 34816, L_VT = 53248, L_LM = 71680, L_TB = 89088, L_GV = 107520;
constexpr int RQ = 272, LMS = 68, RT = 144;

struct Raw { unsigned v[33]; float br, ar; };
DI void prep_load(const Params& p, int item, Raw& R, int lane, int wave) {
    const int bh = item >> 5, n = item & 31, b = bh >> 3, h = bh & 7, i0 = wave * 8, c0 = 2 * lane;
    const bf16_t* PROJ = (const bf16_t*)(p.ws + WS_B);
#pragma unroll
    for (int seg = 0; seg < 3; ++seg)
#pragma unroll
        for (int jj = 0; jj < 11; ++jj) {
            const int sp = n * 64 + i0 - 3 + jj;
            unsigned v = 0u;
            if (sp >= 0) v = *(const unsigned*)(PROJ + (size_t)(b * SEQ + sp) * PP + C_DN + seg * 1024 + h * HD + c0);
            R.v[seg * 11 + jj] = v;
        }
    R.br = 0.f; R.ar = 0.f;
    if (wave == 0) { const float* BA = (const float*)(p.ws + WS_BA); const size_t t = (size_t)(b * SEQ + n * 64 + lane);
        R.br = BA[t * 16 + h]; R.ar = BA[t * 16 + 8 + h]; }
}
#define DN_BAR() do { asm volatile("s_waitcnt lgkmcnt(0)" ::: "memory"); __builtin_amdgcn_s_barrier(); asm volatile("" ::: "memory"); } while (0)
DI void prep_chunk(const Params& p, LAS unsigned char* lds, int item, int nitem, Raw& R, int tid, int lane, int wave) {
    asm volatile("" : "+v"(tid), "+v"(lane));
    const int bh = item >> 5, n = item & 31, b = bh >> 3, h = bh & 7;
    unsigned char* rec = p.ws + WS_DNP + (size_t)item * DN_STRIDE;
    LAS float* LM = (LAS float*)(lds + L_LM);
    LAS float* GV = (LAS float*)(lds + L_GV);
    REPS(31) {
        const int i0 = wave * 8, c0 = 2 * lane;
#pragma unroll
        for (int seg = 0; seg < 3; ++seg) {
            const int chan = seg * 1024 + h * HD + c0;
            float w0[4], w1[4];
#pragma unroll
            for (int j = 0; j < 4; ++j) { const f32x2 wv = *(const f32x2*)(p.conv_w + j * 3072 + chan); w0[j] = wv.x; w1[j] = wv.y; }
            float r0[11], r1[11];
#pragma unroll
            for (int jj = 0; jj < 11; ++jj) { const unsigned v = R.v[seg * 11 + jj]; r0[jj] = bflo(v); r1[jj] = bfhi(v); }
            float ya[8], yb[8];
#pragma unroll
            for (int i = 0; i < 8; ++i) {
                float y0 = 0.f, y1 = 0.f;
#pragma unroll
                for (int j = 0; j < 4; ++j) { y0 += w0[j] * r0[i + j]; y1 += w1[j] * r1[i + j]; }
                y0 = siluf_(y0); y1 = siluf_(y1);
                if (seg < 2) {
                    const float ss = wave_sum(y0 * y0 + y1 * y1);
                    const float rn = (seg == 0 ? SCALE_Q : 1.0f) * rsqrt_(ss + EPS);
                    y0 *= rn; y1 *= rn;
                    *(LAS unsigned*)(lds + (seg == 0 ? L_QB : L_KB) + (i0 + i) * RQ + c0 * 2) = cvtpk(y0, y1);
                }
                ya[i] = y0; yb[i] = y1;
            }
            if (seg >= 1) {
                LAS unsigned char* tb = lds + (seg == 1 ? L_KT : L_VT) + c0 * RT + i0 * 2;
                u32x4 o0, o1;
                o0.x = cvtpk(ya[0], ya[1]); o0.y = cvtpk(ya[2], ya[3]); o0.z = cvtpk(ya[4], ya[5]); o0.w = cvtpk(ya[6], ya[7]);
                o1.x = cvtpk(yb[0], yb[1]); o1.y = cvtpk(yb[2], yb[3]); o1.z = cvtpk(yb[4], yb[5]); o1.w = cvtpk(yb[6], yb[7]);
                *(LAS u32x4*)tb = o0; *(LAS u32x4*)(tb + RT) = o1;
            }
        }
        if (wave == 0) {
            const float br = R.br, ar = R.ar;
            const float beta = sigmoidf_(br);
            const float xs = ar + p.dt_bias[h];
            const float sp = xs > 20.f ? xs : log1pf(expf(xs));
            float g = -expf(p.a_log[h]) * sp;
#pragma unroll
            for (int o = 1; o < 64; o <<= 1) { const float u = __shfl_up(g, o); if (lane >= o) g += u; }
            const float g63 = __shfl(g, 63);
            GV[lane] = g; GV[64 + lane] = beta; GV[128 + lane] = expf(g); GV[192 + lane] = expf(g63 - g);
        }
    }
    if (nitem >= 0) prep_load(p, nitem, R, lane, wave);
    DN_BAR();
    REPS(32) {
        const int mt = wave >> 1, nt = wave & 1, r = lane & 31, hi = lane >> 5;
        if (mt < 2) {
            const LAS unsigned char* Ab = lds + L_KB + (32 * nt + r) * RQ, * Bb = lds + L_QB + (32 * mt + r) * RQ;
            f32x16 acc = f32x16{};
#pragma unroll
            for (int ks = 0; ks < 8; ++ks) acc = MFMA32(*(const LAS bf16x8*)(Ab + (16 * ks + 8 * hi) * 2), *(const LAS bf16x8*)(Bb + (16 * ks + 8 * hi) * 2), acc);
            const int i = 32 * mt + r; const float Gi = GV[i];
            float v[16];
#pragma unroll
            for (int q = 0; q < 16; ++q) { const int j = 32 * nt + crow(q, hi); v[q] = i >= j ? acc[q] * __expf(Gi - GV[j]) : 0.f; }
            u32x4* QKf = (u32x4*)(rec + DN_QK) + ((mt * 4 + 2 * nt) * 64 + lane);
            u32x4 o0, o1;
            o0.x = cvtpk(v[0], v[1]); o0.y = cvtpk(v[2], v[3]); o0.z = cvtpk(v[4], v[5]); o0.w = cvtpk(v[6], v[7]);
            o1.x = cvtpk(v[8], v[9]); o1.y = cvtpk(v[10], v[11]); o1.z = cvtpk(v[12], v[13]); o1.w = cvtpk(v[14], v[15]);
            QKf[0] = o0; QKf[64] = o1;
        } else {
            const LAS unsigned char* Ab = lds + L_KB + (32 * (mt - 2) + r) * RQ, * Bb = lds + L_KB + (32 * nt + r) * RQ;
            f32x16 acc = f32x16{};
#pragma unroll
            for (int ks = 0; ks < 8; ++ks) acc = MFMA32(*(const LAS bf16x8*)(Ab + (16 * ks + 8 * hi) * 2), *(const LAS bf16x8*)(Bb + (16 * ks + 8 * hi) * 2), acc);
            const int j = 32 * nt + r; const float Gj = GV[j];
#pragma unroll
            for (int q = 0; q < 16; ++q) { const int row = 32 * (mt - 2) + crow(q, hi);
                const float e = row > j ? GV[64 + row] * __expf(GV[row] - Gj) : 0.f;
                LM[row * LMS + j] = acc[q] * e; }
        }
    }
    DN_BAR();
    REPS(33) {
        float Lr[64];
#pragma unroll
        for (int jq = 0; jq < 16; ++jq) { const f32x4 l = *(const LAS f32x4*)(LM + lane * LMS + 4 * jq); Lr[4 * jq] = l.x; Lr[4 * jq + 1] = l.y; Lr[4 * jq + 2] = l.z; Lr[4 * jq + 3] = l.w; }
        float xv[8];
#pragma unroll
        for (int q = 0; q < 8; ++q) xv[q] = (lane == 8 * wave + q) ? 1.0f : 0.0f;
#pragma unroll
        for (int j = 0; j < 63; ++j) {
#pragma unroll
            for (int q = 0; q < 8; ++q) { const float xj = __int_as_float(__builtin_amdgcn_readlane(__float_as_int(xv[q]), j)); xv[q] -= Lr[j] * xj; }
        }
        float t1[8], t2[8];
#pragma unroll
        for (int q = 0; q < 8; ++q) { const float bc = GV[64 + 8 * wave + q]; t1[q] = xv[q] * bc; t2[q] = t1[q] * GV[128 + 8 * wave + q]; }
        u32x4 o1, o2;
        o1.x = cvtpk(t1[0], t1[1]); o1.y = cvtpk(t1[2], t1[3]); o1.z = cvtpk(t1[4], t1[5]); o1.w = cvtpk(t1[6], t1[7]);
        o2.x = cvtpk(t2[0], t2[1]); o2.y = cvtpk(t2[2], t2[3]); o2.z = cvtpk(t2[4], t2[5]); o2.w = cvtpk(t2[6], t2[7]);
        *(LAS u32x4*)(lds + L_TB + lane * RT + wave * 16) = o1; *(LAS u32x4*)(lds + L_TB + 64 * RT + lane * RT + wave * 16) = o2;
    }
    DN_BAR();
    REPS(34) {
        const int r = lane & 31, hi = lane >> 5;
#pragma unroll
        for (int half = 0; half < 2; ++half) {
            const int tix = wave * 2 + half;
            f32x16 acc = f32x16{};
            if (tix < 8) {
                const int mt = tix >> 2, nt = tix & 3;
                const LAS unsigned char* Ab = lds + L_TB + (32 * mt + r) * RT + 16 * hi, * Bb = lds + L_VT + (32 * nt + r) * RT + 16 * hi;
#pragma unroll
                for (int ks = 0; ks < 4; ++ks) acc = MFMA32(*(const LAS bf16x8*)(Ab + 32 * ks), *(const LAS bf16x8*)(Bb + 32 * ks), acc);
                u32x4* Uf = (u32x4*)(rec + DN_U) + ((mt * 4 + nt) * 64 + lane) * 2;
                u32x4 o0, o1;
                o0.x = cvtpk(acc[0], acc[1]); o0.y = cvtpk(acc[2], acc[3]); o0.z = cvtpk(acc[4], acc[5]); o0.w = cvtpk(acc[6], acc[7]);
                o1.x = cvtpk(acc[8], acc[9]); o1.y = cvtpk(acc[10], acc[11]); o1.z = cvtpk(acc[12], acc[13]); o1.w = cvtpk(acc[14], acc[15]);
                Uf[0] = o0; Uf[1] = o1;
            } else {
                const int ntp = (tix - 8) >> 1, mt = tix & 1;
                const LAS unsigned char* Ab = lds + L_KT + (32 * ntp + r) * RT + 16 * hi, * Bb = lds + L_TB + 64 * RT + (32 * mt + r) * RT + 16 * hi;
#pragma unroll
                for (int ks = 0; ks < 4; ++ks) acc = MFMA32(*(const LAS bf16x8*)(Ab + 32 * ks), *(const LAS bf16x8*)(Bb + 32 * ks), acc);
                u32x4* Wf = (u32x4*)(rec + DN_W) + ((mt * 8 + 2 * ntp) * 64 + lane);
                u32x4 o0, o1;
                o0.x = cvtpk(-acc[0], -acc[1]); o0.y = cvtpk(-acc[2], -acc[3]); o0.z = cvtpk(-acc[4], -acc[5]); o0.w = cvtpk(-acc[6], -acc[7]);
                o1.x = cvtpk(-acc[8], -acc[9]); o1.y = cvtpk(-acc[10], -acc[11]); o1.z = cvtpk(-acc[12], -acc[13]); o1.w = cvtpk(-acc[14], -acc[15]);
                Wf[0] = o0; Wf[64] = o1;
            }
        }
#pragma unroll
        for (int rep = 0; rep < 2; ++rep) {
            const int f = tid + 512 * rep, mt = f >> 9, ks = (f >> 6) & 7, fr = f & 31, fh = (f >> 5) & 1, i = 32 * mt + fr;
            const LAS unsigned char* qp = lds + L_QB + i * RQ + (16 * ks + 4 * fh) * 2;
            const u32x2 a = *(const LAS u32x2*)qp, c = *(const LAS u32x2*)(qp + 16);
            const float e = GV[128 + i];
            u32x4 o; o.x = cvtpk(bflo(a.x) * e, bfhi(a.x) * e); o.y = cvtpk(bflo(a.y) * e, bfhi(a.y) * e); o.z = cvtpk(bflo(c.x) * e, bfhi(c.x) * e); o.w = cvtpk(bflo(c.y) * e, bfhi(c.y) * e);
            ((u32x4*)(rec + DN_QD))[f] = o;
        }
#pragma unroll
        for (int rep = 0; rep < 2; ++rep) {
            const int f = tid + 512 * rep, a4 = f >> 8, ks = (f >> 6) & 3, fr = f & 31, fh = (f >> 5) & 1, d = 32 * a4 + fr;
            const LAS unsigned char* kp = lds + L_KT + d * RT + (16 * ks + 4 * fh) * 2;
            const u32x2 a = *(const LAS u32x2*)kp, c = *(const LAS u32x2*)(kp + 16);
            const LAS float* eg = GV + 192 + 16 * ks + 4 * fh;
            u32x4 o; o.x = cvtpk(bflo(a.x) * eg[0], bfhi(a.x) * eg[1]); o.y = cvtpk(bflo(a.y) * eg[2], bfhi(a.y) * eg[3]);
            o.z = cvtpk(bflo(c.x) * eg[8], bfhi(c.x) * eg[9]); o.w = cvtpk(bflo(c.y) * eg[10], bfhi(c.y) * eg[11]);
            ((u32x4*)(rec + DN_KT))[f] = o;
        }
        if (tid == 0) *(float*)(rec + DN_SC) = GV[128 + 63];
    }
    DN_BAR();
}

DI bf16x8 pack_step(const f32x16& x, int s) {
    u32x4 w;
    if (s == 0) { w.x = cvtpk(x[0], x[1]); w.y = cvtpk(x[2], x[3]); w.z = cvtpk(x[4], x[5]); w.w = cvtpk(x[6], x[7]); }
    else { w.x = cvtpk(x[8], x[9]); w.y = cvtpk(x[10], x[11]); w.z = cvtpk(x[12], x[13]); w.w = cvtpk(x[14], x[15]); }
    return __builtin_bit_cast(bf16x8, w);
}

constexpr int RB = 57344;
constexpr int ORS = 272, OB = 64 * ORS;
DI void recur(const Params& p, LAS unsigned char* lds, int bh, int tid, int lane, int wave) {
    asm volatile("" : "+v"(tid), "+v"(lane));
    const int r = lane & 31, hi = lane >> 5, b = bh >> 3, h = bh & 7;
    const unsigned char* rec0 = p.ws + WS_DNP + (size_t)(bh * 32) * DN_STRIDE;
    if (wave >= 4) {
        const int lt = tid - 256;
        const int fg = lt & 7, fr2 = lt >> 3;
        const bf16_t* PROJ = (const bf16_t*)(p.ws + WS_B); bf16_t* YAB = (bf16_t*)(p.ws + WS_A);
        f32x4 g4[4];
#pragma unroll
        for (int j = 0; j < 4; ++j) g4[j] = *(const f32x4*)(p.dn_gain + fg * 16 + 4 * j);
        const bf16_t* zb = PROJ + (size_t)(b * SEQ) * PP + C_Z + h * HD + fg * 16; bf16_t* yb = YAB + (size_t)(b * SEQ) * DM + 1024 + h * HD + fg * 16;
        u32x4 zr[2][2];
#define DN_ZLOAD(n_) do { _Pragma("unroll") for (int ps = 0; ps < 2; ++ps) { const bf16_t* zp = zb + (size_t)((n_) * 64 + fr2 + 32 * ps) * PP; zr[ps][0] = *(const u32x4*)zp; zr[ps][1] = *(const u32x4*)(zp + 8); } } while (0)
#define DN_FINAL(n_) do { const LAS unsigned char* ob = lds + 2 * RB + ((n_) & 1) * OB; \
        _Pragma("unroll") for (int ps = 0; ps < 2; ++ps) { const int row = fr2 + 32 * ps; \
            const u32x4 o0 = *(const LAS u32x4*)(ob + row * ORS + fg * 32), o1 = *(const LAS u32x4*)(ob + row * ORS + fg * 32 + 16); \
            float ov[16] = {bflo(o0.x), bfhi(o0.x), bflo(o0.y), bfhi(o0.y), bflo(o0.z), bfhi(o0.z), bflo(o0.w), bfhi(o0.w), bflo(o1.x), bfhi(o1.x), bflo(o1.y), bfhi(o1.y), bflo(o1.z), bfhi(o1.z), bflo(o1.w), bfhi(o1.w)}; \
            float ss = 0.f; _Pragma("unroll") for (int e = 0; e < 16; ++e) ss += ov[e] * ov[e]; \
            ss += __shfl_xor(ss, 1); ss += __shfl_xor(ss, 2); ss += __shfl_xor(ss, 4); \
            const float rstd = rsqrt_(ss * (1.0f / HD) + EPS); \
            const u32x4 z0 = zr[ps][0], z1 = zr[ps][1]; \
            const float zz[16] = {bflo(z0.x), bfhi(z0.x), bflo(z0.y), bfhi(z0.y), bflo(z0.z), bfhi(z0.z), bflo(z0.w), bfhi(z0.w), bflo(z1.x), bfhi(z1.x), bflo(z1.y), bfhi(z1.y), bflo(z1.z), bfhi(z1.z), bflo(z1.w), bfhi(z1.w)}; \
            float y[16]; _Pragma("unroll") for (int e = 0; e < 16; ++e) y[e] = ov[e] * rstd * g4[e >> 2][e & 3] * siluf_(zz[e]); \
            u32x4 w0, w1; w0.x = cvtpk(y[0], y[1]); w0.y = cvtpk(y[2], y[3]); w0.z = cvtpk(y[4], y[5]); w0.w = cvtpk(y[6], y[7]); \
            w1.x = cvtpk(y[8], y[9]); w1.y = cvtpk(y[10], y[11]); w1.z = cvtpk(y[12], y[13]); w1.w = cvtpk(y[14], y[15]); \
            bf16_t* yp = yb + (size_t)((n_) * 64 + row) * DM; *(u32x4*)yp = w0; *(u32x4*)(yp + 8) = w1; } } while (0)
        u32x4 v[14];
        {   const u32x4* src = (const u32x4*)(rec0 + DN_W) + lt;
#pragma unroll
            for (int k = 0; k < 14; ++k) v[k] = src[k * 256];
#pragma unroll
            for (int k = 0; k < 14; ++k) *(LAS u32x4*)(lds + (k * 256 + lt) * 16) = v[k];
            const u32x4* src1 = (const u32x4*)(rec0 + DN_STRIDE + DN_W) + lt;
#pragma unroll
            for (int k = 0; k < 14; ++k) v[k] = src1[k * 256]; }
        DN_ZLOAD(0);
        DN_BAR();
        for (int n = 0; n < 32; ++n) {
            if (n + 1 < 32) { LAS unsigned char* dst = lds + ((n + 1) & 1) * RB;
#pragma unroll
                for (int k = 0; k < 14; ++k) *(LAS u32x4*)(dst + (k * 256 + lt) * 16) = v[k]; }
            if (n + 2 < 32) { const u32x4* src = (const u32x4*)(rec0 + (size_t)(n + 2) * DN_STRIDE + DN_W) + lt;
#pragma unroll
                for (int k = 0; k < 14; ++k) v[k] = src[k * 256]; }
            if (n >= 1) { DN_FINAL(n - 1); DN_ZLOAD(n); }
            DN_BAR();
        }
        DN_FINAL(31);
#undef DN_ZLOAD
#undef DN_FINAL
    } else {
        const int slice = wave, dv0 = slice * 32;
        f32x16 St[4];
#pragma unroll
        for (int a = 0; a < 4; ++a) St[a] = f32x16{};
        u32x4 un[2][2];
#pragma unroll
        for (int mt = 0; mt < 2; ++mt) { const u32x4* up = (const u32x4*)(rec0 + DN_U) + ((mt * 4 + slice) * 64 + lane) * 2; un[mt][0] = up[0]; un[mt][1] = up[1]; }
        DN_BAR();
        for (int n = 0; n < 32; ++n) {
            const unsigned char* rec = rec0 + (size_t)n * DN_STRIDE;
            const LAS unsigned char* buf = lds + (n & 1) * RB;
            const float eg = *(const float*)(rec + DN_SC);
            f32x16 Vn[2], O[2];
#pragma unroll
            for (int mt = 0; mt < 2; ++mt) { const u32x4 a = un[mt][0], c = un[mt][1];
                Vn[mt][0] = bflo(a.x); Vn[mt][1] = bfhi(a.x); Vn[mt][2] = bflo(a.y); Vn[mt][3] = bfhi(a.y); Vn[mt][4] = bflo(a.z); Vn[mt][5] = bfhi(a.z); Vn[mt][6] = bflo(a.w); Vn[mt][7] = bfhi(a.w);
                Vn[mt][8] = bflo(c.x); Vn[mt][9] = bfhi(c.x); Vn[mt][10] = bflo(c.y); Vn[mt][11] = bfhi(c.y); Vn[mt][12] = bflo(c.z); Vn[mt][13] = bfhi(c.z); Vn[mt][14] = bflo(c.w); Vn[mt][15] = bfhi(c.w); }
            if (n + 1 < 32) {
#pragma unroll
                for (int mt = 0; mt < 2; ++mt) { const u32x4* up = (const u32x4*)(rec + DN_STRIDE + DN_U) + ((mt * 4 + slice) * 64 + lane) * 2; un[mt][0] = up[0]; un[mt][1] = up[1]; } }
            bf16x8 Sf[8];
#pragma unroll
            for (int a = 0; a < 4; ++a) { Sf[2 * a] = pack_step(St[a], 0); Sf[2 * a + 1] = pack_step(St[a], 1); }
#pragma unroll
            for (int mt = 0; mt < 2; ++mt)
#pragma unroll
                for (int ks = 0; ks < 8; ++ks) Vn[mt] = MFMA32(*(const LAS bf16x8*)(buf + ((mt * 8 + ks) * 64 + lane) * 16), Sf[ks], Vn[mt]);
#pragma unroll
            for (int mt = 0; mt < 2; ++mt) { O[mt] = f32x16{};
#pragma unroll
                for (int ks = 0; ks < 8; ++ks) O[mt] = MFMA32(*(const LAS bf16x8*)(buf + 16384 + ((mt * 8 + ks) * 64 + lane) * 16), Sf[ks], O[mt]); }
            bf16x8 Vf[4];
#pragma unroll
            for (int mt = 0; mt < 2; ++mt) { Vf[2 * mt] = pack_step(Vn[mt], 0); Vf[2 * mt + 1] = pack_step(Vn[mt], 1); }
#pragma unroll
            for (int mt = 0; mt < 2; ++mt)
#pragma unroll
                for (int ks = 0; ks < 4; ++ks) O[mt] = MFMA32(*(const LAS bf16x8*)(buf + 49152 + ((mt * 4 + ks) * 64 + lane) * 16), Vf[ks], O[mt]);
#pragma unroll
            for (int a = 0; a < 4; ++a) {
                St[a] = St[a] * eg;
#pragma unroll
                for (int ks = 0; ks < 4; ++ks) St[a] = MFMA32(*(const LAS bf16x8*)(buf + 32768 + ((a * 4 + ks) * 64 + lane) * 16), Vf[ks], St[a]);
            }
            {   LAS unsigned char* ob = lds + 2 * RB + (n & 1) * OB + (dv0 + r) * 2;
#pragma unroll
                for (int mt = 0; mt < 2; ++mt)
#pragma unroll
                    for (int i = 0; i < 16; ++i) *(LAS bf16_t*)(ob + (32 * mt + crow(i, hi)) * ORS) = f2bf(O[mt][i]);
            }
            DN_BAR();
        }
    }
}
}

DI void transpose_tile(const float* W, int N, int k0, int sn0, bf16_t* WT, int dpitch, int drow0, int dk0, int nvalid, LAS float* scr, int lane) {
#pragma unroll 8
    for (int i = 0; i < 32; ++i) { const int kk = 2 * i + (lane >> 5); scr[kk * 33 + (lane & 31)] = W[(size_t)(k0 + kk) * N + sn0 + (lane & 31)]; }
    asm volatile("s_waitcnt lgkmcnt(0)" ::: "memory");
    const int c = lane & 7;
#pragma unroll
    for (int j = 0; j < 4; ++j) { const int n = (lane >> 3) + 8 * j; const LAS float* s = scr + (8 * c) * 33 + n;
        u32x4 o; o.x = cvtpk(s[0 * 33], s[1 * 33]); o.y = cvtpk(s[2 * 33], s[3 * 33]); o.z = cvtpk(s[4 * 33], s[5 * 33]); o.w = cvtpk(s[6 * 33], s[7 * 33]);
        if (n < nvalid) *(u32x4*)(WT + (size_t)(drow0 + n) * dpitch + dk0 + k0 + 8 * c) = o; }
    asm volatile("s_waitcnt lgkmcnt(0)" ::: "memory");
}

DI void phase0(const Params& p, LAS unsigned char* lds, int tid, int lane, int wave, int bid, int G) {
    float* MOD = (float*)(p.ws + WS_MOD);
#if defined(DBL) && DBL == 0
    __syncthreads();
#endif
    if (bid < 192) {
        LAS float* sc = (LAS float*)lds;
        LAS float* red = (LAS float*)(lds + 65536);
        for (int i = tid; i < 8 * 2048; i += 512) { const int bb = i >> 11, k = i & 2047; sc[k * 8 + bb] = siluf_acc(p.c[i]); }
        __syncthreads();
        const int n0 = bid * 64;
        const int ksub = lane >> 4, cg = lane & 15;
        f32x4 acc[8];
#pragma unroll
        for (int bb = 0; bb < 8; ++bb) acc[bb] = (f32x4){0.f, 0.f, 0.f, 0.f};
        const float* wp = p.w_ada + (size_t)(wave * 256 + ksub) * 12288 + n0 + 4 * cg;
#pragma unroll 8
        for (int it = 0; it < 64; ++it) {
            const f32x4 wv = *(const f32x4*)(wp + (size_t)(4 * it) * 12288);
            const LAS float* sp = sc + (wave * 256 + 4 * it + ksub) * 8;
            const f32x4 s0 = *(const LAS f32x4*)sp, s1 = *(const LAS f32x4*)(sp + 4);
            acc[0] += wv * s0.x; acc[1] += wv * s0.y; acc[2] += wv * s0.z; acc[3] += wv * s0.w;
            acc[4] += wv * s1.x; acc[5] += wv * s1.y; acc[6] += wv * s1.z; acc[7] += wv * s1.w;
        }
#pragma unroll
        for (int bb = 0; bb < 8; ++bb) {
#pragma unroll
            for (int e = 0; e < 4; ++e) { float v = acc[bb][e]; v += __shfl_xor(v, 16); v += __shfl_xor(v, 32); acc[bb][e] = v; }
            if (ksub == 0) *(LAS f32x4*)(red + (wave * 8 + bb) * 64 + 4 * cg) = acc[bb];
        }
        __syncthreads();
        { const int bb = tid >> 6, col = tid & 63; float s = 0.f;
#pragma unroll
          for (int w = 0; w < 8; ++w) s += red[(w * 8 + bb) * 64 + col];
          MOD[bb * 12288 + n0 + col] = s + p.b_ada[n0 + col]; }
        __syncthreads();
    } else {
        f32x2* CS = (f32x2*)(p.ws + WS_CS);
        for (int i = (bid - 192) * 512 + tid; i < T * 16; i += (G - 192) * 512) {
            const int t = i >> 4, f = i & 15;
            const float inv = powf(500000.0f, -(float)f * (2.0f / 32.0f));
            const float ang = (float)p.pos[t] * inv;
            float sn, cs; sincosf(ang, &sn, &cs);
            CS[i] = (f32x2){cs, sn};
        }
    }
    LAS float* scr = (LAS float*)(lds + wave * 8448);
    const int gw = bid * 8 + wave, NGW = G * 8;
    bf16_t* WIN = (bf16_t*)(p.ws + WS_WIN); bf16_t* WMD = (bf16_t*)(p.ws + WS_WMD); bf16_t* WOUT = (bf16_t*)(p.ws + WS_WOUT); bf16_t* WR = (bf16_t*)(p.ws + WS_WR);
    constexpr int I_A = 32 * 224, I_B = 32 * 128, I_C = 32, I_M = 16 * 64, I_O = 32 * 64, I_RG = 32, I_RE = 32;
    constexpr int NITEMS = I_A + I_B + I_C + 2 * I_M + I_O + I_RG + I_RE;
    for (int it = gw; it < NITEMS; it += NGW) {
        int r = it;
        if (r < I_A) { const int kb = r / 224, nb = r % 224; transpose_tile(p.w_in, 11280, 64 * kb, 32 * nb, WIN, DM, 32 * nb, 0, 32, scr, lane); continue; } r -= I_A;
        if (r < I_B) { const int kb = r / 128, nb = r % 128; transpose_tile(p.w_in, 11280, 64 * kb, 7184 + 32 * nb, WIN, DM, 7168 + 32 * nb, 0, 32, scr, lane); continue; } r -= I_B;
        if (r < I_C) { transpose_tile(p.w_in, 11280, 64 * r, 7168, (bf16_t*)(p.ws + WS_WBA), DM, 0, 0, 16, scr, lane); continue; } r -= I_C;
        if (r < I_M) { const int kb = r / 64, nb = r % 64; transpose_tile(p.w_bm, DM, 64 * kb, 32 * nb, WMD, DM, 32 * nb, 0, 32, scr, lane); continue; } r -= I_M;
        if (r < I_M) { const int kb = r / 64, nb = r % 64; transpose_tile(p.w_bd, DM, 64 * kb, 32 * nb, WMD, DM, 32 * nb, 1024, 32, scr, lane); continue; } r -= I_M;
        if (r < I_O) { const int kb = r / 64, nb = r % 64; transpose_tile(p.w_out, DM, 64 * kb, 32 * nb, WOUT, DM, 32 * nb, 0, 32, scr, lane); continue; } r -= I_O;
        if (r < I_RG) {
            const int k = r * 64 + lane;
#pragma unroll
            for (int e = 0; e < 4; ++e) WR[e * DM + k] = f2bf(p.w_rg[k * 4 + e]);
#pragma unroll
            for (int e = 36; e < 48; ++e) WR[e * DM + k] = 0;
            continue; } r -= I_RG;
        { transpose_tile(p.w_re, 32, 64 * r, 0, WR, DM, 4, 0, 32, scr, lane); }
    }
}

DI void phase_u1_item(const Params& p, int item, int tid, int lane, int wave) {
    const float* MOD = (const float*)(p.ws + WS_MOD); bf16_t* U1 = (bf16_t*)(p.ws + WS_A);
    const int tokb = item * 64;
    for (int rr = 0; rr < 8; ++rr) {
        const int m = tokb + wave * 8 + rr, b = m >> 11;
        const f32x4* xr = (const f32x4*)(p.x + (size_t)m * DM) + lane;
        f32x4 v[8]; float s = 0.f;
#pragma unroll
        for (int j = 0; j < 8; ++j) { v[j] = xr[64 * j]; s += (v[j].x * v[j].x + v[j].y * v[j].y) + (v[j].z * v[j].z + v[j].w * v[j].w); }
        const float rstd = rsqrt_(wave_sum(s) * (1.0f / DM) + EPS);
        const float* sh = MOD + b * 12288; const float* scl = sh + 2048;
        u32x2* o8 = (u32x2*)(U1 + (size_t)m * DM) + lane;
#pragma unroll
        for (int j = 0; j < 8; ++j) { const int col = 4 * (lane + 64 * j);
            const f32x4 g = *(const f32x4*)(p.g_mix_pre + col), a = *(const f32x4*)(scl + col), c = *(const f32x4*)(sh + col);
            const f32x4 u = (v[j] * rstd * g) * (a + 1.0f) + c;
            o8[64 * j] = (u32x2){cvtpk(u.x, u.y), cvtpk(u.z, u.w)}; }
    }
    __syncthreads();
    if (wave < 4) {
        const int tl = lane & 15, kg = lane >> 4;
        const bf16_t* up = U1 + (size_t)(tokb + wave * 16 + tl) * DM + 8 * kg;
        const bf16_t* wp = (const bf16_t*)(p.ws + WS_WBA) + (size_t)tl * DM + 8 * kg;
        f32x4 a0 = {0.f, 0.f, 0.f, 0.f}, a1 = a0;
#pragma unroll 8
        for (int s = 0; s < 64; s += 2) {
            a0 = MFMA16(*(const bf16x8*)(wp + 32 * s), *(const bf16x8*)(up + 32 * s), a0);
            a1 = MFMA16(*(const bf16x8*)(wp + 32 * s + 32), *(const bf16x8*)(up + 32 * s + 32), a1);
        }
        float* BA = (float*)(p.ws + WS_BA);
        *(f32x4*)(BA + (size_t)(tokb + wave * 16 + tl) * 16 + 4 * kg) = a0 + a1;
    }
}

DI void rotary_item(const Params& p, int item, int lane) {
    const int which = item & 1, h = (item >> 1) & 7, blk = (item >> 4) & 7, b = item >> 7;
    bf16_t* PROJ = (bf16_t*)(p.ws + WS_B);
    const f32x2* CS = (const f32x2*)(p.ws + WS_CS);
    const int tok0 = b * SEQ + blk * 256; const int colb = (which ? C_K : C_Q) + h * HD;
    const int rsub = lane >> 4, i = lane & 15;
    float cs8[8];
#pragma unroll
    for (int e = 0; e < 8; ++e) cs8[e] = 0.f;
    if (which) {
#pragma unroll 16
        for (int it = 0; it < 64; ++it) { const u32x4 v = *(const u32x4*)(PROJ + (size_t)(tok0 + it * 4 + rsub) * PP + colb + 8 * i);
            cs8[0] += bflo(v.x); cs8[1] += bfhi(v.x); cs8[2] += bflo(v.y); cs8[3] += bfhi(v.y); cs8[4] += bflo(v.z); cs8[5] += bfhi(v.z); cs8[6] += bflo(v.w); cs8[7] += bfhi(v.w); }
#pragma unroll
        for (int e = 0; e < 8; ++e) { cs8[e] += __shfl_xor(cs8[e], 16); cs8[e] += __shfl_xor(cs8[e], 32); }
    }
    float a0 = 0.f, a1 = 0.f;
#pragma unroll 16
    for (int it = 0; it < 64; ++it) {
        const int t = tok0 + it * 4 + rsub;
        bf16_t* ptr = PROJ + (size_t)t * PP + colb + i;
        const float x1 = bf2f(ptr[0]), x2 = bf2f(ptr[16]);
        const f32x2 cs = CS[t * 16 + i];
        const unsigned w = cvtpk(x1 * cs.x - x2 * cs.y, x2 * cs.x + x1 * cs.y);
        ptr[0] = (bf16_t)(w & 0xffffu); ptr[16] = (bf16_t)(w >> 16);
        a0 += bflo(w); a1 += bfhi(w);
    }
    if (which) {
        a0 += __shfl_xor(a0, 16); a0 += __shfl_xor(a0, 32); a1 += __shfl_xor(a1, 16); a1 += __shfl_xor(a1, 32);
        bf16_t* KM = (bf16_t*)(p.ws + WS_KMEAN) + ((size_t)(b * 8 + h) * 8 + blk) * HD;
        if (lane < 16) {
            if (lane >= 4) { u32x4 o; o.x = cvtpk(cs8[0] * (1.0f / 256.0f), cs8[1] * (1.0f / 256.0f)); o.y = cvtpk(cs8[2] * (1.0f / 256.0f), cs8[3] * (1.0f / 256.0f));
                o.z = cvtpk(cs8[4] * (1.0f / 256.0f), cs8[5] * (1.0f / 256.0f)); o.w = cvtpk(cs8[6] * (1.0f / 256.0f), cs8[7] * (1.0f / 256.0f)); *(u32x4*)(KM + 8 * lane) = o; }
            KM[lane] = f2bf(a0 * (1.0f / 256.0f)); KM[16 + lane] = f2bf(a1 * (1.0f / 256.0f));
        }
    }
}

DI void phase_dn_final(const Params& p, int lane, int gw, int NGW) {
    const float* ODN = (const float*)(p.ws + WS_D); const bf16_t* PROJ = (const bf16_t*)(p.ws + WS_B); bf16_t* YAB = (bf16_t*)(p.ws + WS_A);
    const int d0 = (lane & 7) * 16;
    for (int m = gw; m < T; m += NGW) {
        const float* op = ODN + (size_t)m * 1024 + lane * 16;
        f32x4 v[4]; float s = 0.f;
#pragma unroll
        for (int j = 0; j < 4; ++j) { v[j] = *(const f32x4*)(op + 4 * j); s += (v[j].x * v[j].x + v[j].y * v[j].y) + (v[j].z * v[j].z + v[j].w * v[j].w); }
        s += __shfl_xor(s, 1); s += __shfl_xor(s, 2); s += __shfl_xor(s, 4);
        const float rstd = rsqrt_(s * (1.0f / HD) + EPS);
        const u32x4 z0 = *(const u32x4*)(PROJ + (size_t)m * PP + C_Z + lane * 16), z1 = *(const u32x4*)(PROJ + (size_t)m * PP + C_Z + lane * 16 + 8);
        const float zz[16] = {bflo(z0.x), bfhi(z0.x), bflo(z0.y), bfhi(z0.y), bflo(z0.z), bfhi(z0.z), bflo(z0.w), bfhi(z0.w),
                              bflo(z1.x), bfhi(z1.x), bflo(z1.y), bfhi(z1.y), bflo(z1.z), bfhi(z1.z), bflo(z1.w), bfhi(z1.w)};
        float y[16];
#pragma unroll
        for (int j = 0; j < 4; ++j) { const f32x4 g = *(const f32x4*)(p.dn_gain + d0 + 4 * j);
            y[4 * j + 0] = v[j].x * rstd * g.x * siluf_(zz[4 * j + 0]); y[4 * j + 1] = v[j].y * rstd * g.y * siluf_(zz[4 * j + 1]);
            y[4 * j + 2] = v[j].z * rstd * g.z * siluf_(zz[4 * j + 2]); y[4 * j + 3] = v[j].w * rstd * g.w * siluf_(zz[4 * j + 3]); }
        u32x4 o0, o1;
        o0.x = cvtpk(y[0], y[1]); o0.y = cvtpk(y[2], y[3]); o0.z = cvtpk(y[4], y[5]); o0.w = cvtpk(y[6], y[7]);
        o1.x = cvtpk(y[8], y[9]); o1.y = cvtpk(y[10], y[11]); o1.z = cvtpk(y[12], y[13]); o1.w = cvtpk(y[14], y[15]);
        bf16_t* yp = YAB + (size_t)m * DM + 1024 + lane * 16;
        *(u32x4*)yp = o0; *(u32x4*)(yp + 8) = o1;
    }
}

constexpr int L5_LG = 0;
constexpr int L5_HIST = 24576;
constexpr int L5_TOK = 24576 + 256;
DI void phase5_item(const Params& p, LAS unsigned char* lds, int item, int tid, int lane, int wave) {
    const float* MOD = (const float*)(p.ws + WS_MOD); const bf16_t* OM = (const bf16_t*)(p.ws + WS_OUTMIX); bf16_t* U2 = (bf16_t*)(p.ws + WS_A);
    const bf16_t* WR = (const bf16_t*)(p.ws + WS_WR);
    LAS unsigned* hist = (LAS unsigned*)(lds + L5_HIST); LAS unsigned* tokw = (LAS unsigned*)(lds + L5_TOK);
    if (tid < 64) hist[tid] = 0u;
    const int tokb = item * 64;
    for (int rr = 0; rr < 8; rr += 2) {
        u32x4 wq[2][4]; f32x4 xa[2][4], xb[2][4];
#pragma unroll
        for (int u = 0; u < 2; ++u) { const int m = tokb + wave * 8 + rr + u;
#pragma unroll
            for (int j = 0; j < 4; ++j) { const int col = 8 * (lane + 64 * j);
                wq[u][j] = *(const u32x4*)(OM + (size_t)m * DM + col);
                xa[u][j] = *(const f32x4*)(p.x + (size_t)m * DM + col); xb[u][j] = *(const f32x4*)(p.x + (size_t)m * DM + col + 4); } }
#pragma unroll
        for (int u = 0; u < 2; ++u) {
        const int m = tokb + wave * 8 + rr + u, b = m >> 11;
        const float* mod = MOD + b * 12288;
        float om[32], xv[32];
        float s = 0.f;
#pragma unroll
        for (int j = 0; j < 4; ++j) {
            const u32x4 w = wq[u][j];
            om[8 * j + 0] = bflo(w.x); om[8 * j + 1] = bfhi(w.x); om[8 * j + 2] = bflo(w.y); om[8 * j + 3] = bfhi(w.y);
            om[8 * j + 4] = bflo(w.z); om[8 * j + 5] = bfhi(w.z); om[8 * j + 6] = bflo(w.w); om[8 * j + 7] = bfhi(w.w);
            const f32x4 x0 = xa[u][j], x1 = xb[u][j];
            xv[8 * j + 0] = x0.x; xv[8 * j + 1] = x0.y; xv[8 * j + 2] = x0.z; xv[8 * j + 3] = x0.w; xv[8 * j + 4] = x1.x; xv[8 * j + 5] = x1.y; xv[8 * j + 6] = x1.z; xv[8 * j + 7] = x1.w;
#pragma unroll
            for (int e = 0; e < 8; ++e) s += om[8 * j + e] * om[8 * j + e]; }
        const float r1 = rsqrt_(wave_sum(s) * (1.0f / DM) + EPS);
        float s2 = 0.f;
#pragma unroll
        for (int j = 0; j < 4; ++j) { const int col = 8 * (lane + 64 * j);
#pragma unroll
            for (int q = 0; q < 2; ++q) { const f32x4 g = *(const f32x4*)(p.g_mix_post + col + 4 * q), gt = *(const f32x4*)(mod + 4096 + col + 4 * q);
                f32x4 o;
                o.x = xv[8 * j + 4 * q + 0] + gt.x * (om[8 * j + 4 * q + 0] * r1 * g.x); o.y = xv[8 * j + 4 * q + 1] + gt.y * (om[8 * j + 4 * q + 1] * r1 * g.y);
                o.z = xv[8 * j + 4 * q + 2] + gt.z * (om[8 * j + 4 * q + 2] * r1 * g.z); o.w = xv[8 * j + 4 * q + 3] + gt.w * (om[8 * j + 4 * q + 3] * r1 * g.w);
                *(f32x4*)(p.out + (size_t)m * DM + col + 4 * q) = o;
                xv[8 * j + 4 * q + 0] = o.x; xv[8 * j + 4 * q + 1] = o.y; xv[8 * j + 4 * q + 2] = o.z; xv[8 * j + 4 * q + 3] = o.w;
                s2 += (o.x * o.x + o.y * o.y) + (o.z * o.z + o.w * o.w); } }
        const float r2 = rsqrt_(wave_sum(s2) * (1.0f / DM) + EPS);
#pragma unroll
        for (int j = 0; j < 4; ++j) { const int col = 8 * (lane + 64 * j); float u8[8];
#pragma unroll
            for (int q = 0; q < 2; ++q) { const f32x4 g = *(const f32x4*)(p.g_ffn_pre + col + 4 * q), sc = *(const f32x4*)(mod + 8192 + col + 4 * q), sh = *(const f32x4*)(mod + 6144 + col + 4 * q);
                u8[4 * q + 0] = (xv[8 * j + 4 * q + 0] * r2 * g.x) * (1.0f + sc.x) + sh.x; u8[4 * q + 1] = (xv[8 * j + 4 * q + 1] * r2 * g.y) * (1.0f + sc.y) + sh.y;
                u8[4 * q + 2] = (xv[8 * j + 4 * q + 2] * r2 * g.z) * (1.0f + sc.z) + sh.z; u8[4 * q + 3] = (xv[8 * j + 4 * q + 3] * r2 * g.w) * (1.0f + sc.w) + sh.w; }
            u32x4 w; w.x = cvtpk(u8[0], u8[1]); w.y = cvtpk(u8[2], u8[3]); w.z = cvtpk(u8[4], u8[5]); w.w = cvtpk(u8[6], u8[7]);
            *(u32x4*)(U2 + (size_t)m * DM + col) = w; }
        }
    }
    __syncthreads();
    {
        const int tl = lane & 15, kg = lane >> 4, tg = wave & 3, kh = wave >> 2;
        const bf16_t* up = U2 + (size_t)(tokb + tg * 16 + tl) * DM + kh * 1024 + 8 * kg;
        const bf16_t* wp = WR + (size_t)tl * DM + kh * 1024 + 8 * kg;
        f32x4 a0 = {0.f, 0.f, 0.f, 0.f}, a1 = a0, a2 = a0;
#pragma unroll 8
        for (int s = 0; s < 32; ++s) {
            const bf16x8 bu = *(const bf16x8*)(up + 32 * s);
            const bf16x8 w0 = *(const bf16x8*)(wp + 32 * s), w1 = *(const bf16x8*)(wp + 16 * DM + 32 * s), w2 = *(const bf16x8*)(wp + 32 * DM + 32 * s);
            a0 = MFMA16(w0, bu, a0); a1 = MFMA16(w1, bu, a1); a2 = MFMA16(w2, bu, a2);
        }
        LAS float* lg = (LAS float*)(lds + L5_LG) + (kh * 4 + tg) * 768 + tl * 48 + 4 * kg;
#pragma unroll
        for (int r = 0; r < 4; ++r) { lg[r] = a0[r]; lg[16 + r] = a1[r]; lg[32 + r] = a2[r]; }
    }
    __syncthreads();
    if (wave < 4) {
        if (lane < 16) {
            const LAS float* l = (const LAS float*)(lds + L5_LG) + wave * 768 + lane * 48; const LAS float* l2 = l + 4 * 768;
            float gl[4]; int gs = 0; float gm;
#pragma unroll
            for (int i = 0; i < 4; ++i) gl[i] = l[i] + l2[i] + p.b_rg[i];
            gm = gl[0];
#pragma unroll
            for (int i = 1; i < 4; ++i) if (gl[i] > gm) { gm = gl[i]; gs = i; }
            float gsum = 0.f;
#pragma unroll
            for (int i = 0; i < 4; ++i) gsum += expf(gl[i] - gm);
            const float pg = 1.0f / gsum;
            float el[8]; float em = -3.0e38f;
#pragma unroll
            for (int i = 0; i < 8; ++i) { const float v = l[4 + 8 * gs + i] + l2[4 + 8 * gs + i] + p.b_re[8 * gs + i]; el[i] = v; em = fmaxf(em, v); }
            float pe[8]; float esum = 0.f;
#pragma unroll
            for (int i = 0; i < 8; ++i) { pe[i] = expf(el[i] - em); esum += pe[i]; }
            int i0 = 0; float p0 = pe[0];
#pragma unroll
            for (int i = 1; i < 8; ++i) if (pe[i] > p0) { p0 = pe[i]; i0 = i; }
            int i1 = -1; float p1 = -1.f;
#pragma unroll
            for (int i = 0; i < 8; ++i) if (i != i0 && pe[i] > p1) { p1 = pe[i]; i1 = i; }
            const float w0 = pg * p0 / (p0 + p1), w1 = pg * p1 / (p0 + p1);
            const int e0 = 8 * gs + i0, e1 = 8 * gs + i1;
            const unsigned lr0 = __hip_atomic_fetch_add(hist + e0, 1u, __ATOMIC_RELAXED, __HIP_MEMORY_SCOPE_WORKGROUP), lr1 = __hip_atomic_fetch_add(hist + e1, 1u, __ATOMIC_RELAXED, __HIP_MEMORY_SCOPE_WORKGROUP);
            LAS unsigned* tw = tokw + (wave * 16 + lane) * 6;
            tw[0] = (unsigned)e0; tw[1] = (unsigned)e1; tw[2] = lr0; tw[3] = lr1; tw[4] = __float_as_uint(w0); tw[5] = __float_as_uint(w1);
        }
    }
    __syncthreads();
    if (tid < 32) { unsigned* cnt = (unsigned*)(p.ws + WS_CTL) + CW_CNT; const unsigned hcount = hist[tid];
        hist[32 + tid] = hcount ? __hip_atomic_fetch_add(cnt + tid, hcount, __ATOMIC_RELAXED, __HIP_MEMORY_SCOPE_AGENT) : 0u; }
    __syncthreads();
    if (tid < 64) {
        const LAS unsigned* tw = tokw + tid * 6; const int tok = tokb + tid;
        const unsigned e0 = tw[0], e1 = tw[1], q0 = hist[32 + e0] + tw[2], q1 = hist[32 + e1] + tw[3];
        int* RT = (int*)(p.ws + WS_RTOK); RT[e0 * ECAP + q0] = tok; RT[e1 * ECAP + q1] = tok;
        u32x4* rec = (u32x4*)(p.ws + WS_REC) + (size_t)tok * 2;
        rec[0] = (u32x4){e0, e1, q0, q1}; rec[1] = (u32x4){tw[4], tw[5], 0u, 0u};
    }
    __syncthreads();
}
DI void expert_copy_gu(const Params& p, int it, LAS float* scr, int lane) {
    const int e = it >> 10, r = it & 1023, up = r >> 9, q = r & 511, kb = q >> 4, nb = q & 15, n0 = 32 * nb;
    const float* W = (up ? p.w_up : p.w_gate) + (size_t)e * DM * FF;
    transpose_tile(W, FF, 64 * kb, n0, (bf16_t*)(p.ws + WS_WGU), DM, e * 1024 + (n0 >> 7) * 256 + (n0 & 127) + up * 128, 0, 32, scr, lane);
}
DI void expert_copy_dn(const Params& p, int it, LAS float* scr, int lane) {
    const int e = it >> 9, q = it & 511, kb = q >> 6, nb = q & 63;
    transpose_tile(p.w_down + (size_t)e * FF * DM, DM, 64 * kb, 32 * nb, (bf16_t*)(p.ws + WS_WDN), FF, e * DM + 32 * nb, 0, 32, scr, lane);
}

struct MoeOrder {
    const LAS int* pref; const LAS int* cnt; int ntn, G, c;
    DI bool next(int i, pg8::Unit& u) const {
        const int L = i * G + c; const int total = pref[32] * ntn; if (L >= total) return false;
        const int tile = L / ntn, pnl = L - tile * ntn;
        int e = 0;
        for (int q = 1; q < 32; ++q) if (tile >= pref[q]) e = q;
        const int m = tile - pref[e];
        u.pm = tile; u.pn = e * ntn + pnl; u.ga = e * ECAP + m * 256; u.gn = cnt[e] - m * 256; return true;
    }
};
DI void moe_tables(const Params& p, LAS int* pref, LAS int* cntl, int tid) {
    if (tid == 0) { const unsigned* cnt = (const unsigned*)(p.ws + WS_CTL) + CW_CNT; int acc = 0;
        for (int e = 0; e < 32; ++e) { const int c = (int)__hip_atomic_load(cnt + e, __ATOMIC_RELAXED, __HIP_MEMORY_SCOPE_AGENT); pref[e] = acc; cntl[e] = c; acc += (c + 255) >> 8; }
        pref[32] = acc; }
    __syncthreads();
}

DI void phase8(const Params& p, const LAS int* pref, int lane, int gw, int NGW) {
    const float* MOD = (const float*)(p.ws + WS_MOD); const bf16_t* YB = (const bf16_t*)(p.ws + WS_YBUF);
    for (int m = gw; m < T; m += NGW) {
        const int b = m >> 11; const float* gt2 = MOD + b * 12288 + 5 * 2048;
        const u32x4* rec = (const u32x4*)(p.ws + WS_REC) + (size_t)m * 2;
        const u32x4 r0 = rec[0], r1 = rec[1];
        const size_t row0 = (size_t)(pref[r0.x] * 256 + (int)r0.z), row1 = (size_t)(pref[r0.y] * 256 + (int)r0.w);
        const float w0 = __uint_as_float(r1.x), w1 = __uint_as_float(r1.y);
        float y[32]; float s = 0.f;
#pragma unroll
        for (int j = 0; j < 4; ++j) { const int col = 8 * (lane + 64 * j);
            const u32x4 a = *(const u32x4*)(YB + row0 * DM + col), c = *(const u32x4*)(YB + row1 * DM + col);
            y[8 * j + 0] = w0 * bflo(a.x) + w1 * bflo(c.x); y[8 * j + 1] = w0 * bfhi(a.x) + w1 * bfhi(c.x);
            y[8 * j + 2] = w0 * bflo(a.y) + w1 * bflo(c.y); y[8 * j + 3] = w0 * bfhi(a.y) + w1 * bfhi(c.y);
            y[8 * j + 4] = w0 * bflo(a.z) + w1 * bflo(c.z); y[8 * j + 5] = w0 * bfhi(a.z) + w1 * bfhi(c.z);
            y[8 * j + 6] = w0 * bflo(a.w) + w1 * bflo(c.w); y[8 * j + 7] = w0 * bfhi(a.w) + w1 * bfhi(c.w);
#pragma unroll
            for (int e = 0; e < 8; ++e) s += y[8 * j + e] * y[8 * j + e]; }
        const float rs = rsqrt_(wave_sum(s) * (1.0f / DM) + EPS);
#pragma unroll
        for (int j = 0; j < 4; ++j) { const int col = 8 * (lane + 64 * j);
#pragma unroll
            for (int q = 0; q < 2; ++q) { float* op = p.out + (size_t)m * DM + col + 4 * q;
                const f32x4 x1 = *(const f32x4*)op, g = *(const f32x4*)(p.g_ffn_post + col + 4 * q), gt = *(const f32x4*)(gt2 + col + 4 * q);
                f32x4 o;
                o.x = x1.x + gt.x * (y[8 * j + 4 * q + 0] * rs * g.x); o.y = x1.y + gt.y * (y[8 * j + 4 * q + 1] * rs * g.y);
                o.z = x1.z + gt.z * (y[8 * j + 4 * q + 2] * rs * g.z); o.w = x1.w + gt.w * (y[8 * j + 4 * q + 3] * rs * g.w);
                *(f32x4*)op = o; } }
    }
}

#define XB_TMO      128
#define XB_XCNT(j)  (256  + 64 * (j))
#define XB_XSUB(j)  (1280 + 64 * (j))
#define XB_XGEN(j)  (2304 + 64 * (j))
#define XB_TOP      3328
#define XB_TOPGEN   3392
#define XCD_BAR_WORDS 3456
#define XB_SPIN_CAP (1u << 18)
DI unsigned xb_ld(unsigned* p)              { return __hip_atomic_load(p, __ATOMIC_RELAXED, __HIP_MEMORY_SCOPE_AGENT); }
DI unsigned xb_add(unsigned* p, unsigned v) { return __hip_atomic_fetch_add(p, v, __ATOMIC_RELAXED, __HIP_MEMORY_SCOPE_AGENT); }
DI unsigned xb_xcc_id() { return (unsigned)__builtin_amdgcn_s_getreg((3 << 11) | 20) & 0xFu; }
#define XB_SPIN(cond, bar) do { unsigned _sp = 0; while (cond) { __builtin_amdgcn_s_sleep(1); \
    if ((++_sp & 255u) == 0u) { if (xb_ld(&(bar)[XB_TMO])) break; if (_sp > XB_SPIN_CAP) { atomicAdd(&(bar)[XB_TMO], 1u); break; } } } } while (0)
struct XcdBarrier { unsigned* bar; unsigned x; volatile LAS unsigned* st; };
DI XcdBarrier xcd_barrier_post(unsigned* bar, volatile LAS unsigned* st) {
    XcdBarrier b; b.bar = bar; b.x = xb_xcc_id(); b.st = st;
    if (threadIdx.x == 0) (void)xb_add(&bar[XB_XCNT(b.x)], 1u);
    return b;
}
DI void xcd_barrier_complete(unsigned* bar, unsigned x, unsigned& nloc, unsigned& nx) {
    const unsigned G = gridDim.x * gridDim.y * gridDim.z;
    unsigned sum, cnt, mine, sp = 0u;
    for (;;) {
        sum = 0u; cnt = 0u; mine = 0u;
#pragma unroll
        for (unsigned j = 0; j < 16; ++j) { const unsigned c = xb_ld(&bar[XB_XCNT(j)]); sum += c; cnt += (c > 0u) ? 1u : 0u; mine = (j == x) ? c : mine; }
        if (sum == G) break;
        __builtin_amdgcn_s_sleep(1);
        if ((++sp & 255u) == 0u) { if (xb_ld(&bar[XB_TMO])) break; if (sp > XB_SPIN_CAP) { atomicAdd(&bar[XB_TMO], 1u); break; } }
    }
    nloc = mine > 0u ? mine : 1u; nx = cnt > 0u ? cnt : 1u;
}
DI void xcd_barrier(const XcdBarrier& b) {
    asm volatile("s_waitcnt vmcnt(0)" ::: "memory");
    __syncthreads();
    if (threadIdx.x == 0) {
        unsigned* bar = b.bar;
        __builtin_amdgcn_s_waitcnt(0);
        unsigned nloc = b.st[0], nx = b.st[1];
        if (nloc == 0u) { xcd_barrier_complete(bar, b.x, nloc, nx); b.st[0] = nloc; b.st[1] = nx; }
        const unsigned old = xb_add(&bar[XB_XSUB(b.x)], 1u);
        const unsigned gen = old / nloc;
        if (old + 1u == (gen + 1u) * nloc) {
            __builtin_amdgcn_fence(__ATOMIC_RELEASE, "agent");
            asm volatile("s_waitcnt vmcnt(0)" ::: "memory");
            const unsigned og = xb_add(&bar[XB_TOP], 1u);
            const unsigned tg = og / nx;
            if (og + 1u == (tg + 1u) * nx) xb_add(&bar[XB_TOPGEN], 1u);
            else XB_SPIN(xb_ld(&bar[XB_TOPGEN]) == tg, bar);
            __builtin_amdgcn_fence(__ATOMIC_ACQUIRE, "agent");
            xb_add(&bar[XB_XGEN(b.x)], 1u);
            asm volatile("s_waitcnt vmcnt(0)" ::: "memory");
        } else {
            XB_SPIN(xb_ld(&bar[XB_XGEN(b.x)]) == gen, bar);
            __builtin_amdgcn_fence(__ATOMIC_ACQUIRE, "agent");
            asm volatile("s_waitcnt vmcnt(0)" ::: "memory");
        }
    }
    __syncthreads();
}

constexpr int NWAVES = 8, NTHREADS = 512;
constexpr int LDS_GEMM = 131072, LDS_TAB = 152576, LDS_BYTES = LDS_TAB + 1024;
constexpr int N_PHASES = 12;
#ifndef DBL
#define DBL -1
#endif
#define REP(k) for (int rep_ = 0; rep_ < ((DBL == (k)) ? 2 : 1); ++rep_)
#ifndef MK_N_LAUNCHES
#define MK_N_LAUNCHES 1
#endif

DI moba::BlockRef attn_ref(const Params& p, int bh, int qb) {
    const int b = bh >> 3, h = bh & 7;
    const bf16_t* PROJ = (const bf16_t*)(p.ws + WS_B);
    moba::BlockRef r;
    r.Q = PROJ + (size_t)(b * SEQ + qb * 256) * PP + C_Q + h * HD;
    r.K = PROJ + (size_t)(b * SEQ) * PP + C_K + h * HD;
    r.V = PROJ + (size_t)(b * SEQ) * PP + C_V + h * HD;
    r.O = (bf16_t*)(p.ws + WS_A) + (size_t)(b * SEQ + qb * 256) * DM + h * HD;
    r.KM = (const bf16_t*)(p.ws + WS_KMEAN) + (size_t)bh * 8 * HD;
    r.P0 = qb * 256;
    return r;
}

typedef const __attribute__((address_space(4))) Params* KParams;
#if defined(__HIP_DEVICE_COMPILE__)
#define LOADP() KParams kq_ = kp_; asm volatile("" : "+s"(kq_)); const Params p = *kq_
#else
#define LOADP() const Params p = p_unused
#endif
__global__ void __launch_bounds__(NTHREADS, 2) fwd_kernel(Params p_unused) {
#if defined(__HIP_DEVICE_COMPILE__)
    const KParams kp_ = (KParams)__builtin_amdgcn_kernarg_segment_ptr();
#else
    const Params* kp_ = &p_unused;
#endif
    extern __shared__ __attribute__((aligned(16))) unsigned char lds_raw[];
    LAS unsigned char* lds = (LAS unsigned char*)lds_raw;
    const int bid = blockIdx.x, G = gridDim.x, NGW = G * NWAVES;
#define IDS() int tid_ = threadIdx.x; asm volatile("" : "+v"(tid_)); const int tid = tid_, lane = tid & 63, wave = __builtin_amdgcn_readfirstlane(tid >> 6), gw = bid * NWAVES + wave; (void)lane; (void)gw; (void)wave
    const int vcu = (G % 8 == 0) ? (bid % 8) * (G / 8) + bid / 8 : bid;
    const int lo = kp_->ph_lo, hi = kp_->ph_hi;
#ifdef ONLY
#define IN(k) ((k) == ONLY && lo <= (k) && (k) < hi)
#else
#define IN(k) (lo <= (k) && (k) < hi)
#endif
    { volatile LAS unsigned* st0 = (volatile LAS unsigned*)(lds + LDS_TAB + 512); if (threadIdx.x < 2) st0[threadIdx.x] = 0u; __syncthreads(); }
    XcdBarrier xbar; xbar.bar = (unsigned*)(kp_->ws + WS_CTL) + CW_BAR; xbar.x = 0; xbar.st = (volatile LAS unsigned*)(lds + LDS_TAB + 512);
#define SEAM(k) do { if (IN(k) && IN((k) + 1)) { if ((k) == 0) { cg::this_grid().sync(); xbar = xcd_barrier_post((unsigned*)(kp_->ws + WS_CTL) + CW_BAR, (volatile LAS unsigned*)(lds + LDS_TAB + 512)); } else xcd_barrier(xbar); } } while (0)

    if (IN(0)) { LOADP(); IDS();
        if (bid == 0) { unsigned* ctl = (unsigned*)(p.ws + WS_CTL); for (int i = tid; i < 8192; i += NTHREADS) ctl[i] = 0u; }
        REP(0) phase0(p, lds, tid, lane, wave, bid, G); }
    SEAM(0);
    if (IN(1)) { LOADP(); IDS(); REP(1) for (int it = bid; it < T / 64; it += G) phase_u1_item(p, it, tid, lane, wave); }
    SEAM(1);
    if (IN(2)) { LOADP(); IDS();
        pg8::Gemm g{(const bf16_t*)(p.ws + WS_A), (const bf16_t*)(p.ws + WS_WIN), DM, nullptr};
        pg8::StaticOrder S; S.init(T, NPROJ, G, bid);
        pg8::EpiStore E{(bf16_t*)(p.ws + WS_B), PP, 64};
        pg8::gemm_phase<pg8::EpiStore, pg8::StaticOrder, true, false>(lds, g, S, E);
#if DBL == 2
        pg8::gemm_phase<pg8::EpiStore, pg8::StaticOrder, true, false>(lds, g, S, E);
#endif
    }
    SEAM(2);
    if (IN(3)) { LOADP(); IDS();
        if (wave < 4) { for (int it = bid * 4 + wave; it < 1024; it += G * 4) rotary_item(p, it, lane); }
        REP(30) { dn::Raw R; if (bid < 64 * 32) dn::prep_load(p, bid, R, lane, wave);
            for (int it = bid; it < 64 * 32; it += G) dn::prep_chunk(p, lds, it, (it + G < 64 * 32) ? it + G : -1, R, tid, lane, wave); }
    }
    SEAM(3);
    if (IN(4)) { LOADP(); IDS();
        const int x = bid & 7, ci = bid >> 3, grp = ci >> 3, bhA = 8 * x + 7 - (ci & 7);
        REP(41) { if (grp == 0) dn::recur(p, lds, 8 * x + ci, tid, lane, wave); }
#ifndef NO_ATTN
        REP(40) {
            const int nblk = grp == 0 ? 1 : (grp == 2 ? 3 : 2);
#define QSEL(i) (grp == 0 ? 4 : grp == 1 ? ((i) == 0 ? 7 : 1) : grp == 2 ? ((i) == 0 ? 6 : ((i) == 1 ? 2 : 0)) : ((i) == 0 ? 5 : 3))
            moba::Seam S;
            moba::BlockRef cur = attn_ref(p, bhA, QSEL(0));
            moba::prime(cur, (char*)lds_raw, S);
            for (int i = 0; i < nblk; ++i) {
                const int in = (i + 1 < nblk) ? i + 1 : i;
                const moba::BlockRef nxt = attn_ref(p, bhA, QSEL(in));
                moba::block(cur, nxt, (char*)lds_raw, S);
                cur = nxt;
            }
#undef QSEL
        }
#endif
    }
    SEAM(4);
    if (IN(6)) { LOADP(); IDS();
        pg8::Gemm g{(const bf16_t*)(p.ws + WS_A), (const bf16_t*)(p.ws + WS_WMD), DM, nullptr};
        pg8::StaticOrder S; S.init(T, DM, G, bid);
        pg8::EpiMerged E{(const bf16_t*)(p.ws + WS_B), (bf16_t*)(p.ws + WS_MERGED)};
        pg8::gemm_phase<pg8::EpiMerged, pg8::StaticOrder, true, false>(lds, g, S, E);
#if DBL == 6
        pg8::gemm_phase<pg8::EpiMerged, pg8::StaticOrder, true, false>(lds, g, S, E);
#endif
    }
    SEAM(6);
    if (IN(7)) { LOADP(); IDS();
        const bool copy_first = ((bid >> 3) & 1) == 0;
        LAS float* scr = (LAS float*)(lds + wave * 8448);
        if (copy_first) { REP(81) for (int it = gw; it < 32 * 1024; it += NGW) expert_copy_gu(p, it, scr, lane); __syncthreads(); }
        {
        pg8::Gemm g{(const bf16_t*)(p.ws + WS_MERGED), (const bf16_t*)(p.ws + WS_WOUT), DM, nullptr};
        pg8::StaticOrder S; S.init(T, DM, G, bid);
        pg8::EpiStore E{(bf16_t*)(p.ws + WS_OUTMIX), DM, 8};
        pg8::gemm_phase<pg8::EpiStore, pg8::StaticOrder, true, false>(lds, g, S, E);
#if DBL == 7
        pg8::gemm_phase<pg8::EpiStore, pg8::StaticOrder, true, false>(lds, g, S, E);
#endif
        }
        if (!copy_first) { REP(81) for (int it = gw; it < 32 * 1024; it += NGW) expert_copy_gu(p, it, scr, lane); }
    }
    SEAM(7);
    if (IN(8)) { LOADP(); IDS();
        for (int it = bid; it < T / 64; it += G) phase5_item(p, lds, it, tid, lane, wave);
    }
    SEAM(8);
    LAS int* pref = (LAS int*)(lds + LDS_TAB); LAS int* cntl = pref + 64;
    if (IN(9)) { LOADP(); IDS();
        moe_tables(p, pref, cntl, tid);
        pg8::Gemm g{(const bf16_t*)(p.ws + WS_A), (const bf16_t*)(p.ws + WS_WGU), DM, (const int*)(p.ws + WS_RTOK)};
        MoeOrder S{pref, cntl, 4, G, bid};
        pg8::EpiGU E{(bf16_t*)(p.ws + WS_H)};
        pg8::gemm_phase<pg8::EpiGU, MoeOrder, true, true>(lds, g, S, E);
#if DBL == 9
        pg8::gemm_phase<pg8::EpiGU, MoeOrder, true, true>(lds, g, S, E);
#endif
        {   const int total = pref[32] * 4, rem = total % G, ncw = rem ? G - rem : G, cw = rem ? bid - rem : bid;
            if (cw >= 0) { LAS float* scr = (LAS float*)(lds + wave * 8448);
                for (int it = cw * NWAVES + wave; it < 32 * 512; it += ncw * NWAVES) expert_copy_dn(p, it, scr, lane); }
        }
    }
    SEAM(9);
    if (IN(10)) { LOADP(); IDS();
        if (!IN(9)) moe_tables(p, pref, cntl, tid);
        pg8::Gemm g{(const bf16_t*)(p.ws + WS_H), (const bf16_t*)(p.ws + WS_WDN), FF, nullptr};
        MoeOrder S{pref, cntl, 8, G, bid};
        pg8::EpiStore E{(bf16_t*)(p.ws + WS_YBUF), DM, 8};
        pg8::gemm_phase<pg8::EpiStore, MoeOrder, true, false>(lds, g, S, E);
#if DBL == 10
        pg8::gemm_phase<pg8::EpiStore, MoeOrder, true, false>(lds, g, S, E);
#endif
    }
    SEAM(10);
    if (IN(11)) { LOADP(); IDS();
        if (!IN(10)) moe_tables(p, pref, cntl, tid);
        phase8(p, pref, lane, gw, NGW);
    }
#undef IN
#undef SEAM
}

extern "C" void kernel_launch(void* const* d_in, const int* in_sizes, int n_in, void* d_out, int out_size, void* d_ws, size_t ws_size, hipStream_t stream) {
    static int grid = 0;
    if (grid == 0) {
        if (n_in != 24 || in_sizes[0] != T * DM || out_size != T * DM || ws_size < WS_END) {
            fprintf(stderr, "kernel_launch: unexpected shapes (n_in %d, in0 %d, out %d, ws %zu); nothing launched\n", n_in, n_in > 0 ? in_sizes[0] : -1, out_size, ws_size); grid = -1; return; }
        int dev = 0, cus = 0, per_cu = 0;
        hipGetDevice(&dev); hipDeviceGetAttribute(&cus, hipDeviceAttributeMultiprocessorCount, dev);
        if (hipFuncSetAttribute((const void*)fwd_kernel, hipFuncAttributeMaxDynamicSharedMemorySize, LDS_BYTES) != hipSuccess) { fprintf(stderr, "kernel_launch: hipFuncSetAttribute failed\n"); grid = -1; return; }
        if (hipOccupancyMaxActiveBlocksPerMultiprocessor(&per_cu, (const void*)fwd_kernel, NTHREADS, LDS_BYTES) != hipSuccess || per_cu < 1) { fprintf(stderr, "kernel_launch: occupancy query says %d blocks per CU\n", per_cu); grid = -1; return; }
        (void)hipGetLastError();
        grid = cus;
        if (cus != 256) { fprintf(stderr, "kernel_launch: built for a 256-CU device (static phase schedules), found %d CUs; nothing launched\n", cus); grid = -1; return; }
    }
    if (grid < 0) return;
    Params p{};
    p.x = (const float*)d_in[0]; p.c = (const float*)d_in[1]; p.pos = (const int*)d_in[2]; p.w_ada = (const float*)d_in[3]; p.b_ada = (const float*)d_in[4];
    p.g_mix_pre = (const float*)d_in[5]; p.g_mix_post = (const float*)d_in[6]; p.g_ffn_pre = (const float*)d_in[7]; p.g_ffn_post = (const float*)d_in[8];
    p.w_in = (const float*)d_in[9]; p.conv_w = (const float*)d_in[10]; p.a_log = (const float*)d_in[11]; p.dt_bias = (const float*)d_in[12]; p.dn_gain = (const float*)d_in[13];
    p.w_bm = (const float*)d_in[14]; p.w_bd = (const float*)d_in[15]; p.w_out = (const float*)d_in[16];
    p.w_rg = (const float*)d_in[17]; p.b_rg = (const float*)d_in[18]; p.w_re = (const float*)d_in[19]; p.b_re = (const float*)d_in[20];
    p.w_gate = (const float*)d_in[21]; p.w_up = (const float*)d_in[22]; p.w_down = (const float*)d_in[23];
    p.out = (float*)d_out; p.ws = (unsigned char*)d_ws;
    for (int li = 0; li < MK_N_LAUNCHES; ++li) {
        p.ph_lo = (MK_N_LAUNCHES == 1) ? 0 : li; p.ph_hi = (MK_N_LAUNCHES == 1) ? N_PHASES : li + 1;
        void* args[] = {&p};
        hipError_t e = hipLaunchCooperativeKernel((const void*)fwd_kernel, dim3(grid), dim3(NTHREADS), args, LDS_BYTES, stream);
        if (e != hipSuccess) { fprintf(stderr, "kernel_launch: cooperative launch failed: %s (grid %d)\n", hipGetErrorString(e), grid); break; }
    }
}
```

```cpp
#include <hip/hip_runtime.h>
#include <hip/hip_cooperative_groups.h>
#include <cstdio>
#include <cstdint>
namespace cg = cooperative_groups;

#define LAS __attribute__((address_space(3)))
#define DI __device__ __forceinline__
typedef unsigned short bf16_t;
typedef short bf16x8 __attribute__((ext_vector_type(8)));
typedef short s16x4 __attribute__((ext_vector_type(4)));
typedef float f32x2 __attribute__((ext_vector_type(2)));
typedef float f32x4 __attribute__((ext_vector_type(4)));
typedef float f32x16 __attribute__((ext_vector_type(16)));
typedef unsigned u32x2 __attribute__((ext_vector_type(2)));
typedef unsigned u32x4 __attribute__((ext_vector_type(4)));
typedef __bf16 bf16x2_t __attribute__((ext_vector_type(2)));

constexpr int NB = 8, SEQ = 2048, T = NB * SEQ, DM = 2048;
constexpr int NHEAD = 8, HD = 128;
constexpr int PP = 11264;
constexpr int NPROJ = 11264;
constexpr int C_Q = 0, C_K = 1024, C_V = 2048, C_DN = 3072, C_Z = 6144, C_GA = 7168, C_GB = 9216;
constexpr int NEXP = 32, FF = 512, ECAP = 16384;
constexpr float EPS = 1e-6f;

constexpr size_t MiB = 1u << 20;
constexpr size_t WS_CTL = 0, CTL_ZERO_BYTES = 1 * MiB;
constexpr size_t WS_MOD = 1 * MiB;
constexpr size_t WS_CS = 2 * MiB;
constexpr size_t WS_KMEAN = 4 * MiB;
constexpr size_t WS_WR = 4 * MiB + 512 * 1024;
constexpr size_t WS_WBA = 4 * MiB + 768 * 1024;
constexpr size_t WS_BA = 5 * MiB;
constexpr size_t WS_REC = 6 * MiB;
constexpr size_t WS_RTOK = 7 * MiB;
constexpr size_t WS_WMD = 10 * MiB;
constexpr size_t WS_WOUT = 18 * MiB;
constexpr size_t WS_A = 26 * MiB;
constexpr size_t WS_B = 90 * MiB;
constexpr size_t WS_C = 442 * MiB;
constexpr size_t WS_D = 588 * MiB;
constexpr size_t WS_END = 652 * MiB;
constexpr size_t WS_OUTMIX = WS_B, WS_WGU = WS_B + 128 * MiB, WS_WDN = WS_B + 256 * MiB, WS_YBUF = WS_B;
constexpr size_t WS_WIN = WS_C, WS_DNP = WS_C, WS_MERGED = WS_C, WS_H = WS_C + 64 * MiB;
constexpr int CW_CNT = 64;
constexpr int CW_BAR = 4096;
constexpr int DN_U = 0, DN_W = 16384, DN_QD = 32768, DN_KT = 49152, DN_QK = 65536, DN_SC = 73728, DN_STRIDE = 73984;

struct Params {
    const float* x; const float* c; const int* pos; const float* w_ada; const float* b_ada;
    const float* g_mix_pre; const float* g_mix_post; const float* g_ffn_pre; const float* g_ffn_post;
    const float* w_in; const float* conv_w; const float* a_log; const float* dt_bias; const float* dn_gain;
    const float* w_bm; const float* w_bd; const float* w_out;
    const float* w_rg; const float* b_rg; const float* w_re; const float* b_re;
    const float* w_gate; const float* w_up; const float* w_down;
    float* out; unsigned char* ws;
    int ph_lo, ph_hi;
};

DI unsigned cvtpk(float lo, float hi) { f32x2 v = {lo, hi}; bf16x2_t b = __builtin_convertvector(v, bf16x2_t); return __builtin_bit_cast(unsigned, b); }
DI float bflo(unsigned w) { return __uint_as_float(w << 16); }
DI float bfhi(unsigned w) { return __uint_as_float(w & 0xffff0000u); }
DI float bf2f(bf16_t b) { return __uint_as_float((unsigned)b << 16); }
DI bf16_t f2bf(float f) { return (bf16_t)(cvtpk(f, 0.f) & 0xffffu); }
DI float wave_sum(float v) {
#pragma unroll
    for (int o = 1; o < 64; o <<= 1) v += __shfl_xor(v, o);
    return v;
}
DI float sigmoidf_(float x) { return __builtin_amdgcn_rcpf(1.f + __expf(-x)); }
DI float siluf_(float x) { return x * __builtin_amdgcn_rcpf(1.f + __expf(-x)); }
DI float rsqrt_(float x) { return __builtin_amdgcn_rsqf(x); }
DI float siluf_acc(float x) { return x / (1.f + expf(-x)); }
constexpr float SCALE_Q = 0.08838834764831845f;
DI int perm16(int p) { return (p & 3) | ((p & 4) << 1) | ((p & 8) >> 1); }
DI int crow(int r, int hi) { return (r & 3) + 8 * (r >> 2) + 4 * hi; }
#define MFMA32(a, b, c) __builtin_amdgcn_mfma_f32_32x32x16_bf16((a), (b), (c), 0, 0, 0)
#define MFMA16(a, b, c) __builtin_amdgcn_mfma_f32_16x16x32_bf16((a), (b), (c), 0, 0, 0)

namespace pg8 {
constexpr int BM = 256, BK = 64, HALF = 128, HTB = HALF * BK * 2, STAGE_BYTES = 8 * HTB, NXCD = 8, WGM = 8;
DI int lds_byte(int r, int c) { const int st = (r >> 4) * 2 + (c >> 5), rr = r & 15, cc = c & 31, ob = rr * 64 + cc * 2; return st * 1024 + (ob ^ (((ob >> 9) & 1) << 5)); }
DI void stage_rc(int b, int& R, int& C) { const int st = b / 1024, sb = b % 1024, swz = sb ^ (((sb >> 9) & 1) << 5); R = (st >> 1) * 16 + swz / 64; C = (st & 1) * 32 + (swz % 64) / 2; }
DI int perm32(int rho) { const int n = rho >> 4, i = rho & 15; return 8 * (i >> 2) + 4 * n + (i & 3); }

struct Unit { int pm, pn, ga, gn; };
struct Gemm { const bf16_t* A; const bf16_t* Bt; int K; const int* gidx; };

struct StaticOrder {
    int nM, nN, nwg, G, c;
    DI void init(int M, int N, int G_, int c_) { nM = M / BM; nN = N / BM; nwg = nM * nN; G = G_; c = c_; }
    DI bool next(int i, Unit& u) const {
        const long L = (long)i * G + c; if (L >= nwg) return false;
        int wgid = (int)L; { const int q = nwg / NXCD, r = nwg % NXCD, xcd = wgid % NXCD, off = wgid / NXCD; wgid = (xcd < r ? xcd * (q + 1) : r * (q + 1) + (xcd - r) * q) + off; }
        const int nig = WGM * nN, gid = wgid / nig, fm = gid * WGM, gsz = (nM - fm) < WGM ? (nM - fm) : WGM;
        u.pm = fm + ((wgid % nig) % gsz); u.pn = (wgid % nig) / gsz; u.ga = 0; u.gn = 0; return true;
    }
};

typedef f32x4 Acc[2][2][4][2];

template <class Epi, class Sched, bool ALIGN_EPI, bool GATHER>
DI void gemm_phase(LAS unsigned char* lds, const Gemm g, const Sched& S, const Epi& E) {
    const int tid = threadIdx.x, wid = __builtin_amdgcn_readfirstlane(tid >> 6), lane = tid & 63, wr = wid >> 2, wc = wid & 3, fr = lane & 15, fq = lane >> 4;
    const int K = g.K, nt = K / BK;
    unsigned voffA[2], voffB[2]; int gR[2], gC[2];
#pragma unroll
    for (int i = 0; i < 2; ++i) { int R, C; stage_rc(tid * 16 + i * 8192, R, C); const int Rb = (R & ~31) + perm32(R & 31);
        voffA[i] = (unsigned)(R * K + C) * 2u; voffB[i] = (unsigned)(Rb * K + C) * 2u; gR[i] = R; gC[i] = C; }
    const size_t kstep = (size_t)(BK * 2);
    const size_t hstep = (size_t)HALF * K * 2;
    const size_t tstep = 2 * hstep;
    const unsigned ldsw = (unsigned)wid * 1024u;
    const int aoff = lds_byte(wr * 64 + fr, fq * 8), boff = lds_byte(wc * 32 + fr, fq * 8);
#define PG8_SA(b, h) (((b) * 2 + (h)) * HTB)
#define PG8_SB(b, h) ((4 + (b) * 2 + (h)) * HTB)
#define PG8_STAGE(bufoff, gbase, voff) do { _Pragma("unroll") for (int _i = 0; _i < 2; ++_i) \
        __builtin_amdgcn_global_load_lds((const unsigned*)((const char*)(gbase) + (voff)[_i]), (LAS unsigned*)(lds + (bufoff) + ldsw + _i * 8192), 16, 0, 0); } while (0)
#define PG8_LDA(dst, b, h) do { _Pragma("unroll") for (int m = 0; m < 4; ++m) _Pragma("unroll") for (int k = 0; k < 2; ++k) dst[m][k] = *(const LAS bf16x8*)(lds + PG8_SA(b, h) + aoff + m * 2048 + k * 1024); } while (0)
#define PG8_LDB(dst, b, h) do { _Pragma("unroll") for (int n = 0; n < 2; ++n) _Pragma("unroll") for (int k = 0; k < 2; ++k) dst[n][k] = *(const LAS bf16x8*)(lds + PG8_SB(b, h) + boff + n * 2048 + k * 1024); } while (0)
#define PG8_MMA(ai, bj, At, Bt) do { __builtin_amdgcn_s_setprio(1); _Pragma("unroll") for (int m = 0; m < 4; ++m) _Pragma("unroll") for (int n = 0; n < 2; ++n) _Pragma("unroll") for (int k = 0; k < 2; ++k) \
        acc[ai][bj][m][n] = __builtin_amdgcn_mfma_f32_16x16x32_bf16(Bt[n][k], At[m][k], acc[ai][bj][m][n], 0, 0, 0); __builtin_amdgcn_s_setprio(0); } while (0)
#define PG8_WAIT_V(n) asm volatile("s_waitcnt vmcnt(" #n ")" ::: "memory")
#define PG8_WAIT_L(n) asm volatile("s_waitcnt lgkmcnt(" #n ")" ::: "memory")
#define PG8_BAR __builtin_amdgcn_s_barrier()
#define PG8_SCHED __builtin_amdgcn_sched_barrier(0)
    Unit cur, nxt; int ui = 0;
    if (!S.next(0, cur)) return;
    Acc acc;
#pragma unroll
    for (int a = 0; a < 2; ++a)
#pragma unroll
        for (int b = 0; b < 2; ++b)
#pragma unroll
            for (int m = 0; m < 4; ++m)
#pragma unroll
                for (int n = 0; n < 2; ++n) acc[a][b][m][n] = (f32x4){0.f, 0.f, 0.f, 0.f};
    bf16x8 At[4][2], B0[2][2], B1[2][2];
    unsigned vA0[2], vA1[2];
#define PG8_SET_VOFF(u) do { if constexpr (GATHER) { _Pragma("unroll") for (int _i = 0; _i < 2; ++_i) { \
                const int _r0 = gR[_i], _r1 = HALF + gR[_i]; \
                const int _t0 = _r0 < (u).gn ? g.gidx[(u).ga + _r0] : 0, _t1 = _r1 < (u).gn ? g.gidx[(u).ga + _r1] : 0; \
                vA0[_i] = (unsigned)(_t0 * K + gC[_i]) * 2u; vA1[_i] = (unsigned)(_t1 * K + gC[_i]) * 2u; } \
        } else { vA0[0] = voffA[0]; vA0[1] = voffA[1]; vA1[0] = voffA[0] + (unsigned)hstep; vA1[1] = voffA[1] + (unsigned)hstep; } } while (0)
    PG8_SET_VOFF(cur);
    const char* cA = GATHER ? (const char*)g.A : (const char*)g.A + (size_t)cur.pm * tstep; const char* cB = (const char*)g.Bt + (size_t)cur.pn * tstep;
    PG8_STAGE(PG8_SB(0, 0), cB, voffB); PG8_STAGE(PG8_SB(0, 1), cB + hstep, voffB); PG8_STAGE(PG8_SA(0, 0), cA, vA0); PG8_STAGE(PG8_SA(0, 1), cA, vA1);
    if (wr == 1) PG8_BAR;
    PG8_WAIT_V(2); PG8_BAR;
    PG8_STAGE(PG8_SB(1, 0), cB + kstep, voffB); PG8_STAGE(PG8_SA(1, 0), cA + kstep, vA0); PG8_STAGE(PG8_SB(1, 1), cB + hstep + kstep, voffB);
    PG8_WAIT_V(6); PG8_BAR;
    for (;;) {
        const bool has_next = S.next(ui + 1, nxt);
        const char* nA = GATHER ? (const char*)g.A : (has_next ? (const char*)g.A + (size_t)nxt.pm * tstep : cA);
        const char* nB = has_next ? (const char*)g.Bt + (size_t)nxt.pn * tstep : cB;
#define PG8_KTRIP(t) do { \
            const bool last = (t == nt - 2); \
            const char* a1 = cA + (size_t)(t + 1) * kstep; \
            const char* a2 = last ? nA : cA + (size_t)(t + 2) * kstep; const char* b2 = last ? nB : cB + (size_t)(t + 2) * kstep; \
            const char* a3 = a2 + kstep; const char* b3 = b2 + kstep; \
            PG8_LDB(B0, 0, 0); PG8_LDB(B1, 0, 1); PG8_SCHED; PG8_LDA(At, 0, 0); PG8_STAGE(PG8_SA(1, 1), a1, vA1); \
            PG8_WAIT_V(8); PG8_WAIT_L(0); PG8_BAR; PG8_MMA(0, 0, At, B0); PG8_MMA(0, 1, At, B1); PG8_BAR; PG8_SCHED; \
            if constexpr (GATHER) { if (last && has_next) PG8_SET_VOFF(nxt); } \
            PG8_LDA(At, 0, 1); PG8_STAGE(PG8_SB(0, 0), b2, voffB); PG8_STAGE(PG8_SB(0, 1), b2 + hstep, voffB); PG8_STAGE(PG8_SA(0, 0), a2, vA0); \
            PG8_WAIT_V(8); PG8_WAIT_L(0); PG8_BAR; PG8_MMA(1, 0, At, B0); PG8_MMA(1, 1, At, B1); PG8_BAR; PG8_SCHED; \
            PG8_LDB(B0, 1, 0); PG8_LDB(B1, 1, 1); PG8_SCHED; PG8_LDA(At, 1, 0); PG8_STAGE(PG8_SA(0, 1), a2, vA1); \
            PG8_WAIT_V(8); PG8_WAIT_L(0); PG8_BAR; PG8_MMA(0, 0, At, B0); PG8_MMA(0, 1, At, B1); PG8_BAR; PG8_SCHED; \
            PG8_LDA(At, 1, 1); PG8_STAGE(PG8_SB(1, 0), b3, voffB); PG8_STAGE(PG8_SB(1, 1), b3 + hstep, voffB); PG8_STAGE(PG8_SA(1, 0), a3, vA0); \
            PG8_WAIT_V(8); PG8_WAIT_L(0); PG8_BAR; PG8_MMA(1, 0, At, B0); PG8_MMA(1, 1, At, B1); PG8_BAR; PG8_SCHED; \
        } while (0)
        if constexpr (Epi::HAS_MID) {
            for (int t = 0; t < (nt >> 1); t += 2) PG8_KTRIP(t);
            E.mid(acc, cur, wr, wc, fr, fq);
            for (int t = (nt >> 1); t < nt; t += 2) PG8_KTRIP(t);
        } else {
            for (int t = 0; t < nt; t += 2) PG8_KTRIP(t);
        }
#undef PG8_KTRIP
        if constexpr (ALIGN_EPI) { if (wr == 0) PG8_BAR; }
        E(acc, cur, wr, wc, fr, fq);
#if defined(DBL) && DBL == 20
        E(acc, cur, wr, wc, fr, fq);
#endif
        if (!has_next) break;
#pragma unroll
        for (int a = 0; a < 2; ++a)
#pragma unroll
            for (int b = 0; b < 2; ++b)
#pragma unroll
                for (int m = 0; m < 4; ++m)
#pragma unroll
                    for (int n = 0; n < 2; ++n) acc[a][b][m][n] = (f32x4){0.f, 0.f, 0.f, 0.f};
        cur = nxt; cA = nA; cB = nB; ++ui;
        if constexpr (ALIGN_EPI) { if (wr == 1) PG8_BAR; }
    }
    PG8_WAIT_V(0);
    if constexpr (!ALIGN_EPI) { if (wr == 0) PG8_BAR; }
    PG8_BAR;
#undef PG8_SET_VOFF
#undef PG8_SA
#undef PG8_SB
#undef PG8_STAGE
#undef PG8_LDA
#undef PG8_LDB
#undef PG8_MMA
#undef PG8_WAIT_V
#undef PG8_WAIT_L
#undef PG8_BAR
#undef PG8_SCHED
}

struct EpiStore {
    static constexpr bool HAS_MID = false;
    bf16_t* O; int ldc; int ntn;
    DI void operator()(const Acc& acc, const Unit& u, int wr, int wc, int fr, int fq) const {
        const int row0 = u.pm * BM + wr * 64 + fr, col0 = (u.pn % ntn) * BM + wc * 32 + 8 * fq;
#pragma unroll
        for (int ai = 0; ai < 2; ++ai)
#pragma unroll
            for (int m = 0; m < 4; ++m) { bf16_t* rowp = O + (size_t)(row0 + ai * HALF + m * 16) * ldc + col0;
#pragma unroll
                for (int bj = 0; bj < 2; ++bj) { const f32x4 v0 = acc[ai][bj][m][0], v1 = acc[ai][bj][m][1];
                    u32x4 w; w.x = cvtpk(v0[0], v0[1]); w.y = cvtpk(v0[2], v0[3]); w.z = cvtpk(v1[0], v1[1]); w.w = cvtpk(v1[2], v1[3]);
                    *(u32x4*)(rowp + bj * HALF) = w; } }
    }
};
struct EpiMerged {
    static constexpr bool HAS_MID = true;
    const bf16_t* P; bf16_t* O;
    DI void mid(Acc& acc, const Unit& u, int wr, int wc, int fr, int fq) const {
        const unsigned ro = (unsigned)((u.pm * BM + wr * 64 + fr) * PP + u.pn * BM + wc * 32 + 8 * fq);
#pragma unroll
        for (int ai = 0; ai < 2; ++ai)
#pragma unroll
            for (int m = 0; m < 4; ++m) {
#pragma unroll
                for (int bj = 0; bj < 2; ++bj) { const unsigned off = ro + (unsigned)((ai * HALF + m * 16) * PP + bj * HALF);
                    const u32x4 a = *(const u32x4*)(P + off + C_GA), b = *(const u32x4*)(P + off + C_GB);
                    float ga[8] = {bflo(a.x), bfhi(a.x), bflo(a.y), bfhi(a.y), bflo(a.z), bfhi(a.z), bflo(a.w), bfhi(a.w)};
                    float gb[8] = {bflo(b.x), bfhi(b.x), bflo(b.y), bfhi(b.y), bflo(b.z), bfhi(b.z), bflo(b.w), bfhi(b.w)};
#pragma unroll
                    for (int n = 0; n < 2; ++n)
#pragma unroll
                        for (int j = 0; j < 4; ++j) { const float r = (1.f + __expf(-gb[4 * n + j])) * __builtin_amdgcn_rcpf(1.f + __expf(-ga[4 * n + j])); acc[ai][bj][m][n][j] *= r; } }
                asm volatile("" ::: "memory"); __builtin_amdgcn_sched_barrier(0); }
    }
    DI void operator()(const Acc& acc, const Unit& u, int wr, int wc, int fr, int fq) const {
        const unsigned ro = (unsigned)((u.pm * BM + wr * 64 + fr) * PP + u.pn * BM + wc * 32 + 8 * fq);
        const unsigned oo = (unsigned)((u.pm * BM + wr * 64 + fr) * DM + u.pn * BM + wc * 32 + 8 * fq);
#pragma unroll
        for (int ai = 0; ai < 2; ++ai)
#pragma unroll
            for (int m = 0; m < 4; ++m) {
#pragma unroll
                for (int bj = 0; bj < 2; ++bj) { const u32x4 b = *(const u32x4*)(P + ro + (unsigned)((ai * HALF + m * 16) * PP + bj * HALF) + C_GB);
                    float gb[8] = {bflo(b.x), bfhi(b.x), bflo(b.y), bfhi(b.y), bflo(b.z), bfhi(b.z), bflo(b.w), bfhi(b.w)};
                    float v[8];
#pragma unroll
                    for (int n = 0; n < 2; ++n)
#pragma unroll
                        for (int j = 0; j < 4; ++j) v[4 * n + j] = acc[ai][bj][m][n][j] * __builtin_amdgcn_rcpf(1.f + __expf(-gb[4 * n + j]));
                    u32x4 w; w.x = cvtpk(v[0], v[1]); w.y = cvtpk(v[2], v[3]); w.z = cvtpk(v[4], v[5]); w.w = cvtpk(v[6], v[7]);
                    *(u32x4*)(O + oo + (unsigned)((ai * HALF + m * 16) * DM + bj * HALF)) = w; }
                asm volatile("" ::: "memory"); __builtin_amdgcn_sched_barrier(0); }
    }
};
struct EpiGU {
    static constexpr bool HAS_MID = false;
    bf16_t* H;
    DI void operator()(const Acc& acc, const Unit& u, int wr, int wc, int fr, int fq) const {
        const int row0 = u.pm * BM + wr * 64 + fr, col0 = (u.pn & 3) * HALF + wc * 32 + 8 * fq;
#pragma unroll
        for (int ai = 0; ai < 2; ++ai)
#pragma unroll
            for (int m = 0; m < 4; ++m) { float v[8];
#pragma unroll
                for (int n = 0; n < 2; ++n)
#pragma unroll
                    for (int j = 0; j < 4; ++j) v[4 * n + j] = siluf_(acc[ai][0][m][n][j]) * acc[ai][1][m][n][j];
                u32x4 w; w.x = cvtpk(v[0], v[1]); w.y = cvtpk(v[2], v[3]); w.z = cvtpk(v[4], v[5]); w.w = cvtpk(v[6], v[7]);
                *(u32x4*)(H + (size_t)(row0 + ai * HALF + m * 16) * FF + col0) = w; }
    }
};
}

namespace moba {
constexpr int NW = 8, QBLK = 32, KVBLK = 64, QB = NW * QBLK, D = 128;
constexpr int RS = PP;
constexpr int RSO = DM;
constexpr float SCALE = 0.08838834764831845f;
constexpr float THR = 8.f;
constexpr int SHM_V = KVBLK * D * 2, SHM_K = KVBLK * D * 2;
constexpr int LDS_BYTES = 2 * SHM_V + 2 * SHM_K + NW * 64 * 4;
typedef bf16_t bf16;
#define KSWZ(row, colB) ((row) * 256 + ((colB) ^ (((row) & 7) << 4)))
#define SBAR() __builtin_amdgcn_sched_barrier(0)
DI int v_st(int k, int c) { const int kk = (k & ~0xC) | ((k & 4) << 1) | ((k & 8) >> 1); return ((kk >> 3) * 4 + (c >> 5)) * 512 + ((kk & 7) * 32 + (c & 31)) * 2; }
DI int v_rd_base(int lane) { return ((lane & 3) << 3) | (((lane >> 2) & 3) << 6) | (((lane >> 4) & 1) << 5) | (((lane >> 5) & 1) << 8); }
constexpr int v_rd_off(int d0, int ks, int half) { return d0 * 512 + ks * 4096 + half * 2048; }
DI bf16x8 load8(const bf16* p) { return *reinterpret_cast<const bf16x8*>(p); }
DI void mask_tile(f32x16& p0, f32x16& p1, int dq) {
    const float NEG = -__builtin_inff();
#pragma unroll
    for (int r = 0; r < 16; ++r) {
        const int c = (r & 3) + 8 * (r >> 2);
        if (dq - c < 0) p0[r] = NEG;
        if (dq - c - 32 < 0) p1[r] = NEG;
    }
}
DI void mask_all(f32x16& p0, f32x16& p1, bool kill) {
    const float NEG = -__builtin_inff();
#pragma unroll
    for (int r = 0; r < 16; ++r) { if (kill) p0[r] = NEG; if (kill) p1[r] = NEG; }
}
DI void partialSM(f32x16& p0, f32x16& p1, float& m_reg, float& mn, float& alpha) {
    float pmax = p0[0];
#pragma unroll
    for (int r = 1; r < 16; ++r) pmax = fmaxf(pmax, p0[r]);
#pragma unroll
    for (int r = 0; r < 16; ++r) pmax = fmaxf(pmax, p1[r]);
    { auto rr = __builtin_amdgcn_permlane32_swap(__float_as_uint(pmax), __float_as_uint(pmax), false, false);
      pmax = fmaxf(__uint_as_float(rr[0]), __uint_as_float(rr[1])); }
    constexpr float C2 = 1.4426950408889634f * SCALE;
    if (__builtin_expect(__all((pmax - m_reg) * SCALE <= THR), 1)) { mn = m_reg; alpha = 1.f; }
    else { mn = fmaxf(m_reg, pmax); alpha = __builtin_amdgcn_exp2f((m_reg - mn) * C2); m_reg = mn; }
    const float mnL = -mn * C2;
#pragma unroll
    for (int r = 0; r < 16; ++r) p0[r] = fmaf(p0[r], C2, mnL);
#pragma unroll
    for (int r = 0; r < 16; ++r) p1[r] = fmaf(p1[r], C2, mnL);
#pragma unroll
    for (int r = 0; r < 16; ++r) p0[r] = __builtin_amdgcn_exp2f(p0[r]);
}
DI void finishSM(f32x16& p0, f32x16& p1, float alpha, float& l_reg, bf16x8& pa0, bf16x8& pa1, bf16x8& pa2, bf16x8& pa3) {
#pragma unroll
    for (int r = 0; r < 16; ++r) p1[r] = __builtin_amdgcn_exp2f(p1[r]);
    float ps = 0;
#pragma unroll
    for (int r = 0; r < 16; ++r) ps += p0[r];
#pragma unroll
    for (int r = 0; r < 16; ++r) ps += p1[r];
    { auto rr = __builtin_amdgcn_permlane32_swap(__float_as_uint(ps), __float_as_uint(ps), false, false);
      ps = __uint_as_float(rr[0]) + __uint_as_float(rr[1]); }
    l_reg = l_reg * alpha + ps;
#define PK4(P, B_, OUT) do { unsigned a0 = cvtpk(P[B_+0], P[B_+1]), a1 = cvtpk(P[B_+2], P[B_+3]);                          \
        unsigned b0 = cvtpk(P[B_+4], P[B_+5]), b1 = cvtpk(P[B_+6], P[B_+7]);                                             \
        auto r0 = __builtin_amdgcn_permlane32_swap(a0, b0, false, false); auto r1 = __builtin_amdgcn_permlane32_swap(a1, b1, false, false); \
        u32x4 w = {r0[0], r1[0], r0[1], r1[1]}; OUT = __builtin_bit_cast(bf16x8, w); } while (0)
    PK4(p0, 0, pa0); PK4(p0, 8, pa1); PK4(p1, 0, pa2); PK4(p1, 8, pa3);
#undef PK4
}
template <int KB>
DI void qkt(f32x16& p0, f32x16& p1, const char* K_lds, int r32, int hi, const bf16x8* qr) {
    p0 = f32x16{}; p1 = f32x16{};
    const char* kb[4];
#pragma unroll
    for (int dd = 0; dd < 4; ++dd) kb[dd] = K_lds + KB * SHM_K + KSWZ(r32, (dd * 16 + hi * 8) * 2);
#pragma unroll
    for (int d0 = 0; d0 < 8; ++d0) { const char* a = kb[d0 & 3] + (d0 >> 2) * 128;
        bf16x8 b0 = *reinterpret_cast<const bf16x8*>(a);
        bf16x8 b1 = *reinterpret_cast<const bf16x8*>(a + 32 * 256);
        p0 = MFMA32(b0, qr[d0], p0);
        p1 = MFMA32(b1, qr[d0], p1); }
}
template <int VB>
DI void pv_tile(f32x16* o, int vb0, bf16x8 pa0, bf16x8 pa1, bf16x8 pa2, bf16x8 pa3) {
#define TRRD(dst, off) asm volatile("ds_read_b64_tr_b16 %0, %1 offset:%2" : "=&v"(dst) : "v"(vb0), "i"(off) : "memory")
#define PV_D0(d0) do { s16x4 l0, l1, l2, l3, h0, h1, h2, h3; constexpr int b_ = VB * SHM_V + v_rd_off(d0, 0, 0); \
        TRRD(l0, b_); TRRD(h0, b_ + 2048); TRRD(l1, b_ + 4096); TRRD(h1, b_ + 6144); TRRD(l2, b_ + 8192); TRRD(h2, b_ + 10240); TRRD(l3, b_ + 12288); TRRD(h3, b_ + 14336); \
        asm volatile("s_waitcnt lgkmcnt(0)" ::: "memory"); SBAR();   \
        o[d0] = MFMA32(pa0, ((bf16x8){l0[0], l0[1], l0[2], l0[3], h0[0], h0[1], h0[2], h0[3]}), o[d0]);   \
        o[d0] = MFMA32(pa1, ((bf16x8){l1[0], l1[1], l1[2], l1[3], h1[0], h1[1], h1[2], h1[3]}), o[d0]);   \
        o[d0] = MFMA32(pa2, ((bf16x8){l2[0], l2[1], l2[2], l2[3], h2[0], h2[1], h2[2], h2[3]}), o[d0]);   \
        o[d0] = MFMA32(pa3, ((bf16x8){l3[0], l3[1], l3[2], l3[3], h3[0], h3[1], h3[2], h3[3]}), o[d0]); } while (0)
    PV_D0(0); PV_D0(1); PV_D0(2); PV_D0(3);
#undef PV_D0
#undef TRRD
}

struct BlockRef { const bf16* Q; const bf16* K; const bf16* V; bf16* O; const bf16* KM; int P0; };
struct Seam { bf16x8 qr[8]; bf16x8 st_v0, st_v1, st_k0, st_k1; };
#define VMW() asm volatile("s_waitcnt vmcnt(0)" ::: "memory")
#define VMWN(n) asm volatile("s_waitcnt vmcnt(%0)" :: "i"(n) : "memory")
#define SLOAD_H(Kp, Vp, k0) do { const bf16* kb__ = (Kp) + (size_t)(k0) * RS; const bf16* vb__ = (Vp) + (size_t)(k0) * RS;              \
                         S.st_v0 = load8(vb__ + goff); S.st_v1 = load8(vb__ + 32 * RS + goff);              \
                         S.st_k0 = load8(kb__ + goff); S.st_k1 = load8(kb__ + 32 * RS + goff); } while (0)
#define SWRITE_HK(bf) do { *(bf16x8*)(K_lds + (bf) * SHM_K + kws) = S.st_k0; *(bf16x8*)(K_lds + (bf) * SHM_K + kws + 32 * 256) = S.st_k1; } while (0)
#define SWRITE_HV(bf) do { *(bf16x8*)(V_lds + (bf) * SHM_V + vst0) = S.st_v0; *(bf16x8*)(V_lds + (bf) * SHM_V + vst1) = S.st_v1; } while (0)
#define SWRITE_H(bf) do { SWRITE_HV(bf); SWRITE_HK(bf); } while (0)
DI void prime(const BlockRef& cur, char* lds, Seam& S) {
    const int tid = threadIdx.x, wid = __builtin_amdgcn_readfirstlane(tid >> 6), lane = tid & 63, r32 = lane & 31, hi = lane >> 5;
    const int sr = tid >> 4, sc = (tid & 15) * 8, kws = KSWZ(sr, sc * 2); char* K_lds = lds + 2 * SHM_V;
    const unsigned goff = (unsigned)(sr * RS + sc), qoff = (unsigned)(r32 * RS + hi * 8);
    { const bf16* qb__ = cur.Q + (size_t)(wid * QBLK) * RS;
#pragma unroll
    for (int d0 = 0; d0 < 8; ++d0) S.qr[d0] = load8(qb__ + qoff + d0 * 16); }
    SLOAD_H(cur.K, cur.V, 0); VMW(); SWRITE_HK(0);
    __syncthreads();
}
DI void block(const BlockRef& cur, const BlockRef& nxt, char* lds, Seam& S) {
    int tid_ = threadIdx.x; asm volatile("" : "+v"(tid_));
    const int tid = tid_, wid = __builtin_amdgcn_readfirstlane(tid >> 6), lane = tid & 63, r32 = lane & 31, hi = lane >> 5;
    const int NT = (cur.P0 + QB) / KVBLK;
    const int qb = cur.P0 / QB;
    const int qlo = cur.P0 + wid * QBLK, qm = qlo + r32 - 4 * hi;
    char* V_lds = lds; char* K_lds = lds + 2 * SHM_V;
    float* ws = (float*)(lds + 2 * SHM_V + 2 * SHM_K) + wid * 64; float* li_l = ws, * al_l = ws + 32;
    unsigned selmask = (1u << qb) - 1u;
    if (qb > 3) {
        f32x16 g0 = f32x16{};
#pragma unroll
        for (int d0 = 0; d0 < 8; ++d0) {
            bf16x8 a = (bf16x8){0, 0, 0, 0, 0, 0, 0, 0};
            if (r32 < 8) a = load8(cur.KM + r32 * D + d0 * 16 + hi * 8);
            g0 = MFMA32(a, S.qr[d0], g0);
        }
        float gt[8];
#pragma unroll
        for (int j = 0; j < 4; ++j) { const float mine = g0[j], oth = __shfl_xor(mine, 32); gt[j] = hi ? oth : mine; gt[4 + j] = hi ? mine : oth; }
        selmask = 0u;
#pragma unroll
        for (int i = 0; i < 8; ++i) { int rank = 0;
#pragma unroll
            for (int j = 0; j < 8; ++j) { if (j != i) { const bool beats = (gt[j] > gt[i]) || (gt[j] == gt[i] && j < i); rank += (j < qb && beats) ? 1 : 0; } }
            if (i < qb && rank < 3) selmask |= (1u << i); }
    }
    float m_reg = -1e30f, l_reg = 0; f32x16 o[4] = {};
    const int sr = tid >> 4, sc = (tid & 15) * 8, vst0 = v_st(sr, sc), vst1 = v_st(32 + sr, sc), kws = KSWZ(sr, sc * 2);
    const unsigned goff = (unsigned)(sr * RS + sc), qoff = (unsigned)(r32 * RS + hi * 8);
    const int vb0 = (int)(uintptr_t)V_lds + v_rd_base(lane);
    const bf16* Kh = cur.K; const bf16* Vh = cur.V;
#define RESC(a) do { if (__any((a) < 1.f)) { if (hi == 0) al_l[r32] = (a); asm volatile("s_waitcnt lgkmcnt(0)" ::: "memory");              \
                     _Pragma("unroll") for (int d_ = 0; d_ < 4; ++d_) _Pragma("unroll") for (int r = 0; r < 16; ++r) o[d_][r] *= al_l[crow(r, hi)]; } } while (0)
#define KBASE(t) ((t) * KVBLK)
#define MASKT(P0_, P1_, t) do { const int kb_ = KBASE(t); const int kblk_ = (t) >> 2; \
        if (kblk_ < qb) { if (qb > 3) mask_all(P0_, P1_, ((selmask >> kblk_) & 1u) == 0u); } \
        else if (kb_ + KVBLK - 1 > qlo) mask_tile(P0_, P1_, qm - kb_); } while (0)
    constexpr int NQL = 8;
#define SEAM_K0() do { VMWN(NQL); SWRITE_HK(0); SBAR(); } while (0)
    f32x16 pA0, pA1, pB0, pB1; float mnA, mnB, alA, alB; bf16x8 pa0, pa1, pa2, pa3;
    SWRITE_HV(0); SBAR();
    if (NT > 1) { SLOAD_H(Kh, Vh, KBASE(1)); }
    SBAR(); qkt<0>(pA0, pA1, K_lds, r32, hi, S.qr);
    MASKT(pA0, pA1, 0); partialSM(pA0, pA1, m_reg, mnA, alA);
    if (NT > 1) { VMW(); SWRITE_H(1); }
    __syncthreads();
#define HALF_STEP(PX0, PX1, mnX, alX, PY0, PY1, alY, t, KB, VB, SB) do {                                                      \
        SBAR(); qkt<KB>(PX0, PX1, K_lds, r32, hi, S.qr);                                             \
        finishSM(PY0, PY1, alY, l_reg, pa0, pa1, pa2, pa3); SBAR();                                                           \
        if ((t) + 1 < NT) { SLOAD_H(Kh, Vh, KBASE((t) + 1)); SBAR(); }                                               \
        pv_tile<VB>(o, vb0, pa0, pa1, pa2, pa3); MASKT(PX0, PX1, (t)); partialSM(PX0, PX1, m_reg, mnX, alX);                                        \
        __syncthreads();                                                                                                      \
        if ((t) + 1 < NT) { VMW(); SWRITE_H(SB); }                                                                          \
        RESC(alX); __syncthreads(); } while (0)
    for (int t = 1; t + 1 < NT; t += 2) {
        HALF_STEP(pB0, pB1, mnB, alB, pA0, pA1, alA, t, 1, 0, 0);
        HALF_STEP(pA0, pA1, mnA, alA, pB0, pB1, alB, t + 1, 0, 1, 1);
    }
    const bool even = (NT & 1) == 0;
    if (even) { SBAR(); qkt<1>(pB0, pB1, K_lds, r32, hi, S.qr); SBAR(); }
    { SLOAD_H(nxt.K, nxt.V, 0); SBAR();
      const bf16* qb__ = nxt.Q + (size_t)(wid * QBLK) * RS;
#pragma unroll
      for (int d0 = 0; d0 < 8; ++d0) S.qr[d0] = load8(qb__ + qoff + d0 * 16); }
    SBAR();
    finishSM(pA0, pA1, alA, l_reg, pa0, pa1, pa2, pa3); SBAR();
    pv_tile<0>(o, vb0, pa0, pa1, pa2, pa3);
    if (even) { MASKT(pB0, pB1, NT - 1); partialSM(pB0, pB1, m_reg, mnB, alB); __syncthreads(); RESC(alB);
        finishSM(pB0, pB1, alB, l_reg, pa0, pa1, pa2, pa3); SBAR(); pv_tile<1>(o, vb0, pa0, pa1, pa2, pa3); }
    SBAR(); SEAM_K0();
    if (hi == 0) li_l[r32] = l_reg; asm volatile("s_waitcnt lgkmcnt(0)" ::: "memory");
    float rli[16];
#pragma unroll
    for (int r = 0; r < 16; ++r) rli[r] = __builtin_amdgcn_rcpf(li_l[crow(r, hi)]);
    bf16* Ow = cur.O + (size_t)(wid * QBLK) * RSO;
    const unsigned ooff = (unsigned)(4 * hi * RSO + r32);
#pragma unroll
    for (int r = 0; r < 16; ++r) { const int orow0 = (r & 3) + 8 * (r >> 2);
#pragma unroll
        for (int d0 = 0; d0 < 4; ++d0) { const float v = o[d0][r] * rli[r];
            const float vn = __shfl_xor(v, 1);
            if ((r32 & 1) == 0) *(unsigned*)(Ow + ooff + (unsigned)(orow0 * RSO + d0 * 32)) = cvtpk(v, vn); } }
    __syncthreads();
#undef RESC
#undef KBASE
#undef MASKT
#undef SEAM_K0
#undef HALF_STEP
}
#undef VMW
#undef VMWN
#undef SLOAD_H
#undef SWRITE_HK
#undef SWRITE_HV
#undef SWRITE_H
#undef KSWZ
#undef SBAR
}

namespace dn {
#ifndef DBL
#define DBL -1
#endif
#define REPS(k) for (int rep_ = 0; rep_ < ((DBL == (k)) ? 2 : 1); ++rep_)
constexpr int L_QB = 0, L_KB = 17408, L_KT = 34816, L_VT = 53248, L_LM = 71680, L_TB = 89088, L_GV = 107520;
constexpr int RQ = 272, LMS = 68, RT = 144;

struct ConvW { f32x2 w[3][4]; float aexp, dtb; };
DI void prep_consts(const Params& p, int h, ConvW& C, int lane) {
#pragma unroll
    for (int seg = 0; seg < 3; ++seg)
#pragma unroll
        for (int j = 0; j < 4; ++j) C.w[seg][j] = *(const f32x2*)(p.conv_w + j * 3072 + seg * 1024 + h * HD + 2 * lane);
    C.aexp = -expf(p.a_log[h]); C.dtb = p.dt_bias[h];
}
struct Raw { unsigned v[33]; float br, ar; };
DI void prep_load(const Params& p, int item, Raw& R, int lane, int wave) {
    const int bh = item >> 5, n = item & 31, b = bh >> 3, h = bh & 7, i0 = wave * 8, c0 = 2 * lane;
    const bf16_t* PROJ = (const bf16_t*)(p.ws + WS_B);
#pragma unroll
    for (int seg = 0; seg < 3; ++seg)
#pragma unroll
        for (int jj = 0; jj < 11; ++jj) {
            const int sp = n * 64 + i0 - 3 + jj;
            unsigned v = 0u;
            if (sp >= 0) v = *(const unsigned*)(PROJ + (size_t)(b * SEQ + sp) * PP + C_DN + seg * 1024 + h * HD + c0);
            R.v[seg * 11 + jj] = v;
        }
    R.br = 0.f; R.ar = 0.f;
    if (wave == 0) { const float* BA = (const float*)(p.ws + WS_BA); const size_t t = (size_t)(b * SEQ + n * 64 + lane);
        R.br = BA[t * 16 + h]; R.ar = BA[t * 16 + 8 + h]; }
}
#define DN_BAR() do { asm volatile("s_waitcnt lgkmcnt(0)" ::: "memory"); __builtin_amdgcn_s_barrier(); asm volatile("" ::: "memory"); } while (0)
DI void prep_chunk(const Params& p, LAS unsigned char* lds, int item, int nitem, Raw& R, const ConvW& CW, int tid, int lane, int wave) {
    asm volatile("" : "+v"(tid), "+v"(lane));
    const int bh = item >> 5, n = item & 31, b = bh >> 3, h = bh & 7;
    unsigned char* rec = p.ws + WS_DNP + (size_t)item * DN_STRIDE;
    LAS float* LM = (LAS float*)(lds + L_LM);
    LAS float* GV = (LAS float*)(lds + L_GV);
    REPS(31) {
        const int i0 = wave * 8, c0 = 2 * lane;
#pragma unroll
        for (int seg = 0; seg < 3; ++seg) {
            float w0[4], w1[4];
#pragma unroll
            for (int j = 0; j < 4; ++j) { w0[j] = CW.w[seg][j].x; w1[j] = CW.w[seg][j].y; }
            float r0[11], r1[11];
#pragma unroll
            for (int jj = 0; jj < 11; ++jj) { const unsigned v = R.v[seg * 11 + jj]; r0[jj] = bflo(v); r1[jj] = bfhi(v); }
            float ya[8], yb[8];
#pragma unroll
            for (int i = 0; i < 8; ++i) {
                float y0 = 0.f, y1 = 0.f;
#pragma unroll
                for (int j = 0; j < 4; ++j) { y0 += w0[j] * r0[i + j]; y1 += w1[j] * r1[i + j]; }
                ya[i] = siluf_(y0); yb[i] = siluf_(y1);
            }
            if (seg < 2) {
                float ss[8];
#pragma unroll
                for (int i = 0; i < 8; ++i) ss[i] = ya[i] * ya[i] + yb[i] * yb[i];
#pragma unroll
                for (int o = 1; o < 64; o <<= 1) { float t[8];
#pragma unroll
                    for (int i = 0; i < 8; ++i) t[i] = __shfl_xor(ss[i], o);
#pragma unroll
                    for (int i = 0; i < 8; ++i) ss[i] += t[i]; }
#pragma unroll
                for (int i = 0; i < 8; ++i) { const float rn = (seg == 0 ? SCALE_Q : 1.0f) * rsqrt_(ss[i] + EPS); ya[i] *= rn; yb[i] *= rn;
                    *(LAS unsigned*)(lds + (seg == 0 ? L_QB : L_KB) + (i0 + i) * RQ + c0 * 2) = cvtpk(ya[i], yb[i]); }
            }
            if (seg >= 1) {
                LAS unsigned char* tb = lds + (seg == 1 ? L_KT : L_VT) + c0 * RT + i0 * 2;
                u32x4 o0, o1;
                o0.x = cvtpk(ya[0], ya[1]); o0.y = cvtpk(ya[2], ya[3]); o0.z = cvtpk(ya[4], ya[5]); o0.w = cvtpk(ya[6], ya[7]);
                o1.x = cvtpk(yb[0], yb[1]); o1.y = cvtpk(yb[2], yb[3]); o1.z = cvtpk(yb[4], yb[5]); o1.w = cvtpk(yb[6], yb[7]);
                *(LAS u32x4*)tb = o0; *(LAS u32x4*)(tb + RT) = o1;
            }
        }
        if (wave == 0) {
            const float br = R.br, ar = R.ar;
            const float beta = sigmoidf_(br);
            const float xs = ar + CW.dtb;
            const float sp = xs > 20.f ? xs : log1pf(expf(xs));
            float g = CW.aexp * sp;
#pragma unroll
            for (int o = 1; o < 64; o <<= 1) { const float u = __shfl_up(g, o); if (lane >= o) g += u; }
            const float g63 = __shfl(g, 63);
            GV[lane] = g; GV[64 + lane] = beta; GV[128 + lane] = expf(g); GV[192 + lane] = expf(g63 - g);
        }
    }
    if (nitem >= 0) prep_load(p, nitem, R, lane, wave);
    DN_BAR();
    REPS(32) {
        const int mt = wave >> 1, nt = wave & 1, r = lane & 31, hi = lane >> 5;
        if (mt < 2) {
            const LAS unsigned char* Ab = lds + L_KB + (32 * nt + r) * RQ, * Bb = lds + L_QB + (32 * mt + r) * RQ;
            f32x16 acc = f32x16{};
#pragma unroll
            for (int ks = 0; ks < 8; ++ks) acc = MFMA32(*(const LAS bf16x8*)(Ab + (16 * ks + 8 * hi) * 2), *(const LAS bf16x8*)(Bb + (16 * ks + 8 * hi) * 2), acc);
            const int i = 32 * mt + r; const float Gi = GV[i];
            float v[16];
#pragma unroll
            for (int q = 0; q < 16; ++q) { const int j = 32 * nt + crow(q, hi); v[q] = i >= j ? acc[q] * __expf(Gi - GV[j]) : 0.f; }
            u32x4* QKf = (u32x4*)(rec + DN_QK) + ((mt * 4 + 2 * nt) * 64 + lane);
            u32x4 o0, o1;
            o0.x = cvtpk(v[0], v[1]); o0.y = cvtpk(v[2], v[3]); o0.z = cvtpk(v[4], v[5]); o0.w = cvtpk(v[6], v[7]);
            o1.x = cvtpk(v[8], v[9]); o1.y = cvtpk(v[10], v[11]); o1.z = cvtpk(v[12], v[13]); o1.w = cvtpk(v[14], v[15]);
            QKf[0] = o0; QKf[64] = o1;
        } else {
            const LAS unsigned char* Ab = lds + L_KB + (32 * (mt - 2) + r) * RQ, * Bb = lds + L_KB + (32 * nt + r) * RQ;
            f32x16 acc = f32x16{};
#pragma unroll
            for (int ks = 0; ks < 8; ++ks) acc = MFMA32(*(const LAS bf16x8*)(Ab + (16 * ks + 8 * hi) * 2), *(const LAS bf16x8*)(Bb + (16 * ks + 8 * hi) * 2), acc);
            const int j = 32 * nt + r; const float Gj = GV[j];
#pragma unroll
            for (int q = 0; q < 16; ++q) { const int row = 32 * (mt - 2) + crow(q, hi);
                const float e = row > j ? GV[64 + row] * __expf(GV[row] - Gj) : 0.f;
                LM[row * LMS + j] = acc[q] * e; }
        }
    }
    DN_BAR();
    REPS(33) {
        float Lr[64];
#pragma unroll
        for (int jq = 0; jq < 16; ++jq) { const f32x4 l = *(const LAS f32x4*)(LM + lane * LMS + 4 * jq); Lr[4 * jq] = l.x; Lr[4 * jq + 1] = l.y; Lr[4 * jq + 2] = l.z; Lr[4 * jq + 3] = l.w; }
        float xv[8];
#pragma unroll
        for (int q = 0; q < 8; ++q) xv[q] = (lane == 8 * wave + q) ? 1.0f : 0.0f;
#pragma unroll
        for (int j = 0; j < 63; ++j) {
#pragma unroll
            for (int q = 0; q < 8; ++q) { const float xj = __int_as_float(__builtin_amdgcn_readlane(__float_as_int(xv[q]), j)); xv[q] -= Lr[j] * xj; }
        }
        float t1[8], t2[8];
#pragma unroll
        for (int q = 0; q < 8; ++q) { const float bc = GV[64 + 8 * wave + q]; t1[q] = xv[q] * bc; t2[q] = t1[q] * GV[128 + 8 * wave + q]; }
        u32x4 o1, o2;
        o1.x = cvtpk(t1[0], t1[1]); o1.y = cvtpk(t1[2], t1[3]); o1.z = cvtpk(t1[4], t1[5]); o1.w = cvtpk(t1[6], t1[7]);
        o2.x = cvtpk(t2[0], t2[1]); o2.y = cvtpk(t2[2], t2[3]); o2.z = cvtpk(t2[4], t2[5]); o2.w = cvtpk(t2[6], t2[7]);
        *(LAS u32x4*)(lds + L_TB + lane * RT + wave * 16) = o1; *(LAS u32x4*)(lds + L_TB + 64 * RT + lane * RT + wave * 16) = o2;
    }
    DN_BAR();
    REPS(34) {
        const int r = lane & 31, hi = lane >> 5;
#pragma unroll
        for (int half = 0; half < 2; ++half) {
            const int tix = wave * 2 + half;
            f32x16 acc = f32x16{};
            if (tix < 8) {
                const int mt = tix >> 2, nt = tix & 3;
                const LAS unsigned char* Ab = lds + L_TB + (32 * mt + r) * RT + 16 * hi, * Bb = lds + L_VT + (32 * nt + r) * RT + 16 * hi;
#pragma unroll
                for (int ks = 0; ks < 4; ++ks) acc = MFMA32(*(const LAS bf16x8*)(Ab + 32 * ks), *(const LAS bf16x8*)(Bb + 32 * ks), acc);
                u32x4* Uf = (u32x4*)(rec + DN_U) + ((mt * 4 + nt) * 64 + lane) * 2;
                u32x4 o0, o1;
                o0.x = cvtpk(acc[0], acc[1]); o0.y = cvtpk(acc[2], acc[3]); o0.z = cvtpk(acc[4], acc[5]); o0.w = cvtpk(acc[6], acc[7]);
                o1.x = cvtpk(acc[8], acc[9]); o1.y = cvtpk(acc[10], acc[11]); o1.z = cvtpk(acc[12], acc[13]); o1.w = cvtpk(acc[14], acc[15]);
                Uf[0] = o0; Uf[1] = o1;
            } else {
                const int ntp = (tix - 8) >> 1, mt = tix & 1;
                const LAS unsigned char* Ab = lds + L_KT + (32 * ntp + r) * RT + 16 * hi, * Bb = lds + L_TB + 64 * RT + (32 * mt + r) * RT + 16 * hi;
#pragma unroll
                for (int ks = 0; ks < 4; ++ks) acc = MFMA32(*(const LAS bf16x8*)(Ab + 32 * ks), *(const LAS bf16x8*)(Bb + 32 * ks), acc);
                u32x4* Wf = (u32x4*)(rec + DN_W) + ((mt * 8 + 2 * ntp) * 64 + lane);
                u32x4 o0, o1;
                o0.x = cvtpk(-acc[0], -acc[1]); o0.y = cvtpk(-acc[2], -acc[3]); o0.z = cvtpk(-acc[4], -acc[5]); o0.w = cvtpk(-acc[6], -acc[7]);
                o1.x = cvtpk(-acc[8], -acc[9]); o1.y = cvtpk(-acc[10], -acc[11]); o1.z = cvtpk(-acc[12], -acc[13]); o1.w = cvtpk(-acc[14], -acc[15]);
                Wf[0] = o0; Wf[64] = o1;
            }
        }
#pragma unroll
        for (int rep = 0; rep < 2; ++rep) {
            const int f = tid + 512 * rep, mt = f >> 9, ks = (f >> 6) & 7, fr = f & 31, fh = (f >> 5) & 1, i = 32 * mt + fr;
            const LAS unsigned char* qp = lds + L_QB + i * RQ + (16 * ks + 4 * fh) * 2;
            const u32x2 a = *(const LAS u32x2*)qp, c = *(const LAS u32x2*)(qp + 16);
            const float e = GV[128 + i];
            u32x4 o; o.x = cvtpk(bflo(a.x) * e, bfhi(a.x) * e); o.y = cvtpk(bflo(a.y) * e, bfhi(a.y) * e); o.z = cvtpk(bflo(c.x) * e, bfhi(c.x) * e); o.w = cvtpk(bflo(c.y) * e, bfhi(c.y) * e);
            ((u32x4*)(rec + DN_QD))[f] = o;
        }
#pragma unroll
        for (int rep = 0; rep < 2; ++rep) {
            const int f = tid + 512 * rep, a4 = f >> 8, ks = (f >> 6) & 3, fr = f & 31, fh = (f >> 5) & 1, d = 32 * a4 + fr;
            const LAS unsigned char* kp = lds + L_KT + d * RT + (16 * ks + 4 * fh) * 2;
            const u32x2 a = *(const LAS u32x2*)kp, c = *(const LAS u32x2*)(kp + 16);
            const LAS float* eg = GV + 192 + 16 * ks + 4 * fh;
            u32x4 o; o.x = cvtpk(bflo(a.x) * eg[0], bfhi(a.x) * eg[1]); o.y = cvtpk(bflo(a.y) * eg[2], bfhi(a.y) * eg[3]);
            o.z = cvtpk(bflo(c.x) * eg[8], bfhi(c.x) * eg[9]); o.w = cvtpk(bflo(c.y) * eg[10], bfhi(c.y) * eg[11]);
            ((u32x4*)(rec + DN_KT))[f] = o;
        }
        if (tid == 0) *(float*)(rec + DN_SC) = GV[128 + 63];
    }
    DN_BAR();
}

DI bf16x8 pack_step(const f32x16& x, int s) {
    u32x4 w;
    if (s == 0) { w.x = cvtpk(x[0], x[1]); w.y = cvtpk(x[2], x[3]); w.z = cvtpk(x[4], x[5]); w.w = cvtpk(x[6], x[7]); }
    else { w.x = cvtpk(x[8], x[9]); w.y = cvtpk(x[10], x[11]); w.z = cvtpk(x[12], x[13]); w.w = cvtpk(x[14], x[15]); }
    return __builtin_bit_cast(bf16x8, w);
}

constexpr int RB = 57344;
constexpr int ORS = 272, OB = 64 * ORS;
DI void recur(const Params& p, LAS unsigned char* lds, int bh, int tid, int lane, int wave) {
    asm volatile("" : "+v"(tid), "+v"(lane));
    const int r = lane & 31, hi = lane >> 5, b = bh >> 3, h = bh & 7;
    const unsigned char* rec0 = p.ws + WS_DNP + (size_t)(bh * 32) * DN_STRIDE;
    if (wave >= 4) {
        const int lt = tid - 256;
        const int fg = lt & 7, fr2 = lt >> 3;
        const bf16_t* PROJ = (const bf16_t*)(p.ws + WS_B); bf16_t* YAB = (bf16_t*)(p.ws + WS_A);
        f32x4 g4[4];
#pragma unroll
        for (int j = 0; j < 4; ++j) g4[j] = *(const f32x4*)(p.dn_gain + fg * 16 + 4 * j);
        const bf16_t* zb = PROJ + (size_t)(b * SEQ) * PP + C_Z + h * HD + fg * 16; bf16_t* yb = YAB + (size_t)(b * SEQ) * DM + 1024 + h * HD + fg * 16;
        u32x4 zr[2][2];
#define DN_ZLOAD(n_) do { _Pragma("unroll") for (int ps = 0; ps < 2; ++ps) { const bf16_t* zp = zb + (size_t)((n_) * 64 + fr2 + 32 * ps) * PP; zr[ps][0] = *(const u32x4*)zp; zr[ps][1] = *(const u32x4*)(zp + 8); } } while (0)
#define DN_FINAL(n_) do { const LAS unsigned char* ob = lds + 2 * RB + ((n_) & 1) * OB; \
        _Pragma("unroll") for (int ps = 0; ps < 2; ++ps) { const int row = fr2 + 32 * ps; \
            const u32x4 o0 = *(const LAS u32x4*)(ob + row * ORS + fg * 32), o1 = *(const LAS u32x4*)(ob + row * ORS + fg * 32 + 16); \
            float ov[16] = {bflo(o0.x), bfhi(o0.x), bflo(o0.y), bfhi(o0.y), bflo(o0.z), bfhi(o0.z), bflo(o0.w), bfhi(o0.w), bflo(o1.x), bfhi(o1.x), bflo(o1.y), bfhi(o1.y), bflo(o1.z), bfhi(o1.z), bflo(o1.w), bfhi(o1.w)}; \
            float ss = 0.f; _Pragma("unroll") for (int e = 0; e < 16; ++e) ss += ov[e] * ov[e]; \
            ss += __shfl_xor(ss, 1); ss += __shfl_xor(ss, 2); ss += __shfl_xor(ss, 4); \
            const float rstd = rsqrt_(ss * (1.0f / HD) + EPS); \
            const u32x4 z0 = zr[ps][0], z1 = zr[ps][1]; \
            const float zz[16] = {bflo(z0.x), bfhi(z0.x), bflo(z0.y), bfhi(z0.y), bflo(z0.z), bfhi(z0.z), bflo(z0.w), bfhi(z0.w), bflo(z1.x), bfhi(z1.x), bflo(z1.y), bfhi(z1.y), bflo(z1.z), bfhi(z1.z), bflo(z1.w), bfhi(z1.w)}; \
            float y[16]; _Pragma("unroll") for (int e = 0; e < 16; ++e) y[e] = ov[e] * rstd * g4[e >> 2][e & 3] * siluf_(zz[e]); \
            u32x4 w0, w1; w0.x = cvtpk(y[0], y[1]); w0.y = cvtpk(y[2], y[3]); w0.z = cvtpk(y[4], y[5]); w0.w = cvtpk(y[6], y[7]); \
            w1.x = cvtpk(y[8], y[9]); w1.y = cvtpk(y[10], y[11]); w1.z = cvtpk(y[12], y[13]); w1.w = cvtpk(y[14], y[15]); \
            bf16_t* yp = yb + (size_t)((n_) * 64 + row) * DM; *(u32x4*)yp = w0; *(u32x4*)(yp + 8) = w1; } } while (0)
        u32x4 v[14];
        {   const u32x4* src = (const u32x4*)(rec0 + DN_W) + lt;
#pragma unroll
            for (int k = 0; k < 14; ++k) v[k] = src[k * 256];
#pragma unroll
            for (int k = 0; k < 14; ++k) *(LAS u32x4*)(lds + (k * 256 + lt) * 16) = v[k];
            const u32x4* src1 = (const u32x4*)(rec0 + DN_STRIDE + DN_W) + lt;
#pragma unroll
            for (int k = 0; k < 14; ++k) v[k] = src1[k * 256]; }
        DN_ZLOAD(0);
        DN_BAR();
        for (int n = 0; n < 32; ++n) {
            if (n + 1 < 32) { LAS unsigned char* dst = lds + ((n + 1) & 1) * RB;
#pragma unroll
                for (int k = 0; k < 14; ++k) *(LAS u32x4*)(dst + (k * 256 + lt) * 16) = v[k]; }
            if (n + 2 < 32) { const u32x4* src = (const u32x4*)(rec0 + (size_t)(n + 2) * DN_STRIDE + DN_W) + lt;
#pragma unroll
                for (int k = 0; k < 14; ++k) v[k] = src[k * 256]; }
            if (n >= 1) { DN_FINAL(n - 1); DN_ZLOAD(n); }
            DN_BAR();
        }
        DN_FINAL(31);
#undef DN_ZLOAD
#undef DN_FINAL
    } else {
        const int slice = wave, dv0 = slice * 32;
        f32x16 St[4];
#pragma unroll
        for (int a = 0; a < 4; ++a) St[a] = f32x16{};
        u32x4 un[2][2];
#pragma unroll
        for (int mt = 0; mt < 2; ++mt) { const u32x4* up = (const u32x4*)(rec0 + DN_U) + ((mt * 4 + slice) * 64 + lane) * 2; un[mt][0] = up[0]; un[mt][1] = up[1]; }
        DN_BAR();
        for (int n = 0; n < 32; ++n) {
            const unsigned char* rec = rec0 + (size_t)n * DN_STRIDE;
            const LAS unsigned char* buf = lds + (n & 1) * RB;
            const float eg = *(const float*)(rec + DN_SC);
            f32x16 Vn[2], O[2];
#pragma unroll
            for (int mt = 0; mt < 2; ++mt) { const u32x4 a = un[mt][0], c = un[mt][1];
                Vn[mt][0] = bflo(a.x); Vn[mt][1] = bfhi(a.x); Vn[mt][2] = bflo(a.y); Vn[mt][3] = bfhi(a.y); Vn[mt][4] = bflo(a.z); Vn[mt][5] = bfhi(a.z); Vn[mt][6] = bflo(a.w); Vn[mt][7] = bfhi(a.w);
                Vn[mt][8] = bflo(c.x); Vn[mt][9] = bfhi(c.x); Vn[mt][10] = bflo(c.y); Vn[mt][11] = bfhi(c.y); Vn[mt][12] = bflo(c.z); Vn[mt][13] = bfhi(c.z); Vn[mt][14] = bflo(c.w); Vn[mt][15] = bfhi(c.w); }
            if (n + 1 < 32) {
#pragma unroll
                for (int mt = 0; mt < 2; ++mt) { const u32x4* up = (const u32x4*)(rec + DN_STRIDE + DN_U) + ((mt * 4 + slice) * 64 + lane) * 2; un[mt][0] = up[0]; un[mt][1] = up[1]; } }
            bf16x8 Sf[8];
#pragma unroll
            for (int a = 0; a < 4; ++a) { Sf[2 * a] = pack_step(St[a], 0); Sf[2 * a + 1] = pack_step(St[a], 1); }
#pragma unroll
            for (int mt = 0; mt < 2; ++mt)
#pragma unroll
                for (int ks = 0; ks < 8; ++ks) Vn[mt] = MFMA32(*(const LAS bf16x8*)(buf + ((mt * 8 + ks) * 64 + lane) * 16), Sf[ks], Vn[mt]);
#pragma unroll
            for (int mt = 0; mt < 2; ++mt) { O[mt] = f32x16{};
#pragma unroll
                for (int ks = 0; ks < 8; ++ks) O[mt] = MFMA32(*(const LAS bf16x8*)(buf + 16384 + ((mt * 8 + ks) * 64 + lane) * 16), Sf[ks], O[mt]); }
            bf16x8 Vf[4];
#pragma unroll
            for (int mt = 0; mt < 2; ++mt) { Vf[2 * mt] = pack_step(Vn[mt], 0); Vf[2 * mt + 1] = pack_step(Vn[mt], 1); }
#pragma unroll
            for (int mt = 0; mt < 2; ++mt)
#pragma unroll
                for (int ks = 0; ks < 4; ++ks) O[mt] = MFMA32(*(const LAS bf16x8*)(buf + 49152 + ((mt * 4 + ks) * 64 + lane) * 16), Vf[ks], O[mt]);
#pragma unroll
            for (int a = 0; a < 4; ++a) {
                St[a] = St[a] * eg;
#pragma unroll
                for (int ks = 0; ks < 4; ++ks) St[a] = MFMA32(*(const LAS bf16x8*)(buf + 32768 + ((a * 4 + ks) * 64 + lane) * 16), Vf[ks], St[a]);
            }
            {   LAS unsigned char* ob = lds + 2 * RB + (n & 1) * OB + (dv0 + r) * 2;
#pragma unroll
                for (int mt = 0; mt < 2; ++mt)
#pragma unroll
                    for (int i = 0; i < 16; ++i) *(LAS bf16_t*)(ob + (32 * mt + crow(i, hi)) * ORS) = f2bf(O[mt][i]);
            }
            DN_BAR();
        }
    }
}
}

DI void transpose_tile(const float* W, int N, int k0, int sn0, bf16_t* WT, int dpitch, int drow0, int dk0, int nvalid, LAS float* scr, int lane) {
#pragma unroll 8
    for (int i = 0; i < 32; ++i) { const int kk = 2 * i + (lane >> 5); scr[kk * 33 + (lane & 31)] = W[(size_t)(k0 + kk) * N + sn0 + (lane & 31)]; }
    asm volatile("s_waitcnt lgkmcnt(0)" ::: "memory");
    const int c = lane & 7;
#pragma unroll
    for (int j = 0; j < 4; ++j) { const int n = (lane >> 3) + 8 * j; const LAS float* s = scr + (8 * c) * 33 + n;
        u32x4 o; o.x = cvtpk(s[0 * 33], s[1 * 33]); o.y = cvtpk(s[2 * 33], s[3 * 33]); o.z = cvtpk(s[4 * 33], s[5 * 33]); o.w = cvtpk(s[6 * 33], s[7 * 33]);
        if (n < nvalid) *(u32x4*)(WT + (size_t)(drow0 + n) * dpitch + dk0 + k0 + 8 * c) = o; }
    asm volatile("s_waitcnt lgkmcnt(0)" ::: "memory");
}

DI void phase0(const Params& p, LAS unsigned char* lds, int tid, int lane, int wave, int bid, int G) {
    float* MOD = (float*)(p.ws + WS_MOD);
#if defined(DBL) && DBL == 0
    __syncthreads();
#endif
    if (bid < 192) {
        LAS float* sc = (LAS float*)lds;
        LAS float* red = (LAS float*)(lds + 65536);
        for (int i = tid; i < 8 * 2048; i += 512) { const int bb = i >> 11, k = i & 2047; sc[k * 8 + bb] = siluf_acc(p.c[i]); }
        __syncthreads();
        const int n0 = bid * 64;
        const int ksub = lane >> 4, cg = lane & 15;
        f32x4 acc[8];
#pragma unroll
        for (int bb = 0; bb < 8; ++bb) acc[bb] = (f32x4){0.f, 0.f, 0.f, 0.f};
        const float* wp = p.w_ada + (size_t)(wave * 256 + ksub) * 12288 + n0 + 4 * cg;
#pragma unroll 8
        for (int it = 0; it < 64; ++it) {
            const f32x4 wv = *(const f32x4*)(wp + (size_t)(4 * it) * 12288);
            const LAS float* sp = sc + (wave * 256 + 4 * it + ksub) * 8;
            const f32x4 s0 = *(const LAS f32x4*)sp, s1 = *(const LAS f32x4*)(sp + 4);
            acc[0] += wv * s0.x; acc[1] += wv * s0.y; acc[2] += wv * s0.z; acc[3] += wv * s0.w;
            acc[4] += wv * s1.x; acc[5] += wv * s1.y; acc[6] += wv * s1.z; acc[7] += wv * s1.w;
        }
#pragma unroll
        for (int bb = 0; bb < 8; ++bb) {
#pragma unroll
            for (int e = 0; e < 4; ++e) { float v = acc[bb][e]; v += __shfl_xor(v, 16); v += __shfl_xor(v, 32); acc[bb][e] = v; }
            if (ksub == 0) *(LAS f32x4*)(red + (wave * 8 + bb) * 64 + 4 * cg) = acc[bb];
        }
        __syncthreads();
        { const int bb = tid >> 6, col = tid & 63; float s = 0.f;
#pragma unroll
          for (int w = 0; w < 8; ++w) s += red[(w * 8 + bb) * 64 + col];
          MOD[bb * 12288 + n0 + col] = s + p.b_ada[n0 + col]; }
        __syncthreads();
    } else {
        f32x2* CS = (f32x2*)(p.ws + WS_CS);
        for (int i = (bid - 192) * 512 + tid; i < T * 16; i += (G - 192) * 512) {
            const int t = i >> 4, f = i & 15;
            const float inv = powf(500000.0f, -(float)f * (2.0f / 32.0f));
            const float ang = (float)p.pos[t] * inv;
            float sn, cs; sincosf(ang, &sn, &cs);
            CS[i] = (f32x2){cs, sn};
        }
    }
    LAS float* scr = (LAS float*)(lds + wave * 8448);
    const int gw = bid * 8 + wave, NGW = G * 8;
    bf16_t* WIN = (bf16_t*)(p.ws + WS_WIN); bf16_t* WMD = (bf16_t*)(p.ws + WS_WMD); bf16_t* WOUT = (bf16_t*)(p.ws + WS_WOUT); bf16_t* WR = (bf16_t*)(p.ws + WS_WR);
    constexpr int I_A = 32 * 224, I_B = 32 * 128, I_C = 32, I_M = 16 * 64, I_O = 32 * 64, I_RG = 32, I_RE = 32;
    constexpr int NITEMS = I_A + I_B + I_C + 2 * I_M + I_O + I_RG + I_RE;
    for (int it = gw; it < NITEMS; it += NGW) {
        int r = it;
        if (r < I_A) { const int kb = r / 224, nb = r % 224; transpose_tile(p.w_in, 11280, 64 * kb, 32 * nb, WIN, DM, 32 * nb, 0, 32, scr, lane); continue; } r -= I_A;
        if (r < I_B) { const int kb = r / 128, nb = r % 128; transpose_tile(p.w_in, 11280, 64 * kb, 7184 + 32 * nb, WIN, DM, 7168 + 32 * nb, 0, 32, scr, lane); continue; } r -= I_B;
        if (r < I_C) { transpose_tile(p.w_in, 11280, 64 * r, 7168, (bf16_t*)(p.ws + WS_WBA), DM, 0, 0, 16, scr, lane); continue; } r -= I_C;
        if (r < I_M) { const int kb = r / 64, nb = r % 64; transpose_tile(p.w_bm, DM, 64 * kb, 32 * nb, WMD, DM, 32 * nb, 0, 32, scr, lane); continue; } r -= I_M;
        if (r < I_M) { const int kb = r / 64, nb = r % 64; transpose_tile(p.w_bd, DM, 64 * kb, 32 * nb, WMD, DM, 32 * nb, 1024, 32, scr, lane); continue; } r -= I_M;
        if (r < I_O) { const int kb = r / 64, nb = r % 64; transpose_tile(p.w_out, DM, 64 * kb, 32 * nb, WOUT, DM, 32 * nb, 0, 32, scr, lane); continue; } r -= I_O;
        if (r < I_RG) {
            const int k = r * 64 + lane;
#pragma unroll
            for (int e = 0; e < 4; ++e) WR[e * DM + k] = f2bf(p.w_rg[k * 4 + e]);
#pragma unroll
            for (int e = 36; e < 48; ++e) WR[e * DM + k] = 0;
            continue; } r -= I_RG;
        { transpose_tile(p.w_re, 32, 64 * r, 0, WR, DM, 4, 0, 32, scr, lane); }
    }
}

DI void phase_u1_item(const Params& p, int item, int tid, int lane, int wave) {
    const float* MOD = (const float*)(p.ws + WS_MOD); bf16_t* U1 = (bf16_t*)(p.ws + WS_A);
    const int tokb = item * 64;
    for (int rr = 0; rr < 8; ++rr) {
        const int m = tokb + wave * 8 + rr, b = m >> 11;
        const f32x4* xr = (const f32x4*)(p.x + (size_t)m * DM) + lane;
        f32x4 v[8]; float s = 0.f;
#pragma unroll
        for (int j = 0; j < 8; ++j) { v[j] = xr[64 * j]; s += (v[j].x * v[j].x + v[j].y * v[j].y) + (v[j].z * v[j].z + v[j].w * v[j].w); }
        const float rstd = rsqrt_(wave_sum(s) * (1.0f / DM) + EPS);
        const float* sh = MOD + b * 12288; const float* scl = sh + 2048;
        u32x2* o8 = (u32x2*)(U1 + (size_t)m * DM) + lane;
#pragma unroll
        for (int j = 0; j < 8; ++j) { const int col = 4 * (lane + 64 * j);
            const f32x4 g = *(const f32x4*)(p.g_mix_pre + col), a = *(const f32x4*)(scl + col), c = *(const f32x4*)(sh + col);
            const f32x4 u = (v[j] * rstd * g) * (a + 1.0f) + c;
            o8[64 * j] = (u32x2){cvtpk(u.x, u.y), cvtpk(u.z, u.w)}; }
    }
    __syncthreads();
    if (wave < 4) {
        const int tl = lane & 15, kg = lane >> 4;
        const bf16_t* up = U1 + (size_t)(tokb + wave * 16 + tl) * DM + 8 * kg;
        const bf16_t* wp = (const bf16_t*)(p.ws + WS_WBA) + (size_t)tl * DM + 8 * kg;
        f32x4 a0 = {0.f, 0.f, 0.f, 0.f}, a1 = a0;
#pragma unroll 8
        for (int s = 0; s < 64; s += 2) {
            a0 = MFMA16(*(const bf16x8*)(wp + 32 * s), *(const bf16x8*)(up + 32 * s), a0);
            a1 = MFMA16(*(const bf16x8*)(wp + 32 * s + 32), *(const bf16x8*)(up + 32 * s + 32), a1);
        }
        float* BA = (float*)(p.ws + WS_BA);
        *(f32x4*)(BA + (size_t)(tokb + wave * 16 + tl) * 16 + 4 * kg) = a0 + a1;
    }
}

DI void rotary_item(const Params& p, int item, int lane) {
    const int which = item & 1, h = (item >> 1) & 7, blk = (item >> 4) & 7, b = item >> 7;
    bf16_t* PROJ = (bf16_t*)(p.ws + WS_B);
    const f32x2* CS = (const f32x2*)(p.ws + WS_CS);
    const int tok0 = b * SEQ + blk * 256; const int colb = (which ? C_K : C_Q) + h * HD;
    const int rsub = lane >> 4, i = lane & 15;
    float cs8[8];
#pragma unroll
    for (int e = 0; e < 8; ++e) cs8[e] = 0.f;
    if (which) {
#pragma unroll 16
        for (int it = 0; it < 64; ++it) { const u32x4 v = *(const u32x4*)(PROJ + (size_t)(tok0 + it * 4 + rsub) * PP + colb + 8 * i);
            cs8[0] += bflo(v.x); cs8[1] += bfhi(v.x); cs8[2] += bflo(v.y); cs8[3] += bfhi(v.y); cs8[4] += bflo(v.z); cs8[5] += bfhi(v.z); cs8[6] += bflo(v.w); cs8[7] += bfhi(v.w); }
#pragma unroll
        for (int e = 0; e < 8; ++e) { cs8[e] += __shfl_xor(cs8[e], 16); cs8[e] += __shfl_xor(cs8[e], 32); }
    }
    float a0 = 0.f, a1 = 0.f;
#pragma unroll 16
    for (int it = 0; it < 64; ++it) {
        const int t = tok0 + it * 4 + rsub;
        bf16_t* ptr = PROJ + (size_t)t * PP + colb + i;
        const float x1 = bf2f(ptr[0]), x2 = bf2f(ptr[16]);
        const f32x2 cs = CS[t * 16 + i];
        const unsigned w = cvtpk(x1 * cs.x - x2 * cs.y, x2 * cs.x + x1 * cs.y);
        ptr[0] = (bf16_t)(w & 0xffffu); ptr[16] = (bf16_t)(w >> 16);
        a0 += bflo(w); a1 += bfhi(w);
    }
    if (which) {
        a0 += __shfl_xor(a0, 16); a0 += __shfl_xor(a0, 32); a1 += __shfl_xor(a1, 16); a1 += __shfl_xor(a1, 32);
        bf16_t* KM = (bf16_t*)(p.ws + WS_KMEAN) + ((size_t)(b * 8 + h) * 8 + blk) * HD;
        if (lane < 16) {
            if (lane >= 4) { u32x4 o; o.x = cvtpk(cs8[0] * (1.0f / 256.0f), cs8[1] * (1.0f / 256.0f)); o.y = cvtpk(cs8[2] * (1.0f / 256.0f), cs8[3] * (1.0f / 256.0f));
                o.z = cvtpk(cs8[4] * (1.0f / 256.0f), cs8[5] * (1.0f / 256.0f)); o.w = cvtpk(cs8[6] * (1.0f / 256.0f), cs8[7] * (1.0f / 256.0f)); *(u32x4*)(KM + 8 * lane) = o; }
            KM[lane] = f2bf(a0 * (1.0f / 256.0f)); KM[16 + lane] = f2bf(a1 * (1.0f / 256.0f));
        }
    }
}

DI void phase_dn_final(const Params& p, int lane, int gw, int NGW) {
    const float* ODN = (const float*)(p.ws + WS_D); const bf16_t* PROJ = (const bf16_t*)(p.ws + WS_B); bf16_t* YAB = (bf16_t*)(p.ws + WS_A);
    const int d0 = (lane & 7) * 16;
    for (int m = gw; m < T; m += NGW) {
        const float* op = ODN + (size_t)m * 1024 + lane * 16;
        f32x4 v[4]; float s = 0.f;
#pragma unroll
        for (int j = 0; j < 4; ++j) { v[j] = *(const f32x4*)(op + 4 * j); s += (v[j].x * v[j].x + v[j].y * v[j].y) + (v[j].z * v[j].z + v[j].w * v[j].w); }
        s += __shfl_xor(s, 1); s += __shfl_xor(s, 2); s += __shfl_xor(s, 4);
        const float rstd = rsqrt_(s * (1.0f / HD) + EPS);
        const u32x4 z0 = *(const u32x4*)(PROJ + (size_t)m * PP + C_Z + lane * 16), z1 = *(const u32x4*)(PROJ + (size_t)m * PP + C_Z + lane * 16 + 8);
        const float zz[16] = {bflo(z0.x), bfhi(z0.x), bflo(z0.y), bfhi(z0.y), bflo(z0.z), bfhi(z0.z), bflo(z0.w), bfhi(z0.w),
                              bflo(z1.x), bfhi(z1.x), bflo(z1.y), bfhi(z1.y), bflo(z1.z), bfhi(z1.z), bflo(z1.w), bfhi(z1.w)};
        float y[16];
#pragma unroll
        for (int j = 0; j < 4; ++j) { const f32x4 g = *(const f32x4*)(p.dn_gain + d0 + 4 * j);
            y[4 * j + 0] = v[j].x * rstd * g.x * siluf_(zz[4 * j + 0]); y[4 * j + 1] = v[j].y * rstd * g.y * siluf_(zz[4 * j + 1]);
            y[4 * j + 2] = v[j].z * rstd * g.z * siluf_(zz[4 * j + 2]); y[4 * j + 3] = v[j].w * rstd * g.w * siluf_(zz[4 * j + 3]); }
        u32x4 o0, o1;
        o0.x = cvtpk(y[0], y[1]); o0.y = cvtpk(y[2], y[3]); o0.z = cvtpk(y[4], y[5]); o0.w = cvtpk(y[6], y[7]);
        o1.x = cvtpk(y[8], y[9]); o1.y = cvtpk(y[10], y[11]); o1.z = cvtpk(y[12], y[13]); o1.w = cvtpk(y[14], y[15]);
        bf16_t* yp = YAB + (size_t)m * DM + 1024 + lane * 16;
        *(u32x4*)yp = o0; *(u32x4*)(yp + 8) = o1;
    }
}

constexpr int L5_LG = 0;
constexpr int L5_HIST = 24576;
constexpr int L5_TOK = 24576 + 256;
DI void phase5_item(const Params& p, LAS unsigned char* lds, int item, int tid, int lane, int wave) {
    const float* MOD = (const float*)(p.ws + WS_MOD); const bf16_t* OM = (const bf16_t*)(p.ws + WS_OUTMIX); bf16_t* U2 = (bf16_t*)(p.ws + WS_A);
    const bf16_t* WR = (const bf16_t*)(p.ws + WS_WR);
    LAS unsigned* hist = (LAS unsigned*)(lds + L5_HIST); LAS unsigned* tokw = (LAS unsigned*)(lds + L5_TOK);
    if (tid < 64) hist[tid] = 0u;
    const int tokb = item * 64;
    for (int rr = 0; rr < 8; rr += 2) {
        u32x4 wq[2][4]; f32x4 xa[2][4], xb[2][4];
#pragma unroll
        for (int u = 0; u < 2; ++u) { const int m = tokb + wave * 8 + rr + u;
#pragma unroll
            for (int j = 0; j < 4; ++j) { const int col = 8 * (lane + 64 * j);
                wq[u][j] = *(const u32x4*)(OM + (size_t)m * DM + col);
                xa[u][j] = *(const f32x4*)(p.x + (size_t)m * DM + col); xb[u][j] = *(const f32x4*)(p.x + (size_t)m * DM + col + 4); } }
#pragma unroll
        for (int u = 0; u < 2; ++u) {
        const int m = tokb + wave * 8 + rr + u, b = m >> 11;
        const float* mod = MOD + b * 12288;
        float om[32], xv[32];
        float s = 0.f;
#pragma unroll
        for (int j = 0; j < 4; ++j) {
            const u32x4 w = wq[u][j];
            om[8 * j + 0] = bflo(w.x); om[8 * j + 1] = bfhi(w.x); om[8 * j + 2] = bflo(w.y); om[8 * j + 3] = bfhi(w.y);
            om[8 * j + 4] = bflo(w.z); om[8 * j + 5] = bfhi(w.z); om[8 * j + 6] = bflo(w.w); om[8 * j + 7] = bfhi(w.w);
            const f32x4 x0 = xa[u][j], x1 = xb[u][j];
            xv[8 * j + 0] = x0.x; xv[8 * j + 1] = x0.y; xv[8 * j + 2] = x0.z; xv[8 * j + 3] = x0.w; xv[8 * j + 4] = x1.x; xv[8 * j + 5] = x1.y; xv[8 * j + 6] = x1.z; xv[8 * j + 7] = x1.w;
#pragma unroll
            for (int e = 0; e < 8; ++e) s += om[8 * j + e] * om[8 * j + e]; }
        const float r1 = rsqrt_(wave_sum(s) * (1.0f / DM) + EPS);
        float s2 = 0.f;
#pragma unroll
        for (int j = 0; j < 4; ++j) { const int col = 8 * (lane + 64 * j);
#pragma unroll
            for (int q = 0; q < 2; ++q) { const f32x4 g = *(const f32x4*)(p.g_mix_post + col + 4 * q), gt = *(const f32x4*)(mod + 4096 + col + 4 * q);
                f32x4 o;
                o.x = xv[8 * j + 4 * q + 0] + gt.x * (om[8 * j + 4 * q + 0] * r1 * g.x); o.y = xv[8 * j + 4 * q + 1] + gt.y * (om[8 * j + 4 * q + 1] * r1 * g.y);
                o.z = xv[8 * j + 4 * q + 2] + gt.z * (om[8 * j + 4 * q + 2] * r1 * g.z); o.w = xv[8 * j + 4 * q + 3] + gt.w * (om[8 * j + 4 * q + 3] * r1 * g.w);
                *(f32x4*)(p.out + (size_t)m * DM + col + 4 * q) = o;
                xv[8 * j + 4 * q + 0] = o.x; xv[8 * j + 4 * q + 1] = o.y; xv[8 * j + 4 * q + 2] = o.z; xv[8 * j + 4 * q + 3] = o.w;
                s2 += (o.x * o.x + o.y * o.y) + (o.z * o.z + o.w * o.w); } }
        const float r2 = rsqrt_(wave_sum(s2) * (1.0f / DM) + EPS);
#pragma unroll
        for (int j = 0; j < 4; ++j) { const int col = 8 * (lane + 64 * j); float u8[8];
#pragma unroll
            for (int q = 0; q < 2; ++q) { const f32x4 g = *(const f32x4*)(p.g_ffn_pre + col + 4 * q), sc = *(const f32x4*)(mod + 8192 + col + 4 * q), sh = *(const f32x4*)(mod + 6144 + col + 4 * q);
                u8[4 * q + 0] = (xv[8 * j + 4 * q + 0] * r2 * g.x) * (1.0f + sc.x) + sh.x; u8[4 * q + 1] = (xv[8 * j + 4 * q + 1] * r2 * g.y) * (1.0f + sc.y) + sh.y;
                u8[4 * q + 2] = (xv[8 * j + 4 * q + 2] * r2 * g.z) * (1.0f + sc.z) + sh.z; u8[4 * q + 3] = (xv[8 * j + 4 * q + 3] * r2 * g.w) * (1.0f + sc.w) + sh.w; }
            u32x4 w; w.x = cvtpk(u8[0], u8[1]); w.y = cvtpk(u8[2], u8[3]); w.z = cvtpk(u8[4], u8[5]); w.w = cvtpk(u8[6], u8[7]);
            *(u32x4*)(U2 + (size_t)m * DM + col) = w; }
        }
    }
    __syncthreads();
    {
        const int tl = lane & 15, kg = lane >> 4, tg = wave & 3, kh = wave >> 2;
        const bf16_t* up = U2 + (size_t)(tokb + tg * 16 + tl) * DM + kh * 1024 + 8 * kg;
        const bf16_t* wp = WR + (size_t)tl * DM + kh * 1024 + 8 * kg;
        f32x4 a0 = {0.f, 0.f, 0.f, 0.f}, a1 = a0, a2 = a0;
#pragma unroll 8
        for (int s = 0; s < 32; ++s) {
            const bf16x8 bu = *(const bf16x8*)(up + 32 * s);
            const bf16x8 w0 = *(const bf16x8*)(wp + 32 * s), w1 = *(const bf16x8*)(wp + 16 * DM + 32 * s), w2 = *(const bf16x8*)(wp + 32 * DM + 32 * s);
            a0 = MFMA16(w0, bu, a0); a1 = MFMA16(w1, bu, a1); a2 = MFMA16(w2, bu, a2);
        }
        LAS float* lg = (LAS float*)(lds + L5_LG) + (kh * 4 + tg) * 768 + tl * 48 + 4 * kg;
#pragma unroll
        for (int r = 0; r < 4; ++r) { lg[r] = a0[r]; lg[16 + r] = a1[r]; lg[32 + r] = a2[r]; }
    }
    __syncthreads();
    if (wave < 4) {
        if (lane < 16) {
            const LAS float* l = (const LAS float*)(lds + L5_LG) + wave * 768 + lane * 48; const LAS float* l2 = l + 4 * 768;
            float gl[4]; int gs = 0; float gm;
#pragma unroll
            for (int i = 0; i < 4; ++i) gl[i] = l[i] + l2[i] + p.b_rg[i];
            gm = gl[0];
#pragma unroll
            for (int i = 1; i < 4; ++i) if (gl[i] > gm) { gm = gl[i]; gs = i; }
            float gsum = 0.f;
#pragma unroll
            for (int i = 0; i < 4; ++i) gsum += expf(gl[i] - gm);
            const float pg = 1.0f / gsum;
            float el[8]; float em = -3.0e38f;
#pragma unroll
            for (int i = 0; i < 8; ++i) { const float v = l[4 + 8 * gs + i] + l2[4 + 8 * gs + i] + p.b_re[8 * gs + i]; el[i] = v; em = fmaxf(em, v); }
            float pe[8]; float esum = 0.f;
#pragma unroll
            for (int i = 0; i < 8; ++i) { pe[i] = expf(el[i] - em); esum += pe[i]; }
            int i0 = 0; float p0 = pe[0];
#pragma unroll
            for (int i = 1; i < 8; ++i) if (pe[i] > p0) { p0 = pe[i]; i0 = i; }
            int i1 = -1; float p1 = -1.f;
#pragma unroll
            for (int i = 0; i < 8; ++i) if (i != i0 && pe[i] > p1) { p1 = pe[i]; i1 = i; }
            const float w0 = pg * p0 / (p0 + p1), w1 = pg * p1 / (p0 + p1);
            const int e0 = 8 * gs + i0, e1 = 8 * gs + i1;
            const unsigned lr0 = __hip_atomic_fetch_add(hist + e0, 1u, __ATOMIC_RELAXED, __HIP_MEMORY_SCOPE_WORKGROUP), lr1 = __hip_atomic_fetch_add(hist + e1, 1u, __ATOMIC_RELAXED, __HIP_MEMORY_SCOPE_WORKGROUP);
            LAS unsigned* tw = tokw + (wave * 16 + lane) * 6;
            tw[0] = (unsigned)e0; tw[1] = (unsigned)e1; tw[2] = lr0; tw[3] = lr1; tw[4] = __float_as_uint(w0); tw[5] = __float_as_uint(w1);
        }
    }
    __syncthreads();
    if (tid < 32) { unsigned* cnt = (unsigned*)(p.ws + WS_CTL) + CW_CNT; const unsigned hcount = hist[tid];
        hist[32 + tid] = hcount ? __hip_atomic_fetch_add(cnt + tid, hcount, __ATOMIC_RELAXED, __HIP_MEMORY_SCOPE_AGENT) : 0u; }
    __syncthreads();
    if (tid < 64) {
        const LAS unsigned* tw = tokw + tid * 6; const int tok = tokb + tid;
        const unsigned e0 = tw[0], e1 = tw[1], q0 = hist[32 + e0] + tw[2], q1 = hist[32 + e1] + tw[3];
        int* RT = (int*)(p.ws + WS_RTOK); RT[e0 * ECAP + q0] = tok; RT[e1 * ECAP + q1] = tok;
        u32x4* rec = (u32x4*)(p.ws + WS_REC) + (size_t)tok * 2;
        rec[0] = (u32x4){e0, e1, q0, q1}; rec[1] = (u32x4){tw[4], tw[5], 0u, 0u};
    }
    __syncthreads();
}
DI void expert_copy_gu(const Params& p, int it, LAS float* scr, int lane) {
    const int e = it >> 10, r = it & 1023, up = r >> 9, q = r & 511, kb = q >> 4, nb = q & 15, n0 = 32 * nb;
    const float* W = (up ? p.w_up : p.w_gate) + (size_t)e * DM * FF;
    transpose_tile(W, FF, 64 * kb, n0, (bf16_t*)(p.ws + WS_WGU), DM, e * 1024 + (n0 >> 7) * 256 + (n0 & 127) + up * 128, 0, 32, scr, lane);
}
DI void expert_copy_dn(const Params& p, int it, LAS float* scr, int lane) {
    const int e = it >> 9, q = it & 511, kb = q >> 6, nb = q & 63;
    transpose_tile(p.w_down + (size_t)e * FF * DM, DM, 64 * kb, 32 * nb, (bf16_t*)(p.ws + WS_WDN), FF, e * DM + 32 * nb, 0, 32, scr, lane);
}

struct MoeOrder {
    const LAS int* pref; const LAS int* cnt; int ntn, G, c;
    DI bool next(int i, pg8::Unit& u) const {
        const int L = i * G + c; const int total = pref[32] * ntn; if (L >= total) return false;
        const int tile = L / ntn, pnl = L - tile * ntn;
        int e = 0;
        for (int q = 1; q < 32; ++q) if (tile >= pref[q]) e = q;
        const int m = tile - pref[e];
        u.pm = tile; u.pn = e * ntn + pnl; u.ga = e * ECAP + m * 256; u.gn = cnt[e] - m * 256; return true;
    }
};
DI void moe_tables(const Params& p, LAS int* pref, LAS int* cntl, int tid) {
    if (tid == 0) { const unsigned* cnt = (const unsigned*)(p.ws + WS_CTL) + CW_CNT; int acc = 0;
        for (int e = 0; e < 32; ++e) { const int c = (int)__hip_atomic_load(cnt + e, __ATOMIC_RELAXED, __HIP_MEMORY_SCOPE_AGENT); pref[e] = acc; cntl[e] = c; acc += (c + 255) >> 8; }
        pref[32] = acc; }
    __syncthreads();
}

DI void phase8(const Params& p, const LAS int* pref, int lane, int gw, int NGW) {
    const float* MOD = (const float*)(p.ws + WS_MOD); const bf16_t* YB = (const bf16_t*)(p.ws + WS_YBUF);
    for (int m = gw; m < T; m += NGW) {
        const int b = m >> 11; const float* gt2 = MOD + b * 12288 + 5 * 2048;
        const u32x4* rec = (const u32x4*)(p.ws + WS_REC) + (size_t)m * 2;
        const u32x4 r0 = rec[0], r1 = rec[1];
        const size_t row0 = (size_t)(pref[r0.x] * 256 + (int)r0.z), row1 = (size_t)(pref[r0.y] * 256 + (int)r0.w);
        const float w0 = __uint_as_float(r1.x), w1 = __uint_as_float(r1.y);
        float y[32]; float s = 0.f;
#pragma unroll
        for (int j = 0; j < 4; ++j) { const int col = 8 * (lane + 64 * j);
            const u32x4 a = *(const u32x4*)(YB + row0 * DM + col), c = *(const u32x4*)(YB + row1 * DM + col);
            y[8 * j + 0] = w0 * bflo(a.x) + w1 * bflo(c.x); y[8 * j + 1] = w0 * bfhi(a.x) + w1 * bfhi(c.x);
            y[8 * j + 2] = w0 * bflo(a.y) + w1 * bflo(c.y); y[8 * j + 3] = w0 * bfhi(a.y) + w1 * bfhi(c.y);
            y[8 * j + 4] = w0 * bflo(a.z) + w1 * bflo(c.z); y[8 * j + 5] = w0 * bfhi(a.z) + w1 * bfhi(c.z);
            y[8 * j + 6] = w0 * bflo(a.w) + w1 * bflo(c.w); y[8 * j + 7] = w0 * bfhi(a.w) + w1 * bfhi(c.w);
#pragma unroll
            for (int e = 0; e < 8; ++e) s += y[8 * j + e] * y[8 * j + e]; }
        const float rs = rsqrt_(wave_sum(s) * (1.0f / DM) + EPS);
#pragma unroll
        for (int j = 0; j < 4; ++j) { const int col = 8 * (lane + 64 * j);
#pragma unroll
            for (int q = 0; q < 2; ++q) { float* op = p.out + (size_t)m * DM + col + 4 * q;
                const f32x4 x1 = *(const f32x4*)op, g = *(const f32x4*)(p.g_ffn_post + col + 4 * q), gt = *(const f32x4*)(gt2 + col + 4 * q);
                f32x4 o;
                o.x = x1.x + gt.x * (y[8 * j + 4 * q + 0] * rs * g.x); o.y = x1.y + gt.y * (y[8 * j + 4 * q + 1] * rs * g.y);
                o.z = x1.z + gt.z * (y[8 * j + 4 * q + 2] * rs * g.z); o.w = x1.w + gt.w * (y[8 * j + 4 * q + 3] * rs * g.w);
                *(f32x4*)op = o; } }
    }
}

#define XB_TMO      128
#define XB_XCNT(j)  (256  + 64 * (j))
#define XB_XSUB(j)  (1280 + 64 * (j))
#define XB_XGEN(j)  (2304 + 64 * (j))
#define XB_TOP      3328
#define XB_TOPGEN   3392
#define XCD_BAR_WORDS 3456
#define XB_SPIN_CAP (1u << 18)
DI unsigned xb_ld(unsigned* p)              { return __hip_atomic_load(p, __ATOMIC_RELAXED, __HIP_MEMORY_SCOPE_AGENT); }
DI unsigned xb_add(unsigned* p, unsigned v) { return __hip_atomic_fetch_add(p, v, __ATOMIC_RELAXED, __HIP_MEMORY_SCOPE_AGENT); }
DI unsigned xb_xcc_id() { return (unsigned)__builtin_amdgcn_s_getreg((3 << 11) | 20) & 0xFu; }
#define XB_SPIN(cond, bar) do { unsigned _sp = 0; while (cond) { __builtin_amdgcn_s_sleep(1); \
    if ((++_sp & 255u) == 0u) { if (xb_ld(&(bar)[XB_TMO])) break; if (_sp > XB_SPIN_CAP) { atomicAdd(&(bar)[XB_TMO], 1u); break; } } } } while (0)
struct XcdBarrier { unsigned* bar; unsigned x; volatile LAS unsigned* st; };
DI XcdBarrier xcd_barrier_post(unsigned* bar, volatile LAS unsigned* st) {
    XcdBarrier b; b.bar = bar; b.x = xb_xcc_id(); b.st = st;
    if (threadIdx.x == 0) (void)xb_add(&bar[XB_XCNT(b.x)], 1u);
    return b;
}
DI void xcd_barrier_complete(unsigned* bar, unsigned x, unsigned& nloc, unsigned& nx) {
    const unsigned G = gridDim.x * gridDim.y * gridDim.z;
    unsigned sum, cnt, mine, sp = 0u;
    for (;;) {
        sum = 0u; cnt = 0u; mine = 0u;
#pragma unroll
        for (unsigned j = 0; j < 16; ++j) { const unsigned c = xb_ld(&bar[XB_XCNT(j)]); sum += c; cnt += (c > 0u) ? 1u : 0u; mine = (j == x) ? c : mine; }
        if (sum == G) break;
        __builtin_amdgcn_s_sleep(1);
        if ((++sp & 255u) == 0u) { if (xb_ld(&bar[XB_TMO])) break; if (sp > XB_SPIN_CAP) { atomicAdd(&bar[XB_TMO], 1u); break; } }
    }
    nloc = mine > 0u ? mine : 1u; nx = cnt > 0u ? cnt : 1u;
}
DI void xcd_barrier(const XcdBarrier& b) {
    asm volatile("s_waitcnt vmcnt(0)" ::: "memory");
    __syncthreads();
    if (threadIdx.x == 0) {
        unsigned* bar = b.bar;
        __builtin_amdgcn_s_waitcnt(0);
        unsigned nloc = b.st[0], nx = b.st[1];
        if (nloc == 0u) { xcd_barrier_complete(bar, b.x, nloc, nx); b.st[0] = nloc; b.st[1] = nx; }
        const unsigned old = xb_add(&bar[XB_XSUB(b.x)], 1u);
        const unsigned gen = old / nloc;
        if (old + 1u == (gen + 1u) * nloc) {
            __builtin_amdgcn_fence(__ATOMIC_RELEASE, "agent");
            asm volatile("s_waitcnt vmcnt(0)" ::: "memory");
            const unsigned og = xb_add(&bar[XB_TOP], 1u);
            const unsigned tg = og / nx;
            if (og + 1u == (tg + 1u) * nx) xb_add(&bar[XB_TOPGEN], 1u);
            else XB_SPIN(xb_ld(&bar[XB_TOPGEN]) == tg, bar);
            __builtin_amdgcn_fence(__ATOMIC_ACQUIRE, "agent");
            xb_add(&bar[XB_XGEN(b.x)], 1u);
            asm volatile("s_waitcnt vmcnt(0)" ::: "memory");
        } else {
            XB_SPIN(xb_ld(&bar[XB_XGEN(b.x)]) == gen, bar);
            __builtin_amdgcn_fence(__ATOMIC_ACQUIRE, "agent");
            asm volatile("s_waitcnt vmcnt(0)" ::: "memory");
        }
    }
    __syncthreads();
}

constexpr int NWAVES = 8, NTHREADS = 512;
constexpr int LDS_GEMM = 131072, LDS_TAB = 152576, LDS_BYTES = LDS_TAB + 1024;
constexpr int N_PHASES = 12;
#ifndef DBL
#define DBL -1
#endif
#define REP(k) for (int rep_ = 0; rep_ < ((DBL == (k)) ? 2 : 1); ++rep_)
#ifndef MK_N_LAUNCHES
#define MK_N_LAUNCHES 1
#endif

DI moba::BlockRef attn_ref(const Params& p, int bh, int qb) {
    const int b = bh >> 3, h = bh & 7;
    const bf16_t* PROJ = (const bf16_t*)(p.ws + WS_B);
    moba::BlockRef r;
    r.Q = PROJ + (size_t)(b * SEQ + qb * 256) * PP + C_Q + h * HD;
    r.K = PROJ + (size_t)(b * SEQ) * PP + C_K + h * HD;
    r.V = PROJ + (size_t)(b * SEQ) * PP + C_V + h * HD;
    r.O = (bf16_t*)(p.ws + WS_A) + (size_t)(b * SEQ + qb * 256) * DM + h * HD;
    r.KM = (const bf16_t*)(p.ws + WS_KMEAN) + (size_t)bh * 8 * HD;
    r.P0 = qb * 256;
    return r;
}

typedef const __attribute__((address_space(4))) Params* KParams;
#if defined(__HIP_DEVICE_COMPILE__)
#define LOADP() KParams kq_ = kp_; asm volatile("" : "+s"(kq_)); const Params p = *kq_
#else
#define LOADP() const Params p = p_unused
#endif
__global__ void __launch_bounds__(NTHREADS, 2) fwd_kernel(Params p_unused) {
#if defined(__HIP_DEVICE_COMPILE__)
    const KParams kp_ = (KParams)__builtin_amdgcn_kernarg_segment_ptr();
#else
    const Params* kp_ = &p_unused;
#endif
    extern __shared__ __attribute__((aligned(16))) unsigned char lds_raw[];
    LAS unsigned char* lds = (LAS unsigned char*)lds_raw;
    const int bid = blockIdx.x, G = gridDim.x, NGW = G * NWAVES;
#define IDS() int tid_ = threadIdx.x; asm volatile("" : "+v"(tid_)); const int tid = tid_, lane = tid & 63, wave = __builtin_amdgcn_readfirstlane(tid >> 6), gw = bid * NWAVES + wave; (void)lane; (void)gw; (void)wave
    const int vcu = (G % 8 == 0) ? (bid % 8) * (G / 8) + bid / 8 : bid;
    const int lo = kp_->ph_lo, hi = kp_->ph_hi;
#ifdef ONLY
#define IN(k) ((k) == ONLY && lo <= (k) && (k) < hi)
#else
#define IN(k) (lo <= (k) && (k) < hi)
#endif
    { volatile LAS unsigned* st0 = (volatile LAS unsigned*)(lds + LDS_TAB + 512); if (threadIdx.x < 2) st0[threadIdx.x] = 0u; __syncthreads(); }
    XcdBarrier xbar; xbar.bar = (unsigned*)(kp_->ws + WS_CTL) + CW_BAR; xbar.x = 0; xbar.st = (volatile LAS unsigned*)(lds + LDS_TAB + 512);
#define SEAM(k) do { if (IN(k) && IN((k) + 1)) { if ((k) == 0) { cg::this_grid().sync(); xbar = xcd_barrier_post((unsigned*)(kp_->ws + WS_CTL) + CW_BAR, (volatile LAS unsigned*)(lds + LDS_TAB + 512)); } else xcd_barrier(xbar); } } while (0)

    if (IN(0)) { LOADP(); IDS();
        if (bid == 0) { unsigned* ctl = (unsigned*)(p.ws + WS_CTL); for (int i = tid; i < 8192; i += NTHREADS) ctl[i] = 0u; }
        REP(0) phase0(p, lds, tid, lane, wave, bid, G); }
    SEAM(0);
    if (IN(1)) { LOADP(); IDS(); REP(1) for (int it = bid; it < T / 64; it += G) phase_u1_item(p, it, tid, lane, wave); }
    SEAM(1);
    if (IN(2)) { LOADP(); IDS();
        pg8::Gemm g{(const bf16_t*)(p.ws + WS_A), (const bf16_t*)(p.ws + WS_WIN), DM, nullptr};
        pg8::StaticOrder S; S.init(T, NPROJ, G, bid);
        pg8::EpiStore E{(bf16_t*)(p.ws + WS_B), PP, 64};
        pg8::gemm_phase<pg8::EpiStore, pg8::StaticOrder, true, false>(lds, g, S, E);
#if DBL == 2
        pg8::gemm_phase<pg8::EpiStore, pg8::StaticOrder, true, false>(lds, g, S, E);
#endif
    }
    SEAM(2);
    if (IN(3)) { LOADP(); IDS();
        if (wave < 4) { for (int it = bid * 4 + wave; it < 1024; it += G * 4) rotary_item(p, it, lane); }
        REP(30) { dn::Raw R; dn::ConvW CW; dn::prep_consts(p, (bid >> 5) & 7, CW, lane); if (bid < 64 * 32) dn::prep_load(p, bid, R, lane, wave);
            for (int it = bid; it < 64 * 32; it += G) dn::prep_chunk(p, lds, it, (it + G < 64 * 32) ? it + G : -1, R, CW, tid, lane, wave); }
    }
    SEAM(3);
    if (IN(4)) { LOADP(); IDS();
        const int x = bid & 7, ci = bid >> 3, grp = ci >> 3, bhA = 8 * x + 7 - (ci & 7);
        REP(41) { if (grp == 0) dn::recur(p, lds, 8 * x + ci, tid, lane, wave); }
#ifndef NO_ATTN
        REP(40) {
            const int nblk = grp == 0 ? 1 : (grp == 2 ? 3 : 2);
#define QSEL(i) (grp == 0 ? 3 : grp == 1 ? ((i) == 0 ? 7 : 1) : grp == 2 ? ((i) == 0 ? 6 : ((i) == 1 ? 2 : 0)) : ((i) == 0 ? 5 : 4))
            moba::Seam S;
            moba::BlockRef cur = attn_ref(p, bhA, QSEL(0));
            moba::prime(cur, (char*)lds_raw, S);
            for (int i = 0; i < nblk; ++i) {
                const int in = (i + 1 < nblk) ? i + 1 : i;
                const moba::BlockRef nxt = attn_ref(p, bhA, QSEL(in));
                moba::block(cur, nxt, (char*)lds_raw, S);
                cur = nxt;
            }
#undef QSEL
        }
#endif
    }
    SEAM(4);
    if (IN(6)) { LOADP(); IDS();
        pg8::Gemm g{(const bf16_t*)(p.ws + WS_A), (const bf16_t*)(p.ws + WS_WMD), DM, nullptr};
        pg8::StaticOrder S; S.init(T, DM, G, bid);
        pg8::EpiMerged E{(const bf16_t*)(p.ws + WS_B), (bf16_t*)(p.ws + WS_MERGED)};
        pg8::gemm_phase<pg8::EpiMerged, pg8::StaticOrder, true, false>(lds, g, S, E);
#if DBL == 6
        pg8::gemm_phase<pg8::EpiMerged, pg8::StaticOrder, true, false>(lds, g, S, E);
#endif
    }
    SEAM(6);
    if (IN(7)) { LOADP(); IDS();
        const bool copy_first = ((bid >> 3) & 1) == 0;
        LAS float* scr = (LAS float*)(lds + wave * 8448);
        if (copy_first) { REP(81) for (int it = gw; it < 32 * 1024; it += NGW) expert_copy_gu(p, it, scr, lane); __syncthreads(); }
        {
        pg8::Gemm g{(const bf16_t*)(p.ws + WS_MERGED), (const bf16_t*)(p.ws + WS_WOUT), DM, nullptr};
        pg8::StaticOrder S; S.init(T, DM, G, bid);
        pg8::EpiStore E{(bf16_t*)(p.ws + WS_OUTMIX), DM, 8};
        pg8::gemm_phase<pg8::EpiStore, pg8::StaticOrder, true, false>(lds, g, S, E);
#if DBL == 7
        pg8::gemm_phase<pg8::EpiStore, pg8::StaticOrder, true, false>(lds, g, S, E);
#endif
        }
        if (!copy_first) { REP(81) for (int it = gw; it < 32 * 1024; it += NGW) expert_copy_gu(p, it, scr, lane); }
    }
    SEAM(7);
    if (IN(8)) { LOADP(); IDS();
        for (int it = bid; it < T / 64; it += G) phase5_item(p, lds, it, tid, lane, wave);
    }
    SEAM(8);
    LAS int* pref = (LAS int*)(lds + LDS_TAB); LAS int* cntl = pref + 64;
    if (IN(9)) { LOADP(); IDS();
        moe_tables(p, pref, cntl, tid);
        pg8::Gemm g{(const bf16_t*)(p.ws + WS_A), (const bf16_t*)(p.ws + WS_WGU), DM, (const int*)(p.ws + WS_RTOK)};
        MoeOrder S{pref, cntl, 4, G, bid};
        pg8::EpiGU E{(bf16_t*)(p.ws + WS_H)};
        pg8::gemm_phase<pg8::EpiGU, MoeOrder, true, true>(lds, g, S, E);
#if DBL == 9
        pg8::gemm_phase<pg8::EpiGU, MoeOrder, true, true>(lds, g, S, E);
#endif
        {   const int total = pref[32] * 4, rem = total % G, ncw = rem ? G - rem : G, cw = rem ? bid - rem : bid;
            if (cw >= 0) { LAS float* scr = (LAS float*)(lds + wave * 8448);
                for (int it = cw * NWAVES + wave; it < 32 * 512; it += ncw * NWAVES) expert_copy_dn(p, it, scr, lane); }
        }
    }
    SEAM(9);
    if (IN(10)) { LOADP(); IDS();
        if (!IN(9)) moe_tables(p, pref, cntl, tid);
        pg8::Gemm g{(const bf16_t*)(p.ws + WS_H), (const bf16_t*)(p.ws + WS_WDN), FF, nullptr};
        MoeOrder S{pref, cntl, 8, G, bid};
        pg8::EpiStore E{(bf16_t*)(p.ws + WS_YBUF), DM, 8};
        pg8::gemm_phase<pg8::EpiStore, MoeOrder, true, false>(lds, g, S, E);
#if DBL == 10
        pg8::gemm_phase<pg8::EpiStore, MoeOrder, true, false>(lds, g, S, E);
#endif
    }
    SEAM(10);
    if (IN(11)) { LOADP(); IDS();
        if (!IN(10)) moe_tables(p, pref, cntl, tid);
        phase8(p, pref, lane, gw, NGW);
    }
#undef IN
#undef SEAM
}

extern "C" void kernel_launch(void* const* d_in, const int* in_sizes, int n_in, void* d_out, int out_size, void* d_ws, size_t ws_size, hipStream_t stream) {
    static int grid = 0;
    if (grid == 0) {
        if (n_in != 24 || in_sizes[0] != T * DM || out_size != T * DM || ws_size < WS_END) {
            fprintf(stderr, "kernel_launch: unexpected shapes (n_in %d, in0 %d, out %d, ws %zu); nothing launched\n", n_in, n_in > 0 ? in_sizes[0] : -1, out_size, ws_size); grid = -1; return; }
        int dev = 0, cus = 0, per_cu = 0;
        hipGetDevice(&dev); hipDeviceGetAttribute(&cus, hipDeviceAttributeMultiprocessorCount, dev);
        if (hipFuncSetAttribute((const void*)fwd_kernel, hipFuncAttributeMaxDynamicSharedMemorySize, LDS_BYTES) != hipSuccess) { fprintf(stderr, "kernel_launch: hipFuncSetAttribute failed\n"); grid = -1; return; }
        if (hipOccupancyMaxActiveBlocksPerMultiprocessor(&per_cu, (const void*)fwd_kernel, NTHREADS, LDS_BYTES) != hipSuccess || per_cu < 1) { fprintf(stderr, "kernel_launch: occupancy query says %d blocks per CU\n", per_cu); grid = -1; return; }
        (void)hipGetLastError();
        grid = cus;
        if (cus != 256) { fprintf(stderr, "kernel_launch: built for a 256-CU device (static phase schedules), found %d CUs; nothing launched\n", cus); grid = -1; return; }
    }
    if (grid < 0) return;
    Params p{};
    p.x = (const float*)d_in[0]; p.c = (const float*)d_in[1]; p.pos = (const int*)d_in[2]; p.w_ada = (const float*)d_in[3]; p.b_ada = (const float*)d_in[4];
    p.g_mix_pre = (const float*)d_in[5]; p.g_mix_post = (const float*)d_in[6]; p.g_ffn_pre = (const float*)d_in[7]; p.g_ffn_post = (const float*)d_in[8];
    p.w_in = (const float*)d_in[9]; p.conv_w = (const float*)d_in[10]; p.a_log = (const float*)d_in[11]; p.dt_bias = (const float*)d_in[12]; p.dn_gain = (const float*)d_in[13];
    p.w_bm = (const float*)d_in[14]; p.w_bd = (const float*)d_in[15]; p.w_out = (const float*)d_in[16];
    p.w_rg = (const float*)d_in[17]; p.b_rg = (const float*)d_in[18]; p.w_re = (const float*)d_in[19]; p.b_re = (const float*)d_in[20];
    p.w_gate = (const float*)d_in[21]; p.w_up = (const float*)d_in[22]; p.w_down = (const float*)d_in[23];
    p.out = (float*)d_out; p.ws = (unsigned char*)d_ws;
    for (int li = 0; li < MK_N_LAUNCHES; ++li) {
        p.ph_lo = (MK_N_LAUNCHES == 1) ? 0 : li; p.ph_hi = (MK_N_LAUNCHES == 1) ? N_PHASES : li + 1;
        void* args[] = {&p};
        hipError_t e = hipLaunchCooperativeKernel((const void*)fwd_kernel, dim3(grid), dim3(NTHREADS), args, LDS_BYTES, stream);
        if (e != hipSuccess) { fprintf(stderr, "kernel_launch: cooperative launch failed: %s (grid %d)\n", hipGetErrorString(e), grid); break; }
    }
}
```

```cpp
#include <hip/hip_runtime.h>
#include <hip/hip_cooperative_groups.h>
#include <cstdio>
#include <cstdint>
namespace cg = cooperative_groups;

#define LAS __attribute__((address_space(3)))
#define DI __device__ __forceinline__
typedef unsigned short bf16_t;
typedef short bf16x8 __attribute__((ext_vector_type(8)));
typedef short s16x4 __attribute__((ext_vector_type(4)));
typedef float f32x2 __attribute__((ext_vector_type(2)));
typedef float f32x4 __attribute__((ext_vector_type(4)));
typedef float f32x16 __attribute__((ext_vector_type(16)));
typedef unsigned u32x2 __attribute__((ext_vector_type(2)));
typedef unsigned u32x4 __attribute__((ext_vector_type(4)));
typedef __bf16 bf16x2_t __attribute__((ext_vector_type(2)));

constexpr int NB = 8, SEQ = 2048, T = NB * SEQ, DM = 2048;
constexpr int NHEAD = 8, HD = 128;
constexpr int PP = 11264;
constexpr int NPROJ = 11264;
constexpr int C_Q = 0, C_K = 1024, C_V = 2048, C_DN = 3072, C_Z = 6144, C_GA = 7168, C_GB = 9216;
constexpr int NEXP = 32, FF = 512, ECAP = 16384;
constexpr float EPS = 1e-6f;

constexpr size_t MiB = 1u << 20;
constexpr size_t WS_CTL = 0, CTL_ZERO_BYTES = 1 * MiB;
constexpr size_t WS_MOD = 1 * MiB;
constexpr size_t WS_CS = 2 * MiB;
constexpr size_t WS_KMEAN = 4 * MiB;
constexpr size_t WS_WR = 4 * MiB + 512 * 1024;
constexpr size_t WS_WBA = 4 * MiB + 768 * 1024;
constexpr size_t WS_BA = 5 * MiB;
constexpr size_t WS_REC = 6 * MiB;
constexpr size_t WS_RTOK = 7 * MiB;
constexpr size_t WS_WMD = 10 * MiB;
constexpr size_t WS_WOUT = 18 * MiB;
constexpr size_t WS_A = 26 * MiB;
constexpr size_t WS_B = 90 * MiB;
constexpr size_t WS_C = 442 * MiB;
constexpr size_t WS_D = 588 * MiB;
constexpr size_t WS_END = 652 * MiB;
constexpr size_t WS_OUTMIX = WS_B, WS_WGU = WS_B + 128 * MiB, WS_WDN = WS_B + 256 * MiB, WS_YBUF = WS_B;
constexpr size_t WS_WIN = WS_C, WS_DNP = WS_C, WS_MERGED = WS_C, WS_H = WS_C + 64 * MiB;
constexpr int CW_CNT = 64;
constexpr int CW_BAR = 4096;
constexpr int DN_U = 0, DN_W = 16384, DN_QD = 32768, DN_KT = 49152, DN_QK = 65536, DN_SC = 73728, DN_STRIDE = 73984;

struct Params {
    const float* x; const float* c; const int* pos; const float* w_ada; const float* b_ada;
    const float* g_mix_pre; const float* g_mix_post; const float* g_ffn_pre; const float* g_ffn_post;
    const float* w_in; const float* conv_w; const float* a_log; const float* dt_bias; const float* dn_gain;
    const float* w_bm; const float* w_bd; const float* w_out;
    const float* w_rg; const float* b_rg; const float* w_re; const float* b_re;
    const float* w_gate; const float* w_up; const float* w_down;
    float* out; unsigned char* ws;
    int ph_lo, ph_hi;
};

DI unsigned cvtpk(float lo, float hi) { f32x2 v = {lo, hi}; bf16x2_t b = __builtin_convertvector(v, bf16x2_t); return __builtin_bit_cast(unsigned, b); }
DI float bflo(unsigned w) { return __uint_as_float(w << 16); }
DI float bfhi(unsigned w) { return __uint_as_float(w & 0xffff0000u); }
DI float bf2f(bf16_t b) { return __uint_as_float((unsigned)b << 16); }
DI bf16_t f2bf(float f) { return (bf16_t)(cvtpk(f, 0.f) & 0xffffu); }
DI float wave_sum(float v) {
#pragma unroll
    for (int o = 1; o < 64; o <<= 1) v += __shfl_xor(v, o);
    return v;
}
DI float sigmoidf_(float x) { return __builtin_amdgcn_rcpf(1.f + __expf(-x)); }
DI float siluf_(float x) { return x * __builtin_amdgcn_rcpf(1.f + __expf(-x)); }
DI float rsqrt_(float x) { return __builtin_amdgcn_rsqf(x); }
DI float siluf_acc(float x) { return x / (1.f + expf(-x)); }
constexpr float SCALE_Q = 0.08838834764831845f;
DI int perm16(int p) { return (p & 3) | ((p & 4) << 1) | ((p & 8) >> 1); }
DI int crow(int r, int hi) { return (r & 3) + 8 * (r >> 2) + 4 * hi; }
#define MFMA32(a, b, c) __builtin_amdgcn_mfma_f32_32x32x16_bf16((a), (b), (c), 0, 0, 0)
#define MFMA16(a, b, c) __builtin_amdgcn_mfma_f32_16x16x32_bf16((a), (b), (c), 0, 0, 0)

namespace pg8 {
constexpr int BM = 256, BK = 64, HALF = 128, HTB = HALF * BK * 2, STAGE_BYTES = 8 * HTB, NXCD = 8, WGM = 8;
DI int lds_byte(int r, int c) { const int st = (r >> 4) * 2 + (c >> 5), rr = r & 15, cc = c & 31, ob = rr * 64 + cc * 2; return st * 1024 + (ob ^ (((ob >> 9) & 1) << 5)); }
DI void stage_rc(int b, int& R, int& C) { const int st = b / 1024, sb = b % 1024, swz = sb ^ (((sb >> 9) & 1) << 5); R = (st >> 1) * 16 + swz / 64; C = (st & 1) * 32 + (swz % 64) / 2; }
DI int perm32(int rho) { const int n = rho >> 4, i = rho & 15; return 8 * (i >> 2) + 4 * n + (i & 3); }

struct Unit { int pm, pn, ga, gn; };
struct Gemm { const bf16_t* A; const bf16_t* Bt; int K; const int* gidx; };

struct StaticOrder {
    int nM, nN, nwg, G, c;
    DI void init(int M, int N, int G_, int c_) { nM = M / BM; nN = N / BM; nwg = nM * nN; G = G_; c = c_; }
    DI bool next(int i, Unit& u) const {
        const long L = (long)i * G + c; if (L >= nwg) return false;
        int wgid = (int)L; { const int q = nwg / NXCD, r = nwg % NXCD, xcd = wgid % NXCD, off = wgid / NXCD; wgid = (xcd < r ? xcd * (q + 1) : r * (q + 1) + (xcd - r) * q) + off; }
        const int nig = WGM * nN, gid = wgid / nig, fm = gid * WGM, gsz = (nM - fm) < WGM ? (nM - fm) : WGM;
        u.pm = fm + ((wgid % nig) % gsz); u.pn = (wgid % nig) / gsz; u.ga = 0; u.gn = 0; return true;
    }
};

typedef f32x4 Acc[2][2][4][2];

template <class Epi, class Sched, bool ALIGN_EPI, bool GATHER>
DI void gemm_phase(LAS unsigned char* lds, const Gemm g, const Sched& S, const Epi& E) {
    const int tid = threadIdx.x, wid = __builtin_amdgcn_readfirstlane(tid >> 6), lane = tid & 63, wr = wid >> 2, wc = wid & 3, fr = lane & 15, fq = lane >> 4;
    const int K = g.K, nt = K / BK;
    unsigned voffA[2], voffB[2]; int gR[2], gC[2];
#pragma unroll
    for (int i = 0; i < 2; ++i) { int R, C; stage_rc(tid * 16 + i * 8192, R, C); const int Rb = (R & ~31) + perm32(R & 31);
        voffA[i] = (unsigned)(R * K + C) * 2u; voffB[i] = (unsigned)(Rb * K + C) * 2u; gR[i] = R; gC[i] = C; }
    const size_t kstep = (size_t)(BK * 2);
    const size_t hstep = (size_t)HALF * K * 2;
    const size_t tstep = 2 * hstep;
    const unsigned ldsw = (unsigned)wid * 1024u;
    const int aoff = lds_byte(wr * 64 + fr, fq * 8), boff = lds_byte(wc * 32 + fr, fq * 8);
#define PG8_SA(b, h) (((b) * 2 + (h)) * HTB)
#define PG8_SB(b, h) ((4 + (b) * 2 + (h)) * HTB)
#define PG8_STAGE(bufoff, gbase, voff) do { _Pragma("unroll") for (int _i = 0; _i < 2; ++_i) \
        __builtin_amdgcn_global_load_lds((const unsigned*)((const char*)(gbase) + (voff)[_i]), (LAS unsigned*)(lds + (bufoff) + ldsw + _i * 8192), 16, 0, 0); } while (0)
#define PG8_LDA(dst, b, h) do { _Pragma("unroll") for (int m = 0; m < 4; ++m) _Pragma("unroll") for (int k = 0; k < 2; ++k) dst[m][k] = *(const LAS bf16x8*)(lds + PG8_SA(b, h) + aoff + m * 2048 + k * 1024); } while (0)
#define PG8_LDB(dst, b, h) do { _Pragma("unroll") for (int n = 0; n < 2; ++n) _Pragma("unroll") for (int k = 0; k < 2; ++k) dst[n][k] = *(const LAS bf16x8*)(lds + PG8_SB(b, h) + boff + n * 2048 + k * 1024); } while (0)
#define PG8_MMA(ai, bj, At, Bt) do { __builtin_amdgcn_s_setprio(1); _Pragma("unroll") for (int m = 0; m < 4; ++m) _Pragma("unroll") for (int n = 0; n < 2; ++n) _Pragma("unroll") for (int k = 0; k < 2; ++k) \
        acc[ai][bj][m][n] = __builtin_amdgcn_mfma_f32_16x16x32_bf16(Bt[n][k], At[m][k], acc[ai][bj][m][n], 0, 0, 0); __builtin_amdgcn_s_setprio(0); } while (0)
#define PG8_WAIT_V(n) asm volatile("s_waitcnt vmcnt(" #n ")" ::: "memory")
#define PG8_WAIT_L(n) asm volatile("s_waitcnt lgkmcnt(" #n ")" ::: "memory")
#define PG8_BAR __builtin_amdgcn_s_barrier()
#define PG8_SCHED __builtin_amdgcn_sched_barrier(0)
    Unit cur, nxt; int ui = 0;
    if (!S.next(0, cur)) return;
    Acc acc;
#pragma unroll
    for (int a = 0; a < 2; ++a)
#pragma unroll
        for (int b = 0; b < 2; ++b)
#pragma unroll
            for (int m = 0; m < 4; ++m)
#pragma unroll
                for (int n = 0; n < 2; ++n) acc[a][b][m][n] = (f32x4){0.f, 0.f, 0.f, 0.f};
    bf16x8 At[4][2], B0[2][2], B1[2][2];
    unsigned vA0[2], vA1[2];
#define PG8_SET_VOFF(u) do { if constexpr (GATHER) { _Pragma("unroll") for (int _i = 0; _i < 2; ++_i) { \
                const int _r0 = gR[_i], _r1 = HALF + gR[_i]; \
                const int _t0 = _r0 < (u).gn ? g.gidx[(u).ga + _r0] : 0, _t1 = _r1 < (u).gn ? g.gidx[(u).ga + _r1] : 0; \
                vA0[_i] = (unsigned)(_t0 * K + gC[_i]) * 2u; vA1[_i] = (unsigned)(_t1 * K + gC[_i]) * 2u; } \
        } else { vA0[0] = voffA[0]; vA0[1] = voffA[1]; vA1[0] = voffA[0] + (unsigned)hstep; vA1[1] = voffA[1] + (unsigned)hstep; } } while (0)
    PG8_SET_VOFF(cur);
    const char* cA = GATHER ? (const char*)g.A : (const char*)g.A + (size_t)cur.pm * tstep; const char* cB = (const char*)g.Bt + (size_t)cur.pn * tstep;
    PG8_STAGE(PG8_SB(0, 0), cB, voffB); PG8_STAGE(PG8_SB(0, 1), cB + hstep, voffB); PG8_STAGE(PG8_SA(0, 0), cA, vA0); PG8_STAGE(PG8_SA(0, 1), cA, vA1);
    if (wr == 1) PG8_BAR;
    PG8_WAIT_V(2); PG8_BAR;
    PG8_STAGE(PG8_SB(1, 0), cB + kstep, voffB); PG8_STAGE(PG8_SA(1, 0), cA + kstep, vA0); PG8_STAGE(PG8_SB(1, 1), cB + hstep + kstep, voffB);
    PG8_WAIT_V(6); PG8_BAR;
    for (;;) {
        const bool has_next = S.next(ui + 1, nxt);
        const char* nA = GATHER ? (const char*)g.A : (has_next ? (const char*)g.A + (size_t)nxt.pm * tstep : cA);
        const char* nB = has_next ? (const char*)g.Bt + (size_t)nxt.pn * tstep : cB;
#define PG8_KTRIP(t) do { \
            const bool last = (t == nt - 2); \
            const char* a1 = cA + (size_t)(t + 1) * kstep; \
            const char* a2 = last ? nA : cA + (size_t)(t + 2) * kstep; const char* b2 = last ? nB : cB + (size_t)(t + 2) * kstep; \
            const char* a3 = a2 + kstep; const char* b3 = b2 + kstep; \
            PG8_LDB(B0, 0, 0); PG8_LDB(B1, 0, 1); PG8_SCHED; PG8_LDA(At, 0, 0); PG8_STAGE(PG8_SA(1, 1), a1, vA1); \
            PG8_WAIT_V(8); PG8_WAIT_L(0); PG8_BAR; PG8_MMA(0, 0, At, B0); PG8_MMA(0, 1, At, B1); PG8_BAR; PG8_SCHED; \
            if constexpr (GATHER) { if (last && has_next) PG8_SET_VOFF(nxt); } \
            PG8_LDA(At, 0, 1); PG8_STAGE(PG8_SB(0, 0), b2, voffB); PG8_STAGE(PG8_SB(0, 1), b2 + hstep, voffB); PG8_STAGE(PG8_SA(0, 0), a2, vA0); \
            PG8_WAIT_V(8); PG8_WAIT_L(0); PG8_BAR; PG8_MMA(1, 0, At, B0); PG8_MMA(1, 1, At, B1); PG8_BAR; PG8_SCHED; \
            PG8_LDB(B0, 1, 0); PG8_LDB(B1, 1, 1); PG8_SCHED; PG8_LDA(At, 1, 0); PG8_STAGE(PG8_SA(0, 1), a2, vA1); \
            PG8_WAIT_V(8); PG8_WAIT_L(0); PG8_BAR; PG8_MMA(0, 0, At, B0); PG8_MMA(0, 1, At, B1); PG8_BAR; PG8_SCHED; \
            PG8_LDA(At, 1, 1); PG8_STAGE(PG8_SB(1, 0), b3, voffB); PG8_STAGE(PG8_SB(1, 1), b3 + hstep, voffB); PG8_STAGE(PG8_SA(1, 0), a3, vA0); \
            PG8_WAIT_V(8); PG8_WAIT_L(0); PG8_BAR; PG8_MMA(1, 0, At, B0); PG8_MMA(1, 1, At, B1); PG8_BAR; PG8_SCHED; \
        } while (0)
        if constexpr (Epi::HAS_MID) {
            for (int t = 0; t < (nt >> 1); t += 2) PG8_KTRIP(t);
            E.mid(acc, cur, wr, wc, fr, fq);
            for (int t = (nt >> 1); t < nt; t += 2) PG8_KTRIP(t);
        } else {
            for (int t = 0; t < nt; t += 2) PG8_KTRIP(t);
        }
#undef PG8_KTRIP
        if constexpr (ALIGN_EPI) { if (wr == 0) PG8_BAR; }
        E(acc, cur, wr, wc, fr, fq);
#if defined(DBL) && DBL == 20
        E(acc, cur, wr, wc, fr, fq);
#endif
        if (!has_next) break;
#pragma unroll
        for (int a = 0; a < 2; ++a)
#pragma unroll
            for (int b = 0; b < 2; ++b)
#pragma unroll
                for (int m = 0; m < 4; ++m)
#pragma unroll
                    for (int n = 0; n < 2; ++n) acc[a][b][m][n] = (f32x4){0.f, 0.f, 0.f, 0.f};
        cur = nxt; cA = nA; cB = nB; ++ui;
        if constexpr (ALIGN_EPI) { if (wr == 1) PG8_BAR; }
    }
    PG8_WAIT_V(0);
    if constexpr (!ALIGN_EPI) { if (wr == 0) PG8_BAR; }
    PG8_BAR;
#undef PG8_SET_VOFF
#undef PG8_SA
#undef PG8_SB
#undef PG8_STAGE
#undef PG8_LDA
#undef PG8_LDB
#undef PG8_MMA
#undef PG8_WAIT_V
#undef PG8_WAIT_L
#undef PG8_BAR
#undef PG8_SCHED
}

struct EpiStore {
    static constexpr bool HAS_MID = false;
    bf16_t* O; int ldc; int ntn;
    DI void operator()(const Acc& acc, const Unit& u, int wr, int wc, int fr, int fq) const {
        const int row0 = u.pm * BM + wr * 64 + fr, col0 = (u.pn % ntn) * BM + wc * 32 + 8 * fq;
#pragma unroll
        for (int ai = 0; ai < 2; ++ai)
#pragma unroll
            for (int m = 0; m < 4; ++m) { bf16_t* rowp = O + (size_t)(row0 + ai * HALF + m * 16) * ldc + col0;
#pragma unroll
                for (int bj = 0; bj < 2; ++bj) { const f32x4 v0 = acc[ai][bj][m][0], v1 = acc[ai][bj][m][1];
                    u32x4 w; w.x = cvtpk(v0[0], v0[1]); w.y = cvtpk(v0[2], v0[3]); w.z = cvtpk(v1[0], v1[1]); w.w = cvtpk(v1[2], v1[3]);
                    *(u32x4*)(rowp + bj * HALF) = w; } }
    }
};
struct EpiMerged {
    static constexpr bool HAS_MID = true;
    const bf16_t* P; bf16_t* O;
    DI void mid(Acc& acc, const Unit& u, int wr, int wc, int fr, int fq) const {
        const unsigned ro = (unsigned)((u.pm * BM + wr * 64 + fr) * PP + u.pn * BM + wc * 32 + 8 * fq);
#pragma unroll
        for (int ai = 0; ai < 2; ++ai)
#pragma unroll
            for (int m = 0; m < 4; ++m) {
#pragma unroll
                for (int bj = 0; bj < 2; ++bj) { const unsigned off = ro + (unsigned)((ai * HALF + m * 16) * PP + bj * HALF);
                    const u32x4 a = *(const u32x4*)(P + off + C_GA), b = *(const u32x4*)(P + off + C_GB);
                    float ga[8] = {bflo(a.x), bfhi(a.x), bflo(a.y), bfhi(a.y), bflo(a.z), bfhi(a.z), bflo(a.w), bfhi(a.w)};
                    float gb[8] = {bflo(b.x), bfhi(b.x), bflo(b.y), bfhi(b.y), bflo(b.z), bfhi(b.z), bflo(b.w), bfhi(b.w)};
#pragma unroll
                    for (int n = 0; n < 2; ++n)
#pragma unroll
                        for (int j = 0; j < 4; ++j) { const float r = (1.f + __expf(-gb[4 * n + j])) * __builtin_amdgcn_rcpf(1.f + __expf(-ga[4 * n + j])); acc[ai][bj][m][n][j] *= r; } }
                asm volatile("" ::: "memory"); __builtin_amdgcn_sched_barrier(0); }
    }
    DI void operator()(const Acc& acc, const Unit& u, int wr, int wc, int fr, int fq) const {
        const unsigned ro = (unsigned)((u.pm * BM + wr * 64 + fr) * PP + u.pn * BM + wc * 32 + 8 * fq);
        const unsigned oo = (unsigned)((u.pm * BM + wr * 64 + fr) * DM + u.pn * BM + wc * 32 + 8 * fq);
#pragma unroll
        for (int ai = 0; ai < 2; ++ai)
#pragma unroll
            for (int m = 0; m < 4; ++m) {
#pragma unroll
                for (int bj = 0; bj < 2; ++bj) { const u32x4 b = *(const u32x4*)(P + ro + (unsigned)((ai * HALF + m * 16) * PP + bj * HALF) + C_GB);
                    float gb[8] = {bflo(b.x), bfhi(b.x), bflo(b.y), bfhi(b.y), bflo(b.z), bfhi(b.z), bflo(b.w), bfhi(b.w)};
                    float v[8];
#pragma unroll
                    for (int n = 0; n < 2; ++n)
#pragma unroll
                        for (int j = 0; j < 4; ++j) v[4 * n + j] = acc[ai][bj][m][n][j] * __builtin_amdgcn_rcpf(1.f + __expf(-gb[4 * n + j]));
                    u32x4 w; w.x = cvtpk(v[0], v[1]); w.y = cvtpk(v[2], v[3]); w.z = cvtpk(v[4], v[5]); w.w = cvtpk(v[6], v[7]);
                    *(u32x4*)(O + oo + (unsigned)((ai * HALF + m * 16) * DM + bj * HALF)) = w; }
                asm volatile("" ::: "memory"); __builtin_amdgcn_sched_barrier(0); }
    }
};
struct EpiGU {
    static constexpr bool HAS_MID = false;
    bf16_t* H;
    DI void operator()(const Acc& acc, const Unit& u, int wr, int wc, int fr, int fq) const {
        const int row0 = u.pm * BM + wr * 64 + fr, col0 = (u.pn & 3) * HALF + wc * 32 + 8 * fq;
#pragma unroll
        for (int ai = 0; ai < 2; ++ai)
#pragma unroll
            for (int m = 0; m < 4; ++m) { float v[8];
#pragma unroll
                for (int n = 0; n < 2; ++n)
#pragma unroll
                    for (int j = 0; j < 4; ++j) v[4 * n + j] = siluf_(acc[ai][0][m][n][j]) * acc[ai][1][m][n][j];
                u32x4 w; w.x = cvtpk(v[0], v[1]); w.y = cvtpk(v[2], v[3]); w.z = cvtpk(v[4], v[5]); w.w = cvtpk(v[6], v[7]);
                *(u32x4*)(H + (size_t)(row0 + ai * HALF + m * 16) * FF + col0) = w; }
    }
};
}

namespace moba {
constexpr int NW = 8, QBLK = 32, KVBLK = 64, QB = NW * QBLK, D = 128;
constexpr int RS = PP;
constexpr int RSO = DM;
constexpr float SCALE = 0.08838834764831845f;
constexpr float THR = 8.f;
constexpr int SHM_V = KVBLK * D * 2, SHM_K = KVBLK * D * 2;
constexpr int LDS_BYTES = 2 * SHM_V + 2 * SHM_K + NW * 64 * 4;
typedef bf16_t bf16;
#define KSWZ(row, colB) ((row) * 256 + ((colB) ^ (((row) & 7) << 4)))
#define SBAR() __builtin_amdgcn_sched_barrier(0)
DI int v_st(int k, int c) { const int kk = (k & ~0xC) | ((k & 4) << 1) | ((k & 8) >> 1); return ((kk >> 3) * 4 + (c >> 5)) * 512 + ((kk & 7) * 32 + (c & 31)) * 2; }
DI int v_rd_base(int lane) { return ((lane & 3) << 3) | (((lane >> 2) & 3) << 6) | (((lane >> 4) & 1) << 5) | (((lane >> 5) & 1) << 8); }
constexpr int v_rd_off(int d0, int ks, int half) { return d0 * 512 + ks * 4096 + half * 2048; }
DI bf16x8 load8(const bf16* p) { return *reinterpret_cast<const bf16x8*>(p); }
DI void mask_tile(f32x16& p0, f32x16& p1, int dq) {
    const float NEG = -__builtin_inff();
#pragma unroll
    for (int r = 0; r < 16; ++r) {
        const int c = (r & 3) + 8 * (r >> 2);
        if (dq - c < 0) p0[r] = NEG;
        if (dq - c - 32 < 0) p1[r] = NEG;
    }
}
DI void mask_all(f32x16& p0, f32x16& p1, bool kill) {
    const float NEG = -__builtin_inff();
#pragma unroll
    for (int r = 0; r < 16; ++r) { if (kill) p0[r] = NEG; if (kill) p1[r] = NEG; }
}
DI void partialSM(f32x16& p0, f32x16& p1, float& m_reg, float& mn, float& alpha) {
    float pmax = p0[0];
#pragma unroll
    for (int r = 1; r < 16; ++r) pmax = fmaxf(pmax, p0[r]);
#pragma unroll
    for (int r = 0; r < 16; ++r) pmax = fmaxf(pmax, p1[r]);
    { auto rr = __builtin_amdgcn_permlane32_swap(__float_as_uint(pmax), __float_as_uint(pmax), false, false);
      pmax = fmaxf(__uint_as_float(rr[0]), __uint_as_float(rr[1])); }
    constexpr float C2 = 1.4426950408889634f * SCALE;
    if (__builtin_expect(__all((pmax - m_reg) * SCALE <= THR), 1)) { mn = m_reg; alpha = 1.f; }
    else { mn = fmaxf(m_reg, pmax); alpha = __builtin_amdgcn_exp2f((m_reg - mn) * C2); m_reg = mn; }
    const float mnL = -mn * C2;
#pragma unroll
    for (int r = 0; r < 16; ++r) p0[r] = fmaf(p0[r], C2, mnL);
#pragma unroll
    for (int r = 0; r < 16; ++r) p1[r] = fmaf(p1[r], C2, mnL);
#pragma unroll
    for (int r = 0; r < 16; ++r) p0[r] = __builtin_amdgcn_exp2f(p0[r]);
}
DI void finishSM(f32x16& p0, f32x16& p1, float alpha, float& l_reg, bf16x8& pa0, bf16x8& pa1, bf16x8& pa2, bf16x8& pa3) {
#pragma unroll
    for (int r = 0; r < 16; ++r) p1[r] = __builtin_amdgcn_exp2f(p1[r]);
    float ps = 0;
#pragma unroll
    for (int r = 0; r < 16; ++r) ps += p0[r];
#pragma unroll
    for (int r = 0; r < 16; ++r) ps += p1[r];
    { auto rr = __builtin_amdgcn_permlane32_swap(__float_as_uint(ps), __float_as_uint(ps), false, false);
      ps = __uint_as_float(rr[0]) + __uint_as_float(rr[1]); }
    l_reg = l_reg * alpha + ps;
#define PK4(P, B_, OUT) do { unsigned a0 = cvtpk(P[B_+0], P[B_+1]), a1 = cvtpk(P[B_+2], P[B_+3]);                          \
        unsigned b0 = cvtpk(P[B_+4], P[B_+5]), b1 = cvtpk(P[B_+6], P[B_+7]);                                             \
        auto r0 = __builtin_amdgcn_permlane32_swap(a0, b0, false, false); auto r1 = __builtin_amdgcn_permlane32_swap(a1, b1, false, false); \
        u32x4 w = {r0[0], r1[0], r0[1], r1[1]}; OUT = __builtin_bit_cast(bf16x8, w); } while (0)
    PK4(p0, 0, pa0); PK4(p0, 8, pa1); PK4(p1, 0, pa2); PK4(p1, 8, pa3);
#undef PK4
}
template <int KB>
DI void qkt(f32x16& p0, f32x16& p1, const char* K_lds, int r32, int hi, const bf16x8* qr) {
    p0 = f32x16{}; p1 = f32x16{};
    const char* kb[4];
#pragma unroll
    for (int dd = 0; dd < 4; ++dd) kb[dd] = K_lds + KB * SHM_K + KSWZ(r32, (dd * 16 + hi * 8) * 2);
#pragma unroll
    for (int d0 = 0; d0 < 8; ++d0) { const char* a = kb[d0 & 3] + (d0 >> 2) * 128;
        bf16x8 b0 = *reinterpret_cast<const bf16x8*>(a);
        bf16x8 b1 = *reinterpret_cast<const bf16x8*>(a + 32 * 256);
        p0 = MFMA32(b0, qr[d0], p0);
        p1 = MFMA32(b1, qr[d0], p1); }
}
template <int VB>
DI void pv_tile(f32x16* o, int vb0, bf16x8 pa0, bf16x8 pa1, bf16x8 pa2, bf16x8 pa3) {
#define TRRD(dst, off) asm volatile("ds_read_b64_tr_b16 %0, %1 offset:%2" : "=&v"(dst) : "v"(vb0), "i"(off) : "memory")
#define PV_D0(d0) do { s16x4 l0, l1, l2, l3, h0, h1, h2, h3; constexpr int b_ = VB * SHM_V + v_rd_off(d0, 0, 0); \
        TRRD(l0, b_); TRRD(h0, b_ + 2048); TRRD(l1, b_ + 4096); TRRD(h1, b_ + 6144); TRRD(l2, b_ + 8192); TRRD(h2, b_ + 10240); TRRD(l3, b_ + 12288); TRRD(h3, b_ + 14336); \
        asm volatile("s_waitcnt lgkmcnt(0)" ::: "memory"); SBAR();   \
        o[d0] = MFMA32(pa0, ((bf16x8){l0[0], l0[1], l0[2], l0[3], h0[0], h0[1], h0[2], h0[3]}), o[d0]);   \
        o[d0] = MFMA32(pa1, ((bf16x8){l1[0], l1[1], l1[2], l1[3], h1[0], h1[1], h1[2], h1[3]}), o[d0]);   \
        o[d0] = MFMA32(pa2, ((bf16x8){l2[0], l2[1], l2[2], l2[3], h2[0], h2[1], h2[2], h2[3]}), o[d0]);   \
        o[d0] = MFMA32(pa3, ((bf16x8){l3[0], l3[1], l3[2], l3[3], h3[0], h3[1], h3[2], h3[3]}), o[d0]); } while (0)
    PV_D0(0); PV_D0(1); PV_D0(2); PV_D0(3);
#undef PV_D0
#undef TRRD
}

struct BlockRef { const bf16* Q; const bf16* K; const bf16* V; bf16* O; const bf16* KM; int P0; };
struct Seam { bf16x8 qr[8]; bf16x8 st_v0, st_v1, st_k0, st_k1; };
#define VMW() asm volatile("s_waitcnt vmcnt(0)" ::: "memory")
#define VMWN(n) asm volatile("s_waitcnt vmcnt(%0)" :: "i"(n) : "memory")
#define SLOAD_H(Kp, Vp, k0) do { const bf16* kb__ = (Kp) + (size_t)(k0) * RS; const bf16* vb__ = (Vp) + (size_t)(k0) * RS;              \
                         S.st_v0 = load8(vb__ + goff); S.st_v1 = load8(vb__ + 32 * RS + goff);              \
                         S.st_k0 = load8(kb__ + goff); S.st_k1 = load8(kb__ + 32 * RS + goff); } while (0)
#define SWRITE_HK(bf) do { *(bf16x8*)(K_lds + (bf) * SHM_K + kws) = S.st_k0; *(bf16x8*)(K_lds + (bf) * SHM_K + kws + 32 * 256) = S.st_k1; } while (0)
#define SWRITE_HV(bf) do { *(bf16x8*)(V_lds + (bf) * SHM_V + vst0) = S.st_v0; *(bf16x8*)(V_lds + (bf) * SHM_V + vst1) = S.st_v1; } while (0)
#define SWRITE_H(bf) do { SWRITE_HV(bf); SWRITE_HK(bf); } while (0)
DI void prime(const BlockRef& cur, char* lds, Seam& S) {
    const int tid = threadIdx.x, wid = __builtin_amdgcn_readfirstlane(tid >> 6), lane = tid & 63, r32 = lane & 31, hi = lane >> 5;
    const int sr = tid >> 4, sc = (tid & 15) * 8, kws = KSWZ(sr, sc * 2); char* K_lds = lds + 2 * SHM_V;
    const unsigned goff = (unsigned)(sr * RS + sc), qoff = (unsigned)(r32 * RS + hi * 8);
    { const bf16* qb__ = cur.Q + (size_t)(wid * QBLK) * RS;
#pragma unroll
    for (int d0 = 0; d0 < 8; ++d0) S.qr[d0] = load8(qb__ + qoff + d0 * 16); }
    SLOAD_H(cur.K, cur.V, 0); VMW(); SWRITE_HK(0);
    __syncthreads();
}
DI void block(const BlockRef& cur, const BlockRef& nxt, char* lds, Seam& S) {
    int tid_ = threadIdx.x; asm volatile("" : "+v"(tid_));
    const int tid = tid_, wid = __builtin_amdgcn_readfirstlane(tid >> 6), lane = tid & 63, r32 = lane & 31, hi = lane >> 5;
    const int NT = (cur.P0 + QB) / KVBLK;
    const int qb = cur.P0 / QB;
    const int qlo = cur.P0 + wid * QBLK, qm = qlo + r32 - 4 * hi;
    char* V_lds = lds; char* K_lds = lds + 2 * SHM_V;
    float* ws = (float*)(lds + 2 * SHM_V + 2 * SHM_K) + wid * 64; float* li_l = ws, * al_l = ws + 32;
    unsigned selmask = (1u << qb) - 1u;
    if (qb > 3) {
        f32x16 g0 = f32x16{};
#pragma unroll
        for (int d0 = 0; d0 < 8; ++d0) {
            bf16x8 a = (bf16x8){0, 0, 0, 0, 0, 0, 0, 0};
            if (r32 < 8) a = load8(cur.KM + r32 * D + d0 * 16 + hi * 8);
            g0 = MFMA32(a, S.qr[d0], g0);
        }
        float gt[8];
#pragma unroll
        for (int j = 0; j < 4; ++j) { const float mine = g0[j], oth = __shfl_xor(mine, 32); gt[j] = hi ? oth : mine; gt[4 + j] = hi ? mine : oth; }
        selmask = 0u;
#pragma unroll
        for (int i = 0; i < 8; ++i) { int rank = 0;
#pragma unroll
            for (int j = 0; j < 8; ++j) { if (j != i) { const bool beats = (gt[j] > gt[i]) || (gt[j] == gt[i] && j < i); rank += (j < qb && beats) ? 1 : 0; } }
            if (i < qb && rank < 3) selmask |= (1u << i); }
    }
    float m_reg = -1e30f, l_reg = 0; f32x16 o[4] = {};
    const int sr = tid >> 4, sc = (tid & 15) * 8, vst0 = v_st(sr, sc), vst1 = v_st(32 + sr, sc), kws = KSWZ(sr, sc * 2);
    const unsigned goff = (unsigned)(sr * RS + sc), qoff = (unsigned)(r32 * RS + hi * 8);
    const int vb0 = (int)(uintptr_t)V_lds + v_rd_base(lane);
    const bf16* Kh = cur.K; const bf16* Vh = cur.V;
#define RESC(a) do { if (__any((a) < 1.f)) { if (hi == 0) al_l[r32] = (a); asm volatile("s_waitcnt lgkmcnt(0)" ::: "memory");              \
                     _Pragma("unroll") for (int d_ = 0; d_ < 4; ++d_) _Pragma("unroll") for (int r = 0; r < 16; ++r) o[d_][r] *= al_l[crow(r, hi)]; } } while (0)
#define KBASE(t) ((t) * KVBLK)
#define MASKT(P0_, P1_, t) do { const int kb_ = KBASE(t); const int kblk_ = (t) >> 2; \
        if (kblk_ < qb) { if (qb > 3) mask_all(P0_, P1_, ((selmask >> kblk_) & 1u) == 0u); } \
        else if (kb_ + KVBLK - 1 > qlo) mask_tile(P0_, P1_, qm - kb_); } while (0)
    constexpr int NQL = 8;
#define SEAM_K0() do { VMWN(NQL); SWRITE_HK(0); SBAR(); } while (0)
    f32x16 pA0, pA1, pB0, pB1; float mnA, mnB, alA, alB; bf16x8 pa0, pa1, pa2, pa3;
    SWRITE_HV(0); SBAR();
    if (NT > 1) { SLOAD_H(Kh, Vh, KBASE(1)); }
    SBAR(); qkt<0>(pA0, pA1, K_lds, r32, hi, S.qr);
    MASKT(pA0, pA1, 0); partialSM(pA0, pA1, m_reg, mnA, alA);
    if (NT > 1) { VMW(); SWRITE_H(1); }
    __syncthreads();
#define HALF_STEP(PX0, PX1, mnX, alX, PY0, PY1, alY, t, KB, VB, SB) do {                                                      \
        SBAR(); qkt<KB>(PX0, PX1, K_lds, r32, hi, S.qr);                                             \
        finishSM(PY0, PY1, alY, l_reg, pa0, pa1, pa2, pa3); SBAR();                                                           \
        if ((t) + 1 < NT) { SLOAD_H(Kh, Vh, KBASE((t) + 1)); SBAR(); }                                               \
        pv_tile<VB>(o, vb0, pa0, pa1, pa2, pa3); MASKT(PX0, PX1, (t)); partialSM(PX0, PX1, m_reg, mnX, alX);                                        \
        __syncthreads();                                                                                                      \
        if ((t) + 1 < NT) { VMW(); SWRITE_H(SB); }                                                                          \
        RESC(alX); __syncthreads(); } while (0)
    for (int t = 1; t + 1 < NT; t += 2) {
        HALF_STEP(pB0, pB1, mnB, alB, pA0, pA1, alA, t, 1, 0, 0);
        HALF_STEP(pA0, pA1, mnA, alA, pB0, pB1, alB, t + 1, 0, 1, 1);
    }
    const bool even = (NT & 1) == 0;
    if (even) { SBAR(); qkt<1>(pB0, pB1, K_lds, r32, hi, S.qr); SBAR(); }
    { SLOAD_H(nxt.K, nxt.V, 0); SBAR();
      const bf16* qb__ = nxt.Q + (size_t)(wid * QBLK) * RS;
#pragma unroll
      for (int d0 = 0; d0 < 8; ++d0) S.qr[d0] = load8(qb__ + qoff + d0 * 16); }
    SBAR();
    finishSM(pA0, pA1, alA, l_reg, pa0, pa1, pa2, pa3); SBAR();
    pv_tile<0>(o, vb0, pa0, pa1, pa2, pa3);
    if (even) { MASKT(pB0, pB1, NT - 1); partialSM(pB0, pB1, m_reg, mnB, alB); __syncthreads(); RESC(alB);
        finishSM(pB0, pB1, alB, l_reg, pa0, pa1, pa2, pa3); SBAR(); pv_tile<1>(o, vb0, pa0, pa1, pa2, pa3); }
    SBAR(); SEAM_K0();
    if (hi == 0) li_l[r32] = l_reg; asm volatile("s_waitcnt lgkmcnt(0)" ::: "memory");
    float rli[16];
#pragma unroll
    for (int r = 0; r < 16; ++r) rli[r] = __builtin_amdgcn_rcpf(li_l[crow(r, hi)]);
    bf16* Ow = cur.O + (size_t)(wid * QBLK) * RSO;
    const unsigned ooff = (unsigned)(4 * hi * RSO + r32);
#pragma unroll
    for (int r = 0; r < 16; ++r) { const int orow0 = (r & 3) + 8 * (r >> 2);
#pragma unroll
        for (int d0 = 0; d0 < 4; ++d0) { const float v = o[d0][r] * rli[r];
            const float vn = __shfl_xor(v, 1);
            if ((r32 & 1) == 0) *(unsigned*)(Ow + ooff + (unsigned)(orow0 * RSO + d0 * 32)) = cvtpk(v, vn); } }
    __syncthreads();
#undef RESC
#undef KBASE
#undef MASKT
#undef SEAM_K0
#undef HALF_STEP
}
#undef VMW
#undef VMWN
#undef SLOAD_H
#undef SWRITE_HK
#undef SWRITE_HV
#undef SWRITE_H
#undef KSWZ
#undef SBAR
}

namespace dn {
#ifndef DBL
#define DBL -1
#endif
#define REPS(k) for (int rep_ = 0; rep_ < ((DBL == (k)) ? 2 : 1); ++rep_)
constexpr int L_QB = 0, L_KB = 17408, L_KT = 34816, L_VT = 53248, L_LM = 71680, L_TB = 89088, L_GV = 107520;
constexpr int RQ = 272, LMS = 68, RT = 144;

struct ConvW { f32x2 w[3][4]; float aexp, dtb; };
DI void prep_consts(const Params& p, int h, ConvW& C, int lane) {
#pragma unroll
    for (int seg = 0; seg < 3; ++seg)
#pragma unroll
        for (int j = 0; j < 4; ++j) C.w[seg][j] = *(const f32x2*)(p.conv_w + j * 3072 + seg * 1024 + h * HD + 2 * lane);
    C.aexp = -expf(p.a_log[h]); C.dtb = p.dt_bias[h];
}
struct Raw { unsigned v[33]; float br, ar; };
DI void prep_load(const Params& p, int item, Raw& R, int lane, int wave) {
    const int bh = item >> 5, n = item & 31, b = bh >> 3, h = bh & 7, i0 = wave * 8, c0 = 2 * lane;
    const bf16_t* PROJ = (const bf16_t*)(p.ws + WS_B);
#pragma unroll
    for (int seg = 0; seg < 3; ++seg)
#pragma unroll
        for (int jj = 0; jj < 11; ++jj) {
            const int sp = n * 64 + i0 - 3 + jj;
            unsigned v = 0u;
            if (sp >= 0) v = *(const unsigned*)(PROJ + (size_t)(b * SEQ + sp) * PP + C_DN + seg * 1024 + h * HD + c0);
            R.v[seg * 11 + jj] = v;
        }
    R.br = 0.f; R.ar = 0.f;
    if (wave == 0) { const float* BA = (const float*)(p.ws + WS_BA); const size_t t = (size_t)(b * SEQ + n * 64 + lane);
        R.br = BA[t * 16 + h]; R.ar = BA[t * 16 + 8 + h]; }
}
#define DN_BAR() do { asm volatile("s_waitcnt lgkmcnt(0)" ::: "memory"); __builtin_amdgcn_s_barrier(); asm volatile("" ::: "memory"); } while (0)
DI void prep_chunk(const Params& p, LAS unsigned char* lds, int item, int nitem, Raw& R, const ConvW& CW, int tid, int lane, int wave) {
    asm volatile("" : "+v"(tid), "+v"(lane));
    const int bh = item >> 5, n = item & 31, b = bh >> 3, h = bh & 7;
    unsigned char* rec = p.ws + WS_DNP + (size_t)item * DN_STRIDE;
    LAS float* LM = (LAS float*)(lds + L_LM);
    LAS float* GV = (LAS float*)(lds + L_GV);
    REPS(31) {
        const int i0 = wave * 8, c0 = 2 * lane;
#pragma unroll
        for (int seg = 0; seg < 3; ++seg) {
            float w0[4], w1[4];
#pragma unroll
            for (int j = 0; j < 4; ++j) { w0[j] = CW.w[seg][j].x; w1[j] = CW.w[seg][j].y; }
            float r0[11], r1[11];
#pragma unroll
            for (int jj = 0; jj < 11; ++jj) { const unsigned v = R.v[seg * 11 + jj]; r0[jj] = bflo(v); r1[jj] = bfhi(v); }
            float ya[8], yb[8];
#pragma unroll
            for (int i = 0; i < 8; ++i) {
                float y0 = 0.f, y1 = 0.f;
#pragma unroll
                for (int j = 0; j < 4; ++j) { y0 += w0[j] * r0[i + j]; y1 += w1[j] * r1[i + j]; }
                ya[i] = siluf_(y0); yb[i] = siluf_(y1);
            }
            if (seg < 2) {
                float ss[8];
#pragma unroll
                for (int i = 0; i < 8; ++i) ss[i] = ya[i] * ya[i] + yb[i] * yb[i];
#pragma unroll
                for (int o = 1; o < 64; o <<= 1) { float t[8];
#pragma unroll
                    for (int i = 0; i < 8; ++i) t[i] = __shfl_xor(ss[i], o);
#pragma unroll
                    for (int i = 0; i < 8; ++i) ss[i] += t[i]; }
#pragma unroll
                for (int i = 0; i < 8; ++i) { const float rn = (seg == 0 ? SCALE_Q : 1.0f) * rsqrt_(ss[i] + EPS); ya[i] *= rn; yb[i] *= rn;
                    *(LAS unsigned*)(lds + (seg == 0 ? L_QB : L_KB) + (i0 + i) * RQ + c0 * 2) = cvtpk(ya[i], yb[i]); }
            }
            if (seg >= 1) {
                LAS unsigned char* tb = lds + (seg == 1 ? L_KT : L_VT) + c0 * RT + i0 * 2;
                u32x4 o0, o1;
                o0.x = cvtpk(ya[0], ya[1]); o0.y = cvtpk(ya[2], ya[3]); o0.z = cvtpk(ya[4], ya[5]); o0.w = cvtpk(ya[6], ya[7]);
                o1.x = cvtpk(yb[0], yb[1]); o1.y = cvtpk(yb[2], yb[3]); o1.z = cvtpk(yb[4], yb[5]); o1.w = cvtpk(yb[6], yb[7]);
                *(LAS u32x4*)tb = o0; *(LAS u32x4*)(tb + RT) = o1;
            }
        }
        if (wave == 0) {
            const float br = R.br, ar = R.ar;
            const float beta = sigmoidf_(br);
            const float xs = ar + CW.dtb;
            const float sp = xs > 20.f ? xs : log1pf(expf(xs));
            float g = CW.aexp * sp;
#pragma unroll
            for (int o = 1; o < 64; o <<= 1) { const float u = __shfl_up(g, o); if (lane >= o) g += u; }
            const float g63 = __shfl(g, 63);
            GV[lane] = g; GV[64 + lane] = beta; GV[128 + lane] = expf(g); GV[192 + lane] = expf(g63 - g);
        }
    }
    if (nitem >= 0) prep_load(p, nitem, R, lane, wave);
    DN_BAR();
    REPS(32) {
        const int mt = wave >> 1, nt = wave & 1, r = lane & 31, hi = lane >> 5;
        if (mt < 2) {
            const LAS unsigned char* Ab = lds + L_KB + (32 * nt + r) * RQ, * Bb = lds + L_QB + (32 * mt + r) * RQ;
            f32x16 acc = f32x16{};
#pragma unroll
            for (int ks = 0; ks < 8; ++ks) acc = MFMA32(*(const LAS bf16x8*)(Ab + (16 * ks + 8 * hi) * 2), *(const LAS bf16x8*)(Bb + (16 * ks + 8 * hi) * 2), acc);
            const int i = 32 * mt + r; const float Gi = GV[i];
            float v[16];
#pragma unroll
            for (int q = 0; q < 16; ++q) { const int j = 32 * nt + crow(q, hi); v[q] = i >= j ? acc[q] * __expf(Gi - GV[j]) : 0.f; }
            u32x4* QKf = (u32x4*)(rec + DN_QK) + ((mt * 4 + 2 * nt) * 64 + lane);
            u32x4 o0, o1;
            o0.x = cvtpk(v[0], v[1]); o0.y = cvtpk(v[2], v[3]); o0.z = cvtpk(v[4], v[5]); o0.w = cvtpk(v[6], v[7]);
            o1.x = cvtpk(v[8], v[9]); o1.y = cvtpk(v[10], v[11]); o1.z = cvtpk(v[12], v[13]); o1.w = cvtpk(v[14], v[15]);
            QKf[0] = o0; QKf[64] = o1;
        } else {
            const LAS unsigned char* Ab = lds + L_KB + (32 * (mt - 2) + r) * RQ, * Bb = lds + L_KB + (32 * nt + r) * RQ;
            f32x16 acc = f32x16{};
#pragma unroll
            for (int ks = 0; ks < 8; ++ks) acc = MFMA32(*(const LAS bf16x8*)(Ab + (16 * ks + 8 * hi) * 2), *(const LAS bf16x8*)(Bb + (16 * ks + 8 * hi) * 2), acc);
            const int j = 32 * nt + r; const float Gj = GV[j];
#pragma unroll
            for (int q = 0; q < 16; ++q) { const int row = 32 * (mt - 2) + crow(q, hi);
                const float e = row > j ? GV[64 + row] * __expf(GV[row] - Gj) : 0.f;
                LM[row * LMS + j] = acc[q] * e; }
        }
    }
    DN_BAR();
    REPS(33) {
        float Lr[64];
#pragma unroll
        for (int jq = 0; jq < 16; ++jq) { const f32x4 l = *(const LAS f32x4*)(LM + lane * LMS + 4 * jq); Lr[4 * jq] = l.x; Lr[4 * jq + 1] = l.y; Lr[4 * jq + 2] = l.z; Lr[4 * jq + 3] = l.w; }
        float xv[8];
#pragma unroll
        for (int q = 0; q < 8; ++q) xv[q] = (lane == 8 * wave + q) ? 1.0f : 0.0f;
#pragma unroll
        for (int j = 0; j < 63; ++j) {
#pragma unroll
            for (int q = 0; q < 8; ++q) { const float xj = __int_as_float(__builtin_amdgcn_readlane(__float_as_int(xv[q]), j)); xv[q] -= Lr[j] * xj; }
        }
        float t1[8], t2[8];
#pragma unroll
        for (int q = 0; q < 8; ++q) { const float bc = GV[64 + 8 * wave + q]; t1[q] = xv[q] * bc; t2[q] = t1[q] * GV[128 + 8 * wave + q]; }
        u32x4 o1, o2;
        o1.x = cvtpk(t1[0], t1[1]); o1.y = cvtpk(t1[2], t1[3]); o1.z = cvtpk(t1[4], t1[5]); o1.w = cvtpk(t1[6], t1[7]);
        o2.x = cvtpk(t2[0], t2[1]); o2.y = cvtpk(t2[2], t2[3]); o2.z = cvtpk(t2[4], t2[5]); o2.w = cvtpk(t2[6], t2[7]);
        *(LAS u32x4*)(lds + L_TB + lane * RT + wave * 16) = o1; *(LAS u32x4*)(lds + L_TB + 64 * RT + lane * RT + wave * 16) = o2;
    }
    DN_BAR();
    REPS(34) {
        const int r = lane & 31, hi = lane >> 5;
#pragma unroll
        for (int half = 0; half < 2; ++half) {
            const int tix = wave * 2 + half;
            f32x16 acc = f32x16{};
            if (tix < 8) {
                const int mt = tix >> 2, nt = tix & 3;
                const LAS unsigned char* Ab = lds + L_TB + (32 * mt + r) * RT + 16 * hi, * Bb = lds + L_VT + (32 * nt + r) * RT + 16 * hi;
#pragma unroll
                for (int ks = 0; ks < 4; ++ks) acc = MFMA32(*(const LAS bf16x8*)(Ab + 32 * ks), *(const LAS bf16x8*)(Bb + 32 * ks), acc);
                u32x4* Uf = (u32x4*)(rec + DN_U) + ((mt * 4 + nt) * 64 + lane) * 2;
                u32x4 o0, o1;
                o0.x = cvtpk(acc[0], acc[1]); o0.y = cvtpk(acc[2], acc[3]); o0.z = cvtpk(acc[4], acc[5]); o0.w = cvtpk(acc[6], acc[7]);
                o1.x = cvtpk(acc[8], acc[9]); o1.y = cvtpk(acc[10], acc[11]); o1.z = cvtpk(acc[12], acc[13]); o1.w = cvtpk(acc[14], acc[15]);
                Uf[0] = o0; Uf[1] = o1;
            } else {
                const int ntp = (tix - 8) >> 1, mt = tix & 1;
                const LAS unsigned char* Ab = lds + L_KT + (32 * ntp + r) * RT + 16 * hi, * Bb = lds + L_TB + 64 * RT + (32 * mt + r) * RT + 16 * hi;
#pragma unroll
                for (int ks = 0; ks < 4; ++ks) acc = MFMA32(*(const LAS bf16x8*)(Ab + 32 * ks), *(const LAS bf16x8*)(Bb + 32 * ks), acc);
                u32x4* Wf = (u32x4*)(rec + DN_W) + ((mt * 8 + 2 * ntp) * 64 + lane);
                u32x4 o0, o1;
                o0.x = cvtpk(-acc[0], -acc[1]); o0.y = cvtpk(-acc[2], -acc[3]); o0.z = cvtpk(-acc[4], -acc[5]); o0.w = cvtpk(-acc[6], -acc[7]);
                o1.x = cvtpk(-acc[8], -acc[9]); o1.y = cvtpk(-acc[10], -acc[11]); o1.z = cvtpk(-acc[12], -acc[13]); o1.w = cvtpk(-acc[14], -acc[15]);
                Wf[0] = o0; Wf[64] = o1;
            }
        }
#pragma unroll
        for (int rep = 0; rep < 2; ++rep) {
            const int f = tid + 512 * rep, mt = f >> 9, ks = (f >> 6) & 7, fr = f & 31, fh = (f >> 5) & 1, i = 32 * mt + fr;
            const LAS unsigned char* qp = lds + L_QB + i * RQ + (16 * ks + 4 * fh) * 2;
            const u32x2 a = *(const LAS u32x2*)qp, c = *(const LAS u32x2*)(qp + 16);
            const float e = GV[128 + i];
            u32x4 o; o.x = cvtpk(bflo(a.x) * e, bfhi(a.x) * e); o.y = cvtpk(bflo(a.y) * e, bfhi(a.y) * e); o.z = cvtpk(bflo(c.x) * e, bfhi(c.x) * e); o.w = cvtpk(bflo(c.y) * e, bfhi(c.y) * e);
            ((u32x4*)(rec + DN_QD))[f] = o;
        }
#pragma unroll
        for (int rep = 0; rep < 2; ++rep) {
            const int f = tid + 512 * rep, a4 = f >> 8, ks = (f >> 6) & 3, fr = f & 31, fh = (f >> 5) & 1, d = 32 * a4 + fr;
            const LAS unsigned char* kp = lds + L_KT + d * RT + (16 * ks + 4 * fh) * 2;
            const u32x2 a = *(const LAS u32x2*)kp, c = *(const LAS u32x2*)(kp + 16);
            const LAS float* eg = GV + 192 + 16 * ks + 4 * fh;
            u32x4 o; o.x = cvtpk(bflo(a.x) * eg[0], bfhi(a.x) * eg[1]); o.y = cvtpk(bflo(a.y) * eg[2], bfhi(a.y) * eg[3]);
            o.z = cvtpk(bflo(c.x) * eg[8], bfhi(c.x) * eg[9]); o.w = cvtpk(bflo(c.y) * eg[10], bfhi(c.y) * eg[11]);
            ((u32x4*)(rec + DN_KT))[f] = o;
        }
        if (tid == 0) *(float*)(rec + DN_SC) = GV[128 + 63];
    }
    DN_BAR();
}

DI bf16x8 pack_step(const f32x16& x, int s) {
    u32x4 w;
    if (s == 0) { w.x = cvtpk(x[0], x[1]); w.y = cvtpk(x[2], x[3]); w.z = cvtpk(x[4], x[5]); w.w = cvtpk(x[6], x[7]); }
    else { w.x = cvtpk(x[8], x[9]); w.y = cvtpk(x[10], x[11]); w.z = cvtpk(x[12], x[13]); w.w = cvtpk(x[14], x[15]); }
    return __builtin_bit_cast(bf16x8, w);
}

constexpr int RB = 57344;
constexpr int ORS = 272, OB = 64 * ORS;
DI void recur(const Params& p, LAS unsigned char* lds, int bh, int tid, int lane, int wave) {
    asm volatile("" : "+v"(tid), "+v"(lane));
    const int r = lane & 31, hi = lane >> 5, b = bh >> 3, h = bh & 7;
    const unsigned char* rec0 = p.ws + WS_DNP + (size_t)(bh * 32) * DN_STRIDE;
    if (wave >= 4) {
        const int lt = tid - 256;
        const int fg = lt & 7, fr2 = lt >> 3;
        const bf16_t* PROJ = (const bf16_t*)(p.ws + WS_B); bf16_t* YAB = (bf16_t*)(p.ws + WS_A);
        f32x4 g4[4];
#pragma unroll
        for (int j = 0; j < 4; ++j) g4[j] = *(const f32x4*)(p.dn_gain + fg * 16 + 4 * j);
        const bf16_t* zb = PROJ + (size_t)(b * SEQ) * PP + C_Z + h * HD + fg * 16; bf16_t* yb = YAB + (size_t)(b * SEQ) * DM + 1024 + h * HD + fg * 16;
        u32x4 zr[2][2];
#define DN_ZLOAD(n_) do { _Pragma("unroll") for (int ps = 0; ps < 2; ++ps) { const bf16_t* zp = zb + (size_t)((n_) * 64 + fr2 + 32 * ps) * PP; zr[ps][0] = *(const u32x4*)zp; zr[ps][1] = *(const u32x4*)(zp + 8); } } while (0)
#define DN_FINAL(n_) do { const LAS unsigned char* ob = lds + 2 * RB + ((n_) & 1) * OB; \
        _Pragma("unroll") for (int ps = 0; ps < 2; ++ps) { const int row = fr2 + 32 * ps; \
            const u32x4 o0 = *(const LAS u32x4*)(ob + row * ORS + fg * 32), o1 = *(const LAS u32x4*)(ob + row * ORS + fg * 32 + 16); \
            float ov[16] = {bflo(o0.x), bfhi(o0.x), bflo(o0.y), bfhi(o0.y), bflo(o0.z), bfhi(o0.z), bflo(o0.w), bfhi(o0.w), bflo(o1.x), bfhi(o1.x), bflo(o1.y), bfhi(o1.y), bflo(o1.z), bfhi(o1.z), bflo(o1.w), bfhi(o1.w)}; \
            float ss = 0.f; _Pragma("unroll") for (int e = 0; e < 16; ++e) ss += ov[e] * ov[e]; \
            ss += __shfl_xor(ss, 1); ss += __shfl_xor(ss, 2); ss += __shfl_xor(ss, 4); \
            const float rstd = rsqrt_(ss * (1.0f / HD) + EPS); \
            const u32x4 z0 = zr[ps][0], z1 = zr[ps][1]; \
            const float zz[16] = {bflo(z0.x), bfhi(z0.x), bflo(z0.y), bfhi(z0.y), bflo(z0.z), bfhi(z0.z), bflo(z0.w), bfhi(z0.w), bflo(z1.x), bfhi(z1.x), bflo(z1.y), bfhi(z1.y), bflo(z1.z), bfhi(z1.z), bflo(z1.w), bfhi(z1.w)}; \
            float y[16]; _Pragma("unroll") for (int e = 0; e < 16; ++e) y[e] = ov[e] * rstd * g4[e >> 2][e & 3] * siluf_(zz[e]); \
            u32x4 w0, w1; w0.x = cvtpk(y[0], y[1]); w0.y = cvtpk(y[2], y[3]); w0.z = cvtpk(y[4], y[5]); w0.w = cvtpk(y[6], y[7]); \
            w1.x = cvtpk(y[8], y[9]); w1.y = cvtpk(y[10], y[11]); w1.z = cvtpk(y[12], y[13]); w1.w = cvtpk(y[14], y[15]); \
            bf16_t* yp = yb + (size_t)((n_) * 64 + row) * DM; *(u32x4*)yp = w0; *(u32x4*)(yp + 8) = w1; } } while (0)
        u32x4 v[14];
        {   const u32x4* src = (const u32x4*)(rec0 + DN_W) + lt;
#pragma unroll
            for (int k = 0; k < 14; ++k) v[k] = src[k * 256];
#pragma unroll
            for (int k = 0; k < 14; ++k) *(LAS u32x4*)(lds + (k * 256 + lt) * 16) = v[k];
            const u32x4* src1 = (const u32x4*)(rec0 + DN_STRIDE + DN_W) + lt;
#pragma unroll
            for (int k = 0; k < 14; ++k) v[k] = src1[k * 256]; }
        DN_ZLOAD(0);
        DN_BAR();
        for (int n = 0; n < 32; ++n) {
            if (n + 1 < 32) { LAS unsigned char* dst = lds + ((n + 1) & 1) * RB;
#pragma unroll
                for (int k = 0; k < 14; ++k) *(LAS u32x4*)(dst + (k * 256 + lt) * 16) = v[k]; }
            if (n + 2 < 32) { const u32x4* src = (const u32x4*)(rec0 + (size_t)(n + 2) * DN_STRIDE + DN_W) + lt;
#pragma unroll
                for (int k = 0; k < 14; ++k) v[k] = src[k * 256]; }
            if (n >= 1) { DN_FINAL(n - 1); DN_ZLOAD(n); }
            DN_BAR();
        }
        DN_FINAL(31);
#undef DN_ZLOAD
#undef DN_FINAL
    } else {
        const int slice = wave, dv0 = slice * 32;
        f32x16 St[4];
#pragma unroll
        for (int a = 0; a < 4; ++a) St[a] = f32x16{};
        u32x4 un[2][2];
#pragma unroll
        for (int mt = 0; mt < 2; ++mt) { const u32x4* up = (const u32x4*)(rec0 + DN_U) + ((mt * 4 + slice) * 64 + lane) * 2; un[mt][0] = up[0]; un[mt][1] = up[1]; }
        DN_BAR();
        for (int n = 0; n < 32; ++n) {
            const unsigned char* rec = rec0 + (size_t)n * DN_STRIDE;
            const LAS unsigned char* buf = lds + (n & 1) * RB;
            const float eg = *(const float*)(rec + DN_SC);
            f32x16 Vn[2], O[2];
#pragma unroll
            for (int mt = 0; mt < 2; ++mt) { const u32x4 a = un[mt][0], c = un[mt][1];
                Vn[mt][0] = bflo(a.x); Vn[mt][1] = bfhi(a.x); Vn[mt][2] = bflo(a.y); Vn[mt][3] = bfhi(a.y); Vn[mt][4] = bflo(a.z); Vn[mt][5] = bfhi(a.z); Vn[mt][6] = bflo(a.w); Vn[mt][7] = bfhi(a.w);
                Vn[mt][8] = bflo(c.x); Vn[mt][9] = bfhi(c.x); Vn[mt][10] = bflo(c.y); Vn[mt][11] = bfhi(c.y); Vn[mt][12] = bflo(c.z); Vn[mt][13] = bfhi(c.z); Vn[mt][14] = bflo(c.w); Vn[mt][15] = bfhi(c.w); }
            if (n + 1 < 32) {
#pragma unroll
                for (int mt = 0; mt < 2; ++mt) { const u32x4* up = (const u32x4*)(rec + DN_STRIDE + DN_U) + ((mt * 4 + slice) * 64 + lane) * 2; un[mt][0] = up[0]; un[mt][1] = up[1]; } }
            bf16x8 Sf[8];
#pragma unroll
            for (int a = 0; a < 4; ++a) { Sf[2 * a] = pack_step(St[a], 0); Sf[2 * a + 1] = pack_step(St[a], 1); }
#pragma unroll
            for (int mt = 0; mt < 2; ++mt)
#pragma unroll
                for (int ks = 0; ks < 8; ++ks) Vn[mt] = MFMA32(*(const LAS bf16x8*)(buf + ((mt * 8 + ks) * 64 + lane) * 16), Sf[ks], Vn[mt]);
#pragma unroll
            for (int mt = 0; mt < 2; ++mt) { O[mt] = f32x16{};
#pragma unroll
                for (int ks = 0; ks < 8; ++ks) O[mt] = MFMA32(*(const LAS bf16x8*)(buf + 16384 + ((mt * 8 + ks) * 64 + lane) * 16), Sf[ks], O[mt]); }
            bf16x8 Vf[4];
#pragma unroll
            for (int mt = 0; mt < 2; ++mt) { Vf[2 * mt] = pack_step(Vn[mt], 0); Vf[2 * mt + 1] = pack_step(Vn[mt], 1); }
#pragma unroll
            for (int mt = 0; mt < 2; ++mt)
#pragma unroll
                for (int ks = 0; ks < 4; ++ks) O[mt] = MFMA32(*(const LAS bf16x8*)(buf + 49152 + ((mt * 4 + ks) * 64 + lane) * 16), Vf[ks], O[mt]);
#pragma unroll
            for (int a = 0; a < 4; ++a) {
                St[a] = St[a] * eg;
#pragma unroll
                for (int ks = 0; ks < 4; ++ks) St[a] = MFMA32(*(const LAS bf16x8*)(buf + 32768 + ((a * 4 + ks) * 64 + lane) * 16), Vf[ks], St[a]);
            }
            {   LAS unsigned char* ob = lds + 2 * RB + (n & 1) * OB + (dv0 + r) * 2;
#pragma unroll
                for (int mt = 0; mt < 2; ++mt)
#pragma unroll
                    for (int i = 0; i < 16; ++i) *(LAS bf16_t*)(ob + (32 * mt + crow(i, hi)) * ORS) = f2bf(O[mt][i]);
            }
            DN_BAR();
        }
    }
}
}

DI void transpose_tile(const float* W, int N, int k0, int sn0, bf16_t* WT, int dpitch, int drow0, int dk0, int nvalid, LAS float* scr, int lane) {
#pragma unroll 8
    for (int i = 0; i < 32; ++i) { const int kk = 2 * i + (lane >> 5); scr[kk * 33 + (lane & 31)] = W[(size_t)(k0 + kk) * N + sn0 + (lane & 31)]; }
    asm volatile("s_waitcnt lgkmcnt(0)" ::: "memory");
    const int c = lane & 7;
#pragma unroll
    for (int j = 0; j < 4; ++j) { const int n = (lane >> 3) + 8 * j; const LAS float* s = scr + (8 * c) * 33 + n;
        u32x4 o; o.x = cvtpk(s[0 * 33], s[1 * 33]); o.y = cvtpk(s[2 * 33], s[3 * 33]); o.z = cvtpk(s[4 * 33], s[5 * 33]); o.w = cvtpk(s[6 * 33], s[7 * 33]);
        if (n < nvalid) *(u32x4*)(WT + (size_t)(drow0 + n) * dpitch + dk0 + k0 + 8 * c) = o; }
    asm volatile("s_waitcnt lgkmcnt(0)" ::: "memory");
}

DI void phase0(const Params& p, LAS unsigned char* lds, int tid, int lane, int wave, int bid, int G) {
    float* MOD = (float*)(p.ws + WS_MOD);
#if defined(DBL) && DBL == 0
    __syncthreads();
#endif
    if (bid < 192) {
        LAS float* sc = (LAS float*)lds;
        LAS float* red = (LAS float*)(lds + 65536);
        for (int i = tid; i < 8 * 2048; i += 512) { const int bb = i >> 11, k = i & 2047; sc[k * 8 + bb] = siluf_acc(p.c[i]); }
        __syncthreads();
        const int n0 = bid * 64;
        const int ksub = lane >> 4, cg = lane & 15;
        f32x4 acc[8];
#pragma unroll
        for (int bb = 0; bb < 8; ++bb) acc[bb] = (f32x4){0.f, 0.f, 0.f, 0.f};
        const float* wp = p.w_ada + (size_t)(wave * 256 + ksub) * 12288 + n0 + 4 * cg;
#pragma unroll 8
        for (int it = 0; it < 64; ++it) {
            const f32x4 wv = *(const f32x4*)(wp + (size_t)(4 * it) * 12288);
            const LAS float* sp = sc + (wave * 256 + 4 * it + ksub) * 8;
            const f32x4 s0 = *(const LAS f32x4*)sp, s1 = *(const LAS f32x4*)(sp + 4);
            acc[0] += wv * s0.x; acc[1] += wv * s0.y; acc[2] += wv * s0.z; acc[3] += wv * s0.w;
            acc[4] += wv * s1.x; acc[5] += wv * s1.y; acc[6] += wv * s1.z; acc[7] += wv * s1.w;
        }
#pragma unroll
        for (int bb = 0; bb < 8; ++bb) {
#pragma unroll
            for (int e = 0; e < 4; ++e) { float v = acc[bb][e]; v += __shfl_xor(v, 16); v += __shfl_xor(v, 32); acc[bb][e] = v; }
            if (ksub == 0) *(LAS f32x4*)(red + (wave * 8 + bb) * 64 + 4 * cg) = acc[bb];
        }
        __syncthreads();
        { const int bb = tid >> 6, col = tid & 63; float s = 0.f;
#pragma unroll
          for (int w = 0; w < 8; ++w) s += red[(w * 8 + bb) * 64 + col];
          MOD[bb * 12288 + n0 + col] = s + p.b_ada[n0 + col]; }
        __syncthreads();
    } else {
        f32x2* CS = (f32x2*)(p.ws + WS_CS);
        for (int i = (bid - 192) * 512 + tid; i < T * 16; i += (G - 192) * 512) {
            const int t = i >> 4, f = i & 15;
            const float inv = powf(500000.0f, -(float)f * (2.0f / 32.0f));
            const float ang = (float)p.pos[t] * inv;
            float sn, cs; sincosf(ang, &sn, &cs);
            CS[i] = (f32x2){cs, sn};
        }
    }
    LAS float* scr = (LAS float*)(lds + wave * 8448);
    const int gw = bid * 8 + wave, NGW = G * 8;
    bf16_t* WIN = (bf16_t*)(p.ws + WS_WIN); bf16_t* WMD = (bf16_t*)(p.ws + WS_WMD); bf16_t* WOUT = (bf16_t*)(p.ws + WS_WOUT); bf16_t* WR = (bf16_t*)(p.ws + WS_WR);
    constexpr int I_A = 32 * 224, I_B = 32 * 128, I_C = 32, I_M = 16 * 64, I_O = 32 * 64, I_RG = 32, I_RE = 32;
    constexpr int NITEMS = I_A + I_B + I_C + 2 * I_M + I_O + I_RG + I_RE;
    for (int it = gw; it < NITEMS; it += NGW) {
        int r = it;
        if (r < I_A) { const int kb = r / 224, nb = r % 224; transpose_tile(p.w_in, 11280, 64 * kb, 32 * nb, WIN, DM, 32 * nb, 0, 32, scr, lane); continue; } r -= I_A;
        if (r < I_B) { const int kb = r / 128, nb = r % 128; transpose_tile(p.w_in, 11280, 64 * kb, 7184 + 32 * nb, WIN, DM, 7168 + 32 * nb, 0, 32, scr, lane); continue; } r -= I_B;
        if (r < I_C) { transpose_tile(p.w_in, 11280, 64 * r, 7168, (bf16_t*)(p.ws + WS_WBA), DM, 0, 0, 16, scr, lane); continue; } r -= I_C;
        if (r < I_M) { const int kb = r / 64, nb = r % 64; transpose_tile(p.w_bm, DM, 64 * kb, 32 * nb, WMD, DM, 32 * nb, 0, 32, scr, lane); continue; } r -= I_M;
        if (r < I_M) { const int kb = r / 64, nb = r % 64; transpose_tile(p.w_bd, DM, 64 * kb, 32 * nb, WMD, DM, 32 * nb, 1024, 32, scr, lane); continue; } r -= I_M;
        if (r < I_O) { const int kb = r / 64, nb = r % 64; transpose_tile(p.w_out, DM, 64 * kb, 32 * nb, WOUT, DM, 32 * nb, 0, 32, scr, lane); continue; } r -= I_O;
        if (r < I_RG) {
            const int k = r * 64 + lane;
#pragma unroll
            for (int e = 0; e < 4; ++e) WR[e * DM + k] = f2bf(p.w_rg[k * 4 + e]);
#pragma unroll
            for (int e = 36; e < 48; ++e) WR[e * DM + k] = 0;
            continue; } r -= I_RG;
        { transpose_tile(p.w_re, 32, 64 * r, 0, WR, DM, 4, 0, 32, scr, lane); }
    }
}

DI void phase_u1_item(const Params& p, int item, int tid, int lane, int wave) {
    const float* MOD = (const float*)(p.ws + WS_MOD); bf16_t* U1 = (bf16_t*)(p.ws + WS_A);
    const int tokb = item * 64;
    for (int rr = 0; rr < 8; ++rr) {
        const int m = tokb + wave * 8 + rr, b = m >> 11;
        const f32x4* xr = (const f32x4*)(p.x + (size_t)m * DM) + lane;
        f32x4 v[8]; float s = 0.f;
#pragma unroll
        for (int j = 0; j < 8; ++j) { v[j] = xr[64 * j]; s += (v[j].x * v[j].x + v[j].y * v[j].y) + (v[j].z * v[j].z + v[j].w * v[j].w); }
        const float rstd = rsqrt_(wave_sum(s) * (1.0f / DM) + EPS);
        const float* sh = MOD + b * 12288; const float* scl = sh + 2048;
        u32x2* o8 = (u32x2*)(U1 + (size_t)m * DM) + lane;
#pragma unroll
        for (int j = 0; j < 8; ++j) { const int col = 4 * (lane + 64 * j);
            const f32x4 g = *(const f32x4*)(p.g_mix_pre + col), a = *(const f32x4*)(scl + col), c = *(const f32x4*)(sh + col);
            const f32x4 u = (v[j] * rstd * g) * (a + 1.0f) + c;
            o8[64 * j] = (u32x2){cvtpk(u.x, u.y), cvtpk(u.z, u.w)}; }
    }
    __syncthreads();
    if (wave < 4) {
        const int tl = lane & 15, kg = lane >> 4;
        const bf16_t* up = U1 + (size_t)(tokb + wave * 16 + tl) * DM + 8 * kg;
        const bf16_t* wp = (const bf16_t*)(p.ws + WS_WBA) + (size_t)tl * DM + 8 * kg;
        f32x4 a0 = {0.f, 0.f, 0.f, 0.f}, a1 = a0;
#pragma unroll 8
        for (int s = 0; s < 64; s += 2) {
            a0 = MFMA16(*(const bf16x8*)(wp + 32 * s), *(const bf16x8*)(up + 32 * s), a0);
            a1 = MFMA16(*(const bf16x8*)(wp + 32 * s + 32), *(const bf16x8*)(up + 32 * s + 32), a1);
        }
        float* BA = (float*)(p.ws + WS_BA);
        *(f32x4*)(BA + (size_t)(tokb + wave * 16 + tl) * 16 + 4 * kg) = a0 + a1;
    }
}

DI void rotary_item(const Params& p, int item, int lane) {
    const int which = item & 1, h = (item >> 1) & 7, blk = (item >> 4) & 7, b = item >> 7;
    bf16_t* PROJ = (bf16_t*)(p.ws + WS_B);
    const f32x2* CS = (const f32x2*)(p.ws + WS_CS);
    const int tok0 = b * SEQ + blk * 256; const int colb = (which ? C_K : C_Q) + h * HD;
    const int rsub = lane >> 4, i = lane & 15;
    float cs8[8];
#pragma unroll
    for (int e = 0; e < 8; ++e) cs8[e] = 0.f;
    if (which) {
#pragma unroll 16
        for (int it = 0; it < 64; ++it) { const u32x4 v = *(const u32x4*)(PROJ + (size_t)(tok0 + it * 4 + rsub) * PP + colb + 8 * i);
            cs8[0] += bflo(v.x); cs8[1] += bfhi(v.x); cs8[2] += bflo(v.y); cs8[3] += bfhi(v.y); cs8[4] += bflo(v.z); cs8[5] += bfhi(v.z); cs8[6] += bflo(v.w); cs8[7] += bfhi(v.w); }
#pragma unroll
        for (int e = 0; e < 8; ++e) { cs8[e] += __shfl_xor(cs8[e], 16); cs8[e] += __shfl_xor(cs8[e], 32); }
    }
    float a0 = 0.f, a1 = 0.f;
#pragma unroll 16
    for (int it = 0; it < 64; ++it) {
        const int t = tok0 + it * 4 + rsub;
        bf16_t* ptr = PROJ + (size_t)t * PP + colb + i;
        const float x1 = bf2f(ptr[0]), x2 = bf2f(ptr[16]);
        const f32x2 cs = CS[t * 16 + i];
        const unsigned w = cvtpk(x1 * cs.x - x2 * cs.y, x2 * cs.x + x1 * cs.y);
        ptr[0] = (bf16_t)(w & 0xffffu); ptr[16] = (bf16_t)(w >> 16);
        a0 += bflo(w); a1 += bfhi(w);
    }
    if (which) {
        a0 += __shfl_xor(a0, 16); a0 += __shfl_xor(a0, 32); a1 += __shfl_xor(a1, 16); a1 += __shfl_xor(a1, 32);
        bf16_t* KM = (bf16_t*)(p.ws + WS_KMEAN) + ((size_t)(b * 8 + h) * 8 + blk) * HD;
        if (lane < 16) {
            if (lane >= 4) { u32x4 o; o.x = cvtpk(cs8[0] * (1.0f / 256.0f), cs8[1] * (1.0f / 256.0f)); o.y = cvtpk(cs8[2] * (1.0f / 256.0f), cs8[3] * (1.0f / 256.0f));
                o.z = cvtpk(cs8[4] * (1.0f / 256.0f), cs8[5] * (1.0f / 256.0f)); o.w = cvtpk(cs8[6] * (1.0f / 256.0f), cs8[7] * (1.0f / 256.0f)); *(u32x4*)(KM + 8 * lane) = o; }
            KM[lane] = f2bf(a0 * (1.0f / 256.0f)); KM[16 + lane] = f2bf(a1 * (1.0f / 256.0f));
        }
    }
}

DI void phase_dn_final(const Params& p, int lane, int gw, int NGW) {
    const float* ODN = (const float*)(p.ws + WS_D); const bf16_t* PROJ = (const bf16_t*)(p.ws + WS_B); bf16_t* YAB = (bf16_t*)(p.ws + WS_A);
    const int d0 = (lane & 7) * 16;
    for (int m = gw; m < T; m += NGW) {
        const float* op = ODN + (size_t)m * 1024 + lane * 16;
        f32x4 v[4]; float s = 0.f;
#pragma unroll
        for (int j = 0; j < 4; ++j) { v[j] = *(const f32x4*)(op + 4 * j); s += (v[j].x * v[j].x + v[j].y * v[j].y) + (v[j].z * v[j].z + v[j].w * v[j].w); }
        s += __shfl_xor(s, 1); s += __shfl_xor(s, 2); s += __shfl_xor(s, 4);
        const float rstd = rsqrt_(s * (1.0f / HD) + EPS);
        const u32x4 z0 = *(const u32x4*)(PROJ + (size_t)m * PP + C_Z + lane * 16), z1 = *(const u32x4*)(PROJ + (size_t)m * PP + C_Z + lane * 16 + 8);
        const float zz[16] = {bflo(z0.x), bfhi(z0.x), bflo(z0.y), bfhi(z0.y), bflo(z0.z), bfhi(z0.z), bflo(z0.w), bfhi(z0.w),
                              bflo(z1.x), bfhi(z1.x), bflo(z1.y), bfhi(z1.y), bflo(z1.z), bfhi(z1.z), bflo(z1.w), bfhi(z1.w)};
        float y[16];
#pragma unroll
        for (int j = 0; j < 4; ++j) { const f32x4 g = *(const f32x4*)(p.dn_gain + d0 + 4 * j);
            y[4 * j + 0] = v[j].x * rstd * g.x * siluf_(zz[4 * j + 0]); y[4 * j + 1] = v[j].y * rstd * g.y * siluf_(zz[4 * j + 1]);
            y[4 * j + 2] = v[j].z * rstd * g.z * siluf_(zz[4 * j + 2]); y[4 * j + 3] = v[j].w * rstd * g.w * siluf_(zz[4 * j + 3]); }
        u32x4 o0, o1;
        o0.x = cvtpk(y[0], y[1]); o0.y = cvtpk(y[2], y[3]); o0.z = cvtpk(y[4], y[5]); o0.w = cvtpk(y[6], y[7]);
        o1.x = cvtpk(y[8], y[9]); o1.y = cvtpk(y[10], y[11]); o1.z = cvtpk(y[12], y[13]); o1.w = cvtpk(y[14], y[15]);
        bf16_t* yp = YAB + (size_t)m * DM + 1024 + lane * 16;
        *(u32x4*)yp = o0; *(u32x4*)(yp + 8) = o1;
    }
}

constexpr int L5_LG = 0;
constexpr int L5_HIST = 24576;
constexpr int L5_TOK = 24576 + 256;
DI void phase5_item(const Params& p, LAS unsigned char* lds, int item, int tid, int lane, int wave) {
    const float* MOD = (const float*)(p.ws + WS_MOD); const bf16_t* OM = (const bf16_t*)(p.ws + WS_OUTMIX); bf16_t* U2 = (bf16_t*)(p.ws + WS_A);
    const bf16_t* WR = (const bf16_t*)(p.ws + WS_WR); bf16_t* X1 = (bf16_t*)(p.ws + WS_D);
    LAS unsigned* hist = (LAS unsigned*)(lds + L5_HIST); LAS unsigned* tokw = (LAS unsigned*)(lds + L5_TOK);
    if (tid < 64) hist[tid] = 0u;
    const int tokb = item * 64;
    for (int rr = 0; rr < 8; rr += 2) {
        u32x4 wq[2][4]; f32x4 xa[2][4], xb[2][4];
#pragma unroll
        for (int u = 0; u < 2; ++u) { const int m = tokb + wave * 8 + rr + u;
#pragma unroll
            for (int j = 0; j < 4; ++j) { const int col = 8 * (lane + 64 * j);
                wq[u][j] = *(const u32x4*)(OM + (size_t)m * DM + col);
                xa[u][j] = *(const f32x4*)(p.x + (size_t)m * DM + col); xb[u][j] = *(const f32x4*)(p.x + (size_t)m * DM + col + 4); } }
#pragma unroll
        for (int u = 0; u < 2; ++u) {
        const int m = tokb + wave * 8 + rr + u, b = m >> 11;
        const float* mod = MOD + b * 12288;
        float om[32], xv[32];
        float s = 0.f;
#pragma unroll
        for (int j = 0; j < 4; ++j) {
            const u32x4 w = wq[u][j];
            om[8 * j + 0] = bflo(w.x); om[8 * j + 1] = bfhi(w.x); om[8 * j + 2] = bflo(w.y); om[8 * j + 3] = bfhi(w.y);
            om[8 * j + 4] = bflo(w.z); om[8 * j + 5] = bfhi(w.z); om[8 * j + 6] = bflo(w.w); om[8 * j + 7] = bfhi(w.w);
            const f32x4 x0 = xa[u][j], x1 = xb[u][j];
            xv[8 * j + 0] = x0.x; xv[8 * j + 1] = x0.y; xv[8 * j + 2] = x0.z; xv[8 * j + 3] = x0.w; xv[8 * j + 4] = x1.x; xv[8 * j + 5] = x1.y; xv[8 * j + 6] = x1.z; xv[8 * j + 7] = x1.w;
#pragma unroll
            for (int e = 0; e < 8; ++e) s += om[8 * j + e] * om[8 * j + e]; }
        const float r1 = rsqrt_(wave_sum(s) * (1.0f / DM) + EPS);
        float s2 = 0.f;
#pragma unroll
        for (int j = 0; j < 4; ++j) { const int col = 8 * (lane + 64 * j);
#pragma unroll
            for (int q = 0; q < 2; ++q) { const f32x4 g = *(const f32x4*)(p.g_mix_post + col + 4 * q), gt = *(const f32x4*)(mod + 4096 + col + 4 * q);
                f32x4 o;
                o.x = xv[8 * j + 4 * q + 0] + gt.x * (om[8 * j + 4 * q + 0] * r1 * g.x); o.y = xv[8 * j + 4 * q + 1] + gt.y * (om[8 * j + 4 * q + 1] * r1 * g.y);
                o.z = xv[8 * j + 4 * q + 2] + gt.z * (om[8 * j + 4 * q + 2] * r1 * g.z); o.w = xv[8 * j + 4 * q + 3] + gt.w * (om[8 * j + 4 * q + 3] * r1 * g.w);
                *(u32x2*)(X1 + (size_t)m * DM + col + 4 * q) = (u32x2){cvtpk(o.x, o.y), cvtpk(o.z, o.w)};
                xv[8 * j + 4 * q + 0] = o.x; xv[8 * j + 4 * q + 1] = o.y; xv[8 * j + 4 * q + 2] = o.z; xv[8 * j + 4 * q + 3] = o.w;
                s2 += (o.x * o.x + o.y * o.y) + (o.z * o.z + o.w * o.w); } }
        const float r2 = rsqrt_(wave_sum(s2) * (1.0f / DM) + EPS);
#pragma unroll
        for (int j = 0; j < 4; ++j) { const int col = 8 * (lane + 64 * j); float u8[8];
#pragma unroll
            for (int q = 0; q < 2; ++q) { const f32x4 g = *(const f32x4*)(p.g_ffn_pre + col + 4 * q), sc = *(const f32x4*)(mod + 8192 + col + 4 * q), sh = *(const f32x4*)(mod + 6144 + col + 4 * q);
                u8[4 * q + 0] = (xv[8 * j + 4 * q + 0] * r2 * g.x) * (1.0f + sc.x) + sh.x; u8[4 * q + 1] = (xv[8 * j + 4 * q + 1] * r2 * g.y) * (1.0f + sc.y) + sh.y;
                u8[4 * q + 2] = (xv[8 * j + 4 * q + 2] * r2 * g.z) * (1.0f + sc.z) + sh.z; u8[4 * q + 3] = (xv[8 * j + 4 * q + 3] * r2 * g.w) * (1.0f + sc.w) + sh.w; }
            u32x4 w; w.x = cvtpk(u8[0], u8[1]); w.y = cvtpk(u8[2], u8[3]); w.z = cvtpk(u8[4], u8[5]); w.w = cvtpk(u8[6], u8[7]);
            *(u32x4*)(U2 + (size_t)m * DM + col) = w; }
        }
    }
    __syncthreads();
    {
        const int tl = lane & 15, kg = lane >> 4, tg = wave & 3, kh = wave >> 2;
        const bf16_t* up = U2 + (size_t)(tokb + tg * 16 + tl) * DM + kh * 1024 + 8 * kg;
        const bf16_t* wp = WR + (size_t)tl * DM + kh * 1024 + 8 * kg;
        f32x4 a0 = {0.f, 0.f, 0.f, 0.f}, a1 = a0, a2 = a0;
#pragma unroll 8
        for (int s = 0; s < 32; ++s) {
            const bf16x8 bu = *(const bf16x8*)(up + 32 * s);
            const bf16x8 w0 = *(const bf16x8*)(wp + 32 * s), w1 = *(const bf16x8*)(wp + 16 * DM + 32 * s), w2 = *(const bf16x8*)(wp + 32 * DM + 32 * s);
            a0 = MFMA16(w0, bu, a0); a1 = MFMA16(w1, bu, a1); a2 = MFMA16(w2, bu, a2);
        }
        LAS float* lg = (LAS float*)(lds + L5_LG) + (kh * 4 + tg) * 768 + tl * 48 + 4 * kg;
#pragma unroll
        for (int r = 0; r < 4; ++r) { lg[r] = a0[r]; lg[16 + r] = a1[r]; lg[32 + r] = a2[r]; }
    }
    __syncthreads();
    if (wave < 4) {
        if (lane < 16) {
            const LAS float* l = (const LAS float*)(lds + L5_LG) + wave * 768 + lane * 48; const LAS float* l2 = l + 4 * 768;
            float gl[4]; int gs = 0; float gm;
#pragma unroll
            for (int i = 0; i < 4; ++i) gl[i] = l[i] + l2[i] + p.b_rg[i];
            gm = gl[0];
#pragma unroll
            for (int i = 1; i < 4; ++i) if (gl[i] > gm) { gm = gl[i]; gs = i; }
            float gsum = 0.f;
#pragma unroll
            for (int i = 0; i < 4; ++i) gsum += expf(gl[i] - gm);
            const float pg = 1.0f / gsum;
            float el[8]; float em = -3.0e38f;
#pragma unroll
            for (int i = 0; i < 8; ++i) { const float v = l[4 + 8 * gs + i] + l2[4 + 8 * gs + i] + p.b_re[8 * gs + i]; el[i] = v; em = fmaxf(em, v); }
            float pe[8]; float esum = 0.f;
#pragma unroll
            for (int i = 0; i < 8; ++i) { pe[i] = expf(el[i] - em); esum += pe[i]; }
            int i0 = 0; float p0 = pe[0];
#pragma unroll
            for (int i = 1; i < 8; ++i) if (pe[i] > p0) { p0 = pe[i]; i0 = i; }
            int i1 = -1; float p1 = -1.f;
#pragma unroll
            for (int i = 0; i < 8; ++i) if (i != i0 && pe[i] > p1) { p1 = pe[i]; i1 = i; }
            const float w0 = pg * p0 / (p0 + p1), w1 = pg * p1 / (p0 + p1);
            const int e0 = 8 * gs + i0, e1 = 8 * gs + i1;
            const unsigned lr0 = __hip_atomic_fetch_add(hist + e0, 1u, __ATOMIC_RELAXED, __HIP_MEMORY_SCOPE_WORKGROUP), lr1 = __hip_atomic_fetch_add(hist + e1, 1u, __ATOMIC_RELAXED, __HIP_MEMORY_SCOPE_WORKGROUP);
            LAS unsigned* tw = tokw + (wave * 16 + lane) * 6;
            tw[0] = (unsigned)e0; tw[1] = (unsigned)e1; tw[2] = lr0; tw[3] = lr1; tw[4] = __float_as_uint(w0); tw[5] = __float_as_uint(w1);
        }
    }
    __syncthreads();
    if (tid < 32) { unsigned* cnt = (unsigned*)(p.ws + WS_CTL) + CW_CNT; const unsigned hcount = hist[tid];
        hist[32 + tid] = hcount ? __hip_atomic_fetch_add(cnt + tid, hcount, __ATOMIC_RELAXED, __HIP_MEMORY_SCOPE_AGENT) : 0u; }
    __syncthreads();
    if (tid < 64) {
        const LAS unsigned* tw = tokw + tid * 6; const int tok = tokb + tid;
        const unsigned e0 = tw[0], e1 = tw[1], q0 = hist[32 + e0] + tw[2], q1 = hist[32 + e1] + tw[3];
        int* RT = (int*)(p.ws + WS_RTOK); RT[e0 * ECAP + q0] = tok; RT[e1 * ECAP + q1] = tok;
        u32x4* rec = (u32x4*)(p.ws + WS_REC) + (size_t)tok * 2;
        rec[0] = (u32x4){e0, e1, q0, q1}; rec[1] = (u32x4){tw[4], tw[5], 0u, 0u};
    }
    __syncthreads();
}
DI void expert_copy_gu(const Params& p, int it, LAS float* scr, int lane) {
    const int e = it >> 10, r = it & 1023, up = r >> 9, q = r & 511, kb = q >> 4, nb = q & 15, n0 = 32 * nb;
    const float* W = (up ? p.w_up : p.w_gate) + (size_t)e * DM * FF;
    transpose_tile(W, FF, 64 * kb, n0, (bf16_t*)(p.ws + WS_WGU), DM, e * 1024 + (n0 >> 7) * 256 + (n0 & 127) + up * 128, 0, 32, scr, lane);
}
DI void expert_copy_dn(const Params& p, int it, LAS float* scr, int lane) {
    const int e = it >> 9, q = it & 511, kb = q >> 6, nb = q & 63;
    transpose_tile(p.w_down + (size_t)e * FF * DM, DM, 64 * kb, 32 * nb, (bf16_t*)(p.ws + WS_WDN), FF, e * DM + 32 * nb, 0, 32, scr, lane);
}

struct MoeOrder {
    const LAS int* pref; const LAS int* cnt; int ntn, G, c;
    DI bool next(int i, pg8::Unit& u) const {
        const int L = i * G + c; const int total = pref[32] * ntn; if (L >= total) return false;
        const int tile = L / ntn, pnl = L - tile * ntn;
        int e = 0;
        for (int q = 1; q < 32; ++q) if (tile >= pref[q]) e = q;
        const int m = tile - pref[e];
        u.pm = tile; u.pn = e * ntn + pnl; u.ga = e * ECAP + m * 256; u.gn = cnt[e] - m * 256; return true;
    }
};
DI void moe_tables(const Params& p, LAS int* pref, LAS int* cntl, int tid) {
    if (tid < 32) { const unsigned* cnt = (const unsigned*)(p.ws + WS_CTL) + CW_CNT; cntl[tid] = (int)__hip_atomic_load(cnt + tid, __ATOMIC_RELAXED, __HIP_MEMORY_SCOPE_AGENT); }
    __syncthreads();
    if (tid == 0) { int acc = 0;
        for (int e = 0; e < 32; ++e) { pref[e] = acc; acc += (cntl[e] + 255) >> 8; }
        pref[32] = acc; }
    __syncthreads();
}

DI void phase8(const Params& p, const LAS int* pref, int lane, int gw, int NGW) {
    const float* MOD = (const float*)(p.ws + WS_MOD); const bf16_t* YB = (const bf16_t*)(p.ws + WS_YBUF); const bf16_t* X1 = (const bf16_t*)(p.ws + WS_D);
    for (int m = gw; m < T; m += NGW) {
        const int b = m >> 11; const float* gt2 = MOD + b * 12288 + 5 * 2048;
        const u32x4* rec = (const u32x4*)(p.ws + WS_REC) + (size_t)m * 2;
        const u32x4 r0 = rec[0], r1 = rec[1];
        const size_t row0 = (size_t)(pref[r0.x] * 256 + (int)r0.z), row1 = (size_t)(pref[r0.y] * 256 + (int)r0.w);
        const float w0 = __uint_as_float(r1.x), w1 = __uint_as_float(r1.y);
        float y[32]; float s = 0.f;
#pragma unroll
        for (int j = 0; j < 4; ++j) { const int col = 8 * (lane + 64 * j);
            const u32x4 a = *(const u32x4*)(YB + row0 * DM + col), c = *(const u32x4*)(YB + row1 * DM + col);
            y[8 * j + 0] = w0 * bflo(a.x) + w1 * bflo(c.x); y[8 * j + 1] = w0 * bfhi(a.x) + w1 * bfhi(c.x);
            y[8 * j + 2] = w0 * bflo(a.y) + w1 * bflo(c.y); y[8 * j + 3] = w0 * bfhi(a.y) + w1 * bfhi(c.y);
            y[8 * j + 4] = w0 * bflo(a.z) + w1 * bflo(c.z); y[8 * j + 5] = w0 * bfhi(a.z) + w1 * bfhi(c.z);
            y[8 * j + 6] = w0 * bflo(a.w) + w1 * bflo(c.w); y[8 * j + 7] = w0 * bfhi(a.w) + w1 * bfhi(c.w);
#pragma unroll
            for (int e = 0; e < 8; ++e) s += y[8 * j + e] * y[8 * j + e]; }
        const float rs = rsqrt_(wave_sum(s) * (1.0f / DM) + EPS);
#pragma unroll
        for (int j = 0; j < 4; ++j) { const int col = 8 * (lane + 64 * j);
#pragma unroll
            for (int q = 0; q < 2; ++q) { float* op = p.out + (size_t)m * DM + col + 4 * q;
                const u32x2 xw = *(const u32x2*)(X1 + (size_t)m * DM + col + 4 * q);
                const f32x4 x1 = {bflo(xw.x), bfhi(xw.x), bflo(xw.y), bfhi(xw.y)}, g = *(const f32x4*)(p.g_ffn_post + col + 4 * q), gt = *(const f32x4*)(gt2 + col + 4 * q);
                f32x4 o;
                o.x = x1.x + gt.x * (y[8 * j + 4 * q + 0] * rs * g.x); o.y = x1.y + gt.y * (y[8 * j + 4 * q + 1] * rs * g.y);
                o.z = x1.z + gt.z * (y[8 * j + 4 * q + 2] * rs * g.z); o.w = x1.w + gt.w * (y[8 * j + 4 * q + 3] * rs * g.w);
                *(f32x4*)op = o; } }
    }
}

#define XB_TMO      128
#define XB_XCNT(j)  (256  + 64 * (j))
#define XB_XSUB(j)  (1280 + 64 * (j))
#define XB_XGEN(j)  (2304 + 64 * (j))
#define XB_TOP      3328
#define XB_TOPGEN   3392
#define XCD_BAR_WORDS 3456
#define XB_SPIN_CAP (1u << 18)
DI unsigned xb_ld(unsigned* p)              { return __hip_atomic_load(p, __ATOMIC_RELAXED, __HIP_MEMORY_SCOPE_AGENT); }
DI unsigned xb_add(unsigned* p, unsigned v) { return __hip_atomic_fetch_add(p, v, __ATOMIC_RELAXED, __HIP_MEMORY_SCOPE_AGENT); }
DI unsigned xb_xcc_id() { return (unsigned)__builtin_amdgcn_s_getreg((3 << 11) | 20) & 0xFu; }
#define XB_SPIN(cond, bar) do { unsigned _sp = 0; while (cond) { __builtin_amdgcn_s_sleep(1); \
    if ((++_sp & 255u) == 0u) { if (xb_ld(&(bar)[XB_TMO])) break; if (_sp > XB_SPIN_CAP) { atomicAdd(&(bar)[XB_TMO], 1u); break; } } } } while (0)
struct XcdBarrier { unsigned* bar; unsigned x; volatile LAS unsigned* st; };
DI XcdBarrier xcd_barrier_post(unsigned* bar, volatile LAS unsigned* st) {
    XcdBarrier b; b.bar = bar; b.x = xb_xcc_id(); b.st = st;
    if (threadIdx.x == 0) (void)xb_add(&bar[XB_XCNT(b.x)], 1u);
    return b;
}
DI void xcd_barrier_complete(unsigned* bar, unsigned x, unsigned& nloc, unsigned& nx) {
    const unsigned G = gridDim.x * gridDim.y * gridDim.z;
    unsigned sum, cnt, mine, sp = 0u;
    for (;;) {
        sum = 0u; cnt = 0u; mine = 0u;
#pragma unroll
        for (unsigned j = 0; j < 16; ++j) { const unsigned c = xb_ld(&bar[XB_XCNT(j)]); sum += c; cnt += (c > 0u) ? 1u : 0u; mine = (j == x) ? c : mine; }
        if (sum == G) break;
        __builtin_amdgcn_s_sleep(1);
        if ((++sp & 255u) == 0u) { if (xb_ld(&bar[XB_TMO])) break; if (sp > XB_SPIN_CAP) { atomicAdd(&bar[XB_TMO], 1u); break; } }
    }
    nloc = mine > 0u ? mine : 1u; nx = cnt > 0u ? cnt : 1u;
}
DI void xcd_barrier(const XcdBarrier& b) {
    asm volatile("s_waitcnt vmcnt(0)" ::: "memory");
    __syncthreads();
    if (threadIdx.x == 0) {
        unsigned* bar = b.bar;
        __builtin_amdgcn_s_waitcnt(0);
        unsigned nloc = b.st[0], nx = b.st[1];
        if (nloc == 0u) { xcd_barrier_complete(bar, b.x, nloc, nx); b.st[0] = nloc; b.st[1] = nx; }
        const unsigned old = xb_add(&bar[XB_XSUB(b.x)], 1u);
        const unsigned gen = old / nloc;
        if (old + 1u == (gen + 1u) * nloc) {
            __builtin_amdgcn_fence(__ATOMIC_RELEASE, "agent");
            asm volatile("s_waitcnt vmcnt(0)" ::: "memory");
            const unsigned og = xb_add(&bar[XB_TOP], 1u);
            const unsigned tg = og / nx;
            if (og + 1u == (tg + 1u) * nx) xb_add(&bar[XB_TOPGEN], 1u);
            else XB_SPIN(xb_ld(&bar[XB_TOPGEN]) == tg, bar);
            __builtin_amdgcn_fence(__ATOMIC_ACQUIRE, "agent");
            xb_add(&bar[XB_XGEN(b.x)], 1u);
            asm volatile("s_waitcnt vmcnt(0)" ::: "memory");
        } else {
            XB_SPIN(xb_ld(&bar[XB_XGEN(b.x)]) == gen, bar);
            __builtin_amdgcn_fence(__ATOMIC_ACQUIRE, "agent");
            asm volatile("s_waitcnt vmcnt(0)" ::: "memory");
        }
    }
    __syncthreads();
}

constexpr int NWAVES = 8, NTHREADS = 512;
constexpr int LDS_GEMM = 131072, LDS_TAB = 152576, LDS_BYTES = LDS_TAB + 1024;
constexpr int N_PHASES = 12;
#ifndef DBL
#define DBL -1
#endif
#define REP(k) for (int rep_ = 0; rep_ < ((DBL == (k)) ? 2 : 1); ++rep_)
#ifndef MK_N_LAUNCHES
#define MK_N_LAUNCHES 1
#endif

DI moba::BlockRef attn_ref(const Params& p, int bh, int qb) {
    const int b = bh >> 3, h = bh & 7;
    const bf16_t* PROJ = (const bf16_t*)(p.ws + WS_B);
    moba::BlockRef r;
    r.Q = PROJ + (size_t)(b * SEQ + qb * 256) * PP + C_Q + h * HD;
    r.K = PROJ + (size_t)(b * SEQ) * PP + C_K + h * HD;
    r.V = PROJ + (size_t)(b * SEQ) * PP + C_V + h * HD;
    r.O = (bf16_t*)(p.ws + WS_A) + (size_t)(b * SEQ + qb * 256) * DM + h * HD;
    r.KM = (const bf16_t*)(p.ws + WS_KMEAN) + (size_t)bh * 8 * HD;
    r.P0 = qb * 256;
    return r;
}

typedef const __attribute__((address_space(4))) Params* KParams;
#if defined(__HIP_DEVICE_COMPILE__)
#define LOADP() KParams kq_ = kp_; asm volatile("" : "+s"(kq_)); const Params p = *kq_
#else
#define LOADP() const Params p = p_unused
#endif
__global__ void __launch_bounds__(NTHREADS, 2) fwd_kernel(Params p_unused) {
#if defined(__HIP_DEVICE_COMPILE__)
    const KParams kp_ = (KParams)__builtin_amdgcn_kernarg_segment_ptr();
#else
    const Params* kp_ = &p_unused;
#endif
    extern __shared__ __attribute__((aligned(16))) unsigned char lds_raw[];
    LAS unsigned char* lds = (LAS unsigned char*)lds_raw;
    const int bid = blockIdx.x, G = gridDim.x, NGW = G * NWAVES;
#define IDS() int tid_ = threadIdx.x; asm volatile("" : "+v"(tid_)); const int tid = tid_, lane = tid & 63, wave = __builtin_amdgcn_readfirstlane(tid >> 6), gw = bid * NWAVES + wave; (void)lane; (void)gw; (void)wave
    const int vcu = (G % 8 == 0) ? (bid % 8) * (G / 8) + bid / 8 : bid;
    const int lo = kp_->ph_lo, hi = kp_->ph_hi;
#ifdef ONLY
#define IN(k) ((k) == ONLY && lo <= (k) && (k) < hi)
#else
#define IN(k) (lo <= (k) && (k) < hi)
#endif
    { volatile LAS unsigned* st0 = (volatile LAS unsigned*)(lds + LDS_TAB + 512); if (threadIdx.x < 2) st0[threadIdx.x] = 0u; __syncthreads(); }
    XcdBarrier xbar; xbar.bar = (unsigned*)(kp_->ws + WS_CTL) + CW_BAR; xbar.x = 0; xbar.st = (volatile LAS unsigned*)(lds + LDS_TAB + 512);
#define SEAM(k) do { if (IN(k) && IN((k) + 1)) { if ((k) == 0) { cg::this_grid().sync(); xbar = xcd_barrier_post((unsigned*)(kp_->ws + WS_CTL) + CW_BAR, (volatile LAS unsigned*)(lds + LDS_TAB + 512)); } else xcd_barrier(xbar); } } while (0)

    if (IN(0)) { LOADP(); IDS();
        if (bid == 0) { unsigned* ctl = (unsigned*)(p.ws + WS_CTL); for (int i = tid; i < 8192; i += NTHREADS) ctl[i] = 0u; }
        REP(0) phase0(p, lds, tid, lane, wave, bid, G); }
    SEAM(0);
    if (IN(1)) { LOADP(); IDS(); REP(1) for (int it = bid; it < T / 64; it += G) phase_u1_item(p, it, tid, lane, wave); }
    SEAM(1);
    if (IN(2)) { LOADP(); IDS();
        pg8::Gemm g{(const bf16_t*)(p.ws + WS_A), (const bf16_t*)(p.ws + WS_WIN), DM, nullptr};
        pg8::StaticOrder S; S.init(T, NPROJ, G, bid);
        pg8::EpiStore E{(bf16_t*)(p.ws + WS_B), PP, 64};
        pg8::gemm_phase<pg8::EpiStore, pg8::StaticOrder, true, false>(lds, g, S, E);
#if DBL == 2
        pg8::gemm_phase<pg8::EpiStore, pg8::StaticOrder, true, false>(lds, g, S, E);
#endif
    }
    SEAM(2);
    if (IN(3)) { LOADP(); IDS();
        if (wave < 4) { for (int it = bid * 4 + wave; it < 1024; it += G * 4) rotary_item(p, it, lane); }
        REP(30) { dn::Raw R; dn::ConvW CW; dn::prep_consts(p, (bid >> 5) & 7, CW, lane); if (bid < 64 * 32) dn::prep_load(p, bid, R, lane, wave);
            for (int it = bid; it < 64 * 32; it += G) dn::prep_chunk(p, lds, it, (it + G < 64 * 32) ? it + G : -1, R, CW, tid, lane, wave); }
    }
    SEAM(3);
    if (IN(4)) { LOADP(); IDS();
        const int x = bid & 7, ci = bid >> 3, grp = ci >> 3, bhA = 8 * x + 7 - (ci & 7);
        REP(41) { if (grp == 0) dn::recur(p, lds, 8 * x + ci, tid, lane, wave); }
#ifndef NO_ATTN
        REP(40) {
            const int nblk = grp == 0 ? 1 : (grp == 2 ? 3 : 2);
#define QSEL(i) (grp == 0 ? 3 : grp == 1 ? ((i) == 0 ? 7 : 1) : grp == 2 ? ((i) == 0 ? 6 : ((i) == 1 ? 2 : 0)) : ((i) == 0 ? 5 : 4))
            moba::Seam S;
            moba::BlockRef cur = attn_ref(p, bhA, QSEL(0));
            moba::prime(cur, (char*)lds_raw, S);
            for (int i = 0; i < nblk; ++i) {
                const int in = (i + 1 < nblk) ? i + 1 : i;
                const moba::BlockRef nxt = attn_ref(p, bhA, QSEL(in));
                moba::block(cur, nxt, (char*)lds_raw, S);
                cur = nxt;
            }
#undef QSEL
        }
#endif
    }
    SEAM(4);
    if (IN(6)) { LOADP(); IDS();
        pg8::Gemm g{(const bf16_t*)(p.ws + WS_A), (const bf16_t*)(p.ws + WS_WMD), DM, nullptr};
        pg8::StaticOrder S; S.init(T, DM, G, bid);
        pg8::EpiMerged E{(const bf16_t*)(p.ws + WS_B), (bf16_t*)(p.ws + WS_MERGED)};
        pg8::gemm_phase<pg8::EpiMerged, pg8::StaticOrder, true, false>(lds, g, S, E);
#if DBL == 6
        pg8::gemm_phase<pg8::EpiMerged, pg8::StaticOrder, true, false>(lds, g, S, E);
#endif
    }
    SEAM(6);
    if (IN(7)) { LOADP(); IDS();
        const bool copy_first = ((bid >> 3) & 1) == 0;
        LAS float* scr = (LAS float*)(lds + wave * 8448);
        if (copy_first) { REP(81) for (int it = gw; it < 32 * 1024; it += NGW) expert_copy_gu(p, it, scr, lane); __syncthreads(); }
        {
        pg8::Gemm g{(const bf16_t*)(p.ws + WS_MERGED), (const bf16_t*)(p.ws + WS_WOUT), DM, nullptr};
        pg8::StaticOrder S; S.init(T, DM, G, bid);
        pg8::EpiStore E{(bf16_t*)(p.ws + WS_OUTMIX), DM, 8};
        pg8::gemm_phase<pg8::EpiStore, pg8::StaticOrder, true, false>(lds, g, S, E);
#if DBL == 7
        pg8::gemm_phase<pg8::EpiStore, pg8::StaticOrder, true, false>(lds, g, S, E);
#endif
        }
        if (!copy_first) { REP(81) for (int it = gw; it < 32 * 1024; it += NGW) expert_copy_gu(p, it, scr, lane); }
    }
    SEAM(7);
    if (IN(8)) { LOADP(); IDS();
        for (int it = bid; it < T / 64; it += G) phase5_item(p, lds, it, tid, lane, wave);
    }
    SEAM(8);
    LAS int* pref = (LAS int*)(lds + LDS_TAB); LAS int* cntl = pref + 64;
    if (IN(9)) { LOADP(); IDS();
        moe_tables(p, pref, cntl, tid);
        pg8::Gemm g{(const bf16_t*)(p.ws + WS_A), (const bf16_t*)(p.ws + WS_WGU), DM, (const int*)(p.ws + WS_RTOK)};
        MoeOrder S{pref, cntl, 4, G, bid};
        pg8::EpiGU E{(bf16_t*)(p.ws + WS_H)};
        pg8::gemm_phase<pg8::EpiGU, MoeOrder, true, true>(lds, g, S, E);
#if DBL == 9
        pg8::gemm_phase<pg8::EpiGU, MoeOrder, true, true>(lds, g, S, E);
#endif
        {   const int total = pref[32] * 4, rem = total % G, ncw = rem ? G - rem : G, cw = rem ? bid - rem : bid;
            if (cw >= 0) { LAS float* scr = (LAS float*)(lds + wave * 8448);
                for (int it = cw * NWAVES + wave; it < 32 * 512; it += ncw * NWAVES) expert_copy_dn(p, it, scr, lane); }
        }
    }
    SEAM(9);
    if (IN(10)) { LOADP(); IDS();
        if (!IN(9)) moe_tables(p, pref, cntl, tid);
        pg8::Gemm g{(const bf16_t*)(p.ws + WS_H), (const bf16_t*)(p.ws + WS_WDN), FF, nullptr};
        MoeOrder S{pref, cntl, 8, G, bid};
        pg8::EpiStore E{(bf16_t*)(p.ws + WS_YBUF), DM, 8};
        pg8::gemm_phase<pg8::EpiStore, MoeOrder, true, false>(lds, g, S, E);
#if DBL == 10
        pg8::gemm_phase<pg8::EpiStore, MoeOrder, true, false>(lds, g, S, E);
#endif
    }
    SEAM(10);
    if (IN(11)) { LOADP(); IDS();
        if (!IN(10)) moe_tables(p, pref, cntl, tid);
        phase8(p, pref, lane, gw, NGW);
    }
#undef IN
#undef SEAM
}

extern "C" void kernel_launch(void* const* d_in, const int* in_sizes, int n_in, void* d_out, int out_size, void* d_ws, size_t ws_size, hipStream_t stream) {
    static int grid = 0;
    if (grid == 0) {
        if (n_in != 24 || in_sizes[0] != T * DM || out_size != T * DM || ws_size < WS_END) {
            fprintf(stderr, "kernel_launch: unexpected shapes (n_in %d, in0 %d, out %d, ws %zu); nothing launched\n", n_in, n_in > 0 ? in_sizes[0] : -1, out_size, ws_size); grid = -1; return; }
        int dev = 0, cus = 0, per_cu = 0;
        hipGetDevice(&dev); hipDeviceGetAttribute(&cus, hipDeviceAttributeMultiprocessorCount, dev);
        if (hipFuncSetAttribute((const void*)fwd_kernel, hipFuncAttributeMaxDynamicSharedMemorySize, LDS_BYTES) != hipSuccess) { fprintf(stderr, "kernel_launch: hipFuncSetAttribute failed\n"); grid = -1; return; }
        if (hipOccupancyMaxActiveBlocksPerMultiprocessor(&per_cu, (const void*)fwd_kernel, NTHREADS, LDS_BYTES) != hipSuccess || per_cu < 1) { fprintf(stderr, "kernel_launch: occupancy query says %d blocks per CU\n", per_cu); grid = -1; return; }
        (void)hipGetLastError();
        grid = cus;
        if (cus != 256) { fprintf(stderr, "kernel_launch: built for a 256-CU device (static phase schedules), found %d CUs; nothing launched\n", cus); grid = -1; return; }
    }
    if (grid < 0) return;
    Params p{};
    p.x = (const float*)d_in[0]; p.c = (const float*)d_in[1]; p.pos = (const int*)d_in[2]; p.w_ada = (const float*)d_in[3]; p.b_ada = (const float*)d_in[4];
    p.g_mix_pre = (const float*)d_in[5]; p.g_mix_post = (const float*)d_in[6]; p.g_ffn_pre = (const float*)d_in[7]; p.g_ffn_post = (const float*)d_in[8];
    p.w_in = (const float*)d_in[9]; p.conv_w = (const float*)d_in[10]; p.a_log = (const float*)d_in[11]; p.dt_bias = (const float*)d_in[12]; p.dn_gain = (const float*)d_in[13];
    p.w_bm = (const float*)d_in[14]; p.w_bd = (const float*)d_in[15]; p.w_out = (const float*)d_in[16];
    p.w_rg = (const float*)d_in[17]; p.b_rg = (const float*)d_in[18]; p.w_re = (const float*)d_in[19]; p.b_re = (const float*)d_in[20];
    p.w_gate = (const float*)d_in[21]; p.w_up = (const float*)d_in[22]; p.w_down = (const float*)d_in[23];
    p.out = (float*)d_out; p.ws = (unsigned char*)d_ws;
    for (int li = 0; li < MK_N_LAUNCHES; ++li) {
        p.ph_lo = (MK_N_LAUNCHES == 1) ? 0 : li; p.ph_hi = (MK_N_LAUNCHES == 1) ? N_PHASES : li + 1;
        void* args[] = {&p};
        hipError_t e = hipLaunchCooperativeKernel((const void*)fwd_kernel, dim3(grid), dim3(NTHREADS), args, LDS_BYTES, stream);
        if (e != hipSuccess) { fprintf(stderr, "kernel_launch: cooperative launch failed: %s (grid %d)\n", hipGetErrorString(e), grid); break; }
    }
}
```

```cpp
#include <hip/hip_runtime.h>
#include <hip/hip_cooperative_groups.h>
#include <cstdio>
#include <cstdint>
namespace cg = cooperative_groups;

#define LAS __attribute__((address_space(3)))
#define DI __device__ __forceinline__
typedef unsigned short bf16_t;
typedef short bf16x8 __attribute__((ext_vector_type(8)));
typedef short s16x4 __attribute__((ext_vector_type(4)));
typedef float f32x2 __attribute__((ext_vector_type(2)));
typedef float f32x4 __attribute__((ext_vector_type(4)));
typedef float f32x16 __attribute__((ext_vector_type(16)));
typedef unsigned u32x2 __attribute__((ext_vector_type(2)));
typedef unsigned u32x4 __attribute__((ext_vector_type(4)));
typedef __bf16 bf16x2_t __attribute__((ext_vector_type(2)));

constexpr int NB = 8, SEQ = 2048, T = NB * SEQ, DM = 2048;
constexpr int NHEAD = 8, HD = 128;
constexpr int PP = 11264;
constexpr int NPROJ = 11264;
constexpr int C_Q = 0, C_K = 1024, C_V = 2048, C_DN = 3072, C_Z = 6144, C_GA = 7168, C_GB = 9216;
constexpr int NEXP = 32, FF = 512, ECAP = 16384;
constexpr float EPS = 1e-6f;

constexpr size_t MiB = 1u << 20;
constexpr size_t WS_CTL = 0, CTL_ZERO_BYTES = 1 * MiB;
constexpr size_t WS_MOD = 1 * MiB;
constexpr size_t WS_CS = 2 * MiB;
constexpr size_t WS_KMEAN = 4 * MiB;
constexpr size_t WS_WR = 4 * MiB + 512 * 1024;
constexpr size_t WS_WBA = 4 * MiB + 768 * 1024;
constexpr size_t WS_BA = 5 * MiB;
constexpr size_t WS_REC = 6 * MiB;
constexpr size_t WS_RTOK = 7 * MiB;
constexpr size_t WS_WMD = 10 * MiB;
constexpr size_t WS_WOUT = 18 * MiB;
constexpr size_t WS_A = 26 * MiB;
constexpr size_t WS_B = 90 * MiB;
constexpr size_t WS_C = 442 * MiB;
constexpr size_t WS_D = 588 * MiB;
constexpr size_t WS_GATEF = 588 * MiB;
constexpr size_t WS_U2F = 652 * MiB;
constexpr size_t WS_END = 716 * MiB;
constexpr float SU = 4.0f, SW = 32.0f, SH = 2.0f;
constexpr size_t WS_OUTMIX = WS_B, WS_WGU = WS_B + 128 * MiB, WS_WDN = WS_B + 256 * MiB, WS_YBUF = WS_B;
constexpr size_t WS_WIN = WS_C, WS_DNP = WS_C, WS_MERGED = WS_C, WS_H = WS_C + 64 * MiB;
constexpr int CW_CNT = 64;
constexpr int CW_BAR = 4096;
constexpr int DN_U = 0, DN_W = 16384, DN_QD = 32768, DN_KT = 49152, DN_QK = 65536, DN_SC = 73728, DN_STRIDE = 73984;

struct Params {
    const float* x; const float* c; const int* pos; const float* w_ada; const float* b_ada;
    const float* g_mix_pre; const float* g_mix_post; const float* g_ffn_pre; const float* g_ffn_post;
    const float* w_in; const float* conv_w; const float* a_log; const float* dt_bias; const float* dn_gain;
    const float* w_bm; const float* w_bd; const float* w_out;
    const float* w_rg; const float* b_rg; const float* w_re; const float* b_re;
    const float* w_gate; const float* w_up; const float* w_down;
    float* out; unsigned char* ws;
    int ph_lo, ph_hi;
};

DI unsigned cvtpk(float lo, float hi) { f32x2 v = {lo, hi}; bf16x2_t b = __builtin_convertvector(v, bf16x2_t); return __builtin_bit_cast(unsigned, b); }
DI float bflo(unsigned w) { return __uint_as_float(w << 16); }
DI float bfhi(unsigned w) { return __uint_as_float(w & 0xffff0000u); }
DI float bf2f(bf16_t b) { return __uint_as_float((unsigned)b << 16); }
DI bf16_t f2bf(float f) { return (bf16_t)(cvtpk(f, 0.f) & 0xffffu); }
#define DPP_ADD(v, ctrl) ((v) + __builtin_bit_cast(float, __builtin_amdgcn_update_dpp(0, __builtin_bit_cast(int, (v)), (ctrl), 0xf, 0xf, false)))
DI float wave_sum(float v) {
    v = DPP_ADD(v, 0xB1); v = DPP_ADD(v, 0x4E); v = DPP_ADD(v, 0x141); v = DPP_ADD(v, 0x140);
    const float r0 = __builtin_bit_cast(float, __builtin_amdgcn_readlane(__builtin_bit_cast(int, v), 0)), r1 = __builtin_bit_cast(float, __builtin_amdgcn_readlane(__builtin_bit_cast(int, v), 16));
    const float r2 = __builtin_bit_cast(float, __builtin_amdgcn_readlane(__builtin_bit_cast(int, v), 32)), r3 = __builtin_bit_cast(float, __builtin_amdgcn_readlane(__builtin_bit_cast(int, v), 48));
    return (r0 + r1) + (r2 + r3);
}
DI float sigmoidf_(float x) { return __builtin_amdgcn_rcpf(1.f + __expf(-x)); }
DI float siluf_(float x) { return x * __builtin_amdgcn_rcpf(1.f + __expf(-x)); }
DI float rsqrt_(float x) { return __builtin_amdgcn_rsqf(x); }
DI float siluf_acc(float x) { return x / (1.f + expf(-x)); }
constexpr float SCALE_Q = 0.08838834764831845f;
DI unsigned cvt4_fp8(float a, float b, float cc, float d) { int w = 0; w = __builtin_amdgcn_cvt_pk_fp8_f32(a, b, w, false); w = __builtin_amdgcn_cvt_pk_fp8_f32(cc, d, w, true); return (unsigned)w; }
DI int perm16(int p) { return (p & 3) | ((p & 4) << 1) | ((p & 8) >> 1); }
DI int crow(int r, int hi) { return (r & 3) + 8 * (r >> 2) + 4 * hi; }
#define MFMA32(a, b, c) __builtin_amdgcn_mfma_f32_32x32x16_bf16((a), (b), (c), 0, 0, 0)
#define MFMA16(a, b, c) __builtin_amdgcn_mfma_f32_16x16x32_bf16((a), (b), (c), 0, 0, 0)

namespace pg8 {
constexpr int BM = 256, BK = 64, HALF = 128, HTB = HALF * BK * 2, STAGE_BYTES = 8 * HTB, NXCD = 8, WGM = 4;
DI int lds_byte(int r, int c) { const int st = (r >> 4) * 2 + (c >> 5), rr = r & 15, cc = c & 31, ob = rr * 64 + cc * 2; return st * 1024 + (ob ^ (((ob >> 9) & 1) << 5)); }
DI void stage_rc(int b, int& R, int& C) { const int st = b / 1024, sb = b % 1024, swz = sb ^ (((sb >> 9) & 1) << 5); R = (st >> 1) * 16 + swz / 64; C = (st & 1) * 32 + (swz % 64) / 2; }
DI int perm32(int rho) { const int n = rho >> 4, i = rho & 15; return 8 * (i >> 2) + 4 * n + (i & 3); }

struct Unit { int pm, pn, ga, gn; };
struct Gemm { const bf16_t* A; const bf16_t* Bt; int K; const int* gidx; };

struct StaticOrder {
    int nM, nN, nwg, G, c, i0 = 0, imax = 1 << 30;
    DI void init(int M, int N, int G_, int c_) { nM = M / BM; nN = N / BM; nwg = nM * nN; G = G_; c = c_; }
    DI bool next(int i, Unit& u) const {
        if (i >= imax) return false;
        const long L = (long)(i + i0) * G + c; if (L >= nwg) return false;
        int wgid = (int)L; { const int q = nwg / NXCD, r = nwg % NXCD, xcd = wgid % NXCD, off = wgid / NXCD; wgid = (xcd < r ? xcd * (q + 1) : r * (q + 1) + (xcd - r) * q) + off; }
        const int nig = WGM * nN, gid = wgid / nig, fm = gid * WGM, gsz = (nM - fm) < WGM ? (nM - fm) : WGM;
        u.pm = fm + ((wgid % nig) % gsz); u.pn = (wgid % nig) / gsz; u.ga = 0; u.gn = 0; return true;
    }
};

typedef f32x4 Acc[2][2][4][2];
typedef int v4i_t __attribute__((ext_vector_type(4)));
typedef int v8i_t __attribute__((ext_vector_type(8)));

template <class Epi, class Sched, bool ALIGN_EPI, bool GATHER, bool FP8 = false>
DI void gemm_phase(LAS unsigned char* lds, const Gemm g, const Sched& S, const Epi& E) {
    const int tid = threadIdx.x, wid = __builtin_amdgcn_readfirstlane(tid >> 6), lane = tid & 63, wr = wid >> 2, wc = wid & 3, fr = lane & 15, fq = lane >> 4;
    int K_ = FP8 ? (g.K >> 1) : g.K; if constexpr (FP8) asm volatile("" : "+s"(K_));
    const int K = K_, nt = K / BK;
    unsigned voffA[2], voffB[2];
#pragma unroll
    for (int i = 0; i < 2; ++i) { int R, C; stage_rc(tid * 16 + i * 8192, R, C); const int Rb = (R & ~31) + perm32(R & 31);
        voffA[i] = (unsigned)(R * K + C) * 2u; voffB[i] = (unsigned)(Rb * K + C) * 2u; }
    const size_t kstep = (size_t)(BK * 2);
    const size_t hstep = (size_t)HALF * K * 2;
    const size_t tstep = 2 * hstep;
    const unsigned ldsw = (unsigned)wid * 1024u;
    const int aoff = FP8 ? lds_byte(wr * 64 + fr, fq * 16) : lds_byte(wr * 64 + fr, fq * 8), boff = FP8 ? lds_byte(wc * 32 + fr, fq * 16) : lds_byte(wc * 32 + fr, fq * 8);
#define PG8_SA(b, h) (((b) * 2 + (h)) * HTB)
#define PG8_SB(b, h) ((4 + (b) * 2 + (h)) * HTB)
#define PG8_STAGE(bufoff, gbase, voff) do { _Pragma("unroll") for (int _i = 0; _i < 2; ++_i) \
        __builtin_amdgcn_global_load_lds((const unsigned*)((const char*)(gbase) + (voff)[_i]), (LAS unsigned*)(lds + (bufoff) + ldsw + _i * 8192), 16, 0, 0); } while (0)
#define PG8_LD8(p_) __builtin_shufflevector(*(const LAS v4i_t*)(p_), *(const LAS v4i_t*)((p_) + 16), 0, 1, 2, 3, 4, 5, 6, 7)
#define PG8_LDA(dst, b, h) do { if constexpr (FP8) { _Pragma("unroll") for (int m = 0; m < 4; ++m) dst##8[m] = PG8_LD8(lds + PG8_SA(b, h) + aoff + m * 2048); } \
        else { _Pragma("unroll") for (int m = 0; m < 4; ++m) _Pragma("unroll") for (int k = 0; k < 2; ++k) dst[m][k] = *(const LAS bf16x8*)(lds + PG8_SA(b, h) + aoff + m * 2048 + k * 1024); } } while (0)
#define PG8_LDB(dst, b, h) do { if constexpr (FP8) { _Pragma("unroll") for (int n = 0; n < 2; ++n) dst##8[n] = PG8_LD8(lds + PG8_SB(b, h) + boff + n * 2048); } \
        else { _Pragma("unroll") for (int n = 0; n < 2; ++n) _Pragma("unroll") for (int k = 0; k < 2; ++k) dst[n][k] = *(const LAS bf16x8*)(lds + PG8_SB(b, h) + boff + n * 2048 + k * 1024); } } while (0)
#define PG8_MMA(ai, bj, At, Bt) do { __builtin_amdgcn_s_setprio(1); \
        if constexpr (FP8) { _Pragma("unroll") for (int m = 0; m < 4; ++m) _Pragma("unroll") for (int n = 0; n < 2; ++n) \
            asm volatile("v_mfma_scale_f32_16x16x128_f8f6f4 %0, %1, %2, %0, %3, %3 op_sel_hi:[0,0,0]" : "+v"(acc[ai][bj][m][n]) : "v"(Bt##8[n]), "v"(At##8[m]), "v"(sc127)); } \
        else { _Pragma("unroll") for (int m = 0; m < 4; ++m) _Pragma("unroll") for (int n = 0; n < 2; ++n) _Pragma("unroll") for (int k = 0; k < 2; ++k) \
            acc[ai][bj][m][n] = __builtin_amdgcn_mfma_f32_16x16x32_bf16(Bt[n][k], At[m][k], acc[ai][bj][m][n], 0, 0, 0); } \
        __builtin_amdgcn_s_setprio(0); } while (0)
#define PG8_WAIT_V(n) asm volatile("s_waitcnt vmcnt(" #n ")" ::: "memory")
#define PG8_WAIT_L(n) asm volatile("s_waitcnt lgkmcnt(" #n ")" ::: "memory")
#define PG8_BAR __builtin_amdgcn_s_barrier()
#define PG8_SCHED __builtin_amdgcn_sched_barrier(0)
    Unit cur, nxt; int ui = 0;
    if (!S.next(0, cur)) return;
    Acc acc;
#pragma unroll
    for (int a = 0; a < 2; ++a)
#pragma unroll
        for (int b = 0; b < 2; ++b)
#pragma unroll
            for (int m = 0; m < 4; ++m)
#pragma unroll
                for (int n = 0; n < 2; ++n) { acc[a][b][m][n] = (f32x4){0.f, 0.f, 0.f, 0.f}; if constexpr (FP8) asm volatile("" : "+v"(acc[a][b][m][n])); }
    bf16x8 At[4][2], B0[2][2], B1[2][2];
    v8i_t At8[4], B08[2], B18[2];
    const int sc127 = 0x7f7f7f7f;
    unsigned vA0[2], vA1[2];
#define PG8_SET_VOFF(u) do { if constexpr (GATHER) { _Pragma("unroll") for (int _i = 0; _i < 2; ++_i) { \
                int _R, _C; stage_rc(tid * 16 + _i * 8192, _R, _C); const int _r0 = _R, _r1 = HALF + _R; \
                const int _t0 = _r0 < (u).gn ? g.gidx[(u).ga + _r0] : 0, _t1 = _r1 < (u).gn ? g.gidx[(u).ga + _r1] : 0; \
                vA0[_i] = (unsigned)(_t0 * K + _C) * 2u; vA1[_i] = (unsigned)(_t1 * K + _C) * 2u; } \
        } else { vA0[0] = voffA[0]; vA0[1] = voffA[1]; vA1[0] = voffA[0] + (unsigned)hstep; vA1[1] = voffA[1] + (unsigned)hstep; } } while (0)
    PG8_SET_VOFF(cur);
    const char* cA = GATHER ? (const char*)g.A : (const char*)g.A + (size_t)cur.pm * tstep; const char* cB = (const char*)g.Bt + (size_t)cur.pn * tstep;
    PG8_STAGE(PG8_SB(0, 0), cB, voffB); PG8_STAGE(PG8_SB(0, 1), cB + hstep, voffB); PG8_STAGE(PG8_SA(0, 0), cA, vA0); PG8_STAGE(PG8_SA(0, 1), cA, vA1);
    if (wr == 1) PG8_BAR;
    PG8_WAIT_V(2); PG8_BAR;
    PG8_STAGE(PG8_SB(1, 0), cB + kstep, voffB); PG8_STAGE(PG8_SA(1, 0), cA + kstep, vA0); PG8_STAGE(PG8_SB(1, 1), cB + hstep + kstep, voffB);
    PG8_WAIT_V(6); PG8_BAR;
    for (;;) {
        const bool has_next = S.next(ui + 1, nxt);
        const char* nA = GATHER ? (const char*)g.A : (has_next ? (const char*)g.A + (size_t)nxt.pm * tstep : cA);
        const char* nB = has_next ? (const char*)g.Bt + (size_t)nxt.pn * tstep : cB;
#define PG8_KTRIP(t) do { \
            const bool last = (t == nt - 2); \
            const char* a1 = cA + (size_t)(t + 1) * kstep; \
            const char* a2 = last ? nA : cA + (size_t)(t + 2) * kstep; const char* b2 = last ? nB : cB + (size_t)(t + 2) * kstep; \
            const char* a3 = a2 + kstep; const char* b3 = b2 + kstep; \
            PG8_LDB(B0, 0, 0); PG8_LDB(B1, 0, 1); PG8_SCHED; PG8_LDA(At, 0, 0); PG8_STAGE(PG8_SA(1, 1), a1, vA1); \
            PG8_WAIT_V(8); PG8_WAIT_L(0); PG8_BAR; PG8_MMA(0, 0, At, B0); PG8_MMA(0, 1, At, B1); PG8_BAR; PG8_SCHED; \
            if constexpr (GATHER) { if (last && has_next) PG8_SET_VOFF(nxt); } \
            PG8_LDA(At, 0, 1); PG8_STAGE(PG8_SB(0, 0), b2, voffB); PG8_STAGE(PG8_SB(0, 1), b2 + hstep, voffB); PG8_STAGE(PG8_SA(0, 0), a2, vA0); \
            PG8_WAIT_V(8); PG8_WAIT_L(0); PG8_BAR; PG8_MMA(1, 0, At, B0); PG8_MMA(1, 1, At, B1); PG8_BAR; PG8_SCHED; \
            PG8_LDB(B0, 1, 0); PG8_LDB(B1, 1, 1); PG8_SCHED; PG8_LDA(At, 1, 0); PG8_STAGE(PG8_SA(0, 1), a2, vA1); \
            PG8_WAIT_V(8); PG8_WAIT_L(0); PG8_BAR; PG8_MMA(0, 0, At, B0); PG8_MMA(0, 1, At, B1); PG8_BAR; PG8_SCHED; \
            PG8_LDA(At, 1, 1); PG8_STAGE(PG8_SB(1, 0), b3, voffB); PG8_STAGE(PG8_SB(1, 1), b3 + hstep, voffB); PG8_STAGE(PG8_SA(1, 0), a3, vA0); \
            PG8_WAIT_V(8); PG8_WAIT_L(0); PG8_BAR; PG8_MMA(1, 0, At, B0); PG8_MMA(1, 1, At, B1); PG8_BAR; PG8_SCHED; \
        } while (0)
        if constexpr (Epi::HAS_MID) {
            for (int t = 0; t < (nt >> 1); t += 2) PG8_KTRIP(t);
            E.mid(acc, cur, wr, wc, fr, fq);
            for (int t = (nt >> 1); t < nt; t += 2) PG8_KTRIP(t);
        } else {
            for (int t = 0; t < nt; t += 2) PG8_KTRIP(t);
        }
#undef PG8_KTRIP
        if constexpr (ALIGN_EPI) { if (wr == 0) PG8_BAR; }
        if constexpr (FP8) asm volatile("s_nop 15\n\ts_nop 15" ::: "memory");
        E(acc, cur, wr, wc, fr, fq);
#if defined(DBL) && DBL == 20
        E(acc, cur, wr, wc, fr, fq);
#endif
        if (!has_next) break;
#pragma unroll
        for (int a = 0; a < 2; ++a)
#pragma unroll
            for (int b = 0; b < 2; ++b)
#pragma unroll
                for (int m = 0; m < 4; ++m)
#pragma unroll
                    for (int n = 0; n < 2; ++n) { acc[a][b][m][n] = (f32x4){0.f, 0.f, 0.f, 0.f}; if constexpr (FP8) asm volatile("" : "+v"(acc[a][b][m][n])); }
        cur = nxt; cA = nA; cB = nB; ++ui;
        if constexpr (ALIGN_EPI) { if (wr == 1) PG8_BAR; }
    }
    PG8_WAIT_V(0);
    if constexpr (!ALIGN_EPI) { if (wr == 0) PG8_BAR; }
    PG8_BAR;
#undef PG8_SET_VOFF
#undef PG8_SA
#undef PG8_SB
#undef PG8_STAGE
#undef PG8_LDA
#undef PG8_LD8
#undef PG8_LDB
#undef PG8_MMA
#undef PG8_WAIT_V
#undef PG8_WAIT_L
#undef PG8_BAR
#undef PG8_SCHED
}

struct EpiStore {
    static constexpr bool HAS_MID = false;
    bf16_t* O; int ldc; int ntn;
    DI void operator()(const Acc& acc, const Unit& u, int wr, int wc, int fr, int fq) const {
        const int row0 = u.pm * BM + wr * 64 + fr, col0 = (u.pn % ntn) * BM + wc * 32 + 8 * fq;
#pragma unroll
        for (int ai = 0; ai < 2; ++ai)
#pragma unroll
            for (int m = 0; m < 4; ++m) { bf16_t* rowp = O + (size_t)(row0 + ai * HALF + m * 16) * ldc + col0;
#pragma unroll
                for (int bj = 0; bj < 2; ++bj) { const f32x4 v0 = acc[ai][bj][m][0], v1 = acc[ai][bj][m][1];
                    u32x4 w; w.x = cvtpk(v0[0], v0[1]); w.y = cvtpk(v0[2], v0[3]); w.z = cvtpk(v1[0], v1[1]); w.w = cvtpk(v1[2], v1[3]);
                    *(u32x4*)(rowp + bj * HALF) = w; } }
    }
};
struct EpiProj {
    static constexpr bool HAS_MID = false;
    bf16_t* O; u32x4* GF;
    DI void operator()(const Acc& acc, const Unit& u, int wr, int wc, int fr, int fq) const {
        if (u.pn < 28) {
            const int row0 = u.pm * BM + wr * 64 + fr, col0 = u.pn * BM + wc * 32 + 8 * fq;
#pragma unroll
            for (int ai = 0; ai < 2; ++ai)
#pragma unroll
                for (int m = 0; m < 4; ++m) { bf16_t* rowp = O + (size_t)(row0 + ai * HALF + m * 16) * PP + col0;
#pragma unroll
                    for (int bj = 0; bj < 2; ++bj) { const f32x4 v0 = acc[ai][bj][m][0], v1 = acc[ai][bj][m][1];
                        u32x4 w; w.x = cvtpk(v0[0], v0[1]); w.y = cvtpk(v0[2], v0[3]); w.z = cvtpk(v1[0], v1[1]); w.w = cvtpk(v1[2], v1[3]);
                        *(u32x4*)(rowp + bj * HALF) = w; } }
        } else {
            const int pl = u.pn - 28, which = pl >> 3, pnl = pl & 7, wave = wr * 4 + wc, lane = fq * 16 + fr;
            u32x4* base = GF + ((size_t)(which * 512 + u.pm * 8 + pnl) * 8 + wave) * 16 * 64 + lane;
#pragma unroll
            for (int ai = 0; ai < 2; ++ai)
#pragma unroll
                for (int m = 0; m < 4; ++m)
#pragma unroll
                    for (int bj = 0; bj < 2; ++bj) { const f32x4 v0 = acc[ai][bj][m][0], v1 = acc[ai][bj][m][1];
                        u32x4 w; w.x = cvtpk(sigmoidf_(v0[0]), sigmoidf_(v0[1])); w.y = cvtpk(sigmoidf_(v0[2]), sigmoidf_(v0[3])); w.z = cvtpk(sigmoidf_(v1[0]), sigmoidf_(v1[1])); w.w = cvtpk(sigmoidf_(v1[2]), sigmoidf_(v1[3]));
                        base[((ai * 4 + m) * 2 + bj) * 64] = w; }
        }
    }
};
struct EpiMerged {
    static constexpr bool HAS_MID = true;
    const u32x4* GF; bf16_t* O;
    DI void mid(Acc& acc, const Unit& u, int wr, int wc, int fr, int fq) const {
        const u32x4* ga = GF + ((size_t)(u.pm * 8 + u.pn) * 8 + (wr * 4 + wc)) * 16 * 64 + (fq * 16 + fr); const u32x4* gb = ga + (size_t)512 * 8 * 16 * 64;
#pragma unroll
        for (int ai = 0; ai < 2; ++ai)
#pragma unroll
            for (int m = 0; m < 4; ++m) {
#pragma unroll
                for (int bj = 0; bj < 2; ++bj) { const u32x4 a = ga[((ai * 4 + m) * 2 + bj) * 64], b = gb[((ai * 4 + m) * 2 + bj) * 64];
                    const float sa[8] = {bflo(a.x), bfhi(a.x), bflo(a.y), bfhi(a.y), bflo(a.z), bfhi(a.z), bflo(a.w), bfhi(a.w)};
                    const float sb[8] = {bflo(b.x), bfhi(b.x), bflo(b.y), bfhi(b.y), bflo(b.z), bfhi(b.z), bflo(b.w), bfhi(b.w)};
#pragma unroll
                    for (int n = 0; n < 2; ++n)
#pragma unroll
                        for (int j = 0; j < 4; ++j) acc[ai][bj][m][n][j] *= sa[4 * n + j] * __builtin_amdgcn_rcpf(sb[4 * n + j]); }
                asm volatile("" ::: "memory"); __builtin_amdgcn_sched_barrier(0); }
    }
    DI void operator()(const Acc& acc, const Unit& u, int wr, int wc, int fr, int fq) const {
        const u32x4* gb = GF + ((size_t)(512 + u.pm * 8 + u.pn) * 8 + (wr * 4 + wc)) * 16 * 64 + (fq * 16 + fr);
        const unsigned oo = (unsigned)((u.pm * BM + wr * 64 + fr) * DM + u.pn * BM + wc * 32 + 8 * fq);
#pragma unroll
        for (int ai = 0; ai < 2; ++ai)
#pragma unroll
            for (int m = 0; m < 4; ++m) {
#pragma unroll
                for (int bj = 0; bj < 2; ++bj) { const u32x4 b = gb[((ai * 4 + m) * 2 + bj) * 64];
                    const float sb[8] = {bflo(b.x), bfhi(b.x), bflo(b.y), bfhi(b.y), bflo(b.z), bfhi(b.z), bflo(b.w), bfhi(b.w)};
                    float v[8];
#pragma unroll
                    for (int n = 0; n < 2; ++n)
#pragma unroll
                        for (int j = 0; j < 4; ++j) v[4 * n + j] = acc[ai][bj][m][n][j] * sb[4 * n + j];
                    u32x4 w; w.x = cvtpk(v[0], v[1]); w.y = cvtpk(v[2], v[3]); w.z = cvtpk(v[4], v[5]); w.w = cvtpk(v[6], v[7]);
                    *(u32x4*)(O + oo + (unsigned)((ai * HALF + m * 16) * DM + bj * HALF)) = w; }
                asm volatile("" ::: "memory"); __builtin_amdgcn_sched_barrier(0); }
    }
};
struct EpiGU {
    static constexpr bool HAS_MID = false;
    bf16_t* H;
    DI void operator()(const Acc& acc, const Unit& u, int wr, int wc, int fr, int fq) const {
        const int row0 = u.pm * BM + wr * 64 + fr, col0 = (u.pn & 3) * HALF + wc * 32 + 8 * fq;
#pragma unroll
        for (int ai = 0; ai < 2; ++ai)
#pragma unroll
            for (int m = 0; m < 4; ++m) { float v[8];
#pragma unroll
                for (int n = 0; n < 2; ++n)
#pragma unroll
                    for (int j = 0; j < 4; ++j) v[4 * n + j] = siluf_(acc[ai][0][m][n][j]) * acc[ai][1][m][n][j];
                u32x4 w; w.x = cvtpk(v[0], v[1]); w.y = cvtpk(v[2], v[3]); w.z = cvtpk(v[4], v[5]); w.w = cvtpk(v[6], v[7]);
                *(u32x4*)(H + (size_t)(row0 + ai * HALF + m * 16) * FF + col0) = w; }
    }
};
struct EpiGU8 {
    static constexpr bool HAS_MID = false;
    unsigned char* H; float inv, sh;
    DI void operator()(const Acc& acc, const Unit& u, int wr, int wc, int fr, int fq) const {
        const unsigned o0 = (unsigned)((u.pm * BM + wr * 64 + fr) * FF + (u.pn & 3) * HALF + wc * 32 + 8 * fq);
#pragma unroll
        for (int ai = 0; ai < 2; ++ai)
#pragma unroll
            for (int m = 0; m < 4; ++m) { float v[8];
#pragma unroll
                for (int n = 0; n < 2; ++n)
#pragma unroll
                    for (int j = 0; j < 4; ++j) v[4 * n + j] = siluf_(acc[ai][0][m][n][j] * inv) * (acc[ai][1][m][n][j] * inv) * sh;
                *(u32x2*)(H + o0 + (unsigned)((ai * HALF + m * 16) * FF)) = (u32x2){cvt4_fp8(v[0], v[1], v[2], v[3]), cvt4_fp8(v[4], v[5], v[6], v[7])};
                asm volatile("" ::: "memory"); }
    }
};
struct EpiStoreS {
    static constexpr bool HAS_MID = false;
    bf16_t* O; int ldc; int ntn; float inv;
    DI void operator()(const Acc& acc, const Unit& u, int wr, int wc, int fr, int fq) const {
        const unsigned o0 = (unsigned)((u.pm * BM + wr * 64 + fr) * ldc + (u.pn % ntn) * BM + wc * 32 + 8 * fq);
#pragma unroll
        for (int ai = 0; ai < 2; ++ai)
#pragma unroll
            for (int m = 0; m < 4; ++m) {
#pragma unroll
                for (int bj = 0; bj < 2; ++bj) { const f32x4 v0 = acc[ai][bj][m][0] * inv, v1 = acc[ai][bj][m][1] * inv;
                    u32x4 w; w.x = cvtpk(v0[0], v0[1]); w.y = cvtpk(v0[2], v0[3]); w.z = cvtpk(v1[0], v1[1]); w.w = cvtpk(v1[2], v1[3]);
                    *(u32x4*)(O + o0 + (unsigned)((ai * HALF + m * 16) * ldc + bj * HALF)) = w; }
                asm volatile("" ::: "memory"); }
    }
};
}

namespace moba {
constexpr int NW = 8, QBLK = 32, KVBLK = 64, QB = NW * QBLK, D = 128;
constexpr int RS = PP;
constexpr int RSO = DM;
constexpr float SCALE = 0.08838834764831845f;
constexpr float THR = 8.f;
constexpr int SHM_V = KVBLK * D * 2, SHM_K = KVBLK * D * 2;
constexpr int LDS_BYTES = 2 * SHM_V + 2 * SHM_K + NW * 64 * 4;
typedef bf16_t bf16;
#define KSWZ(row, colB) ((row) * 256 + ((colB) ^ (((row) & 7) << 4)))
#define SBAR() __builtin_amdgcn_sched_barrier(0)
DI int v_st(int k, int c) { const int kk = (k & ~0xC) | ((k & 4) << 1) | ((k & 8) >> 1); return ((kk >> 3) * 4 + (c >> 5)) * 512 + ((kk & 7) * 32 + (c & 31)) * 2; }
DI int v_rd_base(int lane) { return ((lane & 3) << 3) | (((lane >> 2) & 3) << 6) | (((lane >> 4) & 1) << 5) | (((lane >> 5) & 1) << 8); }
constexpr int v_rd_off(int d0, int ks, int half) { return d0 * 512 + ks * 4096 + half * 2048; }
DI bf16x8 load8(const bf16* p) { return *reinterpret_cast<const bf16x8*>(p); }
DI void mask_tile(f32x16& p0, f32x16& p1, int dq) {
    const float NEG = -__builtin_inff();
#pragma unroll
    for (int r = 0; r < 16; ++r) {
        const int c = (r & 3) + 8 * (r >> 2);
        if (dq - c < 0) p0[r] = NEG;
        if (dq - c - 32 < 0) p1[r] = NEG;
    }
}
DI void mask_all(f32x16& p0, f32x16& p1, bool kill) {
    const float NEG = -__builtin_inff();
#pragma unroll
    for (int r = 0; r < 16; ++r) { if (kill) p0[r] = NEG; if (kill) p1[r] = NEG; }
}
DI void partialSM(f32x16& p0, f32x16& p1, float& m_reg, float& mn, float& alpha) {
    float pmax = p0[0];
#pragma unroll
    for (int r = 1; r < 16; ++r) pmax = fmaxf(pmax, p0[r]);
#pragma unroll
    for (int r = 0; r < 16; ++r) pmax = fmaxf(pmax, p1[r]);
    { auto rr = __builtin_amdgcn_permlane32_swap(__float_as_uint(pmax), __float_as_uint(pmax), false, false);
      pmax = fmaxf(__uint_as_float(rr[0]), __uint_as_float(rr[1])); }
    constexpr float C2 = 1.4426950408889634f * SCALE;
    if (__builtin_expect(__all((pmax - m_reg) * SCALE <= THR), 1)) { mn = m_reg; alpha = 1.f; }
    else { mn = fmaxf(m_reg, pmax); alpha = __builtin_amdgcn_exp2f((m_reg - mn) * C2); m_reg = mn; }
    const float mnL = -mn * C2;
#pragma unroll
    for (int r = 0; r < 16; ++r) p0[r] = fmaf(p0[r], C2, mnL);
#pragma unroll
    for (int r = 0; r < 16; ++r) p1[r] = fmaf(p1[r], C2, mnL);
#pragma unroll
    for (int r = 0; r < 16; ++r) p0[r] = __builtin_amdgcn_exp2f(p0[r]);
}
DI void finishSM(f32x16& p0, f32x16& p1, float alpha, float& l_reg, bf16x8& pa0, bf16x8& pa1, bf16x8& pa2, bf16x8& pa3) {
#pragma unroll
    for (int r = 0; r < 16; ++r) p1[r] = __builtin_amdgcn_exp2f(p1[r]);
    float ps = 0;
#pragma unroll
    for (int r = 0; r < 16; ++r) ps += p0[r];
#pragma unroll
    for (int r = 0; r < 16; ++r) ps += p1[r];
    { auto rr = __builtin_amdgcn_permlane32_swap(__float_as_uint(ps), __float_as_uint(ps), false, false);
      ps = __uint_as_float(rr[0]) + __uint_as_float(rr[1]); }
    l_reg = l_reg * alpha + ps;
#define PK4(P, B_, OUT) do { unsigned a0 = cvtpk(P[B_+0], P[B_+1]), a1 = cvtpk(P[B_+2], P[B_+3]);                          \
        unsigned b0 = cvtpk(P[B_+4], P[B_+5]), b1 = cvtpk(P[B_+6], P[B_+7]);                                             \
        auto r0 = __builtin_amdgcn_permlane32_swap(a0, b0, false, false); auto r1 = __builtin_amdgcn_permlane32_swap(a1, b1, false, false); \
        u32x4 w = {r0[0], r1[0], r0[1], r1[1]}; OUT = __builtin_bit_cast(bf16x8, w); } while (0)
    PK4(p0, 0, pa0); PK4(p0, 8, pa1); PK4(p1, 0, pa2); PK4(p1, 8, pa3);
#undef PK4
}
template <int KB>
DI void qkt(f32x16& p0, f32x16& p1, const char* K_lds, int r32, int hi, const bf16x8* qr) {
    p0 = f32x16{}; p1 = f32x16{};
    const char* kb[4];
#pragma unroll
    for (int dd = 0; dd < 4; ++dd) kb[dd] = K_lds + KB * SHM_K + KSWZ(r32, (dd * 16 + hi * 8) * 2);
#pragma unroll
    for (int d0 = 0; d0 < 8; ++d0) { const char* a = kb[d0 & 3] + (d0 >> 2) * 128;
        bf16x8 b0 = *reinterpret_cast<const bf16x8*>(a);
        bf16x8 b1 = *reinterpret_cast<const bf16x8*>(a + 32 * 256);
        p0 = MFMA32(b0, qr[d0], p0);
        p1 = MFMA32(b1, qr[d0], p1); }
}
template <int VB>
DI void pv_tile(f32x16* o, int vb0, bf16x8 pa0, bf16x8 pa1, bf16x8 pa2, bf16x8 pa3) {
#define TRRD(dst, off) asm volatile("ds_read_b64_tr_b16 %0, %1 offset:%2" : "=&v"(dst) : "v"(vb0), "i"(off) : "memory")
#define PV_D0(d0) do { s16x4 l0, l1, l2, l3, h0, h1, h2, h3; constexpr int b_ = VB * SHM_V + v_rd_off(d0, 0, 0); \
        TRRD(l0, b_); TRRD(h0, b_ + 2048); TRRD(l1, b_ + 4096); TRRD(h1, b_ + 6144); TRRD(l2, b_ + 8192); TRRD(h2, b_ + 10240); TRRD(l3, b_ + 12288); TRRD(h3, b_ + 14336); \
        asm volatile("s_waitcnt lgkmcnt(0)" ::: "memory"); SBAR();   \
        o[d0] = MFMA32(pa0, ((bf16x8){l0[0], l0[1], l0[2], l0[3], h0[0], h0[1], h0[2], h0[3]}), o[d0]);   \
        o[d0] = MFMA32(pa1, ((bf16x8){l1[0], l1[1], l1[2], l1[3], h1[0], h1[1], h1[2], h1[3]}), o[d0]);   \
        o[d0] = MFMA32(pa2, ((bf16x8){l2[0], l2[1], l2[2], l2[3], h2[0], h2[1], h2[2], h2[3]}), o[d0]);   \
        o[d0] = MFMA32(pa3, ((bf16x8){l3[0], l3[1], l3[2], l3[3], h3[0], h3[1], h3[2], h3[3]}), o[d0]); } while (0)
    PV_D0(0); PV_D0(1); PV_D0(2); PV_D0(3);
#undef PV_D0
#undef TRRD
}

struct BlockRef { const bf16* Q; const bf16* K; const bf16* V; bf16* O; const bf16* KM; int P0; };
struct Seam { bf16x8 qr[8]; bf16x8 st_v0, st_v1, st_k0, st_k1; };
#define VMW() asm volatile("s_waitcnt vmcnt(0)" ::: "memory")
#define VMWN(n) asm volatile("s_waitcnt vmcnt(%0)" :: "i"(n) : "memory")
#define SLOAD_H(Kp, Vp, k0) do { const bf16* kb__ = (Kp) + (size_t)(k0) * RS; const bf16* vb__ = (Vp) + (size_t)(k0) * RS;              \
                         S.st_v0 = load8(vb__ + goff); S.st_v1 = load8(vb__ + 32 * RS + goff);              \
                         S.st_k0 = load8(kb__ + goff); S.st_k1 = load8(kb__ + 32 * RS + goff); } while (0)
#define SWRITE_HK(bf) do { *(bf16x8*)(K_lds + (bf) * SHM_K + kws) = S.st_k0; *(bf16x8*)(K_lds + (bf) * SHM_K + kws + 32 * 256) = S.st_k1; } while (0)
#define SWRITE_HV(bf) do { *(bf16x8*)(V_lds + (bf) * SHM_V + vst0) = S.st_v0; *(bf16x8*)(V_lds + (bf) * SHM_V + vst1) = S.st_v1; } while (0)
#define SWRITE_H(bf) do { SWRITE_HV(bf); SWRITE_HK(bf); } while (0)
DI void prime(const BlockRef& cur, char* lds, Seam& S) {
    const int tid = threadIdx.x, wid = __builtin_amdgcn_readfirstlane(tid >> 6), lane = tid & 63, r32 = lane & 31, hi = lane >> 5;
    const int sr = tid >> 4, sc = (tid & 15) * 8, kws = KSWZ(sr, sc * 2); char* K_lds = lds + 2 * SHM_V;
    const unsigned goff = (unsigned)(sr * RS + sc), qoff = (unsigned)(r32 * RS + hi * 8);
    { const bf16* qb__ = cur.Q + (size_t)(wid * QBLK) * RS;
#pragma unroll
    for (int d0 = 0; d0 < 8; ++d0) S.qr[d0] = load8(qb__ + qoff + d0 * 16); }
    SLOAD_H(cur.K, cur.V, 0); VMW(); SWRITE_HK(0);
    __syncthreads();
}
DI void block(const BlockRef& cur, const BlockRef& nxt, char* lds, Seam& S) {
    int tid_ = threadIdx.x; asm volatile("" : "+v"(tid_));
    const int tid = tid_, wid = __builtin_amdgcn_readfirstlane(tid >> 6), lane = tid & 63, r32 = lane & 31, hi = lane >> 5;
    const int NT = (cur.P0 + QB) / KVBLK;
    const int qb = cur.P0 / QB;
    const int qlo = cur.P0 + wid * QBLK, qm = qlo + r32 - 4 * hi;
    char* V_lds = lds; char* K_lds = lds + 2 * SHM_V;
    float* ws = (float*)(lds + 2 * SHM_V + 2 * SHM_K) + wid * 64; float* li_l = ws, * al_l = ws + 32;
    unsigned selmask = (1u << qb) - 1u;
    if (qb > 3) {
        f32x16 g0 = f32x16{};
#pragma unroll
        for (int d0 = 0; d0 < 8; ++d0) {
            bf16x8 a = (bf16x8){0, 0, 0, 0, 0, 0, 0, 0};
            if (r32 < 8) a = load8(cur.KM + r32 * D + d0 * 16 + hi * 8);
            g0 = MFMA32(a, S.qr[d0], g0);
        }
        float gt[8];
#pragma unroll
        for (int j = 0; j < 4; ++j) { const float mine = g0[j], oth = __shfl_xor(mine, 32); gt[j] = hi ? oth : mine; gt[4 + j] = hi ? mine : oth; }
        selmask = 0u;
#pragma unroll
        for (int i = 0; i < 8; ++i) { int rank = 0;
#pragma unroll
            for (int j = 0; j < 8; ++j) { if (j != i) { const bool beats = (gt[j] > gt[i]) || (gt[j] == gt[i] && j < i); rank += (j < qb && beats) ? 1 : 0; } }
            if (i < qb && rank < 3) selmask |= (1u << i); }
    }
    float m_reg = -1e30f, l_reg = 0; f32x16 o[4] = {};
    const int sr = tid >> 4, sc = (tid & 15) * 8, vst0 = v_st(sr, sc), vst1 = v_st(32 + sr, sc), kws = KSWZ(sr, sc * 2);
    const unsigned goff = (unsigned)(sr * RS + sc), qoff = (unsigned)(r32 * RS + hi * 8);
    const int vb0 = (int)(uintptr_t)V_lds + v_rd_base(lane);
    const bf16* Kh = cur.K; const bf16* Vh = cur.V;
#define RESC(a) do { if (__any((a) < 1.f)) { if (hi == 0) al_l[r32] = (a); asm volatile("s_waitcnt lgkmcnt(0)" ::: "memory");              \
                     _Pragma("unroll") for (int d_ = 0; d_ < 4; ++d_) _Pragma("unroll") for (int r = 0; r < 16; ++r) o[d_][r] *= al_l[crow(r, hi)]; } } while (0)
#define KBASE(t) ((t) * KVBLK)
#define MASKT(P0_, P1_, t) do { const int kb_ = KBASE(t); const int kblk_ = (t) >> 2; \
        if (kblk_ < qb) { if (qb > 3) mask_all(P0_, P1_, ((selmask >> kblk_) & 1u) == 0u); } \
        else if (kb_ + KVBLK - 1 > qlo) mask_tile(P0_, P1_, qm - kb_); } while (0)
    constexpr int NQL = 8;
#define SEAM_K0() do { VMWN(NQL); SWRITE_HK(0); SBAR(); } while (0)
    f32x16 pA0, pA1, pB0, pB1; float mnA, mnB, alA, alB; bf16x8 pa0, pa1, pa2, pa3;
    SWRITE_HV(0); SBAR();
    if (NT > 1) { SLOAD_H(Kh, Vh, KBASE(1)); }
    SBAR(); qkt<0>(pA0, pA1, K_lds, r32, hi, S.qr);
    MASKT(pA0, pA1, 0); partialSM(pA0, pA1, m_reg, mnA, alA);
    if (NT > 1) { VMW(); SWRITE_H(1); }
    __syncthreads();
#define HALF_STEP(PX0, PX1, mnX, alX, PY0, PY1, alY, t, KB, VB, SB) do {                                                      \
        SBAR(); qkt<KB>(PX0, PX1, K_lds, r32, hi, S.qr);                                             \
        finishSM(PY0, PY1, alY, l_reg, pa0, pa1, pa2, pa3); SBAR();                                                           \
        if ((t) + 1 < NT) { SLOAD_H(Kh, Vh, KBASE((t) + 1)); SBAR(); }                                               \
        pv_tile<VB>(o, vb0, pa0, pa1, pa2, pa3); MASKT(PX0, PX1, (t)); partialSM(PX0, PX1, m_reg, mnX, alX);                                        \
        __syncthreads();                                                                                                      \
        if ((t) + 1 < NT) { VMW(); SWRITE_H(SB); }                                                                          \
        RESC(alX); __syncthreads(); } while (0)
    for (int t = 1; t + 1 < NT; t += 2) {
        HALF_STEP(pB0, pB1, mnB, alB, pA0, pA1, alA, t, 1, 0, 0);
        HALF_STEP(pA0, pA1, mnA, alA, pB0, pB1, alB, t + 1, 0, 1, 1);
    }
    const bool even = (NT & 1) == 0;
    if (even) { SBAR(); qkt<1>(pB0, pB1, K_lds, r32, hi, S.qr); SBAR(); }
    { SLOAD_H(nxt.K, nxt.V, 0); SBAR();
      const bf16* qb__ = nxt.Q + (size_t)(wid * QBLK) * RS;
#pragma unroll
      for (int d0 = 0; d0 < 8; ++d0) S.qr[d0] = load8(qb__ + qoff + d0 * 16); }
    SBAR();
    finishSM(pA0, pA1, alA, l_reg, pa0, pa1, pa2, pa3); SBAR();
    pv_tile<0>(o, vb0, pa0, pa1, pa2, pa3);
    if (even) { MASKT(pB0, pB1, NT - 1); partialSM(pB0, pB1, m_reg, mnB, alB); __syncthreads(); RESC(alB);
        finishSM(pB0, pB1, alB, l_reg, pa0, pa1, pa2, pa3); SBAR(); pv_tile<1>(o, vb0, pa0, pa1, pa2, pa3); }
    SBAR(); SEAM_K0();
    if (hi == 0) li_l[r32] = l_reg; asm volatile("s_waitcnt lgkmcnt(0)" ::: "memory");
    float rli[16];
#pragma unroll
    for (int r = 0; r < 16; ++r) rli[r] = __builtin_amdgcn_rcpf(li_l[crow(r, hi)]);
    bf16* Ow = cur.O + (size_t)(wid * QBLK) * RSO;
    const unsigned ooff = (unsigned)(4 * hi * RSO + r32);
#pragma unroll
    for (int r = 0; r < 16; ++r) { const int orow0 = (r & 3) + 8 * (r >> 2);
#pragma unroll
        for (int d0 = 0; d0 < 4; ++d0) { const float v = o[d0][r] * rli[r];
            const float vn = __shfl_xor(v, 1);
            if ((r32 & 1) == 0) *(unsigned*)(Ow + ooff + (unsigned)(orow0 * RSO + d0 * 32)) = cvtpk(v, vn); } }
    __syncthreads();
#undef RESC
#undef KBASE
#undef MASKT
#undef SEAM_K0
#undef HALF_STEP
}
#undef VMW
#undef VMWN
#undef SLOAD_H
#undef SWRITE_HK
#undef SWRITE_HV
#undef SWRITE_H
#undef KSWZ
#undef SBAR
}

namespace dn {
#ifndef DBL
#define DBL -1
#endif
#define REPS(k) for (int rep_ = 0; rep_ < ((DBL == (k)) ? 2 : 1); ++rep_)
constexpr int L_QB = 0, L_KB = 17408, L_KT = 34816, L_VT = 53248, L_LM = 71680, L_TB = 89088, L_GV = 107520;
constexpr int RQ = 272, LMS = 68, RT = 144;

struct ConvW { f32x2 w[3][4]; float aexp, dtb; };
DI void prep_consts(const Params& p, int h, ConvW& C, int lane) {
#pragma unroll
    for (int seg = 0; seg < 3; ++seg)
#pragma unroll
        for (int j = 0; j < 4; ++j) C.w[seg][j] = *(const f32x2*)(p.conv_w + j * 3072 + seg * 1024 + h * HD + 2 * lane);
    C.aexp = -expf(p.a_log[h]); C.dtb = p.dt_bias[h];
}
struct Raw { unsigned v[33]; float br, ar; };
DI void prep_load(const Params& p, int item, Raw& R, int lane, int wave) {
    const int bh = item >> 5, n = item & 31, b = bh >> 3, h = bh & 7, i0 = wave * 8, c0 = 2 * lane;
    const bf16_t* PROJ = (const bf16_t*)(p.ws + WS_B);
#pragma unroll
    for (int seg = 0; seg < 3; ++seg)
#pragma unroll
        for (int jj = 0; jj < 11; ++jj) {
            const int sp = n * 64 + i0 - 3 + jj;
            unsigned v = 0u;
            if (sp >= 0) v = *(const unsigned*)(PROJ + (size_t)(b * SEQ + sp) * PP + C_DN + seg * 1024 + h * HD + c0);
            R.v[seg * 11 + jj] = v;
        }
    R.br = 0.f; R.ar = 0.f;
    if (wave == 0) { const float* BA = (const float*)(p.ws + WS_BA); const size_t t = (size_t)(b * SEQ + n * 64 + lane);
        R.br = BA[t * 16 + h]; R.ar = BA[t * 16 + 8 + h]; }
}
#define DN_BAR() do { asm volatile("s_waitcnt lgkmcnt(0)" ::: "memory"); __builtin_amdgcn_s_barrier(); asm volatile("" ::: "memory"); } while (0)
DI void prep_chunk(const Params& p, LAS unsigned char* lds, int item, int nitem, Raw& R, const ConvW& CW, int tid, int lane, int wave) {
    asm volatile("" : "+v"(tid), "+v"(lane));
    const int bh = item >> 5, n = item & 31, b = bh >> 3, h = bh & 7;
    unsigned char* rec = p.ws + WS_DNP + (size_t)item * DN_STRIDE;
    LAS float* LM = (LAS float*)(lds + L_LM);
    LAS float* GV = (LAS float*)(lds + L_GV);
    REPS(31) {
        const int i0 = wave * 8, c0 = 2 * lane;
#pragma unroll
        for (int seg = 0; seg < 3; ++seg) {
            float w0[4], w1[4];
#pragma unroll
            for (int j = 0; j < 4; ++j) { w0[j] = CW.w[seg][j].x; w1[j] = CW.w[seg][j].y; }
            float r0[11], r1[11];
#pragma unroll
            for (int jj = 0; jj < 11; ++jj) { const unsigned v = R.v[seg * 11 + jj]; r0[jj] = bflo(v); r1[jj] = bfhi(v); }
            float ya[8], yb[8];
#pragma unroll
            for (int i = 0; i < 8; ++i) {
                float y0 = 0.f, y1 = 0.f;
#pragma unroll
                for (int j = 0; j < 4; ++j) { y0 += w0[j] * r0[i + j]; y1 += w1[j] * r1[i + j]; }
                ya[i] = siluf_(y0); yb[i] = siluf_(y1);
            }
            if (seg < 2) {
                float ss[8];
#pragma unroll
                for (int i = 0; i < 8; ++i) ss[i] = ya[i] * ya[i] + yb[i] * yb[i];
#pragma unroll
                for (int o = 1; o < 64; o <<= 1) { float t[8];
#pragma unroll
                    for (int i = 0; i < 8; ++i) t[i] = __shfl_xor(ss[i], o);
#pragma unroll
                    for (int i = 0; i < 8; ++i) ss[i] += t[i]; }
#pragma unroll
                for (int i = 0; i < 8; ++i) { const float rn = (seg == 0 ? SCALE_Q : 1.0f) * rsqrt_(ss[i] + EPS); ya[i] *= rn; yb[i] *= rn;
                    *(LAS unsigned*)(lds + (seg == 0 ? L_QB : L_KB) + (i0 + i) * RQ + c0 * 2) = cvtpk(ya[i], yb[i]); }
            }
            if (seg >= 1) {
                LAS unsigned char* tb = lds + (seg == 1 ? L_KT : L_VT) + c0 * RT + i0 * 2;
                u32x4 o0, o1;
                o0.x = cvtpk(ya[0], ya[1]); o0.y = cvtpk(ya[2], ya[3]); o0.z = cvtpk(ya[4], ya[5]); o0.w = cvtpk(ya[6], ya[7]);
                o1.x = cvtpk(yb[0], yb[1]); o1.y = cvtpk(yb[2], yb[3]); o1.z = cvtpk(yb[4], yb[5]); o1.w = cvtpk(yb[6], yb[7]);
                *(LAS u32x4*)tb = o0; *(LAS u32x4*)(tb + RT) = o1;
            }
        }
        if (wave == 0) {
            const float br = R.br, ar = R.ar;
            const float beta = sigmoidf_(br);
            const float xs = ar + CW.dtb;
            const float sp = xs > 20.f ? xs : log1pf(expf(xs));
            float g = CW.aexp * sp;
#pragma unroll
            for (int o = 1; o < 64; o <<= 1) { const float u = __shfl_up(g, o); if (lane >= o) g += u; }
            const float g63 = __shfl(g, 63);
            GV[lane] = g; GV[64 + lane] = beta; GV[128 + lane] = expf(g); GV[192 + lane] = expf(g63 - g);
        }
    }
    if (nitem >= 0) prep_load(p, nitem, R, lane, wave);
    DN_BAR();
    REPS(32) {
        const int mt = wave >> 1, nt = wave & 1, r = lane & 31, hi = lane >> 5;
        if (mt < 2) {
            const LAS unsigned char* Ab = lds + L_KB + (32 * nt + r) * RQ, * Bb = lds + L_QB + (32 * mt + r) * RQ;
            f32x16 acc = f32x16{};
#pragma unroll
            for (int ks = 0; ks < 8; ++ks) acc = MFMA32(*(const LAS bf16x8*)(Ab + (16 * ks + 8 * hi) * 2), *(const LAS bf16x8*)(Bb + (16 * ks + 8 * hi) * 2), acc);
            const int i = 32 * mt + r; const float Gi = GV[i];
            float v[16];
#pragma unroll
            for (int q = 0; q < 16; ++q) { const int j = 32 * nt + crow(q, hi); v[q] = i >= j ? acc[q] * __expf(Gi - GV[j]) : 0.f; }
            u32x4* QKf = (u32x4*)(rec + DN_QK) + ((mt * 4 + 2 * nt) * 64 + lane);
            u32x4 o0, o1;
            o0.x = cvtpk(v[0], v[1]); o0.y = cvtpk(v[2], v[3]); o0.z = cvtpk(v[4], v[5]); o0.w = cvtpk(v[6], v[7]);
            o1.x = cvtpk(v[8], v[9]); o1.y = cvtpk(v[10], v[11]); o1.z = cvtpk(v[12], v[13]); o1.w = cvtpk(v[14], v[15]);
            QKf[0] = o0; QKf[64] = o1;
        } else {
            const LAS unsigned char* Ab = lds + L_KB + (32 * (mt - 2) + r) * RQ, * Bb = lds + L_KB + (32 * nt + r) * RQ;
            f32x16 acc = f32x16{};
#pragma unroll
            for (int ks = 0; ks < 8; ++ks) acc = MFMA32(*(const LAS bf16x8*)(Ab + (16 * ks + 8 * hi) * 2), *(const LAS bf16x8*)(Bb + (16 * ks + 8 * hi) * 2), acc);
            const int j = 32 * nt + r; const float Gj = GV[j];
#pragma unroll
            for (int q = 0; q < 16; ++q) { const int row = 32 * (mt - 2) + crow(q, hi);
                const float e = row > j ? GV[64 + row] * __expf(GV[row] - Gj) : 0.f;
                LM[row * LMS + j] = acc[q] * e; }
        }
    }
    DN_BAR();
    REPS(33) {
        float Lr[64];
#pragma unroll
        for (int jq = 0; jq < 16; ++jq) { const f32x4 l = *(const LAS f32x4*)(LM + lane * LMS + 4 * jq); Lr[4 * jq] = l.x; Lr[4 * jq + 1] = l.y; Lr[4 * jq + 2] = l.z; Lr[4 * jq + 3] = l.w; }
        float xv[8];
#pragma unroll
        for (int q = 0; q < 8; ++q) xv[q] = (lane == 8 * wave + q) ? 1.0f : 0.0f;
#pragma unroll
        for (int j = 0; j < 63; ++j) {
#pragma unroll
            for (int q = 0; q < 8; ++q) { const float xj = __int_as_float(__builtin_amdgcn_readlane(__float_as_int(xv[q]), j)); xv[q] -= Lr[j] * xj; }
        }
        float t1[8], t2[8];
#pragma unroll
        for (int q = 0; q < 8; ++q) { const float bc = GV[64 + 8 * wave + q]; t1[q] = xv[q] * bc; t2[q] = t1[q] * GV[128 + 8 * wave + q]; }
        u32x4 o1, o2;
        o1.x = cvtpk(t1[0], t1[1]); o1.y = cvtpk(t1[2], t1[3]); o1.z = cvtpk(t1[4], t1[5]); o1.w = cvtpk(t1[6], t1[7]);
        o2.x = cvtpk(t2[0], t2[1]); o2.y = cvtpk(t2[2], t2[3]); o2.z = cvtpk(t2[4], t2[5]); o2.w = cvtpk(t2[6], t2[7]);
        *(LAS u32x4*)(lds + L_TB + lane * RT + wave * 16) = o1; *(LAS u32x4*)(lds + L_TB + 64 * RT + lane * RT + wave * 16) = o2;
    }
    DN_BAR();
    REPS(34) {
        const int r = lane & 31, hi = lane >> 5;
#pragma unroll
        for (int half = 0; half < 2; ++half) {
            const int tix = wave * 2 + half;
            f32x16 acc = f32x16{};
            if (tix < 8) {
                const int mt = tix >> 2, nt = tix & 3;
                const LAS unsigned char* Ab = lds + L_TB + (32 * mt + r) * RT + 16 * hi, * Bb = lds + L_VT + (32 * nt + r) * RT + 16 * hi;
#pragma unroll
                for (int ks = 0; ks < 4; ++ks) acc = MFMA32(*(const LAS bf16x8*)(Ab + 32 * ks), *(const LAS bf16x8*)(Bb + 32 * ks), acc);
                u32x4* Uf = (u32x4*)(rec + DN_U) + ((mt * 4 + nt) * 64 + lane) * 2;
                u32x4 o0, o1;
                o0.x = cvtpk(acc[0], acc[1]); o0.y = cvtpk(acc[2], acc[3]); o0.z = cvtpk(acc[4], acc[5]); o0.w = cvtpk(acc[6], acc[7]);
                o1.x = cvtpk(acc[8], acc[9]); o1.y = cvtpk(acc[10], acc[11]); o1.z = cvtpk(acc[12], acc[13]); o1.w = cvtpk(acc[14], acc[15]);
                Uf[0] = o0; Uf[1] = o1;
            } else {
                const int ntp = (tix - 8) >> 1, mt = tix & 1;
                const LAS unsigned char* Ab = lds + L_KT + (32 * ntp + r) * RT + 16 * hi, * Bb = lds + L_TB + 64 * RT + (32 * mt + r) * RT + 16 * hi;
#pragma unroll
                for (int ks = 0; ks < 4; ++ks) acc = MFMA32(*(const LAS bf16x8*)(Ab + 32 * ks), *(const LAS bf16x8*)(Bb + 32 * ks), acc);
                u32x4* Wf = (u32x4*)(rec + DN_W) + ((mt * 8 + 2 * ntp) * 64 + lane);
                u32x4 o0, o1;
                o0.x = cvtpk(-acc[0], -acc[1]); o0.y = cvtpk(-acc[2], -acc[3]); o0.z = cvtpk(-acc[4], -acc[5]); o0.w = cvtpk(-acc[6], -acc[7]);
                o1.x = cvtpk(-acc[8], -acc[9]); o1.y = cvtpk(-acc[10], -acc[11]); o1.z = cvtpk(-acc[12], -acc[13]); o1.w = cvtpk(-acc[14], -acc[15]);
                Wf[0] = o0; Wf[64] = o1;
            }
        }
#pragma unroll
        for (int rep = 0; rep < 2; ++rep) {
            const int f = tid + 512 * rep, mt = f >> 9, ks = (f >> 6) & 7, fr = f & 31, fh = (f >> 5) & 1, i = 32 * mt + fr;
            const LAS unsigned char* qp = lds + L_QB + i * RQ + (16 * ks + 4 * fh) * 2;
            const u32x2 a = *(const LAS u32x2*)qp, c = *(const LAS u32x2*)(qp + 16);
            const float e = GV[128 + i];
            u32x4 o; o.x = cvtpk(bflo(a.x) * e, bfhi(a.x) * e); o.y = cvtpk(bflo(a.y) * e, bfhi(a.y) * e); o.z = cvtpk(bflo(c.x) * e, bfhi(c.x) * e); o.w = cvtpk(bflo(c.y) * e, bfhi(c.y) * e);
            ((u32x4*)(rec + DN_QD))[f] = o;
        }
#pragma unroll
        for (int rep = 0; rep < 2; ++rep) {
            const int f = tid + 512 * rep, a4 = f >> 8, ks = (f >> 6) & 3, fr = f & 31, fh = (f >> 5) & 1, d = 32 * a4 + fr;
            const LAS unsigned char* kp = lds + L_KT + d * RT + (16 * ks + 4 * fh) * 2;
            const u32x2 a = *(const LAS u32x2*)kp, c = *(const LAS u32x2*)(kp + 16);
            const LAS float* eg = GV + 192 + 16 * ks + 4 * fh;
            u32x4 o; o.x = cvtpk(bflo(a.x) * eg[0], bfhi(a.x) * eg[1]); o.y = cvtpk(bflo(a.y) * eg[2], bfhi(a.y) * eg[3]);
            o.z = cvtpk(bflo(c.x) * eg[8], bfhi(c.x) * eg[9]); o.w = cvtpk(bflo(c.y) * eg[10], bfhi(c.y) * eg[11]);
            ((u32x4*)(rec + DN_KT))[f] = o;
        }
        if (tid == 0) *(float*)(rec + DN_SC) = GV[128 + 63];
    }
    DN_BAR();
}

DI bf16x8 pack_step(const f32x16& x, int s) {
    u32x4 w;
    if (s == 0) { w.x = cvtpk(x[0], x[1]); w.y = cvtpk(x[2], x[3]); w.z = cvtpk(x[4], x[5]); w.w = cvtpk(x[6], x[7]); }
    else { w.x = cvtpk(x[8], x[9]); w.y = cvtpk(x[10], x[11]); w.z = cvtpk(x[12], x[13]); w.w = cvtpk(x[14], x[15]); }
    return __builtin_bit_cast(bf16x8, w);
}

constexpr int RB = 57344;
constexpr int ORS = 272, OB = 64 * ORS;
DI void recur(const Params& p, LAS unsigned char* lds, int bh, int tid, int lane, int wave) {
    asm volatile("" : "+v"(tid), "+v"(lane));
    const int r = lane & 31, hi = lane >> 5, b = bh >> 3, h = bh & 7;
    const unsigned char* rec0 = p.ws + WS_DNP + (size_t)(bh * 32) * DN_STRIDE;
    if (wave >= 4) {
        const int lt = tid - 256;
        const int fg = lt & 7, fr2 = lt >> 3;
        const bf16_t* PROJ = (const bf16_t*)(p.ws + WS_B); bf16_t* YAB = (bf16_t*)(p.ws + WS_A);
        f32x4 g4[4];
#pragma unroll
        for (int j = 0; j < 4; ++j) g4[j] = *(const f32x4*)(p.dn_gain + fg * 16 + 4 * j);
        const bf16_t* zb = PROJ + (size_t)(b * SEQ) * PP + C_Z + h * HD + fg * 16; bf16_t* yb = YAB + (size_t)(b * SEQ) * DM + 1024 + h * HD + fg * 16;
        u32x4 zr[2][2];
#define DN_ZLOAD(n_) do { _Pragma("unroll") for (int ps = 0; ps < 2; ++ps) { const bf16_t* zp = zb + (size_t)((n_) * 64 + fr2 + 32 * ps) * PP; zr[ps][0] = *(const u32x4*)zp; zr[ps][1] = *(const u32x4*)(zp + 8); } } while (0)
#define DN_FINAL(n_) do { const LAS unsigned char* ob = lds + 2 * RB + ((n_) & 1) * OB; \
        _Pragma("unroll") for (int ps = 0; ps < 2; ++ps) { const int row = fr2 + 32 * ps; \
            const u32x4 o0 = *(const LAS u32x4*)(ob + row * ORS + fg * 32), o1 = *(const LAS u32x4*)(ob + row * ORS + fg * 32 + 16); \
            float ov[16] = {bflo(o0.x), bfhi(o0.x), bflo(o0.y), bfhi(o0.y), bflo(o0.z), bfhi(o0.z), bflo(o0.w), bfhi(o0.w), bflo(o1.x), bfhi(o1.x), bflo(o1.y), bfhi(o1.y), bflo(o1.z), bfhi(o1.z), bflo(o1.w), bfhi(o1.w)}; \
            float ss = 0.f; _Pragma("unroll") for (int e = 0; e < 16; ++e) ss += ov[e] * ov[e]; \
            ss += __shfl_xor(ss, 1); ss += __shfl_xor(ss, 2); ss += __shfl_xor(ss, 4); \
            const float rstd = rsqrt_(ss * (1.0f / HD) + EPS); \
            const u32x4 z0 = zr[ps][0], z1 = zr[ps][1]; \
            const float zz[16] = {bflo(z0.x), bfhi(z0.x), bflo(z0.y), bfhi(z0.y), bflo(z0.z), bfhi(z0.z), bflo(z0.w), bfhi(z0.w), bflo(z1.x), bfhi(z1.x), bflo(z1.y), bfhi(z1.y), bflo(z1.z), bfhi(z1.z), bflo(z1.w), bfhi(z1.w)}; \
            float y[16]; _Pragma("unroll") for (int e = 0; e < 16; ++e) y[e] = ov[e] * rstd * g4[e >> 2][e & 3] * siluf_(zz[e]); \
            u32x4 w0, w1; w0.x = cvtpk(y[0], y[1]); w0.y = cvtpk(y[2], y[3]); w0.z = cvtpk(y[4], y[5]); w0.w = cvtpk(y[6], y[7]); \
            w1.x = cvtpk(y[8], y[9]); w1.y = cvtpk(y[10], y[11]); w1.z = cvtpk(y[12], y[13]); w1.w = cvtpk(y[14], y[15]); \
            bf16_t* yp = yb + (size_t)((n_) * 64 + row) * DM; *(u32x4*)yp = w0; *(u32x4*)(yp + 8) = w1; } } while (0)
        u32x4 va[14], vb[14];
#define DN_LD(V_, n_) do { const u32x4* src_ = (const u32x4*)(rec0 + (size_t)(n_) * DN_STRIDE + DN_W) + lt; _Pragma("unroll") for (int k = 0; k < 14; ++k) V_[k] = src_[k * 256]; } while (0)
#define DN_ST(V_, n_) do { LAS unsigned char* dst_ = lds + ((n_) & 1) * RB; _Pragma("unroll") for (int k = 0; k < 14; ++k) *(LAS u32x4*)(dst_ + (k * 256 + lt) * 16) = V_[k]; } while (0)
        DN_LD(va, 0); DN_LD(vb, 1);
        DN_ST(va, 0);
        DN_LD(va, 2);
        DN_ZLOAD(0);
        DN_BAR();
        for (int n = 0; n < 32; n += 2) {
            DN_ST(vb, n + 1);
            if (n + 3 < 32) DN_LD(vb, n + 3);
            if (n >= 1) { DN_FINAL(n - 1); DN_ZLOAD(n); }
            DN_BAR();
            if (n + 2 < 32) DN_ST(va, n + 2);
            if (n + 4 < 32) DN_LD(va, n + 4);
            DN_FINAL(n); DN_ZLOAD(n + 1);
            DN_BAR();
        }
        DN_FINAL(31);
#undef DN_ZLOAD
#undef DN_FINAL
#undef DN_LD
#undef DN_ST
    } else {
        const int slice = wave, dv0 = slice * 32;
        f32x16 St[4];
#pragma unroll
        for (int a = 0; a < 4; ++a) St[a] = f32x16{};
        const float egv = *(const float*)(rec0 + (size_t)(lane & 31) * DN_STRIDE + DN_SC);
        u32x4 un[2][2];
#pragma unroll
        for (int mt = 0; mt < 2; ++mt) { const u32x4* up = (const u32x4*)(rec0 + DN_U) + ((mt * 4 + slice) * 64 + lane) * 2; un[mt][0] = up[0]; un[mt][1] = up[1]; }
        DN_BAR();
        for (int n = 0; n < 32; ++n) {
            const unsigned char* rec = rec0 + (size_t)n * DN_STRIDE;
            const LAS unsigned char* buf = lds + (n & 1) * RB;
            const float eg = __int_as_float(__builtin_amdgcn_readlane(__float_as_int(egv), n));
            f32x16 Vn[2], O[2];
#pragma unroll
            for (int mt = 0; mt < 2; ++mt) { const u32x4 a = un[mt][0], c = un[mt][1];
                Vn[mt][0] = bflo(a.x); Vn[mt][1] = bfhi(a.x); Vn[mt][2] = bflo(a.y); Vn[mt][3] = bfhi(a.y); Vn[mt][4] = bflo(a.z); Vn[mt][5] = bfhi(a.z); Vn[mt][6] = bflo(a.w); Vn[mt][7] = bfhi(a.w);
                Vn[mt][8] = bflo(c.x); Vn[mt][9] = bfhi(c.x); Vn[mt][10] = bflo(c.y); Vn[mt][11] = bfhi(c.y); Vn[mt][12] = bflo(c.z); Vn[mt][13] = bfhi(c.z); Vn[mt][14] = bflo(c.w); Vn[mt][15] = bfhi(c.w); }
            if (n + 1 < 32) {
#pragma unroll
                for (int mt = 0; mt < 2; ++mt) { const u32x4* up = (const u32x4*)(rec + DN_STRIDE + DN_U) + ((mt * 4 + slice) * 64 + lane) * 2; un[mt][0] = up[0]; un[mt][1] = up[1]; } }
            bf16x8 Sf[8];
#pragma unroll
            for (int a = 0; a < 4; ++a) { Sf[2 * a] = pack_step(St[a], 0); Sf[2 * a + 1] = pack_step(St[a], 1); }
#pragma unroll
            for (int mt = 0; mt < 2; ++mt)
#pragma unroll
                for (int ks = 0; ks < 8; ++ks) Vn[mt] = MFMA32(*(const LAS bf16x8*)(buf + ((mt * 8 + ks) * 64 + lane) * 16), Sf[ks], Vn[mt]);
#pragma unroll
            for (int mt = 0; mt < 2; ++mt) { O[mt] = f32x16{};
#pragma unroll
                for (int ks = 0; ks < 8; ++ks) O[mt] = MFMA32(*(const LAS bf16x8*)(buf + 16384 + ((mt * 8 + ks) * 64 + lane) * 16), Sf[ks], O[mt]); }
            bf16x8 Vf[4];
#pragma unroll
            for (int mt = 0; mt < 2; ++mt) { Vf[2 * mt] = pack_step(Vn[mt], 0); Vf[2 * mt + 1] = pack_step(Vn[mt], 1); }
#pragma unroll
            for (int mt = 0; mt < 2; ++mt)
#pragma unroll
                for (int ks = 0; ks < 4; ++ks) O[mt] = MFMA32(*(const LAS bf16x8*)(buf + 49152 + ((mt * 4 + ks) * 64 + lane) * 16), Vf[ks], O[mt]);
#pragma unroll
            for (int a = 0; a < 4; ++a) {
                St[a] = St[a] * eg;
#pragma unroll
                for (int ks = 0; ks < 4; ++ks) St[a] = MFMA32(*(const LAS bf16x8*)(buf + 32768 + ((a * 4 + ks) * 64 + lane) * 16), Vf[ks], St[a]);
            }
            {   LAS unsigned char* ob = lds + 2 * RB + (n & 1) * OB + (dv0 + r) * 2;
#pragma unroll
                for (int mt = 0; mt < 2; ++mt)
#pragma unroll
                    for (int i = 0; i < 16; ++i) *(LAS bf16_t*)(ob + (32 * mt + crow(i, hi)) * ORS) = f2bf(O[mt][i]);
            }
            DN_BAR();
        }
    }
}
}

DI void transpose_tile(const float* W, int N, int k0, int sn0, bf16_t* WT, int dpitch, int drow0, int dk0, int nvalid, LAS float* scr, int lane) {
    {
        f32x4 v[8];
#pragma unroll
        for (int i = 0; i < 8; ++i) v[i] = *(const f32x4*)(W + (size_t)(k0 + 8 * i + (lane >> 3)) * N + sn0 + 4 * (lane & 7));
#pragma unroll
        for (int i = 0; i < 8; ++i) { LAS float* d = scr + (8 * i + (lane >> 3)) * 33 + 4 * (lane & 7); d[0] = v[i].x; d[1] = v[i].y; d[2] = v[i].z; d[3] = v[i].w; }
    }
    asm volatile("s_waitcnt lgkmcnt(0)" ::: "memory");
    const int c = lane & 7;
#pragma unroll
    for (int j = 0; j < 4; ++j) { const int n = (lane >> 3) + 8 * j; const LAS float* s = scr + (8 * c) * 33 + n;
        u32x4 o; o.x = cvtpk(s[0 * 33], s[1 * 33]); o.y = cvtpk(s[2 * 33], s[3 * 33]); o.z = cvtpk(s[4 * 33], s[5 * 33]); o.w = cvtpk(s[6 * 33], s[7 * 33]);
        if (n < nvalid) *(u32x4*)(WT + (size_t)(drow0 + n) * dpitch + dk0 + k0 + 8 * c) = o; }
    asm volatile("s_waitcnt lgkmcnt(0)" ::: "memory");
}

DI void transpose_tile8(const float* W, int N, int k0, int sn0, unsigned char* WT, int dpitch, int drow0, float sc, LAS float* scr, int lane) {
    {   f32x4 v[8];
#pragma unroll
        for (int i = 0; i < 8; ++i) v[i] = *(const f32x4*)(W + (size_t)(k0 + 8 * i + (lane >> 3)) * N + sn0 + 4 * (lane & 7));
#pragma unroll
        for (int i = 0; i < 8; ++i) { LAS float* d = scr + (8 * i + (lane >> 3)) * 33 + 4 * (lane & 7); d[0] = v[i].x; d[1] = v[i].y; d[2] = v[i].z; d[3] = v[i].w; }
    }
    asm volatile("s_waitcnt lgkmcnt(0)" ::: "memory");
    const int c = lane & 7;
#pragma unroll
    for (int j = 0; j < 4; ++j) { const int n = (lane >> 3) + 8 * j; const LAS float* s = scr + (8 * c) * 33 + n;
        *(u32x2*)(WT + (size_t)(drow0 + n) * dpitch + k0 + 8 * c) = (u32x2){cvt4_fp8(s[0 * 33] * sc, s[1 * 33] * sc, s[2 * 33] * sc, s[3 * 33] * sc), cvt4_fp8(s[4 * 33] * sc, s[5 * 33] * sc, s[6 * 33] * sc, s[7 * 33] * sc)}; }
    asm volatile("s_waitcnt lgkmcnt(0)" ::: "memory");
}

DI void phase0(const Params& p, LAS unsigned char* lds, int tid, int lane, int wave, int bid, int G) {
    float* MOD = (float*)(p.ws + WS_MOD);
#if defined(DBL) && DBL == 0
    __syncthreads();
#endif
    if (bid < 192) {
        LAS float* sc = (LAS float*)lds;
        LAS float* red = (LAS float*)(lds + 65536);
        for (int i = tid; i < 8 * 2048; i += 512) { const int bb = i >> 11, k = i & 2047; sc[k * 8 + bb] = siluf_acc(p.c[i]); }
        __syncthreads();
        const int n0 = bid * 64;
        const int ksub = lane >> 4, cg = lane & 15;
        f32x4 acc[8];
#pragma unroll
        for (int bb = 0; bb < 8; ++bb) acc[bb] = (f32x4){0.f, 0.f, 0.f, 0.f};
        const float* wp = p.w_ada + (size_t)(wave * 256 + ksub) * 12288 + n0 + 4 * cg;
#pragma unroll 8
        for (int it = 0; it < 64; ++it) {
            const f32x4 wv = *(const f32x4*)(wp + (size_t)(4 * it) * 12288);
            const LAS float* sp = sc + (wave * 256 + 4 * it + ksub) * 8;
            const f32x4 s0 = *(const LAS f32x4*)sp, s1 = *(const LAS f32x4*)(sp + 4);
            acc[0] += wv * s0.x; acc[1] += wv * s0.y; acc[2] += wv * s0.z; acc[3] += wv * s0.w;
            acc[4] += wv * s1.x; acc[5] += wv * s1.y; acc[6] += wv * s1.z; acc[7] += wv * s1.w;
        }
#pragma unroll
        for (int bb = 0; bb < 8; ++bb) {
#pragma unroll
            for (int e = 0; e < 4; ++e) { float v = acc[bb][e]; v += __shfl_xor(v, 16); v += __shfl_xor(v, 32); acc[bb][e] = v; }
            if (ksub == 0) *(LAS f32x4*)(red + (wave * 8 + bb) * 64 + 4 * cg) = acc[bb];
        }
        __syncthreads();
        { const int bb = tid >> 6, col = tid & 63; float s = 0.f;
#pragma unroll
          for (int w = 0; w < 8; ++w) s += red[(w * 8 + bb) * 64 + col];
          MOD[bb * 12288 + n0 + col] = s + p.b_ada[n0 + col]; }
        __syncthreads();
    } else {
        f32x2* CS = (f32x2*)(p.ws + WS_CS);
        for (int i = (bid - 192) * 512 + tid; i < T * 16; i += (G - 192) * 512) {
            const int t = i >> 4, f = i & 15;
            const float inv = powf(500000.0f, -(float)f * (2.0f / 32.0f));
            const float ang = (float)p.pos[t] * inv;
            float sn, cs; sincosf(ang, &sn, &cs);
            CS[i] = (f32x2){cs, sn};
        }
    }
    LAS float* scr = (LAS float*)(lds + wave * 8448);
    const int gw = bid * 8 + wave, NGW = G * 8;
    bf16_t* WIN = (bf16_t*)(p.ws + WS_WIN); bf16_t* WMD = (bf16_t*)(p.ws + WS_WMD); bf16_t* WOUT = (bf16_t*)(p.ws + WS_WOUT); bf16_t* WR = (bf16_t*)(p.ws + WS_WR);
    constexpr int I_A = 32 * 224, I_B = 32 * 128, I_C = 32, I_M = 16 * 64, I_O = 32 * 64, I_RG = 32, I_RE = 32;
    constexpr int NITEMS = I_A + I_B + I_C + 2 * I_M + I_O + I_RG + I_RE;
    for (int it = gw; it < NITEMS; it += NGW) {
        int r = it;
        if (r < I_A) { const int kb = r / 224, nb = r % 224; transpose_tile(p.w_in, 11280, 64 * kb, 32 * nb, WIN, DM, 32 * nb, 0, 32, scr, lane); continue; } r -= I_A;
        if (r < I_B) { const int kb = r / 128, nb = r % 128; transpose_tile(p.w_in, 11280, 64 * kb, 7184 + 32 * nb, WIN, DM, 7168 + 32 * nb, 0, 32, scr, lane); continue; } r -= I_B;
        if (r < I_C) { transpose_tile(p.w_in, 11280, 64 * r, 7168, (bf16_t*)(p.ws + WS_WBA), DM, 0, 0, 16, scr, lane); continue; } r -= I_C;
        if (r < I_M) { const int kb = r / 64, nb = r % 64; transpose_tile(p.w_bm, DM, 64 * kb, 32 * nb, WMD, DM, 32 * nb, 0, 32, scr, lane); continue; } r -= I_M;
        if (r < I_M) { const int kb = r / 64, nb = r % 64; transpose_tile(p.w_bd, DM, 64 * kb, 32 * nb, WMD, DM, 32 * nb, 1024, 32, scr, lane); continue; } r -= I_M;
        if (r < I_O) { const int kb = r / 64, nb = r % 64; transpose_tile(p.w_out, DM, 64 * kb, 32 * nb, WOUT, DM, 32 * nb, 0, 32, scr, lane); continue; } r -= I_O;
        if (r < I_RG) {
            const int k = r * 64 + lane;
#pragma unroll
            for (int e = 0; e < 4; ++e) WR[e * DM + k] = f2bf(p.w_rg[k * 4 + e]);
#pragma unroll
            for (int e = 36; e < 48; ++e) WR[e * DM + k] = 0;
            continue; } r -= I_RG;
        { transpose_tile(p.w_re, 32, 64 * r, 0, WR, DM, 4, 0, 32, scr, lane); }
    }
}

DI void phase_u1_item(const Params& p, LAS unsigned char* lds, int item, int tid, int lane, int wave) {
    const float* MOD = (const float*)(p.ws + WS_MOD); bf16_t* U1 = (bf16_t*)(p.ws + WS_A);
    const int tokb = item * 64, b = tokb >> 11;
    f32x4 ga[8], sh[8];
    { const float* shp = MOD + b * 12288; const float* scl = shp + 2048;
#pragma unroll
      for (int j = 0; j < 8; ++j) { const int col = 4 * (lane + 64 * j);
          const f32x4 g = *(const f32x4*)(p.g_mix_pre + col), a = *(const f32x4*)(scl + col); ga[j] = g * (a + 1.0f); sh[j] = *(const f32x4*)(shp + col); } }
    for (int rr = 0; rr < 8; rr += 2) {
        f32x4 v[2][8];
#pragma unroll
        for (int u = 0; u < 2; ++u) { const f32x4* xr = (const f32x4*)(p.x + (size_t)(tokb + wave * 8 + rr + u) * DM) + lane;
#pragma unroll
            for (int j = 0; j < 8; ++j) v[u][j] = xr[64 * j]; }
#pragma unroll
        for (int u = 0; u < 2; ++u) { const int m = tokb + wave * 8 + rr + u; float s = 0.f;
#pragma unroll
            for (int j = 0; j < 8; ++j) s += (v[u][j].x * v[u][j].x + v[u][j].y * v[u][j].y) + (v[u][j].z * v[u][j].z + v[u][j].w * v[u][j].w);
            const float rstd = rsqrt_(wave_sum(s) * (1.0f / DM) + EPS);
            u32x2* o8 = (u32x2*)(U1 + (size_t)m * DM) + lane;
#pragma unroll
            for (int j = 0; j < 8; ++j) { const f32x4 uu = (v[u][j] * rstd) * ga[j] + sh[j]; o8[64 * j] = (u32x2){cvtpk(uu.x, uu.y), cvtpk(uu.z, uu.w)}; } }
    }
    __syncthreads();
    {
        const int tl = lane & 15, kg = lane >> 4, tg = wave & 3, kh = wave >> 2;
        const bf16_t* up = U1 + (size_t)(tokb + tg * 16 + tl) * DM + kh * 1024 + 8 * kg;
        const bf16_t* wp = (const bf16_t*)(p.ws + WS_WBA) + (size_t)tl * DM + kh * 1024 + 8 * kg;
        f32x4 a0 = {0.f, 0.f, 0.f, 0.f}, a1 = a0;
#pragma unroll 8
        for (int s = 0; s < 32; s += 2) {
            a0 = MFMA16(*(const bf16x8*)(wp + 32 * s), *(const bf16x8*)(up + 32 * s), a0);
            a1 = MFMA16(*(const bf16x8*)(wp + 32 * s + 32), *(const bf16x8*)(up + 32 * s + 32), a1);
        }
        a0 = a0 + a1;
        LAS f32x4* ex = (LAS f32x4*)lds + (tg * 64 + lane);
        if (kh == 1) *ex = a0;
        __syncthreads();
        if (kh == 0) { a0 = a0 + *ex;
            *(f32x4*)((float*)(p.ws + WS_BA) + (size_t)(tokb + tg * 16 + tl) * 16 + 4 * kg) = a0; }
        __syncthreads();
    }
}

DI void rotary_item(const Params& p, int item, int lane) {
    const int which = item & 1, h = (item >> 1) & 7, blk = (item >> 4) & 7, b = item >> 7;
    bf16_t* PROJ = (bf16_t*)(p.ws + WS_B);
    const f32x2* CS = (const f32x2*)(p.ws + WS_CS);
    const int tok0 = b * SEQ + blk * 256; const int colb = (which ? C_K : C_Q) + h * HD;
    const int rsub = lane >> 4, i = lane & 15;
    float cs8[8];
#pragma unroll
    for (int e = 0; e < 8; ++e) cs8[e] = 0.f;
    if (which) {
#pragma unroll 16
        for (int it = 0; it < 64; ++it) { const u32x4 v = *(const u32x4*)(PROJ + (size_t)(tok0 + it * 4 + rsub) * PP + colb + 8 * i);
            cs8[0] += bflo(v.x); cs8[1] += bfhi(v.x); cs8[2] += bflo(v.y); cs8[3] += bfhi(v.y); cs8[4] += bflo(v.z); cs8[5] += bfhi(v.z); cs8[6] += bflo(v.w); cs8[7] += bfhi(v.w); }
#pragma unroll
        for (int e = 0; e < 8; ++e) { cs8[e] += __shfl_xor(cs8[e], 16); cs8[e] += __shfl_xor(cs8[e], 32); }
    }
    float a0 = 0.f, a1 = 0.f;
#pragma unroll 16
    for (int it = 0; it < 64; ++it) {
        const int t = tok0 + it * 4 + rsub;
        bf16_t* ptr = PROJ + (size_t)t * PP + colb + i;
        const float x1 = bf2f(ptr[0]), x2 = bf2f(ptr[16]);
        const f32x2 cs = CS[t * 16 + i];
        const unsigned w = cvtpk(x1 * cs.x - x2 * cs.y, x2 * cs.x + x1 * cs.y);
        ptr[0] = (bf16_t)(w & 0xffffu); ptr[16] = (bf16_t)(w >> 16);
        a0 += bflo(w); a1 += bfhi(w);
    }
    if (which) {
        a0 += __shfl_xor(a0, 16); a0 += __shfl_xor(a0, 32); a1 += __shfl_xor(a1, 16); a1 += __shfl_xor(a1, 32);
        bf16_t* KM = (bf16_t*)(p.ws + WS_KMEAN) + ((size_t)(b * 8 + h) * 8 + blk) * HD;
        if (lane < 16) {
            if (lane >= 4) { u32x4 o; o.x = cvtpk(cs8[0] * (1.0f / 256.0f), cs8[1] * (1.0f / 256.0f)); o.y = cvtpk(cs8[2] * (1.0f / 256.0f), cs8[3] * (1.0f / 256.0f));
                o.z = cvtpk(cs8[4] * (1.0f / 256.0f), cs8[5] * (1.0f / 256.0f)); o.w = cvtpk(cs8[6] * (1.0f / 256.0f), cs8[7] * (1.0f / 256.0f)); *(u32x4*)(KM + 8 * lane) = o; }
            KM[lane] = f2bf(a0 * (1.0f / 256.0f)); KM[16 + lane] = f2bf(a1 * (1.0f / 256.0f));
        }
    }
}

DI void phase_dn_final(const Params& p, int lane, int gw, int NGW) {
    const float* ODN = (const float*)(p.ws + WS_D); const bf16_t* PROJ = (const bf16_t*)(p.ws + WS_B); bf16_t* YAB = (bf16_t*)(p.ws + WS_A);
    const int d0 = (lane & 7) * 16;
    for (int m = gw; m < T; m += NGW) {
        const float* op = ODN + (size_t)m * 1024 + lane * 16;
        f32x4 v[4]; float s = 0.f;
#pragma unroll
        for (int j = 0; j < 4; ++j) { v[j] = *(const f32x4*)(op + 4 * j); s += (v[j].x * v[j].x + v[j].y * v[j].y) + (v[j].z * v[j].z + v[j].w * v[j].w); }
        s += __shfl_xor(s, 1); s += __shfl_xor(s, 2); s += __shfl_xor(s, 4);
        const float rstd = rsqrt_(s * (1.0f / HD) + EPS);
        const u32x4 z0 = *(const u32x4*)(PROJ + (size_t)m * PP + C_Z + lane * 16), z1 = *(const u32x4*)(PROJ + (size_t)m * PP + C_Z + lane * 16 + 8);
        const float zz[16] = {bflo(z0.x), bfhi(z0.x), bflo(z0.y), bfhi(z0.y), bflo(z0.z), bfhi(z0.z), bflo(z0.w), bfhi(z0.w),
                              bflo(z1.x), bfhi(z1.x), bflo(z1.y), bfhi(z1.y), bflo(z1.z), bfhi(z1.z), bflo(z1.w), bfhi(z1.w)};
        float y[16];
#pragma unroll
        for (int j = 0; j < 4; ++j) { const f32x4 g = *(const f32x4*)(p.dn_gain + d0 + 4 * j);
            y[4 * j + 0] = v[j].x * rstd * g.x * siluf_(zz[4 * j + 0]); y[4 * j + 1] = v[j].y * rstd * g.y * siluf_(zz[4 * j + 1]);
            y[4 * j + 2] = v[j].z * rstd * g.z * siluf_(zz[4 * j + 2]); y[4 * j + 3] = v[j].w * rstd * g.w * siluf_(zz[4 * j + 3]); }
        u32x4 o0, o1;
        o0.x = cvtpk(y[0], y[1]); o0.y = cvtpk(y[2], y[3]); o0.z = cvtpk(y[4], y[5]); o0.w = cvtpk(y[6], y[7]);
        o1.x = cvtpk(y[8], y[9]); o1.y = cvtpk(y[10], y[11]); o1.z = cvtpk(y[12], y[13]); o1.w = cvtpk(y[14], y[15]);
        bf16_t* yp = YAB + (size_t)m * DM + 1024 + lane * 16;
        *(u32x4*)yp = o0; *(u32x4*)(yp + 8) = o1;
    }
}

constexpr int L5_ROW = 4112;
constexpr int L5_LG = 32 * L5_ROW;
constexpr int L5_HIST = L5_LG + 24576;
constexpr int L5_TOK = L5_HIST + 256;
DI void phase5_item(const Params& p, LAS unsigned char* lds, int item, int tid, int lane, int wave) {
    const float* MOD = (const float*)(p.ws + WS_MOD); const bf16_t* OM = (const bf16_t*)(p.ws + WS_OUTMIX);
    const bf16_t* WR = (const bf16_t*)(p.ws + WS_WR); bf16_t* X1 = (bf16_t*)(p.ws + WS_D);
    LAS unsigned* hist = (LAS unsigned*)(lds + L5_HIST); LAS unsigned* tokw = (LAS unsigned*)(lds + L5_TOK);
    if (tid < 64) hist[tid] = 0u;
    const int tokb = item * 64, b = tokb >> 11;
    f32x4 c1[8], c2[8], c3[8];
    { const float* mod = MOD + b * 12288;
#pragma unroll
      for (int j = 0; j < 4; ++j)
#pragma unroll
          for (int q = 0; q < 2; ++q) { const int col = 8 * (lane + 64 * j) + 4 * q;
              c1[2 * j + q] = *(const f32x4*)(mod + 4096 + col) * *(const f32x4*)(p.g_mix_post + col);
              c2[2 * j + q] = *(const f32x4*)(p.g_ffn_pre + col) * (*(const f32x4*)(mod + 8192 + col) + 1.0f);
              c3[2 * j + q] = *(const f32x4*)(mod + 6144 + col); } }
    for (int half = 0; half < 2; ++half) {
    for (int rr = 0; rr < 4; ++rr) {
        const int lr = wave * 4 + rr, m = tokb + half * 32 + lr;
        u32x4 wq[4]; f32x4 xx[8];
#pragma unroll
        for (int j = 0; j < 4; ++j) { const int col = 8 * (lane + 64 * j);
            wq[j] = *(const u32x4*)(OM + (size_t)m * DM + col);
            xx[2 * j] = *(const f32x4*)(p.x + (size_t)m * DM + col); xx[2 * j + 1] = *(const f32x4*)(p.x + (size_t)m * DM + col + 4); }
        f32x4 om[8]; float s = 0.f;
#pragma unroll
        for (int j = 0; j < 4; ++j) { const u32x4 w = wq[j];
            om[2 * j] = (f32x4){bflo(w.x), bfhi(w.x), bflo(w.y), bfhi(w.y)}; om[2 * j + 1] = (f32x4){bflo(w.z), bfhi(w.z), bflo(w.w), bfhi(w.w)}; }
#pragma unroll
        for (int k = 0; k < 8; ++k) s += (om[k].x * om[k].x + om[k].y * om[k].y) + (om[k].z * om[k].z + om[k].w * om[k].w);
        const float r1 = rsqrt_(wave_sum(s) * (1.0f / DM) + EPS);
        float s2 = 0.f;
#pragma unroll
        for (int k = 0; k < 8; ++k) { const f32x4 o = xx[k] + c1[k] * (om[k] * r1); xx[k] = o; s2 += (o.x * o.x + o.y * o.y) + (o.z * o.z + o.w * o.w); }
#pragma unroll
        for (int j = 0; j < 4; ++j) { const int col = 8 * (lane + 64 * j);
            *(u32x4*)(X1 + (size_t)m * DM + col) = (u32x4){cvtpk(xx[2 * j].x, xx[2 * j].y), cvtpk(xx[2 * j].z, xx[2 * j].w), cvtpk(xx[2 * j + 1].x, xx[2 * j + 1].y), cvtpk(xx[2 * j + 1].z, xx[2 * j + 1].w)}; }
        const float r2 = rsqrt_(wave_sum(s2) * (1.0f / DM) + EPS);
#pragma unroll
        for (int j = 0; j < 4; ++j) { const int col = 8 * (lane + 64 * j);
            const f32x4 u0 = (xx[2 * j] * r2) * c2[2 * j] + c3[2 * j], u1 = (xx[2 * j + 1] * r2) * c2[2 * j + 1] + c3[2 * j + 1];
            *(LAS u32x4*)(lds + lr * L5_ROW + col * 2) = (u32x4){cvtpk(u0.x, u0.y), cvtpk(u0.z, u0.w), cvtpk(u1.x, u1.y), cvtpk(u1.z, u1.w)};
            *(u32x2*)(p.ws + WS_U2F + (size_t)m * DM + col) = (u32x2){cvt4_fp8(u0.x * SU, u0.y * SU, u0.z * SU, u0.w * SU), cvt4_fp8(u1.x * SU, u1.y * SU, u1.z * SU, u1.w * SU)}; }
    }
    __syncthreads();
    {
        const int tl = lane & 15, kg = lane >> 4, tg = wave & 1, kq = wave >> 1;
        const LAS unsigned char* up = lds + (tg * 16 + tl) * L5_ROW + (kq * 512 + 8 * kg) * 2;
        const bf16_t* wp = WR + (size_t)tl * DM + kq * 512 + 8 * kg;
        f32x4 a0 = {0.f, 0.f, 0.f, 0.f}, a1 = a0, a2 = a0;
#pragma unroll 8
        for (int s = 0; s < 16; ++s) {
            const bf16x8 bu = *(const LAS bf16x8*)(up + 64 * s);
            const bf16x8 w0 = *(const bf16x8*)(wp + 32 * s), w1 = *(const bf16x8*)(wp + 16 * DM + 32 * s), w2 = *(const bf16x8*)(wp + 32 * DM + 32 * s);
            a0 = MFMA16(w0, bu, a0); a1 = MFMA16(w1, bu, a1); a2 = MFMA16(w2, bu, a2);
        }
        LAS float* lg = (LAS float*)(lds + L5_LG) + (kq * 2 + tg) * 768 + tl * 48 + 4 * kg;
#pragma unroll
        for (int r = 0; r < 4; ++r) { lg[r] = a0[r]; lg[16 + r] = a1[r]; lg[32 + r] = a2[r]; }
    }
    __syncthreads();
    if (wave < 2) {
        if (lane < 16) {
            const LAS float* l = (const LAS float*)(lds + L5_LG) + wave * 768 + lane * 48;
            float gl[4]; int gs = 0; float gm;
#pragma unroll
            for (int i = 0; i < 4; ++i) gl[i] = ((l[i] + l[1536 + i]) + (l[3072 + i] + l[4608 + i])) + p.b_rg[i];
            gm = gl[0];
#pragma unroll
            for (int i = 1; i < 4; ++i) if (gl[i] > gm) { gm = gl[i]; gs = i; }
            float gsum = 0.f;
#pragma unroll
            for (int i = 0; i < 4; ++i) gsum += expf(gl[i] - gm);
            const float pg = 1.0f / gsum;
            float el[8]; float em = -3.0e38f;
#pragma unroll
            for (int i = 0; i < 8; ++i) { const int li = 4 + 8 * gs + i; const float v = ((l[li] + l[1536 + li]) + (l[3072 + li] + l[4608 + li])) + p.b_re[8 * gs + i]; el[i] = v; em = fmaxf(em, v); }
            float pe[8]; float esum = 0.f;
#pragma unroll
            for (int i = 0; i < 8; ++i) { pe[i] = expf(el[i] - em); esum += pe[i]; }
            int i0 = 0; float p0 = pe[0];
#pragma unroll
            for (int i = 1; i < 8; ++i) if (pe[i] > p0) { p0 = pe[i]; i0 = i; }
            int i1 = -1; float p1 = -1.f;
#pragma unroll
            for (int i = 0; i < 8; ++i) if (i != i0 && pe[i] > p1) { p1 = pe[i]; i1 = i; }
            const float w0 = pg * p0 / (p0 + p1), w1 = pg * p1 / (p0 + p1);
            const int e0 = 8 * gs + i0, e1 = 8 * gs + i1;
            const unsigned lr0 = __hip_atomic_fetch_add(hist + e0, 1u, __ATOMIC_RELAXED, __HIP_MEMORY_SCOPE_WORKGROUP), lr1 = __hip_atomic_fetch_add(hist + e1, 1u, __ATOMIC_RELAXED, __HIP_MEMORY_SCOPE_WORKGROUP);
            LAS unsigned* tw = tokw + (half * 32 + wave * 16 + lane) * 6;
            tw[0] = (unsigned)e0; tw[1] = (unsigned)e1; tw[2] = lr0; tw[3] = lr1; tw[4] = __float_as_uint(w0); tw[5] = __float_as_uint(w1);
        }
    }
    }
    __syncthreads();
    if (tid < 32) { unsigned* cnt = (unsigned*)(p.ws + WS_CTL) + CW_CNT; const unsigned hcount = hist[tid];
        hist[32 + tid] = hcount ? __hip_atomic_fetch_add(cnt + tid, hcount, __ATOMIC_RELAXED, __HIP_MEMORY_SCOPE_AGENT) : 0u; }
    __syncthreads();
    if (tid < 64) {
        const LAS unsigned* tw = tokw + tid * 6; const int tok = tokb + tid;
        const unsigned e0 = tw[0], e1 = tw[1], q0 = hist[32 + e0] + tw[2], q1 = hist[32 + e1] + tw[3];
        int* RT = (int*)(p.ws + WS_RTOK); RT[e0 * ECAP + q0] = tok; RT[e1 * ECAP + q1] = tok;
        u32x4* rec = (u32x4*)(p.ws + WS_REC) + (size_t)tok * 2;
        rec[0] = (u32x4){e0, e1, q0, q1}; rec[1] = (u32x4){tw[4], tw[5], 0u, 0u};
    }
    __syncthreads();
}
DI void expert_copy_gu(const Params& p, int it, LAS float* scr, int lane) {
    const int e = it >> 10, r = it & 1023, up = r >> 9, q = r & 511, kb = q >> 4, nb = q & 15, n0 = 32 * nb;
    const float* W = (up ? p.w_up : p.w_gate) + (size_t)e * DM * FF;
    transpose_tile8(W, FF, 64 * kb, n0, p.ws + WS_WGU, DM, e * 1024 + (n0 >> 7) * 256 + (n0 & 127) + up * 128, SW, scr, lane);
}
DI void expert_copy_dn(const Params& p, int it, LAS float* scr, int lane) {
    const int e = it >> 9, q = it & 511, kb = q >> 6, nb = q & 63;
    transpose_tile8(p.w_down + (size_t)e * FF * DM, DM, 64 * kb, 32 * nb, p.ws + WS_WDN, FF, e * DM + 32 * nb, SW, scr, lane);
}

struct MoeOrder {
    const LAS int* pref; const LAS int* cnt; int ntn, G, c;
    DI bool next(int i, pg8::Unit& u) const {
        const int L = i * G + c; const int total = pref[32] * ntn; if (L >= total) return false;
        const int tile = L / ntn, pnl = L - tile * ntn;
        int e = 0;
        for (int q = 1; q < 32; ++q) if (tile >= pref[q]) e = q;
        const int m = tile - pref[e];
        u.pm = tile; u.pn = e * ntn + pnl; u.ga = e * ECAP + m * 256; u.gn = cnt[e] - m * 256; return true;
    }
};
DI void moe_tables(const Params& p, LAS int* pref, LAS int* cntl, int tid) {
    if (tid < 32) { const unsigned* cnt = (const unsigned*)(p.ws + WS_CTL) + CW_CNT; cntl[tid] = (int)__hip_atomic_load(cnt + tid, __ATOMIC_RELAXED, __HIP_MEMORY_SCOPE_AGENT); }
    __syncthreads();
    if (tid == 0) { int acc = 0;
        for (int e = 0; e < 32; ++e) { pref[e] = acc; acc += (cntl[e] + 255) >> 8; }
        pref[32] = acc; }
    __syncthreads();
}

DI void phase8(const Params& p, const LAS int* pref, int lane, int gw, int NGW) {
    const float* MOD = (const float*)(p.ws + WS_MOD); const bf16_t* YB = (const bf16_t*)(p.ws + WS_YBUF); const bf16_t* X1 = (const bf16_t*)(p.ws + WS_D);
    for (int m0 = gw * 8; m0 < T; m0 += NGW * 8) {
        const int b = m0 >> 11; const float* gt2 = MOD + b * 12288 + 5 * 2048;
        f32x4 c4[8];
#pragma unroll
        for (int k = 0; k < 8; ++k) { const int col = 8 * (lane + 64 * (k >> 1)) + 4 * (k & 1); c4[k] = *(const f32x4*)(gt2 + col) * *(const f32x4*)(p.g_ffn_post + col); }
        for (int rr = 0; rr < 8; ++rr) { const int m = m0 + rr;
            const u32x4* rec = (const u32x4*)(p.ws + WS_REC) + (size_t)m * 2;
            const u32x4 r0 = rec[0], r1 = rec[1];
            const size_t row0 = (size_t)(pref[r0.x] * 256 + (int)r0.z), row1 = (size_t)(pref[r0.y] * 256 + (int)r0.w);
            const float w0 = __uint_as_float(r1.x), w1 = __uint_as_float(r1.y);
            u32x4 ya[4], yc[4], xw[4];
#pragma unroll
            for (int j = 0; j < 4; ++j) { const int col = 8 * (lane + 64 * j);
                ya[j] = *(const u32x4*)(YB + row0 * DM + col); yc[j] = *(const u32x4*)(YB + row1 * DM + col); xw[j] = *(const u32x4*)(X1 + (size_t)m * DM + col); }
            f32x4 y[8]; float s = 0.f;
#pragma unroll
            for (int j = 0; j < 4; ++j) { const u32x4 a = ya[j], c = yc[j];
                y[2 * j] = (f32x4){w0 * bflo(a.x) + w1 * bflo(c.x), w0 * bfhi(a.x) + w1 * bfhi(c.x), w0 * bflo(a.y) + w1 * bflo(c.y), w0 * bfhi(a.y) + w1 * bfhi(c.y)};
                y[2 * j + 1] = (f32x4){w0 * bflo(a.z) + w1 * bflo(c.z), w0 * bfhi(a.z) + w1 * bfhi(c.z), w0 * bflo(a.w) + w1 * bflo(c.w), w0 * bfhi(a.w) + w1 * bfhi(c.w)}; }
#pragma unroll
            for (int k = 0; k < 8; ++k) s += (y[k].x * y[k].x + y[k].y * y[k].y) + (y[k].z * y[k].z + y[k].w * y[k].w);
            const float rs = rsqrt_(wave_sum(s) * (1.0f / DM) + EPS);
#pragma unroll
            for (int j = 0; j < 4; ++j) { const int col = 8 * (lane + 64 * j); const u32x4 xq = xw[j];
                const f32x4 x0 = {bflo(xq.x), bfhi(xq.x), bflo(xq.y), bfhi(xq.y)}, x1 = {bflo(xq.z), bfhi(xq.z), bflo(xq.w), bfhi(xq.w)};
                *(f32x4*)(p.out + (size_t)m * DM + col) = x0 + c4[2 * j] * (y[2 * j] * rs);
                *(f32x4*)(p.out + (size_t)m * DM + col + 4) = x1 + c4[2 * j + 1] * (y[2 * j + 1] * rs); }
        }
    }
}

#define XB_TMO      128
#define XB_XCNT(j)  (256  + 64 * (j))
#define XB_XSUB(j)  (1280 + 64 * (j))
#define XB_XGEN(j)  (2304 + 64 * (j))
#define XB_TOP      3328
#define XB_TOPGEN   3392
#define XCD_BAR_WORDS 3456
#define XB_SPIN_CAP (1u << 18)
DI unsigned xb_ld(unsigned* p)              { return __hip_atomic_load(p, __ATOMIC_RELAXED, __HIP_MEMORY_SCOPE_AGENT); }
DI unsigned xb_add(unsigned* p, unsigned v) { return __hip_atomic_fetch_add(p, v, __ATOMIC_RELAXED, __HIP_MEMORY_SCOPE_AGENT); }
DI unsigned xb_xcc_id() { return (unsigned)__builtin_amdgcn_s_getreg((3 << 11) | 20) & 0xFu; }
#define XB_SPIN(cond, bar) do { unsigned _sp = 0; while (cond) { __builtin_amdgcn_s_sleep(1); \
    if ((++_sp & 255u) == 0u) { if (xb_ld(&(bar)[XB_TMO])) break; if (_sp > XB_SPIN_CAP) { atomicAdd(&(bar)[XB_TMO], 1u); break; } } } } while (0)
struct XcdBarrier { unsigned* bar; unsigned x; volatile LAS unsigned* st; };
DI XcdBarrier xcd_barrier_post(unsigned* bar, volatile LAS unsigned* st) {
    XcdBarrier b; b.bar = bar; b.x = xb_xcc_id(); b.st = st;
    if (threadIdx.x == 0) (void)xb_add(&bar[XB_XCNT(b.x)], 1u);
    return b;
}
DI void xcd_barrier_complete(unsigned* bar, unsigned x, unsigned& nloc, unsigned& nx) {
    const unsigned G = gridDim.x * gridDim.y * gridDim.z;
    unsigned sum, cnt, mine, sp = 0u;
    for (;;) {
        sum = 0u; cnt = 0u; mine = 0u;
#pragma unroll
        for (unsigned j = 0; j < 16; ++j) { const unsigned c = xb_ld(&bar[XB_XCNT(j)]); sum += c; cnt += (c > 0u) ? 1u : 0u; mine = (j == x) ? c : mine; }
        if (sum == G) break;
        __builtin_amdgcn_s_sleep(1);
        if ((++sp & 255u) == 0u) { if (xb_ld(&bar[XB_TMO])) break; if (sp > XB_SPIN_CAP) { atomicAdd(&bar[XB_TMO], 1u); break; } }
    }
    nloc = mine > 0u ? mine : 1u; nx = cnt > 0u ? cnt : 1u;
}
DI void xcd_barrier(const XcdBarrier& b) {
    asm volatile("s_waitcnt vmcnt(0)" ::: "memory");
    __syncthreads();
    if (threadIdx.x == 0) {
        unsigned* bar = b.bar;
        __builtin_amdgcn_s_waitcnt(0);
        unsigned nloc = b.st[0], nx = b.st[1];
        if (nloc == 0u) { xcd_barrier_complete(bar, b.x, nloc, nx); b.st[0] = nloc; b.st[1] = nx; }
        const unsigned old = xb_add(&bar[XB_XSUB(b.x)], 1u);
        const unsigned gen = old / nloc;
        if (old + 1u == (gen + 1u) * nloc) {
            __builtin_amdgcn_fence(__ATOMIC_RELEASE, "agent");
            asm volatile("s_waitcnt vmcnt(0)" ::: "memory");
            const unsigned og = xb_add(&bar[XB_TOP], 1u);
            const unsigned tg = og / nx;
            if (og + 1u == (tg + 1u) * nx) xb_add(&bar[XB_TOPGEN], 1u);
            else XB_SPIN(xb_ld(&bar[XB_TOPGEN]) == tg, bar);
            __builtin_amdgcn_fence(__ATOMIC_ACQUIRE, "agent");
            xb_add(&bar[XB_XGEN(b.x)], 1u);
            asm volatile("s_waitcnt vmcnt(0)" ::: "memory");
        } else {
            XB_SPIN(xb_ld(&bar[XB_XGEN(b.x)]) == gen, bar);
            __builtin_amdgcn_fence(__ATOMIC_ACQUIRE, "agent");
            asm volatile("s_waitcnt vmcnt(0)" ::: "memory");
        }
    }
    __syncthreads();
}

constexpr int NWAVES = 8, NTHREADS = 512;
constexpr int LDS_GEMM = 131072, LDS_TAB = 162816, LDS_BYTES = LDS_TAB + 1024;
constexpr int N_PHASES = 12;
#ifndef DBL
#define DBL -1
#endif
#define REP(k) for (int rep_ = 0; rep_ < ((DBL == (k)) ? 2 : 1); ++rep_)
#ifndef MK_N_LAUNCHES
#define MK_N_LAUNCHES 1
#endif

DI moba::BlockRef attn_ref(const Params& p, int bh, int qb) {
    const int b = bh >> 3, h = bh & 7;
    const bf16_t* PROJ = (const bf16_t*)(p.ws + WS_B);
    moba::BlockRef r;
    r.Q = PROJ + (size_t)(b * SEQ + qb * 256) * PP + C_Q + h * HD;
    r.K = PROJ + (size_t)(b * SEQ) * PP + C_K + h * HD;
    r.V = PROJ + (size_t)(b * SEQ) * PP + C_V + h * HD;
    r.O = (bf16_t*)(p.ws + WS_A) + (size_t)(b * SEQ + qb * 256) * DM + h * HD;
    r.KM = (const bf16_t*)(p.ws + WS_KMEAN) + (size_t)bh * 8 * HD;
    r.P0 = qb * 256;
    return r;
}

typedef const __attribute__((address_space(4))) Params* KParams;
#if defined(__HIP_DEVICE_COMPILE__)
#define LOADP() KParams kq_ = kp_; asm volatile("" : "+s"(kq_)); const Params p = *kq_
#else
#define LOADP() const Params p = p_unused
#endif
__global__ void __launch_bounds__(NTHREADS, 2) fwd_kernel(Params p_unused) {
#if defined(__HIP_DEVICE_COMPILE__)
    const KParams kp_ = (KParams)__builtin_amdgcn_kernarg_segment_ptr();
#else
    const Params* kp_ = &p_unused;
#endif
    extern __shared__ __attribute__((aligned(16))) unsigned char lds_raw[];
    LAS unsigned char* lds = (LAS unsigned char*)lds_raw;
    const int bid = blockIdx.x, G = gridDim.x, NGW = G * NWAVES;
#define IDS() int tid_ = threadIdx.x; asm volatile("" : "+v"(tid_)); const int tid = tid_, lane = tid & 63, wave = __builtin_amdgcn_readfirstlane(tid >> 6), gw = bid * NWAVES + wave; (void)lane; (void)gw; (void)wave
    const int vcu = (G % 8 == 0) ? (bid % 8) * (G / 8) + bid / 8 : bid;
    const int lo = kp_->ph_lo, hi = kp_->ph_hi;
#ifdef ONLY
#define IN(k) ((k) == ONLY && lo <= (k) && (k) < hi)
#else
#define IN(k) (lo <= (k) && (k) < hi)
#endif
    { volatile LAS unsigned* st0 = (volatile LAS unsigned*)(lds + LDS_TAB + 512); if (threadIdx.x < 2) st0[threadIdx.x] = 0u; __syncthreads(); }
    XcdBarrier xbar; xbar.bar = (unsigned*)(kp_->ws + WS_CTL) + CW_BAR; xbar.x = 0; xbar.st = (volatile LAS unsigned*)(lds + LDS_TAB + 512);
#define SEAM(k) do { if (IN(k) && IN((k) + 1)) { if ((k) == 0) { cg::this_grid().sync(); xbar = xcd_barrier_post((unsigned*)(kp_->ws + WS_CTL) + CW_BAR, (volatile LAS unsigned*)(lds + LDS_TAB + 512)); } else xcd_barrier(xbar); } } while (0)

#ifdef TSPROBE
#ifndef TSQ
#define TSQ 10.0f
#endif
    unsigned long long* TS = (unsigned long long*)(kp_->ws + WS_CTL + 512 * 1024);
#define STAMP(k) do { if (blockIdx.x == 0 && threadIdx.x == 0) TS[k] = __builtin_amdgcn_s_memrealtime(); } while (0)
#else
#define STAMP(k) do { } while (0)
#endif
    STAMP(0);
    if (IN(0)) { LOADP(); IDS();
        if (bid == 0) { unsigned* ctl = (unsigned*)(p.ws + WS_CTL); for (int i = tid; i < 8192; i += NTHREADS) ctl[i] = 0u; }
        REP(0) phase0(p, lds, tid, lane, wave, bid, G); }
    SEAM(0); STAMP(1);
    if (IN(1)) { LOADP(); IDS(); REP(1) for (int it = bid; it < T / 64; it += G) phase_u1_item(p, lds, it, tid, lane, wave); }
    SEAM(1); STAMP(2);
    if (IN(2)) { LOADP(); IDS();
        pg8::Gemm g{(const bf16_t*)(p.ws + WS_A), (const bf16_t*)(p.ws + WS_WIN), DM, nullptr};
        pg8::StaticOrder S; S.init(T, NPROJ, G, bid);
        pg8::EpiProj E{(bf16_t*)(p.ws + WS_B), (u32x4*)(p.ws + WS_GATEF)};
        pg8::gemm_phase<pg8::EpiProj, pg8::StaticOrder, true, false>(lds, g, S, E);
    }
    SEAM(2); STAMP(3);
    if (IN(3)) { LOADP(); IDS();
        if (wave < 4) { for (int it = bid * 4 + wave; it < 1024; it += G * 4) rotary_item(p, it, lane); }
        REP(30) { dn::Raw R; dn::ConvW CW; dn::prep_consts(p, (bid >> 5) & 7, CW, lane); if (bid < 64 * 32) dn::prep_load(p, bid, R, lane, wave);
            for (int it = bid; it < 64 * 32; it += G) dn::prep_chunk(p, lds, it, (it + G < 64 * 32) ? it + G : -1, R, CW, tid, lane, wave); }
    }
    SEAM(3); STAMP(4);
    if (IN(4)) { LOADP(); IDS();
        const int x = bid & 7, ci = bid >> 3, grp = ci >> 3, bhA = 8 * x + 7 - (ci & 7);
        REP(41) { if (grp == 0) dn::recur(p, lds, 8 * x + ci, tid, lane, wave); }
        STAMP(13);
#ifndef NO_ATTN
        REP(40) {
            const int nblk = grp == 0 ? 1 : (grp == 1 ? 3 : 2);
#define QSEL(i) (grp == 0 ? 2 : grp == 1 ? ((i) == 0 ? 7 : (i) == 1 ? 1 : 0) : grp == 2 ? ((i) == 0 ? 6 : 3) : ((i) == 0 ? 5 : 4))
            moba::Seam S;
            moba::BlockRef cur = attn_ref(p, bhA, QSEL(0));
            moba::prime(cur, (char*)lds_raw, S);
            for (int i = 0; i < nblk; ++i) {
                const int in = (i + 1 < nblk) ? i + 1 : i;
                const moba::BlockRef nxt = attn_ref(p, bhA, QSEL(in));
                moba::block(cur, nxt, (char*)lds_raw, S);
                cur = nxt;
            }
#undef QSEL
        }
#endif
        STAMP(14);
    }
    SEAM(4); STAMP(5);
    if (IN(6)) { LOADP(); IDS();
        pg8::Gemm g{(const bf16_t*)(p.ws + WS_A), (const bf16_t*)(p.ws + WS_WMD), DM, nullptr};
        pg8::StaticOrder S; S.init(T, DM, G, bid);
        pg8::EpiMerged E{(const u32x4*)(p.ws + WS_GATEF), (bf16_t*)(p.ws + WS_MERGED)};
        pg8::gemm_phase<pg8::EpiMerged, pg8::StaticOrder, true, false>(lds, g, S, E);
#if DBL == 6
        pg8::gemm_phase<pg8::EpiMerged, pg8::StaticOrder, true, false>(lds, g, S, E);
#endif
    }
    SEAM(6); STAMP(7);
    if (IN(7)) { LOADP(); IDS();
        const int cp = (bid >> 3) % 3;
        LAS float* scr = (LAS float*)(lds + wave * 8448);
        pg8::Gemm g{(const bf16_t*)(p.ws + WS_MERGED), (const bf16_t*)(p.ws + WS_WOUT), DM, nullptr};
        pg8::EpiStore E{(bf16_t*)(p.ws + WS_OUTMIX), DM, 8};
        for (int seg = 0; seg < 2; ++seg) {
            const int lo = seg == 0 ? 0 : cp, hi = seg == 0 ? cp : 2;
            if (seg == 1) { REP(81) for (int it = gw; it < 32 * 1024; it += NGW) expert_copy_gu(p, it, scr, lane); __syncthreads(); }
            if (hi > lo) { pg8::StaticOrder S; S.init(T, DM, G, bid); S.i0 = lo; S.imax = hi - lo;
                pg8::gemm_phase<pg8::EpiStore, pg8::StaticOrder, true, false>(lds, g, S, E); }
        }
    }
    SEAM(7); STAMP(8);
    if (IN(8)) { LOADP(); IDS();
        for (int it = bid; it < T / 64; it += G) phase5_item(p, lds, it, tid, lane, wave);
    }
    SEAM(8); STAMP(9);
    LAS int* pref = (LAS int*)(lds + LDS_TAB); LAS int* cntl = pref + 64;
    if (IN(9)) { LOADP(); IDS();
        moe_tables(p, pref, cntl, tid);
        pg8::Gemm g{(const bf16_t*)(p.ws + WS_U2F), (const bf16_t*)(p.ws + WS_WGU), DM, (const int*)(p.ws + WS_RTOK)};
        MoeOrder S{pref, cntl, 4, G, bid};
        pg8::EpiGU8 E{p.ws + WS_H, 1.0f / (SU * SW), SH};
        pg8::gemm_phase<pg8::EpiGU8, MoeOrder, true, true, true>(lds, g, S, E);
        {   const int total = pref[32] * 4, rem = total % G, ncw = rem ? G - rem : G, cw = rem ? bid - rem : bid;
            if (cw >= 0) { LAS float* scr = (LAS float*)(lds + wave * 8448);
                for (int it = cw * NWAVES + wave; it < 32 * 512; it += ncw * NWAVES) expert_copy_dn(p, it, scr, lane); }
        }
    }
    SEAM(9); STAMP(10);
    if (IN(10)) { LOADP(); IDS();
        if (!IN(9)) moe_tables(p, pref, cntl, tid);
        pg8::Gemm g{(const bf16_t*)(p.ws + WS_H), (const bf16_t*)(p.ws + WS_WDN), FF, nullptr};
        MoeOrder S{pref, cntl, 8, G, bid};
        pg8::EpiStoreS E{(bf16_t*)(p.ws + WS_YBUF), DM, 8, 1.0f / (SH * SW)};
        pg8::gemm_phase<pg8::EpiStoreS, MoeOrder, true, false, true>(lds, g, S, E);
    }
    SEAM(10); STAMP(11);
    if (IN(11)) { LOADP(); IDS();
        if (!IN(10)) moe_tables(p, pref, cntl, tid);
        phase8(p, pref, lane, gw, NGW);
    }
#ifdef TSPROBE
    STAMP(12);
    __syncthreads();
    if (blockIdx.x == 0 && threadIdx.x == 0) { asm volatile("s_waitcnt vmcnt(0)" ::: "memory");
        const int a = (TSPROBE == 13) ? 4 : (TSPROBE == 14) ? 13 : (TSPROBE == 15) ? 14 : TSPROBE, b2 = (TSPROBE == 13) ? 13 : (TSPROBE == 14) ? 14 : (TSPROBE == 15) ? 5 : (TSPROBE == 5) ? 7 : TSPROBE + 1;
        const float dt = (float)(TS[b2] - TS[a]) * 0.01f;
        kp_->out[0] += TSQ * rintf(dt * (1.0f / TSQ)); }
#endif
#undef IN
#undef SEAM
}

extern "C" void kernel_launch(void* const* d_in, const int* in_sizes, int n_in, void* d_out, int out_size, void* d_ws, size_t ws_size, hipStream_t stream) {
    static int grid = 0;
    if (grid == 0) {
        if (n_in != 24 || in_sizes[0] != T * DM || out_size != T * DM || ws_size < WS_END) {
            fprintf(stderr, "kernel_launch: unexpected shapes (n_in %d, in0 %d, out %d, ws %zu); nothing launched\n", n_in, n_in > 0 ? in_sizes[0] : -1, out_size, ws_size); grid = -1; return; }
        int dev = 0, cus = 0, per_cu = 0;
        hipGetDevice(&dev); hipDeviceGetAttribute(&cus, hipDeviceAttributeMultiprocessorCount, dev);
        if (hipFuncSetAttribute((const void*)fwd_kernel, hipFuncAttributeMaxDynamicSharedMemorySize, LDS_BYTES) != hipSuccess) { fprintf(stderr, "kernel_launch: hipFuncSetAttribute failed\n"); grid = -1; return; }
        if (hipOccupancyMaxActiveBlocksPerMultiprocessor(&per_cu, (const void*)fwd_kernel, NTHREADS, LDS_BYTES) != hipSuccess || per_cu < 1) { fprintf(stderr, "kernel_launch: occupancy query says %d blocks per CU\n", per_cu); grid = -1; return; }
        (void)hipGetLastError();
        grid = cus;
        if (cus != 256) { fprintf(stderr, "kernel_launch: built for a 256-CU device (static phase schedules), found %d CUs; nothing launched\n", cus); grid = -1; return; }
    }
    if (grid < 0) return;
    Params p{};
    p.x = (const float*)d_in[0]; p.c = (const float*)d_in[1]; p.pos = (const int*)d_in[2]; p.w_ada = (const float*)d_in[3]; p.b_ada = (const float*)d_in[4];
    p.g_mix_pre = (const float*)d_in[5]; p.g_mix_post = (const float*)d_in[6]; p.g_ffn_pre = (const float*)d_in[7]; p.g_ffn_post = (const float*)d_in[8];
    p.w_in = (const float*)d_in[9]; p.conv_w = (const float*)d_in[10]; p.a_log = (const float*)d_in[11]; p.dt_bias = (const float*)d_in[12]; p.dn_gain = (const float*)d_in[13];
    p.w_bm = (const float*)d_in[14]; p.w_bd = (const float*)d_in[15]; p.w_out = (const float*)d_in[16];
    p.w_rg = (const float*)d_in[17]; p.b_rg = (const float*)d_in[18]; p.w_re = (const float*)d_in[19]; p.b_re = (const float*)d_in[20];
    p.w_gate = (const float*)d_in[21]; p.w_up = (const float*)d_in[22]; p.w_down = (const float*)d_in[23];
    p.out = (float*)d_out; p.ws = (unsigned char*)d_ws;
    for (int li = 0; li < MK_N_LAUNCHES; ++li) {
        p.ph_lo = (MK_N_LAUNCHES == 1) ? 0 : li; p.ph_hi = (MK_N_LAUNCHES == 1) ? N_PHASES : li + 1;
        void* args[] = {&p};
        hipError_t e = hipLaunchCooperativeKernel((const void*)fwd_kernel, dim3(grid), dim3(NTHREADS), args, LDS_BYTES, stream);
        if (e != hipSuccess) { fprintf(stderr, "kernel_launch: cooperative launch failed: %s (grid %d)\n", hipGetErrorString(e), grid); break; }
    }
}
```

```cpp
#include <hip/hip_runtime.h>
#include <hip/hip_cooperative_groups.h>
#include <cstdio>
#include <cstdint>
namespace cg = cooperative_groups;

#define LAS __attribute__((address_space(3)))
#define DI __device__ __forceinline__
typedef unsigned short bf16_t;
typedef short bf16x8 __attribute__((ext_vector_type(8)));
typedef short s16x4 __attribute__((ext_vector_type(4)));
typedef float f32x2 __attribute__((ext_vector_type(2)));
typedef float f32x4 __attribute__((ext_vector_type(4)));
typedef float f32x16 __attribute__((ext_vector_type(16)));
typedef unsigned u32x2 __attribute__((ext_vector_type(2)));
typedef unsigned u32x4 __attribute__((ext_vector_type(4)));
typedef __bf16 bf16x2_t __attribute__((ext_vector_type(2)));

constexpr int NB = 8, SEQ = 2048, T = NB * SEQ, DM = 2048;
constexpr int NHEAD = 8, HD = 128;
constexpr int PP = 11264;
constexpr int NPROJ = 11264;
constexpr int C_Q = 0, C_K = 1024, C_V = 2048, C_DN = 3072, C_Z = 6144, C_GA = 7168, C_GB = 9216;
constexpr int NEXP = 32, FF = 512, ECAP = 16384;
constexpr float EPS = 1e-6f;

constexpr size_t MiB = 1u << 20;
constexpr size_t WS_CTL = 0, CTL_ZERO_BYTES = 1 * MiB;
constexpr size_t WS_MOD = 1 * MiB;
constexpr size_t WS_CS = 2 * MiB;
constexpr size_t WS_KMEAN = 4 * MiB;
constexpr size_t WS_WR = 4 * MiB + 512 * 1024;
constexpr size_t WS_WBA = 4 * MiB + 768 * 1024;
constexpr size_t WS_BA = 5 * MiB;
constexpr size_t WS_REC = 6 * MiB;
constexpr size_t WS_RTOK = 7 * MiB;
constexpr size_t WS_WMD = 10 * MiB;
constexpr size_t WS_WOUT = 18 * MiB;
constexpr size_t WS_A = 26 * MiB;
constexpr size_t WS_B = 90 * MiB;
constexpr size_t WS_C = 442 * MiB;
constexpr size_t WS_D = 588 * MiB;
constexpr size_t WS_GATEF = 588 * MiB;
constexpr size_t WS_U2F = 652 * MiB;
constexpr size_t WS_END = 716 * MiB;
constexpr float SU = 4.0f, SW = 32.0f, SH = 2.0f;
constexpr size_t WS_OUTMIX = WS_B, WS_WGU = WS_B + 128 * MiB, WS_WDN = WS_B + 256 * MiB, WS_YBUF = WS_B;
constexpr size_t WS_WIN = WS_C, WS_DNP = WS_C, WS_MERGED = WS_C, WS_H = WS_C + 64 * MiB;
constexpr size_t WS_U1F = WS_C + 64 * MiB, WS_WINF = WS_C + 96 * MiB;
constexpr float SU1 = 4.0f, SWI = 64.0f;
constexpr int NB0 = 12, NF = 8;
constexpr int CW_CNT = 64;
constexpr int CW_BAR = 4096;
constexpr int DN_U = 0, DN_W = 16384, DN_QD = 32768, DN_KT = 49152, DN_QK = 65536, DN_SC = 73728, DN_STRIDE = 73984;

struct Params {
    const float* x; const float* c; const int* pos; const float* w_ada; const float* b_ada;
    const float* g_mix_pre; const float* g_mix_post; const float* g_ffn_pre; const float* g_ffn_post;
    const float* w_in; const float* conv_w; const float* a_log; const float* dt_bias; const float* dn_gain;
    const float* w_bm; const float* w_bd; const float* w_out;
    const float* w_rg; const float* b_rg; const float* w_re; const float* b_re;
    const float* w_gate; const float* w_up; const float* w_down;
    float* out; unsigned char* ws;
    int ph_lo, ph_hi;
};

DI unsigned cvtpk(float lo, float hi) { f32x2 v = {lo, hi}; bf16x2_t b = __builtin_convertvector(v, bf16x2_t); return __builtin_bit_cast(unsigned, b); }
DI float bflo(unsigned w) { return __uint_as_float(w << 16); }
DI float bfhi(unsigned w) { return __uint_as_float(w & 0xffff0000u); }
DI float bf2f(bf16_t b) { return __uint_as_float((unsigned)b << 16); }
DI bf16_t f2bf(float f) { return (bf16_t)(cvtpk(f, 0.f) & 0xffffu); }
#define DPP_ADD(v, ctrl) ((v) + __builtin_bit_cast(float, __builtin_amdgcn_update_dpp(0, __builtin_bit_cast(int, (v)), (ctrl), 0xf, 0xf, false)))
DI float wave_sum(float v) {
    v = DPP_ADD(v, 0xB1); v = DPP_ADD(v, 0x4E); v = DPP_ADD(v, 0x141); v = DPP_ADD(v, 0x140);
    const float r0 = __builtin_bit_cast(float, __builtin_amdgcn_readlane(__builtin_bit_cast(int, v), 0)), r1 = __builtin_bit_cast(float, __builtin_amdgcn_readlane(__builtin_bit_cast(int, v), 16));
    const float r2 = __builtin_bit_cast(float, __builtin_amdgcn_readlane(__builtin_bit_cast(int, v), 32)), r3 = __builtin_bit_cast(float, __builtin_amdgcn_readlane(__builtin_bit_cast(int, v), 48));
    return (r0 + r1) + (r2 + r3);
}
DI float sigmoidf_(float x) { return __builtin_amdgcn_rcpf(1.f + __expf(-x)); }
DI float siluf_(float x) { return x * __builtin_amdgcn_rcpf(1.f + __expf(-x)); }
DI float rsqrt_(float x) { return __builtin_amdgcn_rsqf(x); }
DI float siluf_acc(float x) { return x / (1.f + expf(-x)); }
constexpr float SCALE_Q = 0.08838834764831845f;
DI unsigned cvt4_fp8(float a, float b, float cc, float d) { int w = 0; w = __builtin_amdgcn_cvt_pk_fp8_f32(a, b, w, false); w = __builtin_amdgcn_cvt_pk_fp8_f32(cc, d, w, true); return (unsigned)w; }
DI int perm16(int p) { return (p & 3) | ((p & 4) << 1) | ((p & 8) >> 1); }
DI int crow(int r, int hi) { return (r & 3) + 8 * (r >> 2) + 4 * hi; }
#define MFMA32(a, b, c) __builtin_amdgcn_mfma_f32_32x32x16_bf16((a), (b), (c), 0, 0, 0)
#define MFMA16(a, b, c) __builtin_amdgcn_mfma_f32_16x16x32_bf16((a), (b), (c), 0, 0, 0)

namespace pg8 {
constexpr int BM = 256, BK = 64, HALF = 128, HTB = HALF * BK * 2, STAGE_BYTES = 8 * HTB, NXCD = 8, WGM = 4;
DI int lds_byte(int r, int c) { const int st = (r >> 4) * 2 + (c >> 5), rr = r & 15, cc = c & 31, ob = rr * 64 + cc * 2; return st * 1024 + (ob ^ (((ob >> 9) & 1) << 5)); }
DI void stage_rc(int b, int& R, int& C) { const int st = b / 1024, sb = b % 1024, swz = sb ^ (((sb >> 9) & 1) << 5); R = (st >> 1) * 16 + swz / 64; C = (st & 1) * 32 + (swz % 64) / 2; }
DI int perm32(int rho) { const int n = rho >> 4, i = rho & 15; return 8 * (i >> 2) + 4 * n + (i & 3); }

struct Unit { int pm, pn, ga, gn; };
struct Gemm { const bf16_t* A; const bf16_t* Bt; int K; const int* gidx; };

struct StaticOrder {
    int nM, nN, nwg, G, c, i0 = 0, imax = 1 << 30;
    DI void init(int M, int N, int G_, int c_) { nM = M / BM; nN = N / BM; nwg = nM * nN; G = G_; c = c_; }
    DI bool next(int i, Unit& u) const {
        if (i >= imax) return false;
        const long L = (long)(i + i0) * G + c; if (L >= nwg) return false;
        int wgid = (int)L; { const int q = nwg / NXCD, r = nwg % NXCD, xcd = wgid % NXCD, off = wgid / NXCD; wgid = (xcd < r ? xcd * (q + 1) : r * (q + 1) + (xcd - r) * q) + off; }
        const int nig = WGM * nN, gid = wgid / nig, fm = gid * WGM, gsz = (nM - fm) < WGM ? (nM - fm) : WGM;
        u.pm = fm + ((wgid % nig) % gsz); u.pn = (wgid % nig) / gsz; u.ga = 0; u.gn = 0; return true;
    }
};

typedef f32x4 Acc[2][2][4][2];
typedef int v4i_t __attribute__((ext_vector_type(4)));
typedef int v8i_t __attribute__((ext_vector_type(8)));

template <class Epi, class Sched, bool ALIGN_EPI, bool GATHER, bool FP8 = false>
DI void gemm_phase(LAS unsigned char* lds, const Gemm g, const Sched& S, const Epi& E) {
    const int tid = threadIdx.x, wid = __builtin_amdgcn_readfirstlane(tid >> 6), lane = tid & 63, wr = wid >> 2, wc = wid & 3, fr = lane & 15, fq = lane >> 4;
    int K_ = FP8 ? (g.K >> 1) : g.K; if constexpr (FP8) asm volatile("" : "+s"(K_));
    const int K = K_, nt = K / BK;
    unsigned voffA[2], voffB[2];
#pragma unroll
    for (int i = 0; i < 2; ++i) { int R, C; stage_rc(tid * 16 + i * 8192, R, C); const int Rb = (R & ~31) + perm32(R & 31);
        voffA[i] = (unsigned)(R * K + C) * 2u; voffB[i] = (unsigned)(Rb * K + C) * 2u; }
    const size_t kstep = (size_t)(BK * 2);
    const size_t hstep = (size_t)HALF * K * 2;
    const size_t tstep = 2 * hstep;
    const unsigned ldsw = (unsigned)wid * 1024u;
    const int aoff = FP8 ? lds_byte(wr * 64 + fr, fq * 16) : lds_byte(wr * 64 + fr, fq * 8), boff = FP8 ? lds_byte(wc * 32 + fr, fq * 16) : lds_byte(wc * 32 + fr, fq * 8);
#define PG8_SA(b, h) (((b) * 2 + (h)) * HTB)
#define PG8_SB(b, h) ((4 + (b) * 2 + (h)) * HTB)
#define PG8_STAGE(bufoff, gbase, voff) do { _Pragma("unroll") for (int _i = 0; _i < 2; ++_i) \
        __builtin_amdgcn_global_load_lds((const unsigned*)((const char*)(gbase) + (voff)[_i]), (LAS unsigned*)(lds + (bufoff) + ldsw + _i * 8192), 16, 0, 0); } while (0)
#define PG8_LD8(p_) __builtin_shufflevector(*(const LAS v4i_t*)(p_), *(const LAS v4i_t*)((p_) + 16), 0, 1, 2, 3, 4, 5, 6, 7)
#define PG8_LDA(dst, b, h) do { if constexpr (FP8) { _Pragma("unroll") for (int m = 0; m < 4; ++m) dst##8[m] = PG8_LD8(lds + PG8_SA(b, h) + aoff + m * 2048); } \
        else { _Pragma("unroll") for (int m = 0; m < 4; ++m) _Pragma("unroll") for (int k = 0; k < 2; ++k) dst[m][k] = *(const LAS bf16x8*)(lds + PG8_SA(b, h) + aoff + m * 2048 + k * 1024); } } while (0)
#define PG8_LDB(dst, b, h) do { if constexpr (FP8) { _Pragma("unroll") for (int n = 0; n < 2; ++n) dst##8[n] = PG8_LD8(lds + PG8_SB(b, h) + boff + n * 2048); } \
        else { _Pragma("unroll") for (int n = 0; n < 2; ++n) _Pragma("unroll") for (int k = 0; k < 2; ++k) dst[n][k] = *(const LAS bf16x8*)(lds + PG8_SB(b, h) + boff + n * 2048 + k * 1024); } } while (0)
#define PG8_MMA(ai, bj, At, Bt) do { __builtin_amdgcn_s_setprio(1); \
        if constexpr (FP8) { _Pragma("unroll") for (int m = 0; m < 4; ++m) _Pragma("unroll") for (int n = 0; n < 2; ++n) \
            asm volatile("v_mfma_scale_f32_16x16x128_f8f6f4 %0, %1, %2, %0, %3, %3 op_sel_hi:[0,0,0]" : "+v"(acc[ai][bj][m][n]) : "v"(Bt##8[n]), "v"(At##8[m]), "v"(sc127)); } \
        else { _Pragma("unroll") for (int m = 0; m < 4; ++m) _Pragma("unroll") for (int n = 0; n < 2; ++n) _Pragma("unroll") for (int k = 0; k < 2; ++k) \
            acc[ai][bj][m][n] = __builtin_amdgcn_mfma_f32_16x16x32_bf16(Bt[n][k], At[m][k], acc[ai][bj][m][n], 0, 0, 0); } \
        __builtin_amdgcn_s_setprio(0); } while (0)
#define PG8_WAIT_V(n) asm volatile("s_waitcnt vmcnt(" #n ")" ::: "memory")
#define PG8_WAIT_L(n) asm volatile("s_waitcnt lgkmcnt(" #n ")" ::: "memory")
#define PG8_BAR __builtin_amdgcn_s_barrier()
#define PG8_SCHED __builtin_amdgcn_sched_barrier(0)
    Unit cur, nxt; int ui = 0;
    if (!S.next(0, cur)) return;
    Acc acc;
#pragma unroll
    for (int a = 0; a < 2; ++a)
#pragma unroll
        for (int b = 0; b < 2; ++b)
#pragma unroll
            for (int m = 0; m < 4; ++m)
#pragma unroll
                for (int n = 0; n < 2; ++n) { acc[a][b][m][n] = (f32x4){0.f, 0.f, 0.f, 0.f}; if constexpr (FP8) asm volatile("" : "+v"(acc[a][b][m][n])); }
    bf16x8 At[4][2], B0[2][2], B1[2][2];
    v8i_t At8[4], B08[2], B18[2];
    const int sc127 = 0x7f7f7f7f;
    unsigned vA0[2], vA1[2];
#define PG8_SET_VOFF(u) do { if constexpr (GATHER) { _Pragma("unroll") for (int _i = 0; _i < 2; ++_i) { \
                int _R, _C; stage_rc(tid * 16 + _i * 8192, _R, _C); const int _r0 = _R, _r1 = HALF + _R; \
                const int _t0 = _r0 < (u).gn ? g.gidx[(u).ga + _r0] : 0, _t1 = _r1 < (u).gn ? g.gidx[(u).ga + _r1] : 0; \
                vA0[_i] = (unsigned)(_t0 * K + _C) * 2u; vA1[_i] = (unsigned)(_t1 * K + _C) * 2u; } \
        } else { vA0[0] = voffA[0]; vA0[1] = voffA[1]; vA1[0] = voffA[0] + (unsigned)hstep; vA1[1] = voffA[1] + (unsigned)hstep; } } while (0)
    PG8_SET_VOFF(cur);
    const char* cA = GATHER ? (const char*)g.A : (const char*)g.A + (size_t)cur.pm * tstep; const char* cB = (const char*)g.Bt + (size_t)cur.pn * tstep;
    PG8_STAGE(PG8_SB(0, 0), cB, voffB); PG8_STAGE(PG8_SB(0, 1), cB + hstep, voffB); PG8_STAGE(PG8_SA(0, 0), cA, vA0); PG8_STAGE(PG8_SA(0, 1), cA, vA1);
    if (wr == 1) PG8_BAR;
    PG8_WAIT_V(2); PG8_BAR;
    PG8_STAGE(PG8_SB(1, 0), cB + kstep, voffB); PG8_STAGE(PG8_SA(1, 0), cA + kstep, vA0); PG8_STAGE(PG8_SB(1, 1), cB + hstep + kstep, voffB);
    PG8_WAIT_V(6); PG8_BAR;
    for (;;) {
        const bool has_next = S.next(ui + 1, nxt);
        const char* nA = GATHER ? (const char*)g.A : (has_next ? (const char*)g.A + (size_t)nxt.pm * tstep : cA);
        const char* nB = has_next ? (const char*)g.Bt + (size_t)nxt.pn * tstep : cB;
#define PG8_KTRIP(t) do { \
            const bool last = (t == nt - 2); \
            const char* a1 = cA + (size_t)(t + 1) * kstep; \
            const char* a2 = last ? nA : cA + (size_t)(t + 2) * kstep; const char* b2 = last ? nB : cB + (size_t)(t + 2) * kstep; \
            const char* a3 = a2 + kstep; const char* b3 = b2 + kstep; \
            PG8_LDB(B0, 0, 0); PG8_LDB(B1, 0, 1); PG8_SCHED; PG8_LDA(At, 0, 0); PG8_STAGE(PG8_SA(1, 1), a1, vA1); \
            PG8_WAIT_V(8); PG8_WAIT_L(0); PG8_BAR; PG8_MMA(0, 0, At, B0); PG8_MMA(0, 1, At, B1); PG8_BAR; PG8_SCHED; \
            if constexpr (GATHER) { if (last && has_next) PG8_SET_VOFF(nxt); } \
            PG8_LDA(At, 0, 1); PG8_STAGE(PG8_SB(0, 0), b2, voffB); PG8_STAGE(PG8_SB(0, 1), b2 + hstep, voffB); PG8_STAGE(PG8_SA(0, 0), a2, vA0); \
            PG8_WAIT_V(8); PG8_WAIT_L(0); PG8_BAR; PG8_MMA(1, 0, At, B0); PG8_MMA(1, 1, At, B1); PG8_BAR; PG8_SCHED; \
            PG8_LDB(B0, 1, 0); PG8_LDB(B1, 1, 1); PG8_SCHED; PG8_LDA(At, 1, 0); PG8_STAGE(PG8_SA(0, 1), a2, vA1); \
            PG8_WAIT_V(8); PG8_WAIT_L(0); PG8_BAR; PG8_MMA(0, 0, At, B0); PG8_MMA(0, 1, At, B1); PG8_BAR; PG8_SCHED; \
            PG8_LDA(At, 1, 1); PG8_STAGE(PG8_SB(1, 0), b3, voffB); PG8_STAGE(PG8_SB(1, 1), b3 + hstep, voffB); PG8_STAGE(PG8_SA(1, 0), a3, vA0); \
            PG8_WAIT_V(8); PG8_WAIT_L(0); PG8_BAR; PG8_MMA(1, 0, At, B0); PG8_MMA(1, 1, At, B1); PG8_BAR; PG8_SCHED; \
        } while (0)
        if constexpr (Epi::HAS_MID) {
            for (int t = 0; t < (nt >> 1); t += 2) PG8_KTRIP(t);
            E.mid(acc, cur, wr, wc, fr, fq);
            for (int t = (nt >> 1); t < nt; t += 2) PG8_KTRIP(t);
        } else {
            for (int t = 0; t < nt; t += 2) PG8_KTRIP(t);
        }
#undef PG8_KTRIP
        if constexpr (ALIGN_EPI) { if (wr == 0) PG8_BAR; }
        if constexpr (FP8) asm volatile("s_nop 15\n\ts_nop 15" ::: "memory");
        E(acc, cur, wr, wc, fr, fq);
#if defined(DBL) && DBL == 20
        E(acc, cur, wr, wc, fr, fq);
#endif
        if (!has_next) break;
#pragma unroll
        for (int a = 0; a < 2; ++a)
#pragma unroll
            for (int b = 0; b < 2; ++b)
#pragma unroll
                for (int m = 0; m < 4; ++m)
#pragma unroll
                    for (int n = 0; n < 2; ++n) { acc[a][b][m][n] = (f32x4){0.f, 0.f, 0.f, 0.f}; if constexpr (FP8) asm volatile("" : "+v"(acc[a][b][m][n])); }
        cur = nxt; cA = nA; cB = nB; ++ui;
        if constexpr (ALIGN_EPI) { if (wr == 1) PG8_BAR; }
    }
    PG8_WAIT_V(0);
    if constexpr (!ALIGN_EPI) { if (wr == 0) PG8_BAR; }
    PG8_BAR;
#undef PG8_SET_VOFF
#undef PG8_SA
#undef PG8_SB
#undef PG8_STAGE
#undef PG8_LDA
#undef PG8_LD8
#undef PG8_LDB
#undef PG8_MMA
#undef PG8_WAIT_V
#undef PG8_WAIT_L
#undef PG8_BAR
#undef PG8_SCHED
}

struct EpiStore {
    static constexpr bool HAS_MID = false;
    bf16_t* O; int ldc; int ntn;
    DI void operator()(const Acc& acc, const Unit& u, int wr, int wc, int fr, int fq) const {
        const int row0 = u.pm * BM + wr * 64 + fr, col0 = (u.pn % ntn) * BM + wc * 32 + 8 * fq;
#pragma unroll
        for (int ai = 0; ai < 2; ++ai)
#pragma unroll
            for (int m = 0; m < 4; ++m) { bf16_t* rowp = O + (size_t)(row0 + ai * HALF + m * 16) * ldc + col0;
#pragma unroll
                for (int bj = 0; bj < 2; ++bj) { const f32x4 v0 = acc[ai][bj][m][0], v1 = acc[ai][bj][m][1];
                    u32x4 w; w.x = cvtpk(v0[0], v0[1]); w.y = cvtpk(v0[2], v0[3]); w.z = cvtpk(v1[0], v1[1]); w.w = cvtpk(v1[2], v1[3]);
                    *(u32x4*)(rowp + bj * HALF) = w; } }
    }
};
struct EpiProj {
    static constexpr bool HAS_MID = false;
    bf16_t* O; u32x4* GF; int lo, add; float sc;
    DI void operator()(const Acc& acc_, const Unit& u, int wr, int wc, int fr, int fq) const {
        const int pt = u.pn + (u.pn >= lo ? add : 0);
        Acc acc;
#pragma unroll
        for (int a = 0; a < 2; ++a)
#pragma unroll
            for (int b = 0; b < 2; ++b)
#pragma unroll
                for (int m = 0; m < 4; ++m)
#pragma unroll
                    for (int n = 0; n < 2; ++n) acc[a][b][m][n] = acc_[a][b][m][n] * sc;
        if (pt < 28) {
            const int row0 = u.pm * BM + wr * 64 + fr, col0 = pt * BM + wc * 32 + 8 * fq;
#pragma unroll
            for (int ai = 0; ai < 2; ++ai)
#pragma unroll
                for (int m = 0; m < 4; ++m) { bf16_t* rowp = O + (size_t)(row0 + ai * HALF + m * 16) * PP + col0;
#pragma unroll
                    for (int bj = 0; bj < 2; ++bj) { const f32x4 v0 = acc[ai][bj][m][0], v1 = acc[ai][bj][m][1];
                        u32x4 w; w.x = cvtpk(v0[0], v0[1]); w.y = cvtpk(v0[2], v0[3]); w.z = cvtpk(v1[0], v1[1]); w.w = cvtpk(v1[2], v1[3]);
                        *(u32x4*)(rowp + bj * HALF) = w; } }
        } else {
            const int pl = pt - 28, which = pl >> 3, pnl = pl & 7, wave = wr * 4 + wc, lane = fq * 16 + fr;
            u32x4* base = GF + ((size_t)(which * 512 + u.pm * 8 + pnl) * 8 + wave) * 16 * 64 + lane;
#pragma unroll
            for (int ai = 0; ai < 2; ++ai)
#pragma unroll
                for (int m = 0; m < 4; ++m)
#pragma unroll
                    for (int bj = 0; bj < 2; ++bj) { const f32x4 v0 = acc[ai][bj][m][0], v1 = acc[ai][bj][m][1];
                        u32x4 w; w.x = cvtpk(sigmoidf_(v0[0]), sigmoidf_(v0[1])); w.y = cvtpk(sigmoidf_(v0[2]), sigmoidf_(v0[3])); w.z = cvtpk(sigmoidf_(v1[0]), sigmoidf_(v1[1])); w.w = cvtpk(sigmoidf_(v1[2]), sigmoidf_(v1[3]));
                        base[((ai * 4 + m) * 2 + bj) * 64] = w; }
        }
    }
};
struct EpiMerged {
    static constexpr bool HAS_MID = true;
    const u32x4* GF; bf16_t* O;
    DI void mid(Acc& acc, const Unit& u, int wr, int wc, int fr, int fq) const {
        const u32x4* ga = GF + ((size_t)(u.pm * 8 + u.pn) * 8 + (wr * 4 + wc)) * 16 * 64 + (fq * 16 + fr); const u32x4* gb = ga + (size_t)512 * 8 * 16 * 64;
#pragma unroll
        for (int ai = 0; ai < 2; ++ai)
#pragma unroll
            for (int m = 0; m < 4; ++m) {
#pragma unroll
                for (int bj = 0; bj < 2; ++bj) { const u32x4 a = ga[((ai * 4 + m) * 2 + bj) * 64], b = gb[((ai * 4 + m) * 2 + bj) * 64];
                    const float sa[8] = {bflo(a.x), bfhi(a.x), bflo(a.y), bfhi(a.y), bflo(a.z), bfhi(a.z), bflo(a.w), bfhi(a.w)};
                    const float sb[8] = {bflo(b.x), bfhi(b.x), bflo(b.y), bfhi(b.y), bflo(b.z), bfhi(b.z), bflo(b.w), bfhi(b.w)};
#pragma unroll
                    for (int n = 0; n < 2; ++n)
#pragma unroll
                        for (int j = 0; j < 4; ++j) acc[ai][bj][m][n][j] *= sa[4 * n + j] * __builtin_amdgcn_rcpf(sb[4 * n + j]); }
                asm volatile("" ::: "memory"); __builtin_amdgcn_sched_barrier(0); }
    }
    DI void operator()(const Acc& acc, const Unit& u, int wr, int wc, int fr, int fq) const {
        const u32x4* gb = GF + ((size_t)(512 + u.pm * 8 + u.pn) * 8 + (wr * 4 + wc)) * 16 * 64 + (fq * 16 + fr);
        const unsigned oo = (unsigned)((u.pm * BM + wr * 64 + fr) * DM + u.pn * BM + wc * 32 + 8 * fq);
#pragma unroll
        for (int ai = 0; ai < 2; ++ai)
#pragma unroll
            for (int m = 0; m < 4; ++m) {
#pragma unroll
                for (int bj = 0; bj < 2; ++bj) { const u32x4 b = gb[((ai * 4 + m) * 2 + bj) * 64];
                    const float sb[8] = {bflo(b.x), bfhi(b.x), bflo(b.y), bfhi(b.y), bflo(b.z), bfhi(b.z), bflo(b.w), bfhi(b.w)};
                    float v[8];
#pragma unroll
                    for (int n = 0; n < 2; ++n)
#pragma unroll
                        for (int j = 0; j < 4; ++j) v[4 * n + j] = acc[ai][bj][m][n][j] * sb[4 * n + j];
                    u32x4 w; w.x = cvtpk(v[0], v[1]); w.y = cvtpk(v[2], v[3]); w.z = cvtpk(v[4], v[5]); w.w = cvtpk(v[6], v[7]);
                    *(u32x4*)(O + oo + (unsigned)((ai * HALF + m * 16) * DM + bj * HALF)) = w; }
                asm volatile("" ::: "memory"); __builtin_amdgcn_sched_barrier(0); }
    }
};
struct EpiGU {
    static constexpr bool HAS_MID = false;
    bf16_t* H;
    DI void operator()(const Acc& acc, const Unit& u, int wr, int wc, int fr, int fq) const {
        const int row0 = u.pm * BM + wr * 64 + fr, col0 = (u.pn & 3) * HALF + wc * 32 + 8 * fq;
#pragma unroll
        for (int ai = 0; ai < 2; ++ai)
#pragma unroll
            for (int m = 0; m < 4; ++m) { float v[8];
#pragma unroll
                for (int n = 0; n < 2; ++n)
#pragma unroll
                    for (int j = 0; j < 4; ++j) v[4 * n + j] = siluf_(acc[ai][0][m][n][j]) * acc[ai][1][m][n][j];
                u32x4 w; w.x = cvtpk(v[0], v[1]); w.y = cvtpk(v[2], v[3]); w.z = cvtpk(v[4], v[5]); w.w = cvtpk(v[6], v[7]);
                *(u32x4*)(H + (size_t)(row0 + ai * HALF + m * 16) * FF + col0) = w; }
    }
};
struct EpiGU8 {
    static constexpr bool HAS_MID = false;
    unsigned char* H; float inv, sh;
    DI void operator()(const Acc& acc, const Unit& u, int wr, int wc, int fr, int fq) const {
        const unsigned o0 = (unsigned)((u.pm * BM + wr * 64 + fr) * FF + (u.pn & 3) * HALF + wc * 32 + 8 * fq);
#pragma unroll
        for (int ai = 0; ai < 2; ++ai)
#pragma unroll
            for (int m = 0; m < 4; ++m) { float v[8];
#pragma unroll
                for (int n = 0; n < 2; ++n)
#pragma unroll
                    for (int j = 0; j < 4; ++j) v[4 * n + j] = siluf_(acc[ai][0][m][n][j] * inv) * (acc[ai][1][m][n][j] * inv) * sh;
                *(u32x2*)(H + o0 + (unsigned)((ai * HALF + m * 16) * FF)) = (u32x2){cvt4_fp8(v[0], v[1], v[2], v[3]), cvt4_fp8(v[4], v[5], v[6], v[7])};
                asm volatile("" ::: "memory"); }
    }
};
struct EpiStoreS {
    static constexpr bool HAS_MID = false;
    bf16_t* O; int ldc; int ntn; float inv;
    DI void operator()(const Acc& acc, const Unit& u, int wr, int wc, int fr, int fq) const {
        const unsigned o0 = (unsigned)((u.pm * BM + wr * 64 + fr) * ldc + (u.pn % ntn) * BM + wc * 32 + 8 * fq);
#pragma unroll
        for (int ai = 0; ai < 2; ++ai)
#pragma unroll
            for (int m = 0; m < 4; ++m) {
#pragma unroll
                for (int bj = 0; bj < 2; ++bj) { const f32x4 v0 = acc[ai][bj][m][0] * inv, v1 = acc[ai][bj][m][1] * inv;
                    u32x4 w; w.x = cvtpk(v0[0], v0[1]); w.y = cvtpk(v0[2], v0[3]); w.z = cvtpk(v1[0], v1[1]); w.w = cvtpk(v1[2], v1[3]);
                    *(u32x4*)(O + o0 + (unsigned)((ai * HALF + m * 16) * ldc + bj * HALF)) = w; }
                asm volatile("" ::: "memory"); }
    }
};
}

namespace moba {
constexpr int NW = 8, QBLK = 32, KVBLK = 64, QB = NW * QBLK, D = 128;
constexpr int RS = PP;
constexpr int RSO = DM;
constexpr float SCALE = 0.08838834764831845f;
constexpr float THR = 8.f;
constexpr int SHM_V = KVBLK * D * 2, SHM_K = KVBLK * D * 2;
constexpr int LDS_BYTES = 2 * SHM_V + 2 * SHM_K + NW * 64 * 4;
typedef bf16_t bf16;
#define KSWZ(row, colB) ((row) * 256 + ((colB) ^ (((row) & 7) << 4)))
#define SBAR() __builtin_amdgcn_sched_barrier(0)
DI int v_st(int k, int c) { const int kk = (k & ~0xC) | ((k & 4) << 1) | ((k & 8) >> 1); return ((kk >> 3) * 4 + (c >> 5)) * 512 + ((kk & 7) * 32 + (c & 31)) * 2; }
DI int v_rd_base(int lane) { return ((lane & 3) << 3) | (((lane >> 2) & 3) << 6) | (((lane >> 4) & 1) << 5) | (((lane >> 5) & 1) << 8); }
constexpr int v_rd_off(int d0, int ks, int half) { return d0 * 512 + ks * 4096 + half * 2048; }
DI bf16x8 load8(const bf16* p) { return *reinterpret_cast<const bf16x8*>(p); }
DI void mask_tile(f32x16& p0, f32x16& p1, int dq) {
    const float NEG = -__builtin_inff();
#pragma unroll
    for (int r = 0; r < 16; ++r) {
        const int c = (r & 3) + 8 * (r >> 2);
        if (dq - c < 0) p0[r] = NEG;
        if (dq - c - 32 < 0) p1[r] = NEG;
    }
}
DI void mask_all(f32x16& p0, f32x16& p1, bool kill) {
    const float NEG = -__builtin_inff();
#pragma unroll
    for (int r = 0; r < 16; ++r) { if (kill) p0[r] = NEG; if (kill) p1[r] = NEG; }
}
DI void partialSM(f32x16& p0, f32x16& p1, float& m_reg, float& mn, float& alpha) {
    float pmax = p0[0];
#pragma unroll
    for (int r = 1; r < 16; ++r) pmax = fmaxf(pmax, p0[r]);
#pragma unroll
    for (int r = 0; r < 16; ++r) pmax = fmaxf(pmax, p1[r]);
    { auto rr = __builtin_amdgcn_permlane32_swap(__float_as_uint(pmax), __float_as_uint(pmax), false, false);
      pmax = fmaxf(__uint_as_float(rr[0]), __uint_as_float(rr[1])); }
    constexpr float C2 = 1.4426950408889634f * SCALE;
    if (__builtin_expect(__all((pmax - m_reg) * SCALE <= THR), 1)) { mn = m_reg; alpha = 1.f; }
    else { mn = fmaxf(m_reg, pmax); alpha = __builtin_amdgcn_exp2f((m_reg - mn) * C2); m_reg = mn; }
    const float mnL = -mn * C2;
#pragma unroll
    for (int r = 0; r < 16; ++r) p0[r] = fmaf(p0[r], C2, mnL);
#pragma unroll
    for (int r = 0; r < 16; ++r) p1[r] = fmaf(p1[r], C2, mnL);
#pragma unroll
    for (int r = 0; r < 16; ++r) p0[r] = __builtin_amdgcn_exp2f(p0[r]);
}
DI void finishSM(f32x16& p0, f32x16& p1, float alpha, float& l_reg, bf16x8& pa0, bf16x8& pa1, bf16x8& pa2, bf16x8& pa3) {
#pragma unroll
    for (int r = 0; r < 16; ++r) p1[r] = __builtin_amdgcn_exp2f(p1[r]);
    float ps = 0;
#pragma unroll
    for (int r = 0; r < 16; ++r) ps += p0[r];
#pragma unroll
    for (int r = 0; r < 16; ++r) ps += p1[r];
    { auto rr = __builtin_amdgcn_permlane32_swap(__float_as_uint(ps), __float_as_uint(ps), false, false);
      ps = __uint_as_float(rr[0]) + __uint_as_float(rr[1]); }
    l_reg = l_reg * alpha + ps;
#define PK4(P, B_, OUT) do { unsigned a0 = cvtpk(P[B_+0], P[B_+1]), a1 = cvtpk(P[B_+2], P[B_+3]);                          \
        unsigned b0 = cvtpk(P[B_+4], P[B_+5]), b1 = cvtpk(P[B_+6], P[B_+7]);                                             \
        auto r0 = __builtin_amdgcn_permlane32_swap(a0, b0, false, false); auto r1 = __builtin_amdgcn_permlane32_swap(a1, b1, false, false); \
        u32x4 w = {r0[0], r1[0], r0[1], r1[1]}; OUT = __builtin_bit_cast(bf16x8, w); } while (0)
    PK4(p0, 0, pa0); PK4(p0, 8, pa1); PK4(p1, 0, pa2); PK4(p1, 8, pa3);
#undef PK4
}
template <int KB>
DI void qkt(f32x16& p0, f32x16& p1, const char* K_lds, int r32, int hi, const bf16x8* qr) {
    p0 = f32x16{}; p1 = f32x16{};
    const char* kb[4];
#pragma unroll
    for (int dd = 0; dd < 4; ++dd) kb[dd] = K_lds + KB * SHM_K + KSWZ(r32, (dd * 16 + hi * 8) * 2);
#pragma unroll
    for (int d0 = 0; d0 < 8; ++d0) { const char* a = kb[d0 & 3] + (d0 >> 2) * 128;
        bf16x8 b0 = *reinterpret_cast<const bf16x8*>(a);
        bf16x8 b1 = *reinterpret_cast<const bf16x8*>(a + 32 * 256);
        p0 = MFMA32(b0, qr[d0], p0);
        p1 = MFMA32(b1, qr[d0], p1); }
}
template <int VB>
DI void pv_tile(f32x16* o, int vb0, bf16x8 pa0, bf16x8 pa1, bf16x8 pa2, bf16x8 pa3) {
#define TRRD(dst, off) asm volatile("ds_read_b64_tr_b16 %0, %1 offset:%2" : "=&v"(dst) : "v"(vb0), "i"(off) : "memory")
#define PV_D0(d0) do { s16x4 l0, l1, l2, l3, h0, h1, h2, h3; constexpr int b_ = VB * SHM_V + v_rd_off(d0, 0, 0); \
        TRRD(l0, b_); TRRD(h0, b_ + 2048); TRRD(l1, b_ + 4096); TRRD(h1, b_ + 6144); TRRD(l2, b_ + 8192); TRRD(h2, b_ + 10240); TRRD(l3, b_ + 12288); TRRD(h3, b_ + 14336); \
        asm volatile("s_waitcnt lgkmcnt(0)" ::: "memory"); SBAR();   \
        o[d0] = MFMA32(pa0, ((bf16x8){l0[0], l0[1], l0[2], l0[3], h0[0], h0[1], h0[2], h0[3]}), o[d0]);   \
        o[d0] = MFMA32(pa1, ((bf16x8){l1[0], l1[1], l1[2], l1[3], h1[0], h1[1], h1[2], h1[3]}), o[d0]);   \
        o[d0] = MFMA32(pa2, ((bf16x8){l2[0], l2[1], l2[2], l2[3], h2[0], h2[1], h2[2], h2[3]}), o[d0]);   \
        o[d0] = MFMA32(pa3, ((bf16x8){l3[0], l3[1], l3[2], l3[3], h3[0], h3[1], h3[2], h3[3]}), o[d0]); } while (0)
    PV_D0(0); PV_D0(1); PV_D0(2); PV_D0(3);
#undef PV_D0
#undef TRRD
}

struct BlockRef { const bf16* Q; const bf16* K; const bf16* V; bf16* O; const bf16* KM; int P0; };
struct Seam { bf16x8 qr[8]; bf16x8 st_v0, st_v1, st_k0, st_k1; };
#define VMW() asm volatile("s_waitcnt vmcnt(0)" ::: "memory")
#define VMWN(n) asm volatile("s_waitcnt vmcnt(%0)" :: "i"(n) : "memory")
#define SLOAD_H(Kp, Vp, k0) do { const bf16* kb__ = (Kp) + (size_t)(k0) * RS; const bf16* vb__ = (Vp) + (size_t)(k0) * RS;              \
                         S.st_v0 = load8(vb__ + goff); S.st_v1 = load8(vb__ + 32 * RS + goff);              \
                         S.st_k0 = load8(kb__ + goff); S.st_k1 = load8(kb__ + 32 * RS + goff); } while (0)
#define SWRITE_HK(bf) do { *(bf16x8*)(K_lds + (bf) * SHM_K + kws) = S.st_k0; *(bf16x8*)(K_lds + (bf) * SHM_K + kws + 32 * 256) = S.st_k1; } while (0)
#define SWRITE_HV(bf) do { *(bf16x8*)(V_lds + (bf) * SHM_V + vst0) = S.st_v0; *(bf16x8*)(V_lds + (bf) * SHM_V + vst1) = S.st_v1; } while (0)
#define SWRITE_H(bf) do { SWRITE_HV(bf); SWRITE_HK(bf); } while (0)
DI void prime(const BlockRef& cur, char* lds, Seam& S) {
    const int tid = threadIdx.x, wid = __builtin_amdgcn_readfirstlane(tid >> 6), lane = tid & 63, r32 = lane & 31, hi = lane >> 5;
    const int sr = tid >> 4, sc = (tid & 15) * 8, kws = KSWZ(sr, sc * 2); char* K_lds = lds + 2 * SHM_V;
    const unsigned goff = (unsigned)(sr * RS + sc), qoff = (unsigned)(r32 * RS + hi * 8);
    { const bf16* qb__ = cur.Q + (size_t)(wid * QBLK) * RS;
#pragma unroll
    for (int d0 = 0; d0 < 8; ++d0) S.qr[d0] = load8(qb__ + qoff + d0 * 16); }
    SLOAD_H(cur.K, cur.V, 0); VMW(); SWRITE_HK(0);
    __syncthreads();
}
DI void block(const BlockRef& cur, const BlockRef& nxt, char* lds, Seam& S) {
    int tid_ = threadIdx.x; asm volatile("" : "+v"(tid_));
    const int tid = tid_, wid = __builtin_amdgcn_readfirstlane(tid >> 6), lane = tid & 63, r32 = lane & 31, hi = lane >> 5;
    const int NT = (cur.P0 + QB) / KVBLK;
    const int qb = cur.P0 / QB;
    const int qlo = cur.P0 + wid * QBLK, qm = qlo + r32 - 4 * hi;
    char* V_lds = lds; char* K_lds = lds + 2 * SHM_V;
    float* ws = (float*)(lds + 2 * SHM_V + 2 * SHM_K) + wid * 64; float* li_l = ws, * al_l = ws + 32;
    unsigned selmask = (1u << qb) - 1u;
    if (qb > 3) {
        f32x16 g0 = f32x16{};
#pragma unroll
        for (int d0 = 0; d0 < 8; ++d0) {
            bf16x8 a = (bf16x8){0, 0, 0, 0, 0, 0, 0, 0};
            if (r32 < 8) a = load8(cur.KM + r32 * D + d0 * 16 + hi * 8);
            g0 = MFMA32(a, S.qr[d0], g0);
        }
        float gt[8];
#pragma unroll
        for (int j = 0; j < 4; ++j) { const float mine = g0[j], oth = __shfl_xor(mine, 32); gt[j] = hi ? oth : mine; gt[4 + j] = hi ? mine : oth; }
        selmask = 0u;
#pragma unroll
        for (int i = 0; i < 8; ++i) { int rank = 0;
#pragma unroll
            for (int j = 0; j < 8; ++j) { if (j != i) { const bool beats = (gt[j] > gt[i]) || (gt[j] == gt[i] && j < i); rank += (j < qb && beats) ? 1 : 0; } }
            if (i < qb && rank < 3) selmask |= (1u << i); }
    }
    float m_reg = -1e30f, l_reg = 0; f32x16 o[4] = {};
    const int sr = tid >> 4, sc = (tid & 15) * 8, vst0 = v_st(sr, sc), vst1 = v_st(32 + sr, sc), kws = KSWZ(sr, sc * 2);
    const unsigned goff = (unsigned)(sr * RS + sc), qoff = (unsigned)(r32 * RS + hi * 8);
    const int vb0 = (int)(uintptr_t)V_lds + v_rd_base(lane);
    const bf16* Kh = cur.K; const bf16* Vh = cur.V;
#define RESC(a) do { if (__any((a) < 1.f)) { if (hi == 0) al_l[r32] = (a); asm volatile("s_waitcnt lgkmcnt(0)" ::: "memory");              \
                     _Pragma("unroll") for (int d_ = 0; d_ < 4; ++d_) _Pragma("unroll") for (int r = 0; r < 16; ++r) o[d_][r] *= al_l[crow(r, hi)]; } } while (0)
#define KBASE(t) ((t) * KVBLK)
#define MASKT(P0_, P1_, t) do { const int kb_ = KBASE(t); const int kblk_ = (t) >> 2; \
        if (kblk_ < qb) { if (qb > 3) mask_all(P0_, P1_, ((selmask >> kblk_) & 1u) == 0u); } \
        else if (kb_ + KVBLK - 1 > qlo) mask_tile(P0_, P1_, qm - kb_); } while (0)
    constexpr int NQL = 8;
#define SEAM_K0() do { VMWN(NQL); SWRITE_HK(0); SBAR(); } while (0)
    f32x16 pA0, pA1, pB0, pB1; float mnA, mnB, alA, alB; bf16x8 pa0, pa1, pa2, pa3;
    SWRITE_HV(0); SBAR();
    if (NT > 1) { SLOAD_H(Kh, Vh, KBASE(1)); }
    SBAR(); qkt<0>(pA0, pA1, K_lds, r32, hi, S.qr);
    MASKT(pA0, pA1, 0); partialSM(pA0, pA1, m_reg, mnA, alA);
    if (NT > 1) { VMW(); SWRITE_H(1); }
    __syncthreads();
#define HALF_STEP(PX0, PX1, mnX, alX, PY0, PY1, alY, t, KB, VB, SB) do {                                                      \
        SBAR(); qkt<KB>(PX0, PX1, K_lds, r32, hi, S.qr);                                             \
        finishSM(PY0, PY1, alY, l_reg, pa0, pa1, pa2, pa3); SBAR();                                                           \
        if ((t) + 1 < NT) { SLOAD_H(Kh, Vh, KBASE((t) + 1)); SBAR(); }                                               \
        pv_tile<VB>(o, vb0, pa0, pa1, pa2, pa3); MASKT(PX0, PX1, (t)); partialSM(PX0, PX1, m_reg, mnX, alX);                                        \
        __syncthreads();                                                                                                      \
        if ((t) + 1 < NT) { VMW(); SWRITE_H(SB); }                                                                          \
        RESC(alX); __syncthreads(); } while (0)
    for (int t = 1; t + 1 < NT; t += 2) {
        HALF_STEP(pB0, pB1, mnB, alB, pA0, pA1, alA, t, 1, 0, 0);
        HALF_STEP(pA0, pA1, mnA, alA, pB0, pB1, alB, t + 1, 0, 1, 1);
    }
    const bool even = (NT & 1) == 0;
    if (even) { SBAR(); qkt<1>(pB0, pB1, K_lds, r32, hi, S.qr); SBAR(); }
    { SLOAD_H(nxt.K, nxt.V, 0); SBAR();
      const bf16* qb__ = nxt.Q + (size_t)(wid * QBLK) * RS;
#pragma unroll
      for (int d0 = 0; d0 < 8; ++d0) S.qr[d0] = load8(qb__ + qoff + d0 * 16); }
    SBAR();
    finishSM(pA0, pA1, alA, l_reg, pa0, pa1, pa2, pa3); SBAR();
    pv_tile<0>(o, vb0, pa0, pa1, pa2, pa3);
    if (even) { MASKT(pB0, pB1, NT - 1); partialSM(pB0, pB1, m_reg, mnB, alB); __syncthreads(); RESC(alB);
        finishSM(pB0, pB1, alB, l_reg, pa0, pa1, pa2, pa3); SBAR(); pv_tile<1>(o, vb0, pa0, pa1, pa2, pa3); }
    SBAR(); SEAM_K0();
    if (hi == 0) li_l[r32] = l_reg; asm volatile("s_waitcnt lgkmcnt(0)" ::: "memory");
    float rli[16];
#pragma unroll
    for (int r = 0; r < 16; ++r) rli[r] = __builtin_amdgcn_rcpf(li_l[crow(r, hi)]);
    bf16* Ow = cur.O + (size_t)(wid * QBLK) * RSO;
    const unsigned ooff = (unsigned)(4 * hi * RSO + r32);
#pragma unroll
    for (int r = 0; r < 16; ++r) { const int orow0 = (r & 3) + 8 * (r >> 2);
#pragma unroll
        for (int d0 = 0; d0 < 4; ++d0) { const float v = o[d0][r] * rli[r];
            const float vn = __shfl_xor(v, 1);
            if ((r32 & 1) == 0) *(unsigned*)(Ow + ooff + (unsigned)(orow0 * RSO + d0 * 32)) = cvtpk(v, vn); } }
    __syncthreads();
#undef RESC
#undef KBASE
#undef MASKT
#undef SEAM_K0
#undef HALF_STEP
}
#undef VMW
#undef VMWN
#undef SLOAD_H
#undef SWRITE_HK
#undef SWRITE_HV
#undef SWRITE_H
#undef KSWZ
#undef SBAR
}

namespace dn {
#ifndef DBL
#define DBL -1
#endif
#define REPS(k) for (int rep_ = 0; rep_ < ((DBL == (k)) ? 2 : 1); ++rep_)
constexpr int L_QB = 0, L_KB = 17408, L_KT = 34816, L_VT = 53248, L_LM = 71680, L_TB = 89088, L_GV = 107520;
constexpr int RQ = 272, LMS = 68, RT = 144;

struct ConvW { f32x2 w[3][4]; float aexp, dtb; };
DI void prep_consts(const Params& p, int h, ConvW& C, int lane) {
#pragma unroll
    for (int seg = 0; seg < 3; ++seg)
#pragma unroll
        for (int j = 0; j < 4; ++j) C.w[seg][j] = *(const f32x2*)(p.conv_w + j * 3072 + seg * 1024 + h * HD + 2 * lane);
    C.aexp = -expf(p.a_log[h]); C.dtb = p.dt_bias[h];
}
struct Raw { unsigned v[33]; float br, ar; };
DI void prep_load(const Params& p, int item, Raw& R, int lane, int wave) {
    const int bh = item >> 5, n = item & 31, b = bh >> 3, h = bh & 7, i0 = wave * 8, c0 = 2 * lane;
    const bf16_t* PROJ = (const bf16_t*)(p.ws + WS_B);
#pragma unroll
    for (int seg = 0; seg < 3; ++seg)
#pragma unroll
        for (int jj = 0; jj < 11; ++jj) {
            const int sp = n * 64 + i0 - 3 + jj;
            unsigned v = 0u;
            if (sp >= 0) v = *(const unsigned*)(PROJ + (size_t)(b * SEQ + sp) * PP + C_DN + seg * 1024 + h * HD + c0);
            R.v[seg * 11 + jj] = v;
        }
    R.br = 0.f; R.ar = 0.f;
    if (wave == 0) { const float* BA = (const float*)(p.ws + WS_BA); const size_t t = (size_t)(b * SEQ + n * 64 + lane);
        R.br = BA[t * 16 + h]; R.ar = BA[t * 16 + 8 + h]; }
}
#define DN_BAR() do { asm volatile("s_waitcnt lgkmcnt(0)" ::: "memory"); __builtin_amdgcn_s_barrier(); asm volatile("" ::: "memory"); } while (0)
DI void prep_chunk(const Params& p, LAS unsigned char* lds, int item, int nitem, Raw& R, const ConvW& CW, int tid, int lane, int wave) {
    asm volatile("" : "+v"(tid), "+v"(lane));
    const int bh = item >> 5, n = item & 31, b = bh >> 3, h = bh & 7;
    unsigned char* rec = p.ws + WS_DNP + (size_t)item * DN_STRIDE;
    LAS float* LM = (LAS float*)(lds + L_LM);
    LAS float* GV = (LAS float*)(lds + L_GV);
    REPS(31) {
        const int i0 = wave * 8, c0 = 2 * lane;
#pragma unroll
        for (int seg = 0; seg < 3; ++seg) {
            float w0[4], w1[4];
#pragma unroll
            for (int j = 0; j < 4; ++j) { w0[j] = CW.w[seg][j].x; w1[j] = CW.w[seg][j].y; }
            float r0[11], r1[11];
#pragma unroll
            for (int jj = 0; jj < 11; ++jj) { const unsigned v = R.v[seg * 11 + jj]; r0[jj] = bflo(v); r1[jj] = bfhi(v); }
            float ya[8], yb[8];
#pragma unroll
            for (int i = 0; i < 8; ++i) {
                float y0 = 0.f, y1 = 0.f;
#pragma unroll
                for (int j = 0; j < 4; ++j) { y0 += w0[j] * r0[i + j]; y1 += w1[j] * r1[i + j]; }
                ya[i] = siluf_(y0); yb[i] = siluf_(y1);
            }
            if (seg < 2) {
                float ss[8];
#pragma unroll
                for (int i = 0; i < 8; ++i) ss[i] = ya[i] * ya[i] + yb[i] * yb[i];
#pragma unroll
                for (int o = 1; o < 64; o <<= 1) { float t[8];
#pragma unroll
                    for (int i = 0; i < 8; ++i) t[i] = __shfl_xor(ss[i], o);
#pragma unroll
                    for (int i = 0; i < 8; ++i) ss[i] += t[i]; }
#pragma unroll
                for (int i = 0; i < 8; ++i) { const float rn = (seg == 0 ? SCALE_Q : 1.0f) * rsqrt_(ss[i] + EPS); ya[i] *= rn; yb[i] *= rn;
                    *(LAS unsigned*)(lds + (seg == 0 ? L_QB : L_KB) + (i0 + i) * RQ + c0 * 2) = cvtpk(ya[i], yb[i]); }
            }
            if (seg >= 1) {
                LAS unsigned char* tb = lds + (seg == 1 ? L_KT : L_VT) + c0 * RT + i0 * 2;
                u32x4 o0, o1;
                o0.x = cvtpk(ya[0], ya[1]); o0.y = cvtpk(ya[2], ya[3]); o0.z = cvtpk(ya[4], ya[5]); o0.w = cvtpk(ya[6], ya[7]);
                o1.x = cvtpk(yb[0], yb[1]); o1.y = cvtpk(yb[2], yb[3]); o1.z = cvtpk(yb[4], yb[5]); o1.w = cvtpk(yb[6], yb[7]);
                *(LAS u32x4*)tb = o0; *(LAS u32x4*)(tb + RT) = o1;
            }
        }
        if (wave == 0) {
            const float br = R.br, ar = R.ar;
            const float beta = sigmoidf_(br);
            const float xs = ar + CW.dtb;
            const float sp = xs > 20.f ? xs : log1pf(expf(xs));
            float g = CW.aexp * sp;
#pragma unroll
            for (int o = 1; o < 64; o <<= 1) { const float u = __shfl_up(g, o); if (lane >= o) g += u; }
            const float g63 = __shfl(g, 63);
            GV[lane] = g; GV[64 + lane] = beta; GV[128 + lane] = expf(g); GV[192 + lane] = expf(g63 - g);
        }
    }
    if (nitem >= 0) prep_load(p, nitem, R, lane, wave);
    DN_BAR();
    REPS(32) {
        const int mt = wave >> 1, nt = wave & 1, r = lane & 31, hi = lane >> 5;
        if (mt < 2) {
            const LAS unsigned char* Ab = lds + L_KB + (32 * nt + r) * RQ, * Bb = lds + L_QB + (32 * mt + r) * RQ;
            f32x16 acc = f32x16{};
#pragma unroll
            for (int ks = 0; ks < 8; ++ks) acc = MFMA32(*(const LAS bf16x8*)(Ab + (16 * ks + 8 * hi) * 2), *(const LAS bf16x8*)(Bb + (16 * ks + 8 * hi) * 2), acc);
            const int i = 32 * mt + r; const float Gi = GV[i];
            float v[16];
#pragma unroll
            for (int q = 0; q < 16; ++q) { const int j = 32 * nt + crow(q, hi); v[q] = i >= j ? acc[q] * __expf(Gi - GV[j]) : 0.f; }
            u32x4* QKf = (u32x4*)(rec + DN_QK) + ((mt * 4 + 2 * nt) * 64 + lane);
            u32x4 o0, o1;
            o0.x = cvtpk(v[0], v[1]); o0.y = cvtpk(v[2], v[3]); o0.z = cvtpk(v[4], v[5]); o0.w = cvtpk(v[6], v[7]);
            o1.x = cvtpk(v[8], v[9]); o1.y = cvtpk(v[10], v[11]); o1.z = cvtpk(v[12], v[13]); o1.w = cvtpk(v[14], v[15]);
            QKf[0] = o0; QKf[64] = o1;
        } else {
            const LAS unsigned char* Ab = lds + L_KB + (32 * (mt - 2) + r) * RQ, * Bb = lds + L_KB + (32 * nt + r) * RQ;
            f32x16 acc = f32x16{};
#pragma unroll
            for (int ks = 0; ks < 8; ++ks) acc = MFMA32(*(const LAS bf16x8*)(Ab + (16 * ks + 8 * hi) * 2), *(const LAS bf16x8*)(Bb + (16 * ks + 8 * hi) * 2), acc);
            const int j = 32 * nt + r; const float Gj = GV[j];
#pragma unroll
            for (int q = 0; q < 16; ++q) { const int row = 32 * (mt - 2) + crow(q, hi);
                const float e = row > j ? GV[64 + row] * __expf(GV[row] - Gj) : 0.f;
                LM[row * LMS + j] = acc[q] * e; }
        }
    }
    DN_BAR();
    REPS(33) {
        float Lr[64];
#pragma unroll
        for (int jq = 0; jq < 16; ++jq) { const f32x4 l = *(const LAS f32x4*)(LM + lane * LMS + 4 * jq); Lr[4 * jq] = l.x; Lr[4 * jq + 1] = l.y; Lr[4 * jq + 2] = l.z; Lr[4 * jq + 3] = l.w; }
        float xv[8];
#pragma unroll
        for (int q = 0; q < 8; ++q) xv[q] = (lane == 8 * wave + q) ? 1.0f : 0.0f;
#pragma unroll
        for (int j = 0; j < 63; ++j) {
#pragma unroll
            for (int q = 0; q < 8; ++q) { const float xj = __int_as_float(__builtin_amdgcn_readlane(__float_as_int(xv[q]), j)); xv[q] -= Lr[j] * xj; }
        }
        float t1[8], t2[8];
#pragma unroll
        for (int q = 0; q < 8; ++q) { const float bc = GV[64 + 8 * wave + q]; t1[q] = xv[q] * bc; t2[q] = t1[q] * GV[128 + 8 * wave + q]; }
        u32x4 o1, o2;
        o1.x = cvtpk(t1[0], t1[1]); o1.y = cvtpk(t1[2], t1[3]); o1.z = cvtpk(t1[4], t1[5]); o1.w = cvtpk(t1[6], t1[7]);
        o2.x = cvtpk(t2[0], t2[1]); o2.y = cvtpk(t2[2], t2[3]); o2.z = cvtpk(t2[4], t2[5]); o2.w = cvtpk(t2[6], t2[7]);
        *(LAS u32x4*)(lds + L_TB + lane * RT + wave * 16) = o1; *(LAS u32x4*)(lds + L_TB + 64 * RT + lane * RT + wave * 16) = o2;
    }
    DN_BAR();
    REPS(34) {
        const int r = lane & 31, hi = lane >> 5;
#pragma unroll
        for (int half = 0; half < 2; ++half) {
            const int tix = wave * 2 + half;
            f32x16 acc = f32x16{};
            if (tix < 8) {
                const int mt = tix >> 2, nt = tix & 3;
                const LAS unsigned char* Ab = lds + L_TB + (32 * mt + r) * RT + 16 * hi, * Bb = lds + L_VT + (32 * nt + r) * RT + 16 * hi;
#pragma unroll
                for (int ks = 0; ks < 4; ++ks) acc = MFMA32(*(const LAS bf16x8*)(Ab + 32 * ks), *(const LAS bf16x8*)(Bb + 32 * ks), acc);
                u32x4* Uf = (u32x4*)(rec + DN_U) + ((mt * 4 + nt) * 64 + lane) * 2;
                u32x4 o0, o1;
                o0.x = cvtpk(acc[0], acc[1]); o0.y = cvtpk(acc[2], acc[3]); o0.z = cvtpk(acc[4], acc[5]); o0.w = cvtpk(acc[6], acc[7]);
                o1.x = cvtpk(acc[8], acc[9]); o1.y = cvtpk(acc[10], acc[11]); o1.z = cvtpk(acc[12], acc[13]); o1.w = cvtpk(acc[14], acc[15]);
                Uf[0] = o0; Uf[1] = o1;
            } else {
                const int ntp = (tix - 8) >> 1, mt = tix & 1;
                const LAS unsigned char* Ab = lds + L_KT + (32 * ntp + r) * RT + 16 * hi, * Bb = lds + L_TB + 64 * RT + (32 * mt + r) * RT + 16 * hi;
#pragma unroll
                for (int ks = 0; ks < 4; ++ks) acc = MFMA32(*(const LAS bf16x8*)(Ab + 32 * ks), *(const LAS bf16x8*)(Bb + 32 * ks), acc);
                u32x4* Wf = (u32x4*)(rec + DN_W) + ((mt * 8 + 2 * ntp) * 64 + lane);
                u32x4 o0, o1;
                o0.x = cvtpk(-acc[0], -acc[1]); o0.y = cvtpk(-acc[2], -acc[3]); o0.z = cvtpk(-acc[4], -acc[5]); o0.w = cvtpk(-acc[6], -acc[7]);
                o1.x = cvtpk(-acc[8], -acc[9]); o1.y = cvtpk(-acc[10], -acc[11]); o1.z = cvtpk(-acc[12], -acc[13]); o1.w = cvtpk(-acc[14], -acc[15]);
                Wf[0] = o0; Wf[64] = o1;
            }
        }
#pragma unroll
        for (int rep = 0; rep < 2; ++rep) {
            const int f = tid + 512 * rep, mt = f >> 9, ks = (f >> 6) & 7, fr = f & 31, fh = (f >> 5) & 1, i = 32 * mt + fr;
            const LAS unsigned char* qp = lds + L_QB + i * RQ + (16 * ks + 4 * fh) * 2;
            const u32x2 a = *(const LAS u32x2*)qp, c = *(const LAS u32x2*)(qp + 16);
            const float e = GV[128 + i];
            u32x4 o; o.x = cvtpk(bflo(a.x) * e, bfhi(a.x) * e); o.y = cvtpk(bflo(a.y) * e, bfhi(a.y) * e); o.z = cvtpk(bflo(c.x) * e, bfhi(c.x) * e); o.w = cvtpk(bflo(c.y) * e, bfhi(c.y) * e);
            ((u32x4*)(rec + DN_QD))[f] = o;
        }
#pragma unroll
        for (int rep = 0; rep < 2; ++rep) {
            const int f = tid + 512 * rep, a4 = f >> 8, ks = (f >> 6) & 3, fr = f & 31, fh = (f >> 5) & 1, d = 32 * a4 + fr;
            const LAS unsigned char* kp = lds + L_KT + d * RT + (16 * ks + 4 * fh) * 2;
            const u32x2 a = *(const LAS u32x2*)kp, c = *(const LAS u32x2*)(kp + 16);
            const LAS float* eg = GV + 192 + 16 * ks + 4 * fh;
            u32x4 o; o.x = cvtpk(bflo(a.x) * eg[0], bfhi(a.x) * eg[1]); o.y = cvtpk(bflo(a.y) * eg[2], bfhi(a.y) * eg[3]);
            o.z = cvtpk(bflo(c.x) * eg[8], bfhi(c.x) * eg[9]); o.w = cvtpk(bflo(c.y) * eg[10], bfhi(c.y) * eg[11]);
            ((u32x4*)(rec + DN_KT))[f] = o;
        }
        if (tid == 0) *(float*)(rec + DN_SC) = GV[128 + 63];
    }
    DN_BAR();
}

DI bf16x8 pack_step(const f32x16& x, int s) {
    u32x4 w;
    if (s == 0) { w.x = cvtpk(x[0], x[1]); w.y = cvtpk(x[2], x[3]); w.z = cvtpk(x[4], x[5]); w.w = cvtpk(x[6], x[7]); }
    else { w.x = cvtpk(x[8], x[9]); w.y = cvtpk(x[10], x[11]); w.z = cvtpk(x[12], x[13]); w.w = cvtpk(x[14], x[15]); }
    return __builtin_bit_cast(bf16x8, w);
}

constexpr int RB = 57344;
constexpr int ORS = 272, OB = 64 * ORS;
DI void recur(const Params& p, LAS unsigned char* lds, int bh, int tid, int lane, int wave) {
    asm volatile("" : "+v"(tid), "+v"(lane));
    const int r = lane & 31, hi = lane >> 5, b = bh >> 3, h = bh & 7;
    const unsigned char* rec0 = p.ws + WS_DNP + (size_t)(bh * 32) * DN_STRIDE;
    if (wave >= 4) {
        const int lt = tid - 256;
        const int fg = lt & 7, fr2 = lt >> 3;
        const bf16_t* PROJ = (const bf16_t*)(p.ws + WS_B); bf16_t* YAB = (bf16_t*)(p.ws + WS_A);
        f32x4 g4[4];
#pragma unroll
        for (int j = 0; j < 4; ++j) g4[j] = *(const f32x4*)(p.dn_gain + fg * 16 + 4 * j);
        const bf16_t* zb = PROJ + (size_t)(b * SEQ) * PP + C_Z + h * HD + fg * 16; bf16_t* yb = YAB + (size_t)(b * SEQ) * DM + 1024 + h * HD + fg * 16;
        u32x4 zr[2][2];
#define DN_ZLOAD(n_) do { _Pragma("unroll") for (int ps = 0; ps < 2; ++ps) { const bf16_t* zp = zb + (size_t)((n_) * 64 + fr2 + 32 * ps) * PP; zr[ps][0] = *(const u32x4*)zp; zr[ps][1] = *(const u32x4*)(zp + 8); } } while (0)
#define DN_FINAL(n_) do { const LAS unsigned char* ob = lds + 2 * RB + ((n_) & 1) * OB; \
        _Pragma("unroll") for (int ps = 0; ps < 2; ++ps) { const int row = fr2 + 32 * ps; \
            const u32x4 o0 = *(const LAS u32x4*)(ob + row * ORS + fg * 32), o1 = *(const LAS u32x4*)(ob + row * ORS + fg * 32 + 16); \
            float ov[16] = {bflo(o0.x), bfhi(o0.x), bflo(o0.y), bfhi(o0.y), bflo(o0.z), bfhi(o0.z), bflo(o0.w), bfhi(o0.w), bflo(o1.x), bfhi(o1.x), bflo(o1.y), bfhi(o1.y), bflo(o1.z), bfhi(o1.z), bflo(o1.w), bfhi(o1.w)}; \
            float ss = 0.f; _Pragma("unroll") for (int e = 0; e < 16; ++e) ss += ov[e] * ov[e]; \
            ss += __shfl_xor(ss, 1); ss += __shfl_xor(ss, 2); ss += __shfl_xor(ss, 4); \
            const float rstd = rsqrt_(ss * (1.0f / HD) + EPS); \
            const u32x4 z0 = zr[ps][0], z1 = zr[ps][1]; \
            const float zz[16] = {bflo(z0.x), bfhi(z0.x), bflo(z0.y), bfhi(z0.y), bflo(z0.z), bfhi(z0.z), bflo(z0.w), bfhi(z0.w), bflo(z1.x), bfhi(z1.x), bflo(z1.y), bfhi(z1.y), bflo(z1.z), bfhi(z1.z), bflo(z1.w), bfhi(z1.w)}; \
            float y[16]; _Pragma("unroll") for (int e = 0; e < 16; ++e) y[e] = ov[e] * rstd * g4[e >> 2][e & 3] * siluf_(zz[e]); \
            u32x4 w0, w1; w0.x = cvtpk(y[0], y[1]); w0.y = cvtpk(y[2], y[3]); w0.z = cvtpk(y[4], y[5]); w0.w = cvtpk(y[6], y[7]); \
            w1.x = cvtpk(y[8], y[9]); w1.y = cvtpk(y[10], y[11]); w1.z = cvtpk(y[12], y[13]); w1.w = cvtpk(y[14], y[15]); \
            bf16_t* yp = yb + (size_t)((n_) * 64 + row) * DM; *(u32x4*)yp = w0; *(u32x4*)(yp + 8) = w1; } } while (0)
        u32x4 va[14], vb[14];
#define DN_LD(V_, n_) do { const u32x4* src_ = (const u32x4*)(rec0 + (size_t)(n_) * DN_STRIDE + DN_W) + lt; _Pragma("unroll") for (int k = 0; k < 14; ++k) V_[k] = src_[k * 256]; } while (0)
#define DN_ST(V_, n_) do { LAS unsigned char* dst_ = lds + ((n_) & 1) * RB; _Pragma("unroll") for (int k = 0; k < 14; ++k) *(LAS u32x4*)(dst_ + (k * 256 + lt) * 16) = V_[k]; } while (0)
        DN_LD(va, 0); DN_LD(vb, 1);
        DN_ST(va, 0);
        DN_LD(va, 2);
        DN_ZLOAD(0);
        DN_BAR();
        for (int n = 0; n < 32; n += 2) {
            DN_ST(vb, n + 1);
            if (n + 3 < 32) DN_LD(vb, n + 3);
            if (n >= 1) { DN_FINAL(n - 1); DN_ZLOAD(n); }
            DN_BAR();
            if (n + 2 < 32) DN_ST(va, n + 2);
            if (n + 4 < 32) DN_LD(va, n + 4);
            DN_FINAL(n); DN_ZLOAD(n + 1);
            DN_BAR();
        }
        DN_FINAL(31);
#undef DN_ZLOAD
#undef DN_FINAL
#undef DN_LD
#undef DN_ST
    } else {
        const int slice = wave, dv0 = slice * 32;
        f32x16 St[4];
#pragma unroll
        for (int a = 0; a < 4; ++a) St[a] = f32x16{};
        const float egv = *(const float*)(rec0 + (size_t)(lane & 31) * DN_STRIDE + DN_SC);
        u32x4 un[2][2];
#pragma unroll
        for (int mt = 0; mt < 2; ++mt) { const u32x4* up = (const u32x4*)(rec0 + DN_U) + ((mt * 4 + slice) * 64 + lane) * 2; un[mt][0] = up[0]; un[mt][1] = up[1]; }
        DN_BAR();
        for (int n = 0; n < 32; ++n) {
            const unsigned char* rec = rec0 + (size_t)n * DN_STRIDE;
            const LAS unsigned char* buf = lds + (n & 1) * RB;
            const float eg = __int_as_float(__builtin_amdgcn_readlane(__float_as_int(egv), n));
            f32x16 Vn[2], O[2];
#pragma unroll
            for (int mt = 0; mt < 2; ++mt) { const u32x4 a = un[mt][0], c = un[mt][1];
                Vn[mt][0] = bflo(a.x); Vn[mt][1] = bfhi(a.x); Vn[mt][2] = bflo(a.y); Vn[mt][3] = bfhi(a.y); Vn[mt][4] = bflo(a.z); Vn[mt][5] = bfhi(a.z); Vn[mt][6] = bflo(a.w); Vn[mt][7] = bfhi(a.w);
                Vn[mt][8] = bflo(c.x); Vn[mt][9] = bfhi(c.x); Vn[mt][10] = bflo(c.y); Vn[mt][11] = bfhi(c.y); Vn[mt][12] = bflo(c.z); Vn[mt][13] = bfhi(c.z); Vn[mt][14] = bflo(c.w); Vn[mt][15] = bfhi(c.w); }
            if (n + 1 < 32) {
#pragma unroll
                for (int mt = 0; mt < 2; ++mt) { const u32x4* up = (const u32x4*)(rec + DN_STRIDE + DN_U) + ((mt * 4 + slice) * 64 + lane) * 2; un[mt][0] = up[0]; un[mt][1] = up[1]; } }
            bf16x8 Sf[8];
#pragma unroll
            for (int a = 0; a < 4; ++a) { Sf[2 * a] = pack_step(St[a], 0); Sf[2 * a + 1] = pack_step(St[a], 1); }
#pragma unroll
            for (int mt = 0; mt < 2; ++mt)
#pragma unroll
                for (int ks = 0; ks < 8; ++ks) Vn[mt] = MFMA32(*(const LAS bf16x8*)(buf + ((mt * 8 + ks) * 64 + lane) * 16), Sf[ks], Vn[mt]);
#pragma unroll
            for (int mt = 0; mt < 2; ++mt) { O[mt] = f32x16{};
#pragma unroll
                for (int ks = 0; ks < 8; ++ks) O[mt] = MFMA32(*(const LAS bf16x8*)(buf + 16384 + ((mt * 8 + ks) * 64 + lane) * 16), Sf[ks], O[mt]); }
            bf16x8 Vf[4];
#pragma unroll
            for (int mt = 0; mt < 2; ++mt) { Vf[2 * mt] = pack_step(Vn[mt], 0); Vf[2 * mt + 1] = pack_step(Vn[mt], 1); }
#pragma unroll
            for (int mt = 0; mt < 2; ++mt)
#pragma unroll
                for (int ks = 0; ks < 4; ++ks) O[mt] = MFMA32(*(const LAS bf16x8*)(buf + 49152 + ((mt * 4 + ks) * 64 + lane) * 16), Vf[ks], O[mt]);
#pragma unroll
            for (int a = 0; a < 4; ++a) {
                St[a] = St[a] * eg;
#pragma unroll
                for (int ks = 0; ks < 4; ++ks) St[a] = MFMA32(*(const LAS bf16x8*)(buf + 32768 + ((a * 4 + ks) * 64 + lane) * 16), Vf[ks], St[a]);
            }
            {   LAS unsigned char* ob = lds + 2 * RB + (n & 1) * OB + (dv0 + r) * 2;
#pragma unroll
                for (int mt = 0; mt < 2; ++mt)
#pragma unroll
                    for (int i = 0; i < 16; ++i) *(LAS bf16_t*)(ob + (32 * mt + crow(i, hi)) * ORS) = f2bf(O[mt][i]);
            }
            DN_BAR();
        }
    }
}
}

DI void transpose_tile(const float* W, int N, int k0, int sn0, bf16_t* WT, int dpitch, int drow0, int dk0, int nvalid, LAS float* scr, int lane) {
    {
        f32x4 v[8];
#pragma unroll
        for (int i = 0; i < 8; ++i) v[i] = *(const f32x4*)(W + (size_t)(k0 + 8 * i + (lane >> 3)) * N + sn0 + 4 * (lane & 7));
#pragma unroll
        for (int i = 0; i < 8; ++i) { LAS float* d = scr + (8 * i + (lane >> 3)) * 33 + 4 * (lane & 7); d[0] = v[i].x; d[1] = v[i].y; d[2] = v[i].z; d[3] = v[i].w; }
    }
    asm volatile("s_waitcnt lgkmcnt(0)" ::: "memory");
    const int c = lane & 7;
#pragma unroll
    for (int j = 0; j < 4; ++j) { const int n = (lane >> 3) + 8 * j; const LAS float* s = scr + (8 * c) * 33 + n;
        u32x4 o; o.x = cvtpk(s[0 * 33], s[1 * 33]); o.y = cvtpk(s[2 * 33], s[3 * 33]); o.z = cvtpk(s[4 * 33], s[5 * 33]); o.w = cvtpk(s[6 * 33], s[7 * 33]);
        if (n < nvalid) *(u32x4*)(WT + (size_t)(drow0 + n) * dpitch + dk0 + k0 + 8 * c) = o; }
    asm volatile("s_waitcnt lgkmcnt(0)" ::: "memory");
}

DI void transpose_tile8(const float* W, int N, int k0, int sn0, unsigned char* WT, int dpitch, int drow0, float sc, LAS float* scr, int lane) {
    {   f32x4 v[8];
#pragma unroll
        for (int i = 0; i < 8; ++i) v[i] = *(const f32x4*)(W + (size_t)(k0 + 8 * i + (lane >> 3)) * N + sn0 + 4 * (lane & 7));
#pragma unroll
        for (int i = 0; i < 8; ++i) { LAS float* d = scr + (8 * i + (lane >> 3)) * 33 + 4 * (lane & 7); d[0] = v[i].x; d[1] = v[i].y; d[2] = v[i].z; d[3] = v[i].w; }
    }
    asm volatile("s_waitcnt lgkmcnt(0)" ::: "memory");
    const int c = lane & 7;
#pragma unroll
    for (int j = 0; j < 4; ++j) { const int n = (lane >> 3) + 8 * j; const LAS float* s = scr + (8 * c) * 33 + n;
        *(u32x2*)(WT + (size_t)(drow0 + n) * dpitch + k0 + 8 * c) = (u32x2){cvt4_fp8(s[0 * 33] * sc, s[1 * 33] * sc, s[2 * 33] * sc, s[3 * 33] * sc), cvt4_fp8(s[4 * 33] * sc, s[5 * 33] * sc, s[6 * 33] * sc, s[7 * 33] * sc)}; }
    asm volatile("s_waitcnt lgkmcnt(0)" ::: "memory");
}

DI void phase0(const Params& p, LAS unsigned char* lds, int tid, int lane, int wave, int bid, int G) {
    float* MOD = (float*)(p.ws + WS_MOD);
#if defined(DBL) && DBL == 0
    __syncthreads();
#endif
    if (bid < 192) {
        LAS float* sc = (LAS float*)lds;
        LAS float* red = (LAS float*)(lds + 65536);
        for (int i = tid; i < 8 * 2048; i += 512) { const int bb = i >> 11, k = i & 2047; sc[k * 8 + bb] = siluf_acc(p.c[i]); }
        __syncthreads();
        const int n0 = bid * 64;
        const int ksub = lane >> 4, cg = lane & 15;
        f32x4 acc[8];
#pragma unroll
        for (int bb = 0; bb < 8; ++bb) acc[bb] = (f32x4){0.f, 0.f, 0.f, 0.f};
        const float* wp = p.w_ada + (size_t)(wave * 256 + ksub) * 12288 + n0 + 4 * cg;
#pragma unroll 8
        for (int it = 0; it < 64; ++it) {
            const f32x4 wv = *(const f32x4*)(wp + (size_t)(4 * it) * 12288);
            const LAS float* sp = sc + (wave * 256 + 4 * it + ksub) * 8;
            const f32x4 s0 = *(const LAS f32x4*)sp, s1 = *(const LAS f32x4*)(sp + 4);
            acc[0] += wv * s0.x; acc[1] += wv * s0.y; acc[2] += wv * s0.z; acc[3] += wv * s0.w;
            acc[4] += wv * s1.x; acc[5] += wv * s1.y; acc[6] += wv * s1.z; acc[7] += wv * s1.w;
        }
#pragma unroll
        for (int bb = 0; bb < 8; ++bb) {
#pragma unroll
            for (int e = 0; e < 4; ++e) { float v = acc[bb][e]; v += __shfl_xor(v, 16); v += __shfl_xor(v, 32); acc[bb][e] = v; }
            if (ksub == 0) *(LAS f32x4*)(red + (wave * 8 + bb) * 64 + 4 * cg) = acc[bb];
        }
        __syncthreads();
        { const int bb = tid >> 6, col = tid & 63; float s = 0.f;
#pragma unroll
          for (int w = 0; w < 8; ++w) s += red[(w * 8 + bb) * 64 + col];
          MOD[bb * 12288 + n0 + col] = s + p.b_ada[n0 + col]; }
        __syncthreads();
    } else {
        f32x2* CS = (f32x2*)(p.ws + WS_CS);
        for (int i = (bid - 192) * 512 + tid; i < T * 16; i += (G - 192) * 512) {
            const int t = i >> 4, f = i & 15;
            const float inv = powf(500000.0f, -(float)f * (2.0f / 32.0f));
            const float ang = (float)p.pos[t] * inv;
            float sn, cs; sincosf(ang, &sn, &cs);
            CS[i] = (f32x2){cs, sn};
        }
    }
    LAS float* scr = (LAS float*)(lds + wave * 8448);
    const int gw = bid * 8 + wave, NGW = G * 8;
    bf16_t* WIN = (bf16_t*)(p.ws + WS_WIN); bf16_t* WMD = (bf16_t*)(p.ws + WS_WMD); bf16_t* WOUT = (bf16_t*)(p.ws + WS_WOUT); bf16_t* WR = (bf16_t*)(p.ws + WS_WR);
    constexpr int I_A = 32 * 224, I_B = 32 * 128, I_C = 32, I_M = 16 * 64, I_O = 32 * 64, I_RG = 32, I_RE = 32;
    constexpr int NITEMS = I_A + I_B + I_C + 2 * I_M + I_O + I_RG + I_RE;
    for (int it = gw; it < NITEMS; it += NGW) {
        int r = it;
        if (r < I_A + I_B) { const int kb = r / 352, nb = r % 352, cc = 32 * nb, sc0 = cc < 7168 ? cc : cc + 16, t = cc >> 8;
            if (t >= NB0 && t < NB0 + NF) transpose_tile8(p.w_in, 11280, 64 * kb, sc0, p.ws + WS_WINF, DM, cc - NB0 * 256, SWI, scr, lane);
            else transpose_tile(p.w_in, 11280, 64 * kb, sc0, WIN, DM, t < NB0 ? cc : cc - NF * 256, 0, 32, scr, lane);
            continue; } r -= I_A + I_B;
        if (r < I_C) { transpose_tile(p.w_in, 11280, 64 * r, 7168, (bf16_t*)(p.ws + WS_WBA), DM, 0, 0, 16, scr, lane); continue; } r -= I_C;
        if (r < I_M) { const int kb = r / 64, nb = r % 64; transpose_tile(p.w_bm, DM, 64 * kb, 32 * nb, WMD, DM, 32 * nb, 0, 32, scr, lane); continue; } r -= I_M;
        if (r < I_M) { const int kb = r / 64, nb = r % 64; transpose_tile(p.w_bd, DM, 64 * kb, 32 * nb, WMD, DM, 32 * nb, 1024, 32, scr, lane); continue; } r -= I_M;
        if (r < I_O) { const int kb = r / 64, nb = r % 64; transpose_tile(p.w_out, DM, 64 * kb, 32 * nb, WOUT, DM, 32 * nb, 0, 32, scr, lane); continue; } r -= I_O;
        if (r < I_RG) {
            const int k = r * 64 + lane;
#pragma unroll
            for (int e = 0; e < 4; ++e) WR[e * DM + k] = f2bf(p.w_rg[k * 4 + e]);
#pragma unroll
            for (int e = 36; e < 48; ++e) WR[e * DM + k] = 0;
            continue; } r -= I_RG;
        { transpose_tile(p.w_re, 32, 64 * r, 0, WR, DM, 4, 0, 32, scr, lane); }
    }
}

DI void phase_u1_item(const Params& p, LAS unsigned char* lds, int item, int tid, int lane, int wave) {
    const float* MOD = (const float*)(p.ws + WS_MOD); bf16_t* U1 = (bf16_t*)(p.ws + WS_A);
    const int tokb = item * 64, b = tokb >> 11;
    f32x4 ga[8], sh[8];
    { const float* shp = MOD + b * 12288; const float* scl = shp + 2048;
#pragma unroll
      for (int j = 0; j < 8; ++j) { const int col = 4 * (lane + 64 * j);
          const f32x4 g = *(const f32x4*)(p.g_mix_pre + col), a = *(const f32x4*)(scl + col); ga[j] = g * (a + 1.0f); sh[j] = *(const f32x4*)(shp + col); } }
    for (int rr = 0; rr < 8; rr += 2) {
        f32x4 v[2][8];
#pragma unroll
        for (int u = 0; u < 2; ++u) { const f32x4* xr = (const f32x4*)(p.x + (size_t)(tokb + wave * 8 + rr + u) * DM) + lane;
#pragma unroll
            for (int j = 0; j < 8; ++j) v[u][j] = xr[64 * j]; }
#pragma unroll
        for (int u = 0; u < 2; ++u) { const int m = tokb + wave * 8 + rr + u; float s = 0.f;
#pragma unroll
            for (int j = 0; j < 8; ++j) s += (v[u][j].x * v[u][j].x + v[u][j].y * v[u][j].y) + (v[u][j].z * v[u][j].z + v[u][j].w * v[u][j].w);
            const float rstd = rsqrt_(wave_sum(s) * (1.0f / DM) + EPS);
            u32x2* o8 = (u32x2*)(U1 + (size_t)m * DM) + lane;
#pragma unroll
            for (int j = 0; j < 8; ++j) { const f32x4 uu = (v[u][j] * rstd) * ga[j] + sh[j]; o8[64 * j] = (u32x2){cvtpk(uu.x, uu.y), cvtpk(uu.z, uu.w)};
                ((unsigned*)(p.ws + WS_U1F + (size_t)m * DM))[lane + 64 * j] = cvt4_fp8(uu.x * SU1, uu.y * SU1, uu.z * SU1, uu.w * SU1); } }
    }
    __syncthreads();
    {
        const int tl = lane & 15, kg = lane >> 4, tg = wave & 3, kh = wave >> 2;
        const bf16_t* up = U1 + (size_t)(tokb + tg * 16 + tl) * DM + kh * 1024 + 8 * kg;
        const bf16_t* wp = (const bf16_t*)(p.ws + WS_WBA) + (size_t)tl * DM + kh * 1024 + 8 * kg;
        f32x4 a0 = {0.f, 0.f, 0.f, 0.f}, a1 = a0;
#pragma unroll 8
        for (int s = 0; s < 32; s += 2) {
            a0 = MFMA16(*(const bf16x8*)(wp + 32 * s), *(const bf16x8*)(up + 32 * s), a0);
            a1 = MFMA16(*(const bf16x8*)(wp + 32 * s + 32), *(const bf16x8*)(up + 32 * s + 32), a1);
        }
        a0 = a0 + a1;
        LAS f32x4* ex = (LAS f32x4*)lds + (tg * 64 + lane);
        if (kh == 1) *ex = a0;
        __syncthreads();
        if (kh == 0) { a0 = a0 + *ex;
            *(f32x4*)((float*)(p.ws + WS_BA) + (size_t)(tokb + tg * 16 + tl) * 16 + 4 * kg) = a0; }
        __syncthreads();
    }
}

DI void rotary_item(const Params& p, int item, int lane) {
    const int which = item & 1, h = (item >> 1) & 7, blk = (item >> 4) & 7, b = item >> 7;
    bf16_t* PROJ = (bf16_t*)(p.ws + WS_B);
    const f32x2* CS = (const f32x2*)(p.ws + WS_CS);
    const int tok0 = b * SEQ + blk * 256; const int colb = (which ? C_K : C_Q) + h * HD;
    const int rsub = lane >> 4, i = lane & 15;
    float cs8[8];
#pragma unroll
    for (int e = 0; e < 8; ++e) cs8[e] = 0.f;
    if (which) {
#pragma unroll 16
        for (int it = 0; it < 64; ++it) { const u32x4 v = *(const u32x4*)(PROJ + (size_t)(tok0 + it * 4 + rsub) * PP + colb + 8 * i);
            cs8[0] += bflo(v.x); cs8[1] += bfhi(v.x); cs8[2] += bflo(v.y); cs8[3] += bfhi(v.y); cs8[4] += bflo(v.z); cs8[5] += bfhi(v.z); cs8[6] += bflo(v.w); cs8[7] += bfhi(v.w); }
#pragma unroll
        for (int e = 0; e < 8; ++e) { cs8[e] += __shfl_xor(cs8[e], 16); cs8[e] += __shfl_xor(cs8[e], 32); }
    }
    float a0 = 0.f, a1 = 0.f;
#pragma unroll 16
    for (int it = 0; it < 64; ++it) {
        const int t = tok0 + it * 4 + rsub;
        bf16_t* ptr = PROJ + (size_t)t * PP + colb + i;
        const float x1 = bf2f(ptr[0]), x2 = bf2f(ptr[16]);
        const f32x2 cs = CS[t * 16 + i];
        const unsigned w = cvtpk(x1 * cs.x - x2 * cs.y, x2 * cs.x + x1 * cs.y);
        ptr[0] = (bf16_t)(w & 0xffffu); ptr[16] = (bf16_t)(w >> 16);
        a0 += bflo(w); a1 += bfhi(w);
    }
    if (which) {
        a0 += __shfl_xor(a0, 16); a0 += __shfl_xor(a0, 32); a1 += __shfl_xor(a1, 16); a1 += __shfl_xor(a1, 32);
        bf16_t* KM = (bf16_t*)(p.ws + WS_KMEAN) + ((size_t)(b * 8 + h) * 8 + blk) * HD;
        if (lane < 16) {
            if (lane >= 4) { u32x4 o; o.x = cvtpk(cs8[0] * (1.0f / 256.0f), cs8[1] * (1.0f / 256.0f)); o.y = cvtpk(cs8[2] * (1.0f / 256.0f), cs8[3] * (1.0f / 256.0f));
                o.z = cvtpk(cs8[4] * (1.0f / 256.0f), cs8[5] * (1.0f / 256.0f)); o.w = cvtpk(cs8[6] * (1.0f / 256.0f), cs8[7] * (1.0f / 256.0f)); *(u32x4*)(KM + 8 * lane) = o; }
            KM[lane] = f2bf(a0 * (1.0f / 256.0f)); KM[16 + lane] = f2bf(a1 * (1.0f / 256.0f));
        }
    }
}

DI void phase_dn_final(const Params& p, int lane, int gw, int NGW) {
    const float* ODN = (const float*)(p.ws + WS_D); const bf16_t* PROJ = (const bf16_t*)(p.ws + WS_B); bf16_t* YAB = (bf16_t*)(p.ws + WS_A);
    const int d0 = (lane & 7) * 16;
    for (int m = gw; m < T; m += NGW) {
        const float* op = ODN + (size_t)m * 1024 + lane * 16;
        f32x4 v[4]; float s = 0.f;
#pragma unroll
        for (int j = 0; j < 4; ++j) { v[j] = *(const f32x4*)(op + 4 * j); s += (v[j].x * v[j].x + v[j].y * v[j].y) + (v[j].z * v[j].z + v[j].w * v[j].w); }
        s += __shfl_xor(s, 1); s += __shfl_xor(s, 2); s += __shfl_xor(s, 4);
        const float rstd = rsqrt_(s * (1.0f / HD) + EPS);
        const u32x4 z0 = *(const u32x4*)(PROJ + (size_t)m * PP + C_Z + lane * 16), z1 = *(const u32x4*)(PROJ + (size_t)m * PP + C_Z + lane * 16 + 8);
        const float zz[16] = {bflo(z0.x), bfhi(z0.x), bflo(z0.y), bfhi(z0.y), bflo(z0.z), bfhi(z0.z), bflo(z0.w), bfhi(z0.w),
                              bflo(z1.x), bfhi(z1.x), bflo(z1.y), bfhi(z1.y), bflo(z1.z), bfhi(z1.z), bflo(z1.w), bfhi(z1.w)};
        float y[16];
#pragma unroll
        for (int j = 0; j < 4; ++j) { const f32x4 g = *(const f32x4*)(p.dn_gain + d0 + 4 * j);
            y[4 * j + 0] = v[j].x * rstd * g.x * siluf_(zz[4 * j + 0]); y[4 * j + 1] = v[j].y * rstd * g.y * siluf_(zz[4 * j + 1]);
            y[4 * j + 2] = v[j].z * rstd * g.z * siluf_(zz[4 * j + 2]); y[4 * j + 3] = v[j].w * rstd * g.w * siluf_(zz[4 * j + 3]); }
        u32x4 o0, o1;
        o0.x = cvtpk(y[0], y[1]); o0.y = cvtpk(y[2], y[3]); o0.z = cvtpk(y[4], y[5]); o0.w = cvtpk(y[6], y[7]);
        o1.x = cvtpk(y[8], y[9]); o1.y = cvtpk(y[10], y[11]); o1.z = cvtpk(y[12], y[13]); o1.w = cvtpk(y[14], y[15]);
        bf16_t* yp = YAB + (size_t)m * DM + 1024 + lane * 16;
        *(u32x4*)yp = o0; *(u32x4*)(yp + 8) = o1;
    }
}

constexpr int L5_ROW = 4112;
constexpr int L5_LG = 32 * L5_ROW;
constexpr int L5_HIST = L5_LG + 24576;
constexpr int L5_TOK = L5_HIST + 256;
DI void phase5_item(const Params& p, LAS unsigned char* lds, int item, int tid, int lane, int wave) {
    const float* MOD = (const float*)(p.ws + WS_MOD); const bf16_t* OM = (const bf16_t*)(p.ws + WS_OUTMIX);
    const bf16_t* WR = (const bf16_t*)(p.ws + WS_WR); bf16_t* X1 = (bf16_t*)(p.ws + WS_D);
    LAS unsigned* hist = (LAS unsigned*)(lds + L5_HIST); LAS unsigned* tokw = (LAS unsigned*)(lds + L5_TOK);
    if (tid < 64) hist[tid] = 0u;
    const int tokb = item * 64, b = tokb >> 11;
    f32x4 c1[8], c2[8], c3[8];
    { const float* mod = MOD + b * 12288;
#pragma unroll
      for (int j = 0; j < 4; ++j)
#pragma unroll
          for (int q = 0; q < 2; ++q) { const int col = 8 * (lane + 64 * j) + 4 * q;
              c1[2 * j + q] = *(const f32x4*)(mod + 4096 + col) * *(const f32x4*)(p.g_mix_post + col);
              c2[2 * j + q] = *(const f32x4*)(p.g_ffn_pre + col) * (*(const f32x4*)(mod + 8192 + col) + 1.0f);
              c3[2 * j + q] = *(const f32x4*)(mod + 6144 + col); } }
    for (int half = 0; half < 2; ++half) {
    for (int rr = 0; rr < 4; ++rr) {
        const int lr = wave * 4 + rr, m = tokb + half * 32 + lr;
        u32x4 wq[4]; f32x4 xx[8];
#pragma unroll
        for (int j = 0; j < 4; ++j) { const int col = 8 * (lane + 64 * j);
            wq[j] = *(const u32x4*)(OM + (size_t)m * DM + col);
            xx[2 * j] = *(const f32x4*)(p.x + (size_t)m * DM + col); xx[2 * j + 1] = *(const f32x4*)(p.x + (size_t)m * DM + col + 4); }
        f32x4 om[8]; float s = 0.f;
#pragma unroll
        for (int j = 0; j < 4; ++j) { const u32x4 w = wq[j];
            om[2 * j] = (f32x4){bflo(w.x), bfhi(w.x), bflo(w.y), bfhi(w.y)}; om[2 * j + 1] = (f32x4){bflo(w.z), bfhi(w.z), bflo(w.w), bfhi(w.w)}; }
#pragma unroll
        for (int k = 0; k < 8; ++k) s += (om[k].x * om[k].x + om[k].y * om[k].y) + (om[k].z * om[k].z + om[k].w * om[k].w);
        const float r1 = rsqrt_(wave_sum(s) * (1.0f / DM) + EPS);
        float s2 = 0.f;
#pragma unroll
        for (int k = 0; k < 8; ++k) { const f32x4 o = xx[k] + c1[k] * (om[k] * r1); xx[k] = o; s2 += (o.x * o.x + o.y * o.y) + (o.z * o.z + o.w * o.w); }
#pragma unroll
        for (int j = 0; j < 4; ++j) { const int col = 8 * (lane + 64 * j);
            *(u32x4*)(X1 + (size_t)m * DM + col) = (u32x4){cvtpk(xx[2 * j].x, xx[2 * j].y), cvtpk(xx[2 * j].z, xx[2 * j].w), cvtpk(xx[2 * j + 1].x, xx[2 * j + 1].y), cvtpk(xx[2 * j + 1].z, xx[2 * j + 1].w)}; }
        const float r2 = rsqrt_(wave_sum(s2) * (1.0f / DM) + EPS);
#pragma unroll
        for (int j = 0; j < 4; ++j) { const int col = 8 * (lane + 64 * j);
            const f32x4 u0 = (xx[2 * j] * r2) * c2[2 * j] + c3[2 * j], u1 = (xx[2 * j + 1] * r2) * c2[2 * j + 1] + c3[2 * j + 1];
            *(LAS u32x4*)(lds + lr * L5_ROW + col * 2) = (u32x4){cvtpk(u0.x, u0.y), cvtpk(u0.z, u0.w), cvtpk(u1.x, u1.y), cvtpk(u1.z, u1.w)};
            *(u32x2*)(p.ws + WS_U2F + (size_t)m * DM + col) = (u32x2){cvt4_fp8(u0.x * SU, u0.y * SU, u0.z * SU, u0.w * SU), cvt4_fp8(u1.x * SU, u1.y * SU, u1.z * SU, u1.w * SU)}; }
    }
    __syncthreads();
    {
        const int tl = lane & 15, kg = lane >> 4, tg = wave & 1, kq = wave >> 1;
        const LAS unsigned char* up = lds + (tg * 16 + tl) * L5_ROW + (kq * 512 + 8 * kg) * 2;
        const bf16_t* wp = WR + (size_t)tl * DM + kq * 512 + 8 * kg;
        f32x4 a0 = {0.f, 0.f, 0.f, 0.f}, a1 = a0, a2 = a0;
#pragma unroll 8
        for (int s = 0; s < 16; ++s) {
            const bf16x8 bu = *(const LAS bf16x8*)(up + 64 * s);
            const bf16x8 w0 = *(const bf16x8*)(wp + 32 * s), w1 = *(const bf16x8*)(wp + 16 * DM + 32 * s), w2 = *(const bf16x8*)(wp + 32 * DM + 32 * s);
            a0 = MFMA16(w0, bu, a0); a1 = MFMA16(w1, bu, a1); a2 = MFMA16(w2, bu, a2);
        }
        LAS float* lg = (LAS float*)(lds + L5_LG) + (kq * 2 + tg) * 768 + tl * 48 + 4 * kg;
#pragma unroll
        for (int r = 0; r < 4; ++r) { lg[r] = a0[r]; lg[16 + r] = a1[r]; lg[32 + r] = a2[r]; }
    }
    __syncthreads();
    if (wave < 2) {
        if (lane < 16) {
            const LAS float* l = (const LAS float*)(lds + L5_LG) + wave * 768 + lane * 48;
            float gl[4]; int gs = 0; float gm;
#pragma unroll
            for (int i = 0; i < 4; ++i) gl[i] = ((l[i] + l[1536 + i]) + (l[3072 + i] + l[4608 + i])) + p.b_rg[i];
            gm = gl[0];
#pragma unroll
            for (int i = 1; i < 4; ++i) if (gl[i] > gm) { gm = gl[i]; gs = i; }
            float gsum = 0.f;
#pragma unroll
            for (int i = 0; i < 4; ++i) gsum += expf(gl[i] - gm);
            const float pg = 1.0f / gsum;
            float el[8]; float em = -3.0e38f;
#pragma unroll
            for (int i = 0; i < 8; ++i) { const int li = 4 + 8 * gs + i; const float v = ((l[li] + l[1536 + li]) + (l[3072 + li] + l[4608 + li])) + p.b_re[8 * gs + i]; el[i] = v; em = fmaxf(em, v); }
            float pe[8]; float esum = 0.f;
#pragma unroll
            for (int i = 0; i < 8; ++i) { pe[i] = expf(el[i] - em); esum += pe[i]; }
            int i0 = 0; float p0 = pe[0];
#pragma unroll
            for (int i = 1; i < 8; ++i) if (pe[i] > p0) { p0 = pe[i]; i0 = i; }
            int i1 = -1; float p1 = -1.f;
#pragma unroll
            for (int i = 0; i < 8; ++i) if (i != i0 && pe[i] > p1) { p1 = pe[i]; i1 = i; }
            const float w0 = pg * p0 / (p0 + p1), w1 = pg * p1 / (p0 + p1);
            const int e0 = 8 * gs + i0, e1 = 8 * gs + i1;
            const unsigned lr0 = __hip_atomic_fetch_add(hist + e0, 1u, __ATOMIC_RELAXED, __HIP_MEMORY_SCOPE_WORKGROUP), lr1 = __hip_atomic_fetch_add(hist + e1, 1u, __ATOMIC_RELAXED, __HIP_MEMORY_SCOPE_WORKGROUP);
            LAS unsigned* tw = tokw + (half * 32 + wave * 16 + lane) * 6;
            tw[0] = (unsigned)e0; tw[1] = (unsigned)e1; tw[2] = lr0; tw[3] = lr1; tw[4] = __float_as_uint(w0); tw[5] = __float_as_uint(w1);
        }
    }
    }
    __syncthreads();
    if (tid < 32) { unsigned* cnt = (unsigned*)(p.ws + WS_CTL) + CW_CNT; const unsigned hcount = hist[tid];
        hist[32 + tid] = hcount ? __hip_atomic_fetch_add(cnt + tid, hcount, __ATOMIC_RELAXED, __HIP_MEMORY_SCOPE_AGENT) : 0u; }
    __syncthreads();
    if (tid < 64) {
        const LAS unsigned* tw = tokw + tid * 6; const int tok = tokb + tid;
        const unsigned e0 = tw[0], e1 = tw[1], q0 = hist[32 + e0] + tw[2], q1 = hist[32 + e1] + tw[3];
        int* RT = (int*)(p.ws + WS_RTOK); RT[e0 * ECAP + q0] = tok; RT[e1 * ECAP + q1] = tok;
        u32x4* rec = (u32x4*)(p.ws + WS_REC) + (size_t)tok * 2;
        rec[0] = (u32x4){e0, e1, q0, q1}; rec[1] = (u32x4){tw[4], tw[5], 0u, 0u};
    }
    __syncthreads();
}
DI void expert_copy_gu(const Params& p, int it, LAS float* scr, int lane) {
    const int e = it >> 10, r = it & 1023, up = r >> 9, q = r & 511, kb = q >> 4, nb = q & 15, n0 = 32 * nb;
    const float* W = (up ? p.w_up : p.w_gate) + (size_t)e * DM * FF;
    transpose_tile8(W, FF, 64 * kb, n0, p.ws + WS_WGU, DM, e * 1024 + (n0 >> 7) * 256 + (n0 & 127) + up * 128, SW, scr, lane);
}
DI void expert_copy_dn(const Params& p, int it, LAS float* scr, int lane) {
    const int e = it >> 9, q = it & 511, kb = q >> 6, nb = q & 63;
    transpose_tile8(p.w_down + (size_t)e * FF * DM, DM, 64 * kb, 32 * nb, p.ws + WS_WDN, FF, e * DM + 32 * nb, SW, scr, lane);
}

struct MoeOrder {
    const LAS int* pref; const LAS int* cnt; int ntn, G, c;
    DI bool next(int i, pg8::Unit& u) const {
        const int L = i * G + c; const int total = pref[32] * ntn; if (L >= total) return false;
        const int tile = L / ntn, pnl = L - tile * ntn;
        int e = 0;
        for (int q = 1; q < 32; ++q) if (tile >= pref[q]) e = q;
        const int m = tile - pref[e];
        u.pm = tile; u.pn = e * ntn + pnl; u.ga = e * ECAP + m * 256; u.gn = cnt[e] - m * 256; return true;
    }
};
DI void moe_tables(const Params& p, LAS int* pref, LAS int* cntl, int tid) {
    if (tid < 32) { const unsigned* cnt = (const unsigned*)(p.ws + WS_CTL) + CW_CNT; cntl[tid] = (int)__hip_atomic_load(cnt + tid, __ATOMIC_RELAXED, __HIP_MEMORY_SCOPE_AGENT); }
    __syncthreads();
    if (tid == 0) { int acc = 0;
        for (int e = 0; e < 32; ++e) { pref[e] = acc; acc += (cntl[e] + 255) >> 8; }
        pref[32] = acc; }
    __syncthreads();
}

DI void phase8(const Params& p, const LAS int* pref, int lane, int gw, int NGW) {
    const float* MOD = (const float*)(p.ws + WS_MOD); const bf16_t* YB = (const bf16_t*)(p.ws + WS_YBUF); const bf16_t* X1 = (const bf16_t*)(p.ws + WS_D);
    for (int m0 = gw * 8; m0 < T; m0 += NGW * 8) {
        const int b = m0 >> 11; const float* gt2 = MOD + b * 12288 + 5 * 2048;
        f32x4 c4[8];
#pragma unroll
        for (int k = 0; k < 8; ++k) { const int col = 8 * (lane + 64 * (k >> 1)) + 4 * (k & 1); c4[k] = *(const f32x4*)(gt2 + col) * *(const f32x4*)(p.g_ffn_post + col); }
        for (int rr = 0; rr < 8; ++rr) { const int m = m0 + rr;
            const u32x4* rec = (const u32x4*)(p.ws + WS_REC) + (size_t)m * 2;
            const u32x4 r0 = rec[0], r1 = rec[1];
            const size_t row0 = (size_t)(pref[r0.x] * 256 + (int)r0.z), row1 = (size_t)(pref[r0.y] * 256 + (int)r0.w);
            const float w0 = __uint_as_float(r1.x), w1 = __uint_as_float(r1.y);
            u32x4 ya[4], yc[4], xw[4];
#pragma unroll
            for (int j = 0; j < 4; ++j) { const int col = 8 * (lane + 64 * j);
                ya[j] = *(const u32x4*)(YB + row0 * DM + col); yc[j] = *(const u32x4*)(YB + row1 * DM + col); xw[j] = *(const u32x4*)(X1 + (size_t)m * DM + col); }
            f32x4 y[8]; float s = 0.f;
#pragma unroll
            for (int j = 0; j < 4; ++j) { const u32x4 a = ya[j], c = yc[j];
                y[2 * j] = (f32x4){w0 * bflo(a.x) + w1 * bflo(c.x), w0 * bfhi(a.x) + w1 * bfhi(c.x), w0 * bflo(a.y) + w1 * bflo(c.y), w0 * bfhi(a.y) + w1 * bfhi(c.y)};
                y[2 * j + 1] = (f32x4){w0 * bflo(a.z) + w1 * bflo(c.z), w0 * bfhi(a.z) + w1 * bfhi(c.z), w0 * bflo(a.w) + w1 * bflo(c.w), w0 * bfhi(a.w) + w1 * bfhi(c.w)}; }
#pragma unroll
            for (int k = 0; k < 8; ++k) s += (y[k].x * y[k].x + y[k].y * y[k].y) + (y[k].z * y[k].z + y[k].w * y[k].w);
            const float rs = rsqrt_(wave_sum(s) * (1.0f / DM) + EPS);
#pragma unroll
            for (int j = 0; j < 4; ++j) { const int col = 8 * (lane + 64 * j); const u32x4 xq = xw[j];
                const f32x4 x0 = {bflo(xq.x), bfhi(xq.x), bflo(xq.y), bfhi(xq.y)}, x1 = {bflo(xq.z), bfhi(xq.z), bflo(xq.w), bfhi(xq.w)};
                *(f32x4*)(p.out + (size_t)m * DM + col) = x0 + c4[2 * j] * (y[2 * j] * rs);
                *(f32x4*)(p.out + (size_t)m * DM + col + 4) = x1 + c4[2 * j + 1] * (y[2 * j + 1] * rs); }
        }
    }
}

#define XB_TMO      128
#define XB_XCNT(j)  (256  + 64 * (j))
#define XB_XSUB(j)  (1280 + 64 * (j))
#define XB_XGEN(j)  (2304 + 64 * (j))
#define XB_TOP      3328
#define XB_TOPGEN   3392
#define XCD_BAR_WORDS 3456
#define XB_SPIN_CAP (1u << 18)
DI unsigned xb_ld(unsigned* p)              { return __hip_atomic_load(p, __ATOMIC_RELAXED, __HIP_MEMORY_SCOPE_AGENT); }
DI unsigned xb_add(unsigned* p, unsigned v) { return __hip_atomic_fetch_add(p, v, __ATOMIC_RELAXED, __HIP_MEMORY_SCOPE_AGENT); }
DI unsigned xb_xcc_id() { return (unsigned)__builtin_amdgcn_s_getreg((3 << 11) | 20) & 0xFu; }
#define XB_SPIN(cond, bar) do { unsigned _sp = 0; while (cond) { __builtin_amdgcn_s_sleep(1); \
    if ((++_sp & 255u) == 0u) { if (xb_ld(&(bar)[XB_TMO])) break; if (_sp > XB_SPIN_CAP) { atomicAdd(&(bar)[XB_TMO], 1u); break; } } } } while (0)
struct XcdBarrier { unsigned* bar; unsigned x; volatile LAS unsigned* st; };
DI XcdBarrier xcd_barrier_post(unsigned* bar, volatile LAS unsigned* st) {
    XcdBarrier b; b.bar = bar; b.x = xb_xcc_id(); b.st = st;
    if (threadIdx.x == 0) (void)xb_add(&bar[XB_XCNT(b.x)], 1u);
    return b;
}
DI void xcd_barrier_complete(unsigned* bar, unsigned x, unsigned& nloc, unsigned& nx) {
    const unsigned G = gridDim.x * gridDim.y * gridDim.z;
    unsigned sum, cnt, mine, sp = 0u;
    for (;;) {
        sum = 0u; cnt = 0u; mine = 0u;
#pragma unroll
        for (unsigned j = 0; j < 16; ++j) { const unsigned c = xb_ld(&bar[XB_XCNT(j)]); sum += c; cnt += (c > 0u) ? 1u : 0u; mine = (j == x) ? c : mine; }
        if (sum == G) break;
        __builtin_amdgcn_s_sleep(1);
        if ((++sp & 255u) == 0u) { if (xb_ld(&bar[XB_TMO])) break; if (sp > XB_SPIN_CAP) { atomicAdd(&bar[XB_TMO], 1u); break; } }
    }
    nloc = mine > 0u ? mine : 1u; nx = cnt > 0u ? cnt : 1u;
}
DI void xcd_barrier(const XcdBarrier& b) {
    asm volatile("s_waitcnt vmcnt(0)" ::: "memory");
    __syncthreads();
    if (threadIdx.x == 0) {
        unsigned* bar = b.bar;
        __builtin_amdgcn_s_waitcnt(0);
        unsigned nloc = b.st[0], nx = b.st[1];
        if (nloc == 0u) { xcd_barrier_complete(bar, b.x, nloc, nx); b.st[0] = nloc; b.st[1] = nx; }
        const unsigned old = xb_add(&bar[XB_XSUB(b.x)], 1u);
        const unsigned gen = old / nloc;
        if (old + 1u == (gen + 1u) * nloc) {
            __builtin_amdgcn_fence(__ATOMIC_RELEASE, "agent");
            asm volatile("s_waitcnt vmcnt(0)" ::: "memory");
            const unsigned og = xb_add(&bar[XB_TOP], 1u);
            const unsigned tg = og / nx;
            if (og + 1u == (tg + 1u) * nx) xb_add(&bar[XB_TOPGEN], 1u);
            else XB_SPIN(xb_ld(&bar[XB_TOPGEN]) == tg, bar);
            __builtin_amdgcn_fence(__ATOMIC_ACQUIRE, "agent");
            xb_add(&bar[XB_XGEN(b.x)], 1u);
            asm volatile("s_waitcnt vmcnt(0)" ::: "memory");
        } else {
            XB_SPIN(xb_ld(&bar[XB_XGEN(b.x)]) == gen, bar);
            __builtin_amdgcn_fence(__ATOMIC_ACQUIRE, "agent");
            asm volatile("s_waitcnt vmcnt(0)" ::: "memory");
        }
    }
    __syncthreads();
}

constexpr int NWAVES = 8, NTHREADS = 512;
constexpr int LDS_GEMM = 131072, LDS_TAB = 162816, LDS_BYTES = LDS_TAB + 1024;
constexpr int N_PHASES = 12;
#ifndef DBL
#define DBL -1
#endif
#define REP(k) for (int rep_ = 0; rep_ < ((DBL == (k)) ? 2 : 1); ++rep_)
#ifndef MK_N_LAUNCHES
#define MK_N_LAUNCHES 1
#endif

DI moba::BlockRef attn_ref(const Params& p, int bh, int qb) {
    const int b = bh >> 3, h = bh & 7;
    const bf16_t* PROJ = (const bf16_t*)(p.ws + WS_B);
    moba::BlockRef r;
    r.Q = PROJ + (size_t)(b * SEQ + qb * 256) * PP + C_Q + h * HD;
    r.K = PROJ + (size_t)(b * SEQ) * PP + C_K + h * HD;
    r.V = PROJ + (size_t)(b * SEQ) * PP + C_V + h * HD;
    r.O = (bf16_t*)(p.ws + WS_A) + (size_t)(b * SEQ + qb * 256) * DM + h * HD;
    r.KM = (const bf16_t*)(p.ws + WS_KMEAN) + (size_t)bh * 8 * HD;
    r.P0 = qb * 256;
    return r;
}

typedef const __attribute__((address_space(4))) Params* KParams;
#if defined(__HIP_DEVICE_COMPILE__)
#define LOADP() KParams kq_ = kp_; asm volatile("" : "+s"(kq_)); const Params p = *kq_
#else
#define LOADP() const Params p = p_unused
#endif
__global__ void __launch_bounds__(NTHREADS, 2) fwd_kernel(Params p_unused) {
#if defined(__HIP_DEVICE_COMPILE__)
    const KParams kp_ = (KParams)__builtin_amdgcn_kernarg_segment_ptr();
#else
    const Params* kp_ = &p_unused;
#endif
    extern __shared__ __attribute__((aligned(16))) unsigned char lds_raw[];
    LAS unsigned char* lds = (LAS unsigned char*)lds_raw;
    const int bid = blockIdx.x, G = gridDim.x, NGW = G * NWAVES;
#define IDS() int tid_ = threadIdx.x; asm volatile("" : "+v"(tid_)); const int tid = tid_, lane = tid & 63, wave = __builtin_amdgcn_readfirstlane(tid >> 6), gw = bid * NWAVES + wave; (void)lane; (void)gw; (void)wave
    const int vcu = (G % 8 == 0) ? (bid % 8) * (G / 8) + bid / 8 : bid;
    const int lo = kp_->ph_lo, hi = kp_->ph_hi;
#ifdef ONLY
#define IN(k) ((k) == ONLY && lo <= (k) && (k) < hi)
#else
#define IN(k) (lo <= (k) && (k) < hi)
#endif
    { volatile LAS unsigned* st0 = (volatile LAS unsigned*)(lds + LDS_TAB + 512); if (threadIdx.x < 2) st0[threadIdx.x] = 0u; __syncthreads(); }
    XcdBarrier xbar; xbar.bar = (unsigned*)(kp_->ws + WS_CTL) + CW_BAR; xbar.x = 0; xbar.st = (volatile LAS unsigned*)(lds + LDS_TAB + 512);
#define SEAM(k) do { if (IN(k) && IN((k) + 1)) { if ((k) == 0) { cg::this_grid().sync(); xbar = xcd_barrier_post((unsigned*)(kp_->ws + WS_CTL) + CW_BAR, (volatile LAS unsigned*)(lds + LDS_TAB + 512)); } else xcd_barrier(xbar); } } while (0)

#ifdef TSPROBE
#ifndef TSQ
#define TSQ 10.0f
#endif
    unsigned long long* TS = (unsigned long long*)(kp_->ws + WS_CTL + 512 * 1024);
#define STAMP(k) do { if (blockIdx.x == 0 && threadIdx.x == 0) TS[k] = __builtin_amdgcn_s_memrealtime(); } while (0)
#else
#define STAMP(k) do { } while (0)
#endif
    STAMP(0);
    if (IN(0)) { LOADP(); IDS();
        if (bid == 0) { unsigned* ctl = (unsigned*)(p.ws + WS_CTL); for (int i = tid; i < 8192; i += NTHREADS) ctl[i] = 0u; }
        REP(0) phase0(p, lds, tid, lane, wave, bid, G); }
    SEAM(0); STAMP(1);
    if (IN(1)) { LOADP(); IDS(); REP(1) for (int it = bid; it < T / 64; it += G) phase_u1_item(p, lds, it, tid, lane, wave); }
    SEAM(1); STAMP(2);
    if (IN(2)) { LOADP(); IDS();
        pg8::Gemm g{(const bf16_t*)(p.ws + WS_A), (const bf16_t*)(p.ws + WS_WIN), DM, nullptr};
        pg8::StaticOrder S; S.init(T, (44 - NF) * 256, G, bid);
        pg8::EpiProj E{(bf16_t*)(p.ws + WS_B), (u32x4*)(p.ws + WS_GATEF), NB0, NF, 1.0f};
        pg8::gemm_phase<pg8::EpiProj, pg8::StaticOrder, true, false>(lds, g, S, E);
        pg8::Gemm g8{(const bf16_t*)(p.ws + WS_U1F), (const bf16_t*)(p.ws + WS_WINF), DM, nullptr};
        pg8::StaticOrder S8; S8.init(T, NF * 256, G, bid);
        pg8::EpiProj E8{(bf16_t*)(p.ws + WS_B), (u32x4*)(p.ws + WS_GATEF), 0, NB0, 1.0f / (SU1 * SWI)};
        pg8::gemm_phase<pg8::EpiProj, pg8::StaticOrder, true, false, true>(lds, g8, S8, E8);
    }
    SEAM(2); STAMP(3);
    if (IN(3)) { LOADP(); IDS();
        if (wave < 4) { for (int it = bid * 4 + wave; it < 1024; it += G * 4) rotary_item(p, it, lane); }
        REP(30) { dn::Raw R; dn::ConvW CW; dn::prep_consts(p, (bid >> 5) & 7, CW, lane); if (bid < 64 * 32) dn::prep_load(p, bid, R, lane, wave);
            for (int it = bid; it < 64 * 32; it += G) dn::prep_chunk(p, lds, it, (it + G < 64 * 32) ? it + G : -1, R, CW, tid, lane, wave); }
    }
    SEAM(3); STAMP(4);
    if (IN(4)) { LOADP(); IDS();
        const int x = bid & 7, ci = bid >> 3, grp = ci >> 3, bhA = 8 * x + 7 - (ci & 7);
        REP(41) { if (grp == 0) dn::recur(p, lds, 8 * x + ci, tid, lane, wave); }
        STAMP(13);
#ifndef NO_ATTN
        REP(40) {
            const int nblk = grp == 0 ? 1 : (grp == 1 ? 3 : 2);
#define QSEL(i) (grp == 0 ? 2 : grp == 1 ? ((i) == 0 ? 7 : (i) == 1 ? 1 : 0) : grp == 2 ? ((i) == 0 ? 6 : 3) : ((i) == 0 ? 5 : 4))
            moba::Seam S;
            moba::BlockRef cur = attn_ref(p, bhA, QSEL(0));
            moba::prime(cur, (char*)lds_raw, S);
            for (int i = 0; i < nblk; ++i) {
                const int in = (i + 1 < nblk) ? i + 1 : i;
                const moba::BlockRef nxt = attn_ref(p, bhA, QSEL(in));
                moba::block(cur, nxt, (char*)lds_raw, S);
                cur = nxt;
            }
#undef QSEL
        }
#endif
        STAMP(14);
    }
    SEAM(4); STAMP(5);
    if (IN(6)) { LOADP(); IDS();
        pg8::Gemm g{(const bf16_t*)(p.ws + WS_A), (const bf16_t*)(p.ws + WS_WMD), DM, nullptr};
        pg8::StaticOrder S; S.init(T, DM, G, bid);
        pg8::EpiMerged E{(const u32x4*)(p.ws + WS_GATEF), (bf16_t*)(p.ws + WS_MERGED)};
        pg8::gemm_phase<pg8::EpiMerged, pg8::StaticOrder, true, false>(lds, g, S, E);
#if DBL == 6
        pg8::gemm_phase<pg8::EpiMerged, pg8::StaticOrder, true, false>(lds, g, S, E);
#endif
    }
    SEAM(6); STAMP(7);
    if (IN(7)) { LOADP(); IDS();
        const int cp = (bid >> 3) % 3;
        LAS float* scr = (LAS float*)(lds + wave * 8448);
        pg8::Gemm g{(const bf16_t*)(p.ws + WS_MERGED), (const bf16_t*)(p.ws + WS_WOUT), DM, nullptr};
        pg8::EpiStore E{(bf16_t*)(p.ws + WS_OUTMIX), DM, 8};
        for (int seg = 0; seg < 2; ++seg) {
            const int lo = seg == 0 ? 0 : cp, hi = seg == 0 ? cp : 2;
            if (seg == 1) { REP(81) for (int it = gw; it < 32 * 1024; it += NGW) expert_copy_gu(p, it, scr, lane); __syncthreads(); }
            if (hi > lo) { pg8::StaticOrder S; S.init(T, DM, G, bid); S.i0 = lo; S.imax = hi - lo;
                pg8::gemm_phase<pg8::EpiStore, pg8::StaticOrder, true, false>(lds, g, S, E); }
        }
    }
    SEAM(7); STAMP(8);
    if (IN(8)) { LOADP(); IDS();
        for (int it = bid; it < T / 64; it += G) phase5_item(p, lds, it, tid, lane, wave);
    }
    SEAM(8); STAMP(9);
    LAS int* pref = (LAS int*)(lds + LDS_TAB); LAS int* cntl = pref + 64;
    if (IN(9)) { LOADP(); IDS();
        moe_tables(p, pref, cntl, tid);
        pg8::Gemm g{(const bf16_t*)(p.ws + WS_U2F), (const bf16_t*)(p.ws + WS_WGU), DM, (const int*)(p.ws + WS_RTOK)};
        MoeOrder S{pref, cntl, 4, G, bid};
        pg8::EpiGU8 E{p.ws + WS_H, 1.0f / (SU * SW), SH};
        pg8::gemm_phase<pg8::EpiGU8, MoeOrder, true, true, true>(lds, g, S, E);
        {   const int total = pref[32] * 4, rem = total % G, ncw = rem ? G - rem : G, cw = rem ? bid - rem : bid;
            if (cw >= 0) { LAS float* scr = (LAS float*)(lds + wave * 8448);
                for (int it = cw * NWAVES + wave; it < 32 * 512; it += ncw * NWAVES) expert_copy_dn(p, it, scr, lane); }
        }
    }
    SEAM(9); STAMP(10);
    if (IN(10)) { LOADP(); IDS();
        if (!IN(9)) moe_tables(p, pref, cntl, tid);
        pg8::Gemm g{(const bf16_t*)(p.ws + WS_H), (const bf16_t*)(p.ws + WS_WDN), FF, nullptr};
        MoeOrder S{pref, cntl, 8, G, bid};
        pg8::EpiStoreS E{(bf16_t*)(p.ws + WS_YBUF), DM, 8, 1.0f / (SH * SW)};
        pg8::gemm_phase<pg8::EpiStoreS, MoeOrder, true, false, true>(lds, g, S, E);
    }
    SEAM(10); STAMP(11);
    if (IN(11)) { LOADP(); IDS();
        if (!IN(10)) moe_tables(p, pref, cntl, tid);
        phase8(p, pref, lane, gw, NGW);
    }
#ifdef TSPROBE
    STAMP(12);
    __syncthreads();
    if (blockIdx.x == 0 && threadIdx.x == 0) { asm volatile("s_waitcnt vmcnt(0)" ::: "memory");
        const int a = (TSPROBE == 13) ? 4 : (TSPROBE == 14) ? 13 : (TSPROBE == 15) ? 14 : TSPROBE, b2 = (TSPROBE == 13) ? 13 : (TSPROBE == 14) ? 14 : (TSPROBE == 15) ? 5 : (TSPROBE == 5) ? 7 : TSPROBE + 1;
        const float dt = (float)(TS[b2] - TS[a]) * 0.01f;
        kp_->out[0] += TSQ * rintf(dt * (1.0f / TSQ)); }
#endif
#undef IN
#undef SEAM
}

extern "C" void kernel_launch(void* const* d_in, const int* in_sizes, int n_in, void* d_out, int out_size, void* d_ws, size_t ws_size, hipStream_t stream) {
    static int grid = 0;
    if (grid == 0) {
        if (n_in != 24 || in_sizes[0] != T * DM || out_size != T * DM || ws_size < WS_END) {
            fprintf(stderr, "kernel_launch: unexpected shapes (n_in %d, in0 %d, out %d, ws %zu); nothing launched\n", n_in, n_in > 0 ? in_sizes[0] : -1, out_size, ws_size); grid = -1; return; }
        int dev = 0, cus = 0, per_cu = 0;
        hipGetDevice(&dev); hipDeviceGetAttribute(&cus, hipDeviceAttributeMultiprocessorCount, dev);
        if (hipFuncSetAttribute((const void*)fwd_kernel, hipFuncAttributeMaxDynamicSharedMemorySize, LDS_BYTES) != hipSuccess) { fprintf(stderr, "kernel_launch: hipFuncSetAttribute failed\n"); grid = -1; return; }
        if (hipOccupancyMaxActiveBlocksPerMultiprocessor(&per_cu, (const void*)fwd_kernel, NTHREADS, LDS_BYTES) != hipSuccess || per_cu < 1) { fprintf(stderr, "kernel_launch: occupancy query says %d blocks per CU\n", per_cu); grid = -1; return; }
        (void)hipGetLastError();
        grid = cus;
        if (cus != 256) { fprintf(stderr, "kernel_launch: built for a 256-CU device (static phase schedules), found %d CUs; nothing launched\n", cus); grid = -1; return; }
    }
    if (grid < 0) return;
    Params p{};
    p.x = (const float*)d_in[0]; p.c = (const float*)d_in[1]; p.pos = (const int*)d_in[2]; p.w_ada = (const float*)d_in[3]; p.b_ada = (const float*)d_in[4];
    p.g_mix_pre = (const float*)d_in[5]; p.g_mix_post = (const float*)d_in[6]; p.g_ffn_pre = (const float*)d_in[7]; p.g_ffn_post = (const float*)d_in[8];
    p.w_in = (const float*)d_in[9]; p.conv_w = (const float*)d_in[10]; p.a_log = (const float*)d_in[11]; p.dt_bias = (const float*)d_in[12]; p.dn_gain = (const float*)d_in[13];
    p.w_bm = (const float*)d_in[14]; p.w_bd = (const float*)d_in[15]; p.w_out = (const float*)d_in[16];
    p.w_rg = (const float*)d_in[17]; p.b_rg = (const float*)d_in[18]; p.w_re = (const float*)d_in[19]; p.b_re = (const float*)d_in[20];
    p.w_gate = (const float*)d_in[21]; p.w_up = (const float*)d_in[22]; p.w_down = (const float*)d_in[23];
    p.out = (float*)d_out; p.ws = (unsigned char*)d_ws;
    for (int li = 0; li < MK_N_LAUNCHES; ++li) {
        p.ph_lo = (MK_N_LAUNCHES == 1) ? 0 : li; p.ph_hi = (MK_N_LAUNCHES == 1) ? N_PHASES : li + 1;
        void* args[] = {&p};
        hipError_t e = hipLaunchCooperativeKernel((const void*)fwd_kernel, dim3(grid), dim3(NTHREADS), args, LDS_BYTES, stream);
        if (e != hipSuccess) { fprintf(stderr, "kernel_launch: cooperative launch failed: %s (grid %d)\n", hipGetErrorString(e), grid); break; }
    }
}
```
